# Optimizing an MI355X kernel written in HIP

```python
import math
import jax, jax.numpy as jnp
from jax import lax
import numpy as np

D_MODEL = 1024
BATCH = 8
SEQ = 4096
DEPTH = 2

N_META = 16
D_FF = 2816
EPS = 1e-6
FOURIER_GROUPS = 8
FOURIER_GROUP_DIM = 64
D_FOURIER = FOURIER_GROUPS * FOURIER_GROUP_DIM
D_SCONV = 512
SCONV_WIDTH = 3
DN_HEADS = 4
DN_HEAD_DIM = 128
D_DN = DN_HEADS * DN_HEAD_DIM
DN_CONV_WIDTH = 3
CHUNK = 64
N_BRANCH = 3
PROJ_SIZES = (D_FOURIER, 3 * D_SCONV, 3 * D_DN, D_DN, 2 * DN_HEADS, 2 * DN_HEADS, N_BRANCH * D_MODEL)
D_IN_PROJ = D_FOURIER + 3 * D_SCONV + 3 * D_DN + D_DN + 4 * DN_HEADS + N_BRANCH * D_MODEL

kernel_name = "hybrid_fourier_shortconv_gdn_encoder"


def rmsnorm(x, g):
    xf = x.astype(jnp.float32)
    y = xf * lax.rsqrt(jnp.mean(xf * xf, axis=-1, keepdims=True) + EPS)
    return (y * g.astype(jnp.float32)).astype(x.dtype)


def swiglu(x, wi, wo):
    a, b = jnp.split(x @ wi, 2, axis=-1)
    return (jax.nn.silu(a) * b) @ wo


def conv3_centred(x, w):
    xp = jnp.pad(x, ((0, 0), (1, 1), (0, 0)))
    return w[0] * xp[:, :-2] + w[1] * xp[:, 1:-1] + w[2] * xp[:, 2:]


def fourier_mix(u):
    B, L, _ = u.shape
    ug = u.astype(jnp.float32).reshape(B, L, FOURIER_GROUPS, FOURIER_GROUP_DIM)
    y = jnp.fft.fft2(ug, axes=(1, 3), norm="ortho").real
    return y.reshape(B, L, D_FOURIER).astype(u.dtype)


def short_conv_mix(u, w):
    b, c, h = jnp.split(u, 3, axis=-1)
    return b * conv3_centred(c * h, w)


def l2norm(x):
    return x * lax.rsqrt(jnp.sum(x * x, axis=-1, keepdims=True) + EPS)


def chunk_gated_delta(q, k, v, beta, g):
    B, H, N, C, DK = q.shape
    DV = v.shape[-1]
    lower = jnp.tril(jnp.ones((C, C), bool))
    strict = jnp.tril(jnp.ones((C, C), bool), -1)
    gc = jnp.cumsum(g, axis=-1)
    diff = gc[..., :, None] - gc[..., None, :]
    decay_mask = jnp.exp(jnp.where(lower, diff, -jnp.inf))
    k_beta = k * beta[..., None]
    v_beta = v * beta[..., None]
    m = jnp.where(strict, jnp.einsum('bhnck,bhnsk->bhncs', k_beta, k) * decay_mask, 0.0)
    eye = jnp.eye(C, dtype=q.dtype)
    t = lax.linalg.triangular_solve(eye + m, jnp.broadcast_to(eye, m.shape), left_side=True,
                                    lower=True, unit_diagonal=True)
    u = t @ v_beta
    w = t @ (k_beta * jnp.exp(gc)[..., None])
    attn = jnp.einsum('bhnck,bhnsk->bhncs', q, k) * decay_mask
    q_dec = q * jnp.exp(gc)[..., None]
    k_dec = k * jnp.exp(gc[..., -1:] - gc)[..., None]
    g_last = jnp.exp(gc[..., -1])

    def step(S, xs):
        attn_n, u_n, w_n, qd_n, kd_n, gl_n = xs
        v_new = u_n - w_n @ S
        o = qd_n @ S + attn_n @ v_new
        S = S * gl_n[..., None, None] + jnp.swapaxes(kd_n, -1, -2) @ v_new
        return S, o

    xs = tuple(jnp.moveaxis(a, 2, 0) for a in (attn, u, w, q_dec, k_dec, g_last))
    S0 = jnp.zeros((B, H, DK, DV), q.dtype)
    _, o = lax.scan(step, S0, xs)
    return jnp.moveaxis(o, 0, 2)


def deltanet_branch(qkv, z, beta_logit, alpha_logit, conv_w, A_log, dt_bias, norm_w):
    B, L, _ = qkv.shape
    f32 = jnp.float32
    qkv = jax.nn.silu(conv3_centred(qkv, conv_w)).astype(f32)
    q, k, v = jnp.split(qkv, 3, axis=-1)
    q = l2norm(q.reshape(B, L, DN_HEADS, DN_HEAD_DIM)) * (DN_HEAD_DIM ** -0.5)
    k = l2norm(k.reshape(B, L, DN_HEADS, DN_HEAD_DIM))
    v = v.reshape(B, L, DN_HEADS, DN_HEAD_DIM)
    beta = jax.nn.sigmoid(beta_logit.astype(f32)).reshape(B, L, 2, DN_HEADS)
    g = -jnp.exp(A_log.astype(f32)) * jax.nn.softplus(
        alpha_logit.astype(f32).reshape(B, L, 2, DN_HEADS) + dt_bias.astype(f32))
    pad = CHUNK - N_META
    padt = lambda a: jnp.pad(a, ((0, 0), (pad, 0)) + ((0, 0),) * (a.ndim - 2))
    q, k, v, beta, g = padt(q), padt(k), padt(v), padt(beta), padt(g)
    Lp = L + pad
    N = Lp // CHUNK

    def chunks4(a):
        return a.reshape(B, N, CHUNK, DN_HEADS, -1).transpose(0, 3, 1, 2, 4)

    def chunks3(a):
        return a.reshape(B, N, CHUNK, DN_HEADS).transpose(0, 3, 1, 2)

    def unchunk(o):
        return o.transpose(0, 2, 3, 1, 4).reshape(B, Lp, DN_HEADS, DN_HEAD_DIM)

    o_fwd = unchunk(chunk_gated_delta(chunks4(q), chunks4(k), chunks4(v),
                                      chunks3(beta[:, :, 0]), chunks3(g[:, :, 0])))
    fl = lambda a: jnp.flip(a, axis=1)
    o_bwd = fl(unchunk(chunk_gated_delta(chunks4(fl(q)), chunks4(fl(k)), chunks4(fl(v)),
                                         chunks3(fl(beta[:, :, 1])), chunks3(fl(g[:, :, 1])))))
    o = (o_fwd + o_bwd)[:, pad:]
    o = o * lax.rsqrt(jnp.mean(o * o, axis=-1, keepdims=True) + EPS) * norm_w.astype(f32)
    o = o * jax.nn.silu(z.astype(f32).reshape(B, L, DN_HEADS, DN_HEAD_DIM))
    return o.reshape(B, L, D_DN).astype(z.dtype)


def hybrid_mixer(h, w_in, sconv_w, dn_conv_w, dn_A_log, dn_dt_bias, dn_norm,
                 w_fourier, w_sconv_out, w_dn_out, w_out):
    B, L, D = h.shape
    proj = h @ w_in
    idx = [int(s) for s in np.cumsum(PROJ_SIZES)[:-1]]
    u_f, u_sc, u_qkv, z, b_logit, a_logit, gate_logit = jnp.split(proj, idx, axis=-1)
    y_f = fourier_mix(u_f) @ w_fourier
    y_sc = short_conv_mix(u_sc, sconv_w) @ w_sconv_out
    y_dn = deltanet_branch(u_qkv, z, b_logit, a_logit, dn_conv_w, dn_A_log, dn_dt_bias,
                           dn_norm) @ w_dn_out
    gates = jax.nn.sigmoid(gate_logit).reshape(B, L, N_BRANCH, D)
    merged = gates[:, :, 0] * y_f + gates[:, :, 1] * y_sc + gates[:, :, 2] * y_dn
    return merged @ w_out


def setup_inputs(seed: int = 0) -> dict:
    key = jax.random.key(seed)
    ks = jax.random.split(key, 20)
    f32 = jnp.float32

    def dense(k, shape, fan_in):
        return jax.random.normal(k, shape, f32) * fan_in ** -0.5

    x = jax.random.normal(ks[0], (BATCH, SEQ, D_MODEL), f32)
    meta_tokens = jax.random.normal(ks[1], (N_META, D_MODEL), f32)
    norm_gains = 1.0 + 0.05 * jax.random.normal(ks[2], (DEPTH, 6, D_MODEL), f32)
    ffn1_wi = dense(ks[3], (DEPTH, D_MODEL, 2 * D_FF), D_MODEL)
    ffn1_wo = dense(ks[4], (DEPTH, D_FF, D_MODEL), D_FF)
    ffn2_wi = dense(ks[5], (DEPTH, D_MODEL, 2 * D_FF), D_MODEL)
    ffn2_wo = dense(ks[6], (DEPTH, D_FF, D_MODEL), D_FF)
    w_in = dense(ks[7], (DEPTH, D_MODEL, D_IN_PROJ), D_MODEL)
    sconv_w = dense(ks[8], (DEPTH, SCONV_WIDTH, D_SCONV), SCONV_WIDTH)
    dn_conv_w = dense(ks[9], (DEPTH, DN_CONV_WIDTH, 3 * D_DN), DN_CONV_WIDTH)
    dn_A_log = jnp.log(jax.random.uniform(ks[10], (DEPTH, 2, DN_HEADS), f32, 1.0, 16.0))
    dt = jnp.exp(jax.random.uniform(ks[11], (DEPTH, 2, DN_HEADS), f32,
                                    math.log(1e-3), math.log(1e-1)))
    dn_dt_bias = dt + jnp.log(-jnp.expm1(-dt))
    dn_norm = 1.0 + 0.05 * jax.random.normal(ks[12], (DEPTH, DN_HEAD_DIM), f32)
    w_fourier = dense(ks[13], (DEPTH, D_FOURIER, D_MODEL), D_FOURIER)
    w_sconv_out = dense(ks[14], (DEPTH, D_SCONV, D_MODEL), D_SCONV)
    w_dn_out = dense(ks[15], (DEPTH, D_DN, D_MODEL), D_DN)
    w_out = dense(ks[16], (DEPTH, D_MODEL, D_MODEL), D_MODEL)
    return {"x": x, "meta_tokens": meta_tokens, "norm_gains": norm_gains,
            "ffn1_wi": ffn1_wi, "ffn1_wo": ffn1_wo, "ffn2_wi": ffn2_wi, "ffn2_wo": ffn2_wo,
            "w_in": w_in, "sconv_w": sconv_w, "dn_conv_w": dn_conv_w, "dn_A_log": dn_A_log,
            "dn_dt_bias": dn_dt_bias, "dn_norm": dn_norm, "w_fourier": w_fourier,
            "w_sconv_out": w_sconv_out, "w_dn_out": w_dn_out, "w_out": w_out}


def reference(x, meta_tokens, norm_gains, ffn1_wi, ffn1_wo, ffn2_wi, ffn2_wo, w_in, sconv_w,
              dn_conv_w, dn_A_log, dn_dt_bias, dn_norm, w_fourier, w_sconv_out, w_dn_out, w_out):
    B = x.shape[0]
    meta = jnp.broadcast_to(meta_tokens[None].astype(x.dtype), (B, N_META, D_MODEL))
    h = jnp.concatenate([meta, x], axis=1)
    for l in range(DEPTH):
        n = norm_gains[l]
        h = h + 0.5 * rmsnorm(swiglu(rmsnorm(h, n[0]), ffn1_wi[l], ffn1_wo[l]), n[1])
        h = h + rmsnorm(hybrid_mixer(rmsnorm(h, n[2]), w_in[l], sconv_w[l], dn_conv_w[l],
                                     dn_A_log[l], dn_dt_bias[l], dn_norm[l], w_fourier[l],
                                     w_sconv_out[l], w_dn_out[l], w_out[l]), n[3])
        h = h + 0.5 * rmsnorm(swiglu(rmsnorm(h, n[4]), ffn2_wi[l], ffn2_wo[l]), n[5])
    return h[:, N_META:]
```

```cpp
#include <hip/hip_runtime.h>
#include <hip/hip_cooperative_groups.h>
#include <cstdio>
namespace cg = cooperative_groups;

#define LAS __attribute__((address_space(3)))
typedef unsigned short bf16_t;
typedef short bf16x8 __attribute__((ext_vector_type(8)));
typedef float f32x4 __attribute__((ext_vector_type(4)));
typedef unsigned u32x4 __attribute__((ext_vector_type(4)));
typedef unsigned u32x2 __attribute__((ext_vector_type(2)));

constexpr int DM = 1024, NB = 8, SEQ = 4096, NMETA = 16, LL = 4112, TT = NB * LL  , TP = 33024  , DFF = 2816;
constexpr int NIN = 7184;
constexpr int NPROJ = 4864;
constexpr float EPS = 1e-6f;
constexpr int NSTEP = 65, SPL = 22, NSPLIT = 3;
constexpr int KF = 640;

constexpr size_t UU = (size_t)TP * 1024;
constexpr size_t W_WI1 = 0, W_WO1 = W_WI1 + (size_t)5632 * 1024 * 2, W_WI2 = W_WO1 + (size_t)1024 * 2816 * 2, W_WO2 = W_WI2 + (size_t)5632 * 1024 * 2,
                 W_WIN = W_WO2 + (size_t)1024 * 2816 * 2, W_WG = W_WIN + (size_t)NPROJ * 1024 * 2, W_WBR = W_WG + (size_t)3072 * 1024 * 2,
                 W_WOUT = W_WBR + (size_t)3072 * 512 * 2, W_END = W_WOUT + (size_t)1024 * 1024 * 2;
constexpr size_t S_C257 = W_END, S_TWL = S_C257 + (size_t)512 * KF * 2, S_HM = S_TWL + 33024, S_LOGIT = S_HM + (size_t)128 * 1024 * 4,
                 S_GL = S_LOGIT + (size_t)TP * 16 * 4, S_SSAVE = S_GL + 16896, S_END = S_SSAVE + (size_t)512 * 8 * 64 * 16;
constexpr size_t A0 = (S_END + 255) / 256 * 256;
constexpr size_t O_XN = A0, O_Y = A0 + 2 * UU, O_ACT = A0 + 4 * UU;
constexpr size_t O_BR = A0, O_QKV = A0 + 4 * UU, O_Z = A0 + 7 * UU, O_SC = A0 + 8 * UU, O_PQ = A0 + 11 * UU, O_AP = A0 + 8 * UU;
constexpr size_t DNI_SLOTS = (size_t)SPL * 64;
constexpr size_t O_WP = A0 + 8 * UU, O_QP = O_WP + DNI_SLOTS * 16384, O_KD = O_QP + DNI_SLOTS * 16384, O_UF = O_KD + DNI_SLOTS * 16384,
                 O_AT = O_UF + DNI_SLOTS * 16384, O_DNI_END = O_AT + DNI_SLOTS * 8192;
constexpr size_t O_O = (O_DNI_END + 255) / 256 * 256;
constexpr size_t O_XN2 = A0 + 3 * UU, O_GATE = A0 + 5 * UU, O_MG = A0 + 11 * UU;
constexpr size_t WS_NEED = O_O + 2 * UU;
static_assert(WS_NEED <= (size_t)536870912, "workspace");
static_assert(O_AP + (size_t)65536 * KF * 2 <= O_PQ, "A' overlaps PQ");
static_assert(O_O >= O_PQ || true, "");
static_assert(O_MG + 2 * UU <= WS_NEED + 2 * UU, "");

constexpr int LDS_BYTES = 132 * 1024;

#define DBG_CNT ((size_t)33554432)


struct Params { const float* in[17]; float* out; unsigned char* ws; int ph_lo, ph_hi; };

__device__ __forceinline__ float bf2f(unsigned v) { return __uint_as_float(v << 16); }
typedef __bf16 bf16x2_t __attribute__((ext_vector_type(2)));
typedef float f32x2_t __attribute__((ext_vector_type(2)));
__device__ __forceinline__ unsigned cvt_pk_bf16(float lo, float hi) { f32x2_t v = {lo, hi}; bf16x2_t b = __builtin_convertvector(v, bf16x2_t); return __builtin_bit_cast(unsigned, b); }
__device__ __forceinline__ bf16_t f2bf(float f) { return (bf16_t)(cvt_pk_bf16(f, 0.f) & 0xffffu); }
__device__ __forceinline__ void unpack8(const u32x4 v, float* f) {
    f[0] = __uint_as_float(v.x << 16); f[1] = __uint_as_float(v.x & 0xffff0000u); f[2] = __uint_as_float(v.y << 16); f[3] = __uint_as_float(v.y & 0xffff0000u);
    f[4] = __uint_as_float(v.z << 16); f[5] = __uint_as_float(v.z & 0xffff0000u); f[6] = __uint_as_float(v.w << 16); f[7] = __uint_as_float(v.w & 0xffff0000u); }
__device__ __forceinline__ u32x4 pack8(const float* f) { u32x4 w; w.x = cvt_pk_bf16(f[0], f[1]); w.y = cvt_pk_bf16(f[2], f[3]); w.z = cvt_pk_bf16(f[4], f[5]); w.w = cvt_pk_bf16(f[6], f[7]); return w; }
__device__ __forceinline__ int ltid() { int t = threadIdx.x; asm volatile("" : "+v"(t)); return t; }
__device__ __forceinline__ int lbid() { int t = blockIdx.x; asm volatile("" : "+s"(t)); return t; }
__device__ __forceinline__ int lgrid() { int t = gridDim.x; asm volatile("" : "+s"(t)); return t; }
__device__ __forceinline__ float wave_sum(float v) { for (int o = 32; o >= 1; o >>= 1) v += __shfl_xor(v, o); return v; }
__device__ __forceinline__ float sigmoidf_(float x) { return __builtin_amdgcn_rcpf(1.0f + __expf(-x)); }
__device__ __forceinline__ float siluf_(float x) { return x * __builtin_amdgcn_rcpf(1.0f + __expf(-x)); }

namespace pg8 {
constexpr int BM = 256, BK = 64, HALF = 128, HTB = HALF * BK * 2, STAGE_BYTES = 8 * HTB, NXCD = 8, WGM = 8;
__device__ __forceinline__ int lds_byte(int r, int c) { const int st = (r >> 4) * 2 + (c >> 5), rr = r & 15, cc = c & 31, ob = rr * 64 + cc * 2; return st * 1024 + (ob ^ (((ob >> 9) & 1) << 5)); }
__device__ __forceinline__ void stage_rc(int b, int& R, int& C) { const int st = b / 1024, sb = b % 1024, swz = sb ^ (((sb >> 9) & 1) << 5); R = (st >> 1) * 16 + swz / 64; C = (st & 1) * 32 + (swz % 64) / 2; }
__device__ __forceinline__ int perm32(int rho) { const int n = rho >> 4, i = rho & 15; return 8 * (i >> 2) + 4 * n + (i & 3); }
struct Unit { int pm, pn; };
struct Gemm { const bf16_t* A; const bf16_t* Bt; int M, N, K; };
struct StaticOrder {
    int nM, nN, nwg, G, c;
    __device__ void init(int M, int N, int G_, int c_) { nM = M / BM; nN = N / BM; nwg = nM * nN; G = G_; c = c_; }
    __device__ bool next(int i, Unit& u) const {
        const long L = (long)i * G + c; if (L >= nwg) return false;
        int wgid = (int)L; { const int q = nwg / NXCD, r = nwg % NXCD, xcd = wgid % NXCD, off = wgid / NXCD; wgid = (xcd < r ? xcd * (q + 1) : r * (q + 1) + (xcd - r) * q) + off; }
        const int nig = WGM * nN, gid = wgid / nig, fm = gid * WGM, gsz = (nM - fm) < WGM ? (nM - fm) : WGM;
        u.pm = fm + ((wgid % nig) % gsz); u.pn = (wgid % nig) / gsz; return true;
    }
};
struct MergeOrder {
    int G, c;
    __device__ bool next(int i, Unit& u) const { const int L = (i / 3) * G + c; if (L >= 129 * 4) return false; const int j = i % 3; u.pm = j * 129 + (L >> 2); u.pn = j * 4 + (L & 3); return true; }
};

template <class Epi, class Sched>
__device__ __forceinline__ void gemm_phase(LAS unsigned char* lds, const Gemm g, const Sched& S, const Epi& E) {
    const int tid = ltid(), wid = __builtin_amdgcn_readfirstlane(tid >> 6), lane = tid & 63, wr = wid >> 2, wc = wid & 3, fr = lane & 15, fq = lane >> 4;
    const int K = g.K, nt = K / BK;
    unsigned voffA[2], voffB[2];
#pragma unroll
    for (int i = 0; i < 2; ++i) { int R, C; stage_rc(tid * 16 + i * 8192, R, C); const int Rb = Epi::PERM ? ((R & ~31) + perm32(R & 31)) : R;
        voffA[i] = (unsigned)(R * K + C) * 2u; voffB[i] = (unsigned)(Rb * K + C) * 2u; }
    const size_t kstep = (size_t)(BK * 2);
    const size_t hstep = (size_t)HALF * K * 2;
    const size_t tstep = 2 * hstep;
    const unsigned ldsw = (unsigned)wid * 1024u;
    const int aoff = lds_byte(wr * 64 + fr, fq * 8), boff = lds_byte(wc * 32 + fr, fq * 8);
#define PG8_SA(b, h) (((b) * 2 + (h)) * HTB)
#define PG8_SB(b, h) ((4 + (b) * 2 + (h)) * HTB)
#define PG8_STAGE(bufoff, gbase, voff) do { _Pragma("unroll") for (int _i = 0; _i < 2; ++_i) \
        __builtin_amdgcn_global_load_lds((const unsigned*)((const char*)(gbase) + (voff)[_i]), (LAS unsigned*)(lds + (bufoff) + ldsw + _i * 8192), 16, 0, 0); } while (0)
#define PG8_LDA(dst, b, h) do { _Pragma("unroll") for (int m = 0; m < 4; ++m) _Pragma("unroll") for (int k = 0; k < 2; ++k) dst[m][k] = *(const LAS bf16x8*)(lds + PG8_SA(b, h) + aoff + m * 2048 + k * 1024); } while (0)
#define PG8_LDB(dst, b, h) do { _Pragma("unroll") for (int n = 0; n < 2; ++n) _Pragma("unroll") for (int k = 0; k < 2; ++k) dst[n][k] = *(const LAS bf16x8*)(lds + PG8_SB(b, h) + boff + n * 2048 + k * 1024); } while (0)
#define PG8_MMA(ai, bj, At, Bt) do { __builtin_amdgcn_s_setprio(1); _Pragma("unroll") for (int m = 0; m < 4; ++m) _Pragma("unroll") for (int n = 0; n < 2; ++n) _Pragma("unroll") for (int k = 0; k < 2; ++k) \
        acc[ai][bj][m][n] = __builtin_amdgcn_mfma_f32_16x16x32_bf16(Bt[n][k], At[m][k], acc[ai][bj][m][n], 0, 0, 0); __builtin_amdgcn_s_setprio(0); } while (0)
#define PG8_WAIT_V(n) asm volatile("s_waitcnt vmcnt(" #n ")" ::: "memory")
#define PG8_WAIT_L(n) asm volatile("s_waitcnt lgkmcnt(" #n ")" ::: "memory")
#define PG8_BAR __builtin_amdgcn_s_barrier()
#define PG8_SCHED __builtin_amdgcn_sched_barrier(0)
    Unit cur, nxt; int ui = 0;
    if (!S.next(0, cur)) return;
    f32x4 acc[2][2][4][2];
#pragma unroll
    for (int a = 0; a < 2; ++a)
#pragma unroll
        for (int b = 0; b < 2; ++b)
#pragma unroll
            for (int m = 0; m < 4; ++m)
#pragma unroll
                for (int n = 0; n < 2; ++n) acc[a][b][m][n] = (f32x4){0.f, 0.f, 0.f, 0.f};
    bf16x8 At[4][2], B0[2][2], B1[2][2];
    const char* cA = (const char*)g.A + (size_t)cur.pm * tstep; const char* cB = (const char*)g.Bt + (size_t)cur.pn * tstep;
    PG8_STAGE(PG8_SB(0, 0), cB, voffB); PG8_STAGE(PG8_SA(0, 0), cA, voffA); PG8_STAGE(PG8_SB(0, 1), cB + hstep, voffB); PG8_STAGE(PG8_SA(0, 1), cA + hstep, voffA);
    if (wr == 1) PG8_BAR;
    PG8_WAIT_V(4); PG8_BAR;
    PG8_STAGE(PG8_SB(1, 0), cB + kstep, voffB); PG8_STAGE(PG8_SA(1, 0), cA + kstep, voffA); PG8_STAGE(PG8_SB(1, 1), cB + hstep + kstep, voffB);
    PG8_WAIT_V(6); PG8_BAR;
    for (;;) {
        const bool has_next = S.next(ui + 1, nxt);
        const char* nA = has_next ? (const char*)g.A + (size_t)nxt.pm * tstep : cA; const char* nB = has_next ? (const char*)g.Bt + (size_t)nxt.pn * tstep : cB;
        for (int t = 0; t < nt; t += 2) {
            const bool last = (t == nt - 2);
            const char* a1 = cA + (size_t)(t + 1) * kstep;
            const char* a2 = last ? nA : cA + (size_t)(t + 2) * kstep; const char* b2 = last ? nB : cB + (size_t)(t + 2) * kstep;
            const char* a3 = a2 + kstep; const char* b3 = b2 + kstep;
            PG8_LDB(B0, 0, 0); PG8_SCHED; PG8_LDA(At, 0, 0); PG8_STAGE(PG8_SA(1, 1), a1 + hstep, voffA);
            PG8_WAIT_L(8); PG8_BAR; PG8_WAIT_L(0); PG8_MMA(0, 0, At, B0); PG8_BAR; PG8_SCHED;
            PG8_LDB(B1, 0, 1); PG8_STAGE(PG8_SB(0, 0), b2, voffB);
            PG8_BAR; PG8_WAIT_L(0); PG8_MMA(0, 1, At, B1); PG8_BAR;
            PG8_LDA(At, 0, 1); PG8_STAGE(PG8_SA(0, 0), a2, voffA);
            PG8_BAR; PG8_WAIT_L(0); PG8_MMA(1, 0, At, B0); PG8_BAR; PG8_SCHED;
            PG8_STAGE(PG8_SB(0, 1), b2 + hstep, voffB);
            PG8_WAIT_V(6); PG8_BAR; PG8_MMA(1, 1, At, B1); PG8_BAR;
            PG8_LDB(B0, 1, 0); PG8_SCHED; PG8_LDA(At, 1, 0); PG8_STAGE(PG8_SA(0, 1), a2 + hstep, voffA);
            PG8_WAIT_L(8); PG8_BAR; PG8_WAIT_L(0); PG8_MMA(0, 0, At, B0); PG8_BAR; PG8_SCHED;
            PG8_LDB(B1, 1, 1); PG8_STAGE(PG8_SB(1, 0), b3, voffB);
            PG8_BAR; PG8_WAIT_L(0); PG8_MMA(0, 1, At, B1); PG8_BAR;
            PG8_LDA(At, 1, 1); PG8_STAGE(PG8_SA(1, 0), a3, voffA);
            PG8_BAR; PG8_WAIT_L(0); PG8_MMA(1, 0, At, B0); PG8_BAR; PG8_SCHED;
            PG8_STAGE(PG8_SB(1, 1), b3 + hstep, voffB);
            PG8_WAIT_V(6); PG8_BAR; PG8_MMA(1, 1, At, B1); PG8_BAR;
        }
        E(acc, cur, wr, wc, fr, fq);
        if (!has_next) break;
#pragma unroll
        for (int a = 0; a < 2; ++a)
#pragma unroll
            for (int b = 0; b < 2; ++b)
#pragma unroll
                for (int m = 0; m < 4; ++m)
#pragma unroll
                    for (int n = 0; n < 2; ++n) acc[a][b][m][n] = (f32x4){0.f, 0.f, 0.f, 0.f};
        cur = nxt; cA = nA; cB = nB; ++ui;
    }
    PG8_WAIT_V(0);
    if (wr == 0) PG8_BAR;
    PG8_BAR;
#undef PG8_SA
#undef PG8_SB
#undef PG8_STAGE
#undef PG8_LDA
#undef PG8_LDB
#undef PG8_MMA
#undef PG8_WAIT_V
#undef PG8_WAIT_L
#undef PG8_BAR
#undef PG8_SCHED
}

template <int ACT> struct EpiBf16 {
    static constexpr bool PERM = true;
    bf16_t* O; int ldc;
    __device__ __forceinline__ void operator()(const f32x4 (&acc)[2][2][4][2], const Unit& u, int wr, int wc, int fr, int fq) const {
        const int row0 = u.pm * BM + wr * 64 + fr, col0 = u.pn * BM + wc * 32 + 8 * fq;
#pragma unroll
        for (int ai = 0; ai < 2; ++ai)
#pragma unroll
            for (int m = 0; m < 4; ++m) { bf16_t* rowp = O + (size_t)(row0 + ai * HALF + m * 16) * ldc + col0;
#pragma unroll
                for (int bj = 0; bj < 2; ++bj) { f32x4 v0 = acc[ai][bj][m][0], v1 = acc[ai][bj][m][1];
                    if (ACT == 1) {
#pragma unroll
                        for (int j = 0; j < 4; ++j) { v0[j] = sigmoidf_(v0[j]); v1[j] = sigmoidf_(v1[j]); } }
                    u32x4 w; w.x = cvt_pk_bf16(v0[0], v0[1]); w.y = cvt_pk_bf16(v0[2], v0[3]); w.z = cvt_pk_bf16(v1[0], v1[1]); w.w = cvt_pk_bf16(v1[2], v1[3]);
                    *(u32x4*)(rowp + bj * HALF) = w; } }
    }
};
struct EpiSwiglu {
    static constexpr bool PERM = true;
    bf16_t* O;
    __device__ __forceinline__ void operator()(const f32x4 (&acc)[2][2][4][2], const Unit& u, int wr, int wc, int fr, int fq) const {
        const int row0 = u.pm * BM + wr * 64 + fr, col0 = u.pn * 128 + wc * 32 + 8 * fq;
#pragma unroll
        for (int ai = 0; ai < 2; ++ai)
#pragma unroll
            for (int m = 0; m < 4; ++m) { bf16_t* rowp = O + (size_t)(row0 + ai * HALF + m * 16) * DFF + col0;
                const f32x4 a0 = acc[ai][0][m][0], a1 = acc[ai][0][m][1], b0 = acc[ai][1][m][0], b1 = acc[ai][1][m][1];
                float v[8];
#pragma unroll
                for (int j = 0; j < 4; ++j) { v[j] = siluf_(a0[j]) * b0[j]; v[4 + j] = siluf_(a1[j]) * b1[j]; }
                *(u32x4*)rowp = pack8(v); }
    }
};
struct EpiInProj {
    static constexpr bool PERM = true;
    unsigned char* ws;
    __device__ __forceinline__ void operator()(const f32x4 (&acc)[2][2][4][2], const Unit& u, int wr, int wc, int fr, int fq) const {
        const int row0 = u.pm * BM + wr * 64 + fr, pn = u.pn;
        if (pn == 18) {
            if (wc == 0 && fq < 2) { float* Lg = (float*)(ws + S_LOGIT);
#pragma unroll
                for (int ai = 0; ai < 2; ++ai)
#pragma unroll
                    for (int m = 0; m < 4; ++m) { float* rp = Lg + (size_t)(row0 + ai * HALF + m * 16) * 16 + 8 * fq; *(f32x4*)rp = acc[ai][0][m][0]; *(f32x4*)(rp + 4) = acc[ai][0][m][1]; } }
            return; }
        bf16_t* base; int ld, cb;
        if (pn < 4) { base = (bf16_t*)(ws + O_PQ); ld = 1024; cb = pn * 256; }
        else if (pn < 10) { base = (bf16_t*)(ws + O_SC); ld = 1536; cb = (pn - 4) * 256; }
        else if (pn < 16) { base = (bf16_t*)(ws + O_QKV); ld = 1536; cb = (pn - 10) * 256; }
        else { base = (bf16_t*)(ws + O_Z); ld = 512; cb = (pn - 16) * 256; }
        const int col0 = cb + wc * 32 + 8 * fq;
#pragma unroll
        for (int ai = 0; ai < 2; ++ai)
#pragma unroll
            for (int m = 0; m < 4; ++m) { bf16_t* rowp = base + (size_t)(row0 + ai * HALF + m * 16) * ld + col0;
#pragma unroll
                for (int bj = 0; bj < 2; ++bj) { const f32x4 v0 = acc[ai][bj][m][0], v1 = acc[ai][bj][m][1];
                    u32x4 w; w.x = cvt_pk_bf16(v0[0], v0[1]); w.y = cvt_pk_bf16(v0[2], v0[3]); w.z = cvt_pk_bf16(v1[0], v1[1]); w.w = cvt_pk_bf16(v1[2], v1[3]);
                    *(u32x4*)(rowp + bj * HALF) = w; } }
    }
};
struct EpiFourier {
    static constexpr bool PERM = true;
    bf16_t* FM; float sc;
    __device__ __forceinline__ void operator()(const f32x4 (&acc)[2][2][4][2], const Unit& u, int wr, int wc, int fr, int fq) const {
        const int row0 = u.pm * BM + wr * 64 + fr;
        const int colt = u.pn * BM;
        const int b = colt >> 13, k1 = (colt >> 9) & 15, ch0 = (colt & 511) + wc * 32 + 8 * fq;
#pragma unroll
        for (int ai = 0; ai < 2; ++ai)
#pragma unroll
            for (int m = 0; m < 4; ++m) { const int k2 = row0 + ai * HALF + m * 16;
                if (k2 < 257) { bf16_t* rowp = FM + (size_t)(b * LL + k1 + 16 * k2) * 512 + ch0;
#pragma unroll
                    for (int bj = 0; bj < 2; ++bj) { const f32x4 v0 = acc[ai][bj][m][0] * sc, v1 = acc[ai][bj][m][1] * sc;
                        u32x4 w; w.x = cvt_pk_bf16(v0[0], v0[1]); w.y = cvt_pk_bf16(v0[2], v0[3]); w.z = cvt_pk_bf16(v1[0], v1[1]); w.w = cvt_pk_bf16(v1[2], v1[3]);
                        *(u32x4*)(rowp + bj * HALF) = w; } } }
    }
};
struct EpiMerge {
    static constexpr bool PERM = true;
    const bf16_t* GATE; bf16_t* MG; bf16_t* MGB;
    __device__ __forceinline__ void operator()(const f32x4 (&acc)[2][2][4][2], const Unit& u, int wr, int wc, int fr, int fq) const {
        const int j = u.pm / 129, pm = u.pm - j * 129, pn = u.pn & 3;
        const int row0 = pm * BM + wr * 64 + fr, col0 = pn * BM + wc * 32 + 8 * fq;
#pragma unroll
        for (int ai = 0; ai < 2; ++ai)
#pragma unroll
            for (int m = 0; m < 4; ++m) { const size_t r = (size_t)(row0 + ai * HALF + m * 16);
#pragma unroll
                for (int bj = 0; bj < 2; ++bj) {
                    const u32x4 gv = *(const u32x4*)(GATE + r * 3072 + j * 1024 + col0 + bj * HALF);
                    float g[8], v[8]; unpack8(gv, g);
                    const f32x4 v0 = acc[ai][bj][m][0], v1 = acc[ai][bj][m][1];
#pragma unroll
                    for (int e = 0; e < 4; ++e) { v[e] = v0[e] * g[e]; v[4 + e] = v1[e] * g[4 + e]; }
                    const size_t mo = r * 1024 + col0 + bj * HALF;
                    bf16_t* mp = (j == 1 ? MGB : MG) + mo;
                    if (j > 0) { float o[8]; unpack8(*(const u32x4*)((j == 1 ? MG : MGB) + mo), o);
#pragma unroll
                        for (int e = 0; e < 8; ++e) v[e] += o[e]; }
                    *(u32x4*)mp = pack8(v); }
                asm volatile("" ::: "memory"); }
    }
};
}

__device__ void rpass(const Params& P, const bf16_t* Y, bool first_h, const float* gpost, float scale, const float* gpre, bf16_t* XN) {
    const int tid_ = ltid(); const int wave = __builtin_amdgcn_readfirstlane(tid_ >> 6), lane = tid_ & 63;
    float* hm = (float*)(P.ws + S_HM);
    for (int r = lbid() * 8 + wave; r < TT; r += lgrid() * 8) {
        const int b = r / LL, n = r - b * LL;
        const float* hin; float* hout;
        if (n < NMETA) { hout = hm + (size_t)(b * 16 + n) * 1024; hin = first_h ? P.in[1] + (size_t)n * 1024 : hout; }
        else { const size_t o = ((size_t)b * SEQ + (n - NMETA)) * 1024; hout = P.out + o; hin = first_h ? P.in[0] + o : hout; }
        float h[16];
        { const f32x4 a = *(const f32x4*)(hin + lane * 8), b4 = *(const f32x4*)(hin + lane * 8 + 4), c = *(const f32x4*)(hin + 512 + lane * 8), d = *(const f32x4*)(hin + 512 + lane * 8 + 4);
#pragma unroll
          for (int e = 0; e < 4; ++e) { h[e] = a[e]; h[4 + e] = b4[e]; h[8 + e] = c[e]; h[12 + e] = d[e]; } }
        if (Y) {
            float y[16]; unpack8(*(const u32x4*)(Y + (size_t)r * 1024 + lane * 8), y); unpack8(*(const u32x4*)(Y + (size_t)r * 1024 + 512 + lane * 8), y + 8);
            float ss = 0.f;
#pragma unroll
            for (int e = 0; e < 16; ++e) ss += y[e] * y[e];
            ss = wave_sum(ss); const float r1 = rsqrtf(ss * (1.0f / 1024.0f) + EPS) * scale;
#pragma unroll
            for (int e = 0; e < 8; ++e) { h[e] += y[e] * r1 * gpost[lane * 8 + e]; h[8 + e] += y[8 + e] * r1 * gpost[512 + lane * 8 + e]; }
            *(f32x4*)(hout + lane * 8) = (f32x4){h[0], h[1], h[2], h[3]}; *(f32x4*)(hout + lane * 8 + 4) = (f32x4){h[4], h[5], h[6], h[7]};
            *(f32x4*)(hout + 512 + lane * 8) = (f32x4){h[8], h[9], h[10], h[11]}; *(f32x4*)(hout + 512 + lane * 8 + 4) = (f32x4){h[12], h[13], h[14], h[15]};
        }
        if (gpre) {
            float ss = 0.f;
#pragma unroll
            for (int e = 0; e < 16; ++e) ss += h[e] * h[e];
            ss = wave_sum(ss); const float r2 = rsqrtf(ss * (1.0f / 1024.0f) + EPS);
            float o[16];
#pragma unroll
            for (int e = 0; e < 8; ++e) { o[e] = h[e] * r2 * gpre[lane * 8 + e]; o[8 + e] = h[8 + e] * r2 * gpre[512 + lane * 8 + e]; }
            *(u32x4*)(XN + (size_t)r * 1024 + lane * 8) = pack8(o); *(u32x4*)(XN + (size_t)r * 1024 + 512 + lane * 8) = pack8(o + 8);
        }
    }
}

template <class F>
__device__ void cvt_tiles(const float* src, int ld_src, int K, bf16_t* dst, int nrows, F srccol, unsigned char* smem) {
    float* lds = (float*)smem; const int tid = ltid();
    const int ntr = nrows / 64, ntk = K / 64;
    for (int t = lbid(); t < ntr * ntk; t += lgrid()) {
        const int tr = t % ntr, tk = t / ntr; const int c0 = srccol(tr * 64);
        __syncthreads();
#pragma unroll
        for (int i = 0; i < 8; ++i) { const int kk = (tid >> 6) + 8 * i, cc = tid & 63; lds[kk * 65 + cc] = src[(size_t)(tk * 64 + kk) * ld_src + c0 + cc]; }
        __syncthreads();
        const int cc2 = tid >> 3, k8 = (tid & 7) * 8; float v[8];
#pragma unroll
        for (int e = 0; e < 8; ++e) v[e] = lds[(k8 + e) * 65 + cc2];
        *(u32x4*)(dst + (size_t)(tr * 64 + cc2) * K + tk * 64 + k8) = pack8(v);
    }
}
struct ColIdent { int off; __device__ int operator()(int r) const { return r + off; } };
struct ColSwiglu { __device__ int operator()(int r) const { const int pn = r >> 8, rem = r & 255; return (rem >> 7) * DFF + 128 * pn + (rem & 127); } };

__device__ void convert_weights(const Params& P, int l, unsigned char* smem) {
    unsigned char* ws = P.ws; const int tid = ltid();
    cvt_tiles(P.in[3] + (size_t)l * 1024 * 5632, 5632, 1024, (bf16_t*)(ws + W_WI1), 5632, ColSwiglu{}, smem);
    cvt_tiles(P.in[4] + (size_t)l * 2816 * 1024, 1024, 2816, (bf16_t*)(ws + W_WO1), 1024, ColIdent{0}, smem);
    cvt_tiles(P.in[5] + (size_t)l * 1024 * 5632, 5632, 1024, (bf16_t*)(ws + W_WI2), 5632, ColSwiglu{}, smem);
    cvt_tiles(P.in[6] + (size_t)l * 2816 * 1024, 1024, 2816, (bf16_t*)(ws + W_WO2), 1024, ColIdent{0}, smem);
    const float* win = P.in[7] + (size_t)l * 1024 * NIN;
    cvt_tiles(win, NIN, 1024, (bf16_t*)(ws + W_WIN) + (size_t)1024 * 1024, 3584, ColIdent{512}, smem);
    cvt_tiles(win, NIN, 1024, (bf16_t*)(ws + W_WG), 3072, ColIdent{4112}, smem);
    cvt_tiles(P.in[13] + (size_t)l * 512 * 1024, 1024, 512, (bf16_t*)(ws + W_WBR), 1024, ColIdent{0}, smem);
    cvt_tiles(P.in[14] + (size_t)l * 512 * 1024, 1024, 512, (bf16_t*)(ws + W_WBR) + (size_t)1024 * 512, 1024, ColIdent{0}, smem);
    cvt_tiles(P.in[15] + (size_t)l * 512 * 1024, 1024, 512, (bf16_t*)(ws + W_WBR) + (size_t)2048 * 512, 1024, ColIdent{0}, smem);
    cvt_tiles(P.in[16] + (size_t)l * 1024 * 1024, 1024, 1024, (bf16_t*)(ws + W_WOUT), 1024, ColIdent{0}, smem);
    { bf16_t* d = (bf16_t*)(ws + W_WIN) + (size_t)4608 * 1024;
      for (int i = lbid() * 512 + tid; i < 256 * 1024; i += lgrid() * 512) { const int rr = i >> 10, k = i & 1023; d[i] = rr < 16 ? f2bf(win[(size_t)k * NIN + 4096 + rr]) : (bf16_t)0; } }
    { float* Ws = (float*)smem; float* ct = Ws + 64 * 65; float* st = ct + 64;
      __syncthreads();
      if (tid < 64) { float s, c; sincospif((float)tid * (2.0f / 64.0f), &s, &c); ct[tid] = c; st[tid] = s; }
      bf16_t* dp = (bf16_t*)(ws + W_WIN); bf16_t* dq = dp + (size_t)512 * 1024;
      for (int it = lbid(); it < 8 * 16; it += lgrid()) { const int g = it >> 4, kt = it & 15;
          __syncthreads();
#pragma unroll
          for (int i = 0; i < 8; ++i) { const int kk = (tid >> 6) + 8 * i, cc = tid & 63; Ws[kk * 65 + cc] = win[(size_t)(kt * 64 + kk) * NIN + g * 64 + cc]; }
          __syncthreads();
          const int kk = tid & 63;
#pragma unroll 1
          for (int i = 0; i < 8; ++i) { const int cp = (tid >> 6) + 8 * i; float ap = 0.f, aq = 0.f;
#pragma unroll 4
              for (int c = 0; c < 64; ++c) { const float w = Ws[kk * 65 + c]; const int ph = (c * cp) & 63; ap += w * ct[ph]; aq += w * st[ph]; }
              dp[(size_t)(g * 64 + cp) * 1024 + kt * 64 + kk] = f2bf(ap); dq[(size_t)(g * 64 + cp) * 1024 + kt * 64 + kk] = f2bf(aq); }
      }
      __syncthreads(); }
}

__device__ void gen_tables(const Params& P) {
    unsigned char* ws = P.ws; const int gt = lbid() * 512 + ltid(), gs = lgrid() * 512;
    bf16_t* C = (bf16_t*)(ws + S_C257);
    for (int i = gt; i < 512 * KF; i += gs) { const int k2 = i / KF, kk = i - k2 * KF; const int ri = kk >= 320, n2 = kk - ri * 320; float v = 0.f;
        if (k2 < 257 && n2 < 257) { const int m = (k2 * n2) % 257; float s, c; sincospif((float)m * (2.0f / 257.0f), &s, &c); v = ri ? s : c; }
        C[i] = f2bf(v); }
    float* tw = (float*)(ws + S_TWL);
    for (int i = gt; i < LL; i += gs) { float s, c; sincospif((float)i * (2.0f / (float)LL), &s, &c); tw[2 * i] = c; tw[2 * i + 1] = -s; }
}

__device__ void sconv_pass(const Params& P, int l) {
    const int tid_ = ltid(); const int wave = __builtin_amdgcn_readfirstlane(tid_ >> 6), lane = tid_ & 63;
    const bf16_t* SC = (const bf16_t*)(P.ws + O_SC); bf16_t* SCO = (bf16_t*)(P.ws + O_BR) + (size_t)TP * 512;
    const float* w = P.in[8] + (size_t)l * 3 * 512;
    float w0[8], w1[8], w2[8];
#pragma unroll
    for (int e = 0; e < 8; ++e) { w0[e] = w[lane * 8 + e]; w1[e] = w[512 + lane * 8 + e]; w2[e] = w[1024 + lane * 8 + e]; }
    for (int r = lbid() * 8 + wave; r < TT; r += lgrid() * 8) {
        const int b = r / LL, n = r - b * LL; const bf16_t* rp = SC + (size_t)r * 1536 + lane * 8;
        float bb[8], c[8], h[8], acc[8]; unpack8(*(const u32x4*)rp, bb); unpack8(*(const u32x4*)(rp + 512), c); unpack8(*(const u32x4*)(rp + 1024), h);
#pragma unroll
        for (int e = 0; e < 8; ++e) acc[e] = w1[e] * c[e] * h[e];
        if (n > 0) { unpack8(*(const u32x4*)(rp - 1536 + 512), c); unpack8(*(const u32x4*)(rp - 1536 + 1024), h);
#pragma unroll
            for (int e = 0; e < 8; ++e) acc[e] += w0[e] * c[e] * h[e]; }
        if (n < LL - 1) { unpack8(*(const u32x4*)(rp + 1536 + 512), c); unpack8(*(const u32x4*)(rp + 1536 + 1024), h);
#pragma unroll
            for (int e = 0; e < 8; ++e) acc[e] += w2[e] * c[e] * h[e]; }
#pragma unroll
        for (int e = 0; e < 8; ++e) acc[e] *= bb[e];
        *(u32x4*)(SCO + (size_t)r * 512 + lane * 8) = pack8(acc);
    }
}

__device__ void fstep1(const Params& P, unsigned char* smem) {
    const int tid = ltid(), wave = __builtin_amdgcn_readfirstlane(tid >> 6), lane = tid & 63;
    const bf16_t* PQ = (const bf16_t*)(P.ws + O_PQ); bf16_t* AP = (bf16_t*)(P.ws + O_AP); const float* tw = (const float*)(P.ws + S_TWL);
    bf16_t* St = (bf16_t*)smem;
    for (int it = lbid(); it < 8 * 4 * 17; it += lgrid()) {
        const int b = it / 68, rem = it - b * 68, cht = rem / 17, n2t = rem - cht * 17;
        __syncthreads();
#pragma unroll 1
        for (int sub = 0; sub < 2; ++sub) {
            const int n2l = sub * 8 + wave, n2 = n2t * 16 + n2l;
#pragma unroll 1
            for (int cc = 0; cc < 2; ++cc) {
                float are[16], aim[16];
#pragma unroll
                for (int k = 0; k < 16; ++k) { are[k] = 0.f; aim[k] = 0.f; }
                const int chl = 2 * lane + cc;
                if (n2 < 257) {
#pragma unroll 1
                    for (int n1 = 0; n1 < 16; ++n1) {
                        const int n = 257 * n1 + n2; const bf16_t* rp = PQ + (size_t)(b * LL + n) * 1024 + cht * 128 + chl;
                        const float zr = bf2f(rp[0]), zi = -bf2f(rp[512]);
                        const float wr_ = __hip_atomic_load(tw + 2 * n, __ATOMIC_RELAXED, __HIP_MEMORY_SCOPE_AGENT), wi_ = __hip_atomic_load(tw + 2 * n + 1, __ATOMIC_RELAXED, __HIP_MEMORY_SCOPE_AGENT); float cr = 1.f, ci = 0.f;
#pragma unroll
                        for (int k = 0; k < 16; ++k) {
                            are[k] += cr * zr - ci * zi; aim[k] += cr * zi + ci * zr;
                            const float t = cr * wr_ - ci * wi_; ci = cr * wi_ + ci * wr_; cr = t; }
                    }
                }
                bf16_t* sp = St + (chl * 2) * 16 + n2l;
#pragma unroll
                for (int k = 0; k < 16; ++k) { sp[k * 4096] = f2bf(are[k]); sp[k * 4096 + 16] = f2bf(aim[k]); }
            }
        }
        __syncthreads();
#pragma unroll 2
        for (int q = tid; q < 8192; q += 512) { const int half = q & 1, ri = (q >> 1) & 1, chl = (q >> 2) & 127, k1 = q >> 9;
            const int n2c = n2t * 16 + half * 8;
            if (n2c < 320) { const u32x4 v = *(const u32x4*)(St + (size_t)q * 8);
                *(u32x4*)(AP + ((size_t)((b * 16 + k1) * 512 + cht * 128 + chl)) * KF + ri * 320 + n2c) = v; } }
        if (n2t == 16) {
            for (int q = tid; q < 16 * 128 * 2 * 6; q += 512) { const int c6 = q % 6, r2 = q / 6, ri = r2 & 1, chl = (r2 >> 1) & 127, k1 = r2 >> 8;
                *(u32x4*)(AP + ((size_t)((b * 16 + k1) * 512 + cht * 128 + chl)) * KF + ri * 320 + 272 + c6 * 8) = (u32x4){0u, 0u, 0u, 0u}; } }
    }
    __syncthreads();
}

__device__ void dn_prep(const Params& P, int l, unsigned char* smem, int t0, int t1) {
    const int tid = ltid(), wave = __builtin_amdgcn_readfirstlane(tid >> 6), lane = tid & 63, fr = lane & 15, fq = lane >> 4;
    unsigned char* ws = P.ws;
    const bf16_t* QKV = (const bf16_t*)(ws + O_QKV); const float* LG = (const float*)(ws + S_LOGIT);
    bf16_t* WP = (bf16_t*)(ws + O_WP); bf16_t* QP = (bf16_t*)(ws + O_QP); bf16_t* KD = (bf16_t*)(ws + O_KD); bf16_t* UF = (bf16_t*)(ws + O_UF); bf16_t* AT = (bf16_t*)(ws + O_AT);
    float* GL = (float*)(ws + S_GL);
    const float* cw = P.in[9] + (size_t)l * 3 * 1536;
    bf16_t* Qs = (bf16_t*)smem;
    bf16_t* Ks = Qs + 64 * 136;
    bf16_t* KT = Ks + 64 * 136;
    bf16_t* VT = KT + 128 * 72;
    bf16_t* T1 = VT + 128 * 72;
    bf16_t* T2 = T1 + 64 * 72;
    float* Mm = (float*)(T2 + 64 * 72);
    float* Tl = Mm + 64 * 68;
    float* gcs = Tl + 64 * 68;
    float* bts = gcs + 64;
    const int items = (t1 - t0) * 64;
    for (int it = lbid(); it < items; it += lgrid()) {
        const int tl = it >> 6, bhd = it & 63, b = bhd >> 3, h = (bhd >> 1) & 3, dir = bhd & 1;
        const int t = t0 + tl, c = dir ? 64 - t : t; const size_t slot = (size_t)tl * 64 + bhd;
        __syncthreads();
#pragma unroll 1
        for (int rr = 0; rr < 6; ++rr) {
            const int task = tid + 512 * rr, i = task / 48, cg_ = task - i * 48, kind = cg_ >> 4, cgl = cg_ & 15;
            const int n = c * 64 + (dir ? 63 - i : i) - 48;
            float v[8];
#pragma unroll
            for (int e = 0; e < 8; ++e) v[e] = 0.f;
            if (n >= 0) {
                const int col = kind * 512 + h * 128 + cgl * 8; const bf16_t* rp = QKV + (size_t)(b * LL + n) * 1536 + col;
                float x[8]; unpack8(*(const u32x4*)rp, x);
#pragma unroll
                for (int e = 0; e < 8; ++e) v[e] = cw[1536 + col + e] * x[e];
                if (n > 0) { unpack8(*(const u32x4*)(rp - 1536), x);
#pragma unroll
                    for (int e = 0; e < 8; ++e) v[e] += cw[col + e] * x[e]; }
                if (n < LL - 1) { unpack8(*(const u32x4*)(rp + 1536), x);
#pragma unroll
                    for (int e = 0; e < 8; ++e) v[e] += cw[3072 + col + e] * x[e]; }
#pragma unroll
                for (int e = 0; e < 8; ++e) v[e] = siluf_(v[e]);
            }
            float ss = 0.f;
#pragma unroll
            for (int e = 0; e < 8; ++e) ss += v[e] * v[e];
            ss += __shfl_xor(ss, 1); ss += __shfl_xor(ss, 2); ss += __shfl_xor(ss, 4); ss += __shfl_xor(ss, 8);
            if (kind < 2) { const float inv = rsqrtf(ss + EPS) * (kind == 0 ? 0.08838834764831845f : 1.0f);
#pragma unroll
                for (int e = 0; e < 8; ++e) v[e] *= inv; }
            const u32x4 pk = pack8(v);
            if (kind == 0) *(u32x4*)(Qs + i * 136 + cgl * 8) = pk;
            else if (kind == 1) { *(u32x4*)(Ks + i * 136 + cgl * 8) = pk;
#pragma unroll
                for (int e = 0; e < 8; ++e) KT[(cgl * 8 + e) * 72 + i] = f2bf(v[e]); }
            else {
#pragma unroll
                for (int e = 0; e < 8; ++e) VT[(cgl * 8 + e) * 72 + i] = f2bf(v[e]); }
        }
        if (wave == 0) {
            const int i = lane, n = c * 64 + (dir ? 63 - i : i) - 48; float beta = 0.f, g = 0.f;
            if (n >= 0) { const float* lg = LG + (size_t)(b * LL + n) * 16; const float bl = lg[dir * 4 + h], al = lg[8 + dir * 4 + h];
                beta = 1.0f / (1.0f + expf(-bl));
                const float xx = al + P.in[11][l * 8 + dir * 4 + h]; const float sp = xx > 20.f ? xx : log1pf(expf(xx));
                g = -expf(P.in[10][l * 8 + dir * 4 + h]) * sp; }
#pragma unroll
            for (int o = 1; o < 64; o <<= 1) { const float tt = __shfl_up(g, o); if (lane >= o) g += tt; }
            gcs[i] = g; bts[i] = beta;
        }
        __syncthreads();
        if (wave < 4) {
            const int m = wave; f32x4 acc[4];
#pragma unroll
            for (int n = 0; n < 4; ++n) acc[n] = (f32x4){0.f, 0.f, 0.f, 0.f};
#pragma unroll
            for (int s = 0; s < 4; ++s) { const bf16x8 a = *(const bf16x8*)(Ks + (16 * m + fr) * 136 + 32 * s + 8 * fq);
#pragma unroll
                for (int n = 0; n < 4; ++n) { const bf16x8 bb = *(const bf16x8*)(Ks + (16 * n + fr) * 136 + 32 * s + 8 * fq); acc[n] = __builtin_amdgcn_mfma_f32_16x16x32_bf16(a, bb, acc[n], 0, 0, 0); } }
#pragma unroll
            for (int n = 0; n < 4; ++n)
#pragma unroll
                for (int rg = 0; rg < 4; ++rg) { const int i = 16 * n + fr, j = 16 * m + 4 * fq + rg;
                    Mm[j * 68 + i] = (i > j) ? bts[i] * acc[n][rg] * __expf(gcs[i] - gcs[j]) : 0.f; }
        } else {
            const int m = wave - 4; f32x4 acc[4];
#pragma unroll
            for (int n = 0; n < 4; ++n) acc[n] = (f32x4){0.f, 0.f, 0.f, 0.f};
#pragma unroll
            for (int s = 0; s < 4; ++s) { const bf16x8 qf = *(const bf16x8*)(Qs + (16 * m + fr) * 136 + 32 * s + 8 * fq);
#pragma unroll
                for (int n = 0; n < 4; ++n) { const bf16x8 kf = *(const bf16x8*)(Ks + (16 * n + fr) * 136 + 32 * s + 8 * fq); acc[n] = __builtin_amdgcn_mfma_f32_16x16x32_bf16(kf, qf, acc[n], 0, 0, 0); } }
            const int i = 16 * m + fr; const float gi = gcs[i];
#pragma unroll
            for (int s2 = 0; s2 < 2; ++s2) { float v[8];
#pragma unroll
                for (int e = 0; e < 8; ++e) { const int j = 32 * s2 + 16 * (e >> 2) + 4 * fq + (e & 3); v[e] = (i >= j) ? acc[2 * s2 + (e >> 2)][e & 3] * __expf(gi - gcs[j]) : 0.f; }
                *(u32x4*)(AT + slot * 4096 + i * 64 + 32 * s2 + 8 * fq) = pack8(v); }
        }
        __syncthreads();
        if (wave == 0) {
            const float bc = bts[lane], be = bc * __expf(gcs[lane]);
#pragma unroll 1
            for (int rb = 0; rb < 8; ++rb) { const int i0 = rb * 8; float a[8];
#pragma unroll
                for (int r = 0; r < 8; ++r) a[r] = (i0 + r == lane) ? 1.f : 0.f;
#pragma unroll 2
                for (int j = 0; j < i0; ++j) { const float tj = Tl[j * 68 + lane]; const f32x4 m0 = *(const f32x4*)(Mm + j * 68 + i0), m1 = *(const f32x4*)(Mm + j * 68 + i0 + 4);
#pragma unroll
                    for (int r = 0; r < 4; ++r) { a[r] -= m0[r] * tj; a[4 + r] -= m1[r] * tj; } }
#pragma unroll
                for (int r = 0; r < 8; ++r) {
#pragma unroll
                    for (int r2 = 0; r2 < r; ++r2) a[r] -= Mm[(i0 + r2) * 68 + i0 + r] * a[r2];
                    Tl[(i0 + r) * 68 + lane] = a[r]; T1[(i0 + r) * 72 + lane] = f2bf(a[r] * bc); T2[(i0 + r) * 72 + lane] = f2bf(-a[r] * be); } }
            if (lane == 0) GL[slot] = __expf(gcs[63]);
        } else {
            const float glast = gcs[63];
            for (int task = tid - 64; task < 2048; task += 448) {
                if (task < 1024) { const int i = task >> 4, s = (task >> 2) & 3, f4 = task & 3; const float sc = __expf(gcs[i]);
                    const u32x2 a = *(const u32x2*)(Qs + i * 136 + 32 * s + 4 * f4), bq = *(const u32x2*)(Qs + i * 136 + 32 * s + 16 + 4 * f4);
                    float v[8]; v[0] = bf2f(a.x & 0xffffu) * sc; v[1] = __uint_as_float(a.x & 0xffff0000u) * sc; v[2] = bf2f(a.y & 0xffffu) * sc; v[3] = __uint_as_float(a.y & 0xffff0000u) * sc;
                    v[4] = bf2f(bq.x & 0xffffu) * sc; v[5] = __uint_as_float(bq.x & 0xffff0000u) * sc; v[6] = bf2f(bq.y & 0xffffu) * sc; v[7] = __uint_as_float(bq.y & 0xffff0000u) * sc;
                    *(u32x4*)(QP + slot * 8192 + i * 128 + 32 * s + 8 * f4) = pack8(v);
                } else { const int tt = task - 1024, dk = tt >> 3, s2 = (tt >> 2) & 1, f4 = tt & 3; const int i0 = 32 * s2 + 4 * f4;
                    const u32x2 a = *(const u32x2*)(KT + dk * 72 + i0), bq = *(const u32x2*)(KT + dk * 72 + i0 + 16);
                    float v[8]; v[0] = bf2f(a.x & 0xffffu) * __expf(glast - gcs[i0]); v[1] = __uint_as_float(a.x & 0xffff0000u) * __expf(glast - gcs[i0 + 1]);
                    v[2] = bf2f(a.y & 0xffffu) * __expf(glast - gcs[i0 + 2]); v[3] = __uint_as_float(a.y & 0xffff0000u) * __expf(glast - gcs[i0 + 3]);
                    v[4] = bf2f(bq.x & 0xffffu) * __expf(glast - gcs[i0 + 16]); v[5] = __uint_as_float(bq.x & 0xffff0000u) * __expf(glast - gcs[i0 + 17]);
                    v[6] = bf2f(bq.y & 0xffffu) * __expf(glast - gcs[i0 + 18]); v[7] = __uint_as_float(bq.y & 0xffff0000u) * __expf(glast - gcs[i0 + 19]);
                    *(u32x4*)(KD + slot * 8192 + dk * 64 + 32 * s2 + 8 * f4) = pack8(v); }
            }
        }
        __syncthreads();
        if (wave < 4) {
            const int m = wave; f32x4 acc[8];
#pragma unroll
            for (int n = 0; n < 8; ++n) acc[n] = (f32x4){0.f, 0.f, 0.f, 0.f};
#pragma unroll
            for (int s2 = 0; s2 < 2; ++s2) { const bf16x8 a = *(const bf16x8*)(T1 + (16 * m + fr) * 72 + 32 * s2 + 8 * fq);
#pragma unroll
                for (int n = 0; n < 8; ++n) { const bf16x8 bb = *(const bf16x8*)(VT + (16 * n + fr) * 72 + 32 * s2 + 8 * fq); acc[n] = __builtin_amdgcn_mfma_f32_16x16x32_bf16(a, bb, acc[n], 0, 0, 0); } }
#pragma unroll
            for (int n = 0; n < 8; ++n) { u32x2 w; w.x = cvt_pk_bf16(acc[n][0], acc[n][1]); w.y = cvt_pk_bf16(acc[n][2], acc[n][3]);
                *(u32x2*)(UF + slot * 8192 + ((n * 4 + m) * 64 + lane) * 4) = w; }
        } else {
            const int m = wave - 4; f32x4 acc[8];
#pragma unroll
            for (int n = 0; n < 8; ++n) acc[n] = (f32x4){0.f, 0.f, 0.f, 0.f};
#pragma unroll
            for (int s2 = 0; s2 < 2; ++s2) { const bf16x8 tf = *(const bf16x8*)(T2 + (16 * m + fr) * 72 + 32 * s2 + 8 * fq);
#pragma unroll
                for (int n = 0; n < 8; ++n) { const bf16x8 kf = *(const bf16x8*)(KT + (16 * n + fr) * 72 + 32 * s2 + 8 * fq); acc[n] = __builtin_amdgcn_mfma_f32_16x16x32_bf16(kf, tf, acc[n], 0, 0, 0); } }
            const int i = 16 * m + fr;
#pragma unroll
            for (int s = 0; s < 4; ++s) { u32x4 w; w.x = cvt_pk_bf16(acc[2 * s][0], acc[2 * s][1]); w.y = cvt_pk_bf16(acc[2 * s][2], acc[2 * s][3]);
                w.z = cvt_pk_bf16(acc[2 * s + 1][0], acc[2 * s + 1][1]); w.w = cvt_pk_bf16(acc[2 * s + 1][2], acc[2 * s + 1][3]);
                *(u32x4*)(WP + slot * 8192 + i * 128 + 32 * s + 8 * fq) = w; }
        }
    }
    __syncthreads();
}

__device__ void dn_scan(const Params& P, int t0, int t1) {
    const int tid = ltid(), wave = __builtin_amdgcn_readfirstlane(tid >> 6), lane = tid & 63, fr = lane & 15, fq = lane >> 4;
    if (wave >= 2) return;
    unsigned char* ws = P.ws;
    const bf16_t* WP = (const bf16_t*)(ws + O_WP); const bf16_t* QP = (const bf16_t*)(ws + O_QP); const bf16_t* KD = (const bf16_t*)(ws + O_KD);
    const bf16_t* UF = (const bf16_t*)(ws + O_UF); const bf16_t* AT = (const bf16_t*)(ws + O_AT); const float* GL = (const float*)(ws + S_GL);
    bf16_t* OO = (bf16_t*)(ws + O_O); f32x4* SS = (f32x4*)(ws + S_SSAVE);
    const int wid = lbid() * 2 + wave, bhd = wid >> 3, sl = wid & 7, b = bhd >> 3, h = (bhd >> 1) & 3, dir = bhd & 1;
    f32x4 S[8];
#pragma unroll
    for (int t = 0; t < 8; ++t) S[t] = (t0 == 0) ? (f32x4){0.f, 0.f, 0.f, 0.f} : SS[((size_t)wid * 8 + t) * 64 + lane];
#pragma unroll 1
    for (int tl = 0; tl < t1 - t0; ++tl) {
        const size_t slot = (size_t)tl * 64 + bhd; const int t = t0 + tl, c = dir ? 64 - t : t;
        f32x4 av[4], ao[4]; bf16x8 Sb[4];
#pragma unroll
        for (int m = 0; m < 4; ++m) { const u32x2 u = *(const u32x2*)(UF + slot * 8192 + ((sl * 4 + m) * 64 + lane) * 4);
            av[m] = (f32x4){__uint_as_float(u.x << 16), __uint_as_float(u.x & 0xffff0000u), __uint_as_float(u.y << 16), __uint_as_float(u.y & 0xffff0000u)}; ao[m] = (f32x4){0.f, 0.f, 0.f, 0.f}; }
#pragma unroll
        for (int s = 0; s < 4; ++s) { u32x4 w; w.x = cvt_pk_bf16(S[2 * s][0], S[2 * s][1]); w.y = cvt_pk_bf16(S[2 * s][2], S[2 * s][3]); w.z = cvt_pk_bf16(S[2 * s + 1][0], S[2 * s + 1][1]); w.w = cvt_pk_bf16(S[2 * s + 1][2], S[2 * s + 1][3]);
            Sb[s] = __builtin_bit_cast(bf16x8, w); }
#pragma unroll
        for (int m = 0; m < 4; ++m)
#pragma unroll
            for (int s = 0; s < 4; ++s) { const bf16x8 wf = *(const bf16x8*)(WP + slot * 8192 + (16 * m + fr) * 128 + 32 * s + 8 * fq); av[m] = __builtin_amdgcn_mfma_f32_16x16x32_bf16(wf, Sb[s], av[m], 0, 0, 0); }
#pragma unroll
        for (int m = 0; m < 4; ++m)
#pragma unroll
            for (int s = 0; s < 4; ++s) { const bf16x8 qf = *(const bf16x8*)(QP + slot * 8192 + (16 * m + fr) * 128 + 32 * s + 8 * fq); ao[m] = __builtin_amdgcn_mfma_f32_16x16x32_bf16(qf, Sb[s], ao[m], 0, 0, 0); }
        bf16x8 Vb[2];
#pragma unroll
        for (int s2 = 0; s2 < 2; ++s2) { u32x4 w; w.x = cvt_pk_bf16(av[2 * s2][0], av[2 * s2][1]); w.y = cvt_pk_bf16(av[2 * s2][2], av[2 * s2][3]); w.z = cvt_pk_bf16(av[2 * s2 + 1][0], av[2 * s2 + 1][1]); w.w = cvt_pk_bf16(av[2 * s2 + 1][2], av[2 * s2 + 1][3]);
            Vb[s2] = __builtin_bit_cast(bf16x8, w); }
#pragma unroll
        for (int m = 0; m < 4; ++m)
#pragma unroll
            for (int s2 = 0; s2 < 2; ++s2) { const bf16x8 af = *(const bf16x8*)(AT + slot * 4096 + (16 * m + fr) * 64 + 32 * s2 + 8 * fq); ao[m] = __builtin_amdgcn_mfma_f32_16x16x32_bf16(af, Vb[s2], ao[m], 0, 0, 0); }
        const float gl = __hip_atomic_load(GL + slot, __ATOMIC_RELAXED, __HIP_MEMORY_SCOPE_AGENT);
#pragma unroll
        for (int tt = 0; tt < 8; ++tt) { S[tt] = S[tt] * gl;
#pragma unroll
            for (int s2 = 0; s2 < 2; ++s2) { const bf16x8 kf = *(const bf16x8*)(KD + slot * 8192 + (16 * tt + fr) * 64 + 32 * s2 + 8 * fq); S[tt] = __builtin_amdgcn_mfma_f32_16x16x32_bf16(kf, Vb[s2], S[tt], 0, 0, 0); } }
#pragma unroll
        for (int m = 0; m < 4; ++m)
#pragma unroll
            for (int rg = 0; rg < 4; ++rg) { const int i = 16 * m + 4 * fq + rg, n = c * 64 + (dir ? 63 - i : i) - 48;
                if (n >= 0) OO[((size_t)dir * TP + (size_t)b * LL + n) * 512 + h * 128 + sl * 16 + fr] = f2bf(ao[m][rg]); }
    }
    if (t1 < NSTEP) {
#pragma unroll
        for (int t = 0; t < 8; ++t) SS[((size_t)wid * 8 + t) * 64 + lane] = S[t]; }
}

__device__ void dn_out(const Params& P, int l) {
    const int tid_ = ltid(); const int wave = __builtin_amdgcn_readfirstlane(tid_ >> 6), lane = tid_ & 63;
    const bf16_t* OO = (const bf16_t*)(P.ws + O_O); const bf16_t* Z = (const bf16_t*)(P.ws + O_Z); bf16_t* DNO = (bf16_t*)(P.ws + O_BR) + (size_t)2 * TP * 512;
    const float* nw = P.in[12] + (size_t)l * 128; float g[8];
#pragma unroll
    for (int e = 0; e < 8; ++e) g[e] = nw[(lane & 15) * 8 + e];
    for (int r = lbid() * 8 + wave; r < TT; r += lgrid() * 8) {
        float a[8], bq[8], z[8]; unpack8(*(const u32x4*)(OO + (size_t)r * 512 + lane * 8), a); unpack8(*(const u32x4*)(OO + ((size_t)TP + r) * 512 + lane * 8), bq); unpack8(*(const u32x4*)(Z + (size_t)r * 512 + lane * 8), z);
        float ss = 0.f;
#pragma unroll
        for (int e = 0; e < 8; ++e) { a[e] += bq[e]; ss += a[e] * a[e]; }
        ss += __shfl_xor(ss, 1); ss += __shfl_xor(ss, 2); ss += __shfl_xor(ss, 4); ss += __shfl_xor(ss, 8);
        const float inv = rsqrtf(ss * (1.0f / 128.0f) + EPS);
#pragma unroll
        for (int e = 0; e < 8; ++e) a[e] = a[e] * inv * g[e] * siluf_(z[e]);
        *(u32x4*)(DNO + (size_t)r * 512 + lane * 8) = pack8(a);
    }
}

#ifndef SKIP_GEMM
#define GEMM_CALL(a,b,c,d) pg8::gemm_phase(a,b,c,d)
#else
#define GEMM_CALL(a,b,c,d) (void)0
#endif
__global__ void __launch_bounds__(512, 2) fwd_kernel(Params P) {
    extern __shared__ __attribute__((aligned(16))) unsigned char smem[];
    cg::grid_group grid = cg::this_grid();
    unsigned char* ws = P.ws;
    LAS unsigned char* lds = (LAS unsigned char*)smem;
    int ph = 0;
#define PHASE_BEGIN if (ph >= P.ph_lo && ph < P.ph_hi) { const int G = lgrid(), bx = lbid(); (void)G; (void)bx;
#define PHASE_END   if (ph + 1 < P.ph_hi) { asm volatile("s_waitcnt vmcnt(0) lgkmcnt(0)" ::: "memory"); grid.sync(); __builtin_amdgcn_fence(__ATOMIC_ACQUIRE, "agent"); asm volatile("s_waitcnt vmcnt(0)" ::: "memory"); } } ++ph;
    bf16_t* XN = (bf16_t*)(ws + O_XN); bf16_t* Y = (bf16_t*)(ws + O_Y); bf16_t* ACT = (bf16_t*)(ws + O_ACT);
    for (int l = 0; l < 2; ++l) {
        const float* ng = P.in[2] + (size_t)l * 6 * 1024;
        PHASE_BEGIN
#ifndef SKIP_CVT
            convert_weights(P, l, smem);
#endif
            if (l == 0) { gen_tables(P); rpass(P, nullptr, true, nullptr, 0.f, ng, XN); }
        PHASE_END
        PHASE_BEGIN { pg8::Gemm g{XN, (const bf16_t*)(ws + W_WI1), TP, 5632, 1024}; pg8::StaticOrder S; S.init(TP, 5632, G, bx); pg8::EpiSwiglu E{ACT}; GEMM_CALL(lds, g, S, E); } PHASE_END
        PHASE_BEGIN { pg8::Gemm g{ACT, (const bf16_t*)(ws + W_WO1), TP, 1024, 2816}; pg8::StaticOrder S; S.init(TP, 1024, G, bx); pg8::EpiBf16<0> E{Y, 1024}; GEMM_CALL(lds, g, S, E); } PHASE_END
        PHASE_BEGIN rpass(P, Y, l == 0, ng + 1024, 0.5f, ng + 2048, XN); PHASE_END
        PHASE_BEGIN { pg8::Gemm g{XN, (const bf16_t*)(ws + W_WIN), TP, NPROJ, 1024}; pg8::StaticOrder S; S.init(TP, NPROJ, G, bx); pg8::EpiInProj E{ws}; GEMM_CALL(lds, g, S, E); } PHASE_END
        PHASE_BEGIN sconv_pass(P, l); PHASE_END
        PHASE_BEGIN
#ifndef SKIP_F1
 fstep1(P, smem);
#endif
 PHASE_END
        PHASE_BEGIN { pg8::Gemm g{(const bf16_t*)(ws + S_C257), (const bf16_t*)(ws + O_AP), 512, 65536, KF}; pg8::StaticOrder S; S.init(512, 65536, G, bx);
                      pg8::EpiFourier E{(bf16_t*)(ws + O_BR), 0.001949317738791423f  }; GEMM_CALL(lds, g, S, E); } PHASE_END
        for (int sp = 0; sp < NSPLIT; ++sp) { const int t0 = sp * SPL, t1 = (t0 + SPL < NSTEP) ? t0 + SPL : NSTEP;
            PHASE_BEGIN
#ifndef SKIP_PREP
 dn_prep(P, l, smem, t0, t1);
#endif
 PHASE_END
            PHASE_BEGIN
#ifndef SKIP_SCAN
 dn_scan(P, t0, t1);
#endif
 PHASE_END }
        PHASE_BEGIN dn_out(P, l); rpass(P, nullptr, false, nullptr, 0.f, ng + 2048, (bf16_t*)(ws + O_XN2)); PHASE_END
        PHASE_BEGIN { pg8::Gemm g{(const bf16_t*)(ws + O_XN2), (const bf16_t*)(ws + W_WG), TP, 3072, 1024}; pg8::StaticOrder S; S.init(TP, 3072, G, bx); pg8::EpiBf16<1> E{(bf16_t*)(ws + O_GATE), 3072}; GEMM_CALL(lds, g, S, E); } PHASE_END
        PHASE_BEGIN { pg8::Gemm g{(const bf16_t*)(ws + O_BR), (const bf16_t*)(ws + W_WBR), 3 * TP, 3072, 512}; pg8::MergeOrder S{G, bx}; pg8::EpiMerge E{(const bf16_t*)(ws + O_GATE), (bf16_t*)(ws + O_MG), (bf16_t*)(ws + O_XN2)}; GEMM_CALL(lds, g, S, E); } PHASE_END
        PHASE_BEGIN { pg8::Gemm g{(const bf16_t*)(ws + O_MG), (const bf16_t*)(ws + W_WOUT), TP, 1024, 1024}; pg8::StaticOrder S; S.init(TP, 1024, G, bx); pg8::EpiBf16<0> E{Y, 1024}; GEMM_CALL(lds, g, S, E); } PHASE_END
        PHASE_BEGIN rpass(P, Y, false, ng + 3 * 1024, 1.0f, ng + 4 * 1024, XN); PHASE_END
        PHASE_BEGIN { pg8::Gemm g{XN, (const bf16_t*)(ws + W_WI2), TP, 5632, 1024}; pg8::StaticOrder S; S.init(TP, 5632, G, bx); pg8::EpiSwiglu E{ACT}; GEMM_CALL(lds, g, S, E); } PHASE_END
        PHASE_BEGIN { pg8::Gemm g{ACT, (const bf16_t*)(ws + W_WO2), TP, 1024, 2816}; pg8::StaticOrder S; S.init(TP, 1024, G, bx); pg8::EpiBf16<0> E{Y, 1024}; GEMM_CALL(lds, g, S, E); } PHASE_END
        PHASE_BEGIN rpass(P, Y, false, ng + 5 * 1024, 0.5f, l == 0 ? P.in[2] + (size_t)6 * 1024 : nullptr, XN); PHASE_END
    }
#ifdef DBG_FLUSH
    { asm volatile("s_waitcnt vmcnt(0) lgkmcnt(0)" ::: "memory"); grid.sync(); __builtin_amdgcn_fence(__ATOMIC_ACQUIRE, "agent"); asm volatile("s_waitcnt vmcnt(0)" ::: "memory");
      const f32x4* xs = (const f32x4*)P.in[0]; f32x4 a = {0.f, 0.f, 0.f, 0.f};
      for (size_t i = ltid(); i < (size_t)8388608; i += 512) a += xs[i];
      if (a[0] + a[1] + a[2] + a[3] == 1.2345e-30f) ((float*)(ws + S_GL))[4000] = 1.f; }
#endif
#ifdef DBG_OFF
    { asm volatile("s_waitcnt vmcnt(0) lgkmcnt(0)" ::: "memory"); grid.sync(); __builtin_amdgcn_fence(__ATOMIC_ACQUIRE, "agent"); asm volatile("s_waitcnt vmcnt(0)" ::: "memory");
      const bf16_t* src = (const bf16_t*)(ws + DBG_OFF);
      for (size_t i = (size_t)lbid() * 512 + ltid(); i < (size_t)33554432; i += (size_t)lgrid() * 512) P.out[i] = i < (size_t)DBG_CNT ? bf2f(src[i]) : 0.f; }
#endif
}

extern "C" void kernel_launch(void* const* d_in, const int* in_sizes, int n_in, void* d_out, int out_size, void* d_ws, size_t ws_size, hipStream_t stream) {
    static int grid = 0;
    if (grid == 0) {
        int dev = 0, cus = 0, per_cu = 0;
        hipGetDevice(&dev); hipDeviceGetAttribute(&cus, hipDeviceAttributeMultiprocessorCount, dev);
        hipFuncSetAttribute((const void*)fwd_kernel, hipFuncAttributeMaxDynamicSharedMemorySize, LDS_BYTES);
        hipOccupancyMaxActiveBlocksPerMultiprocessor(&per_cu, (const void*)fwd_kernel, 512, LDS_BYTES);
        if (per_cu < 1) { fprintf(stderr, "occupancy query says %d blocks/CU\n", per_cu); per_cu = 1; }
        grid = cus;
        if (ws_size < WS_NEED) fprintf(stderr, "workspace too small: %zu < %zu\n", ws_size, (size_t)WS_NEED);
    }
    Params p{};
    for (int i = 0; i < 17; ++i) p.in[i] = (const float*)d_in[i];
    p.out = (float*)d_out; p.ws = (unsigned char*)d_ws; p.ph_lo = 0; p.ph_hi = 1000;
#ifdef DBG_PHI
    p.ph_hi = DBG_PHI;
#endif
    void* args[] = {&p};
    hipError_t e = hipLaunchCooperativeKernel((const void*)fwd_kernel, dim3(grid), dim3(512), args, LDS_BYTES, stream);
    if (e != hipSuccess) fprintf(stderr, "cooperative launch failed: %s (grid %d)\n", hipGetErrorString(e), grid);
}
```

```cpp
#include <hip/hip_runtime.h>
#include <hip/hip_cooperative_groups.h>
#include <cstdio>
namespace cg = cooperative_groups;

#define LAS __attribute__((address_space(3)))
typedef unsigned short bf16_t;
typedef short bf16x8 __attribute__((ext_vector_type(8)));
typedef float f32x4 __attribute__((ext_vector_type(4)));
typedef unsigned u32x4 __attribute__((ext_vector_type(4)));
typedef unsigned u32x2 __attribute__((ext_vector_type(2)));

constexpr int DM = 1024, NB = 8, SEQ = 4096, NMETA = 16, LL = 4112, TT = NB * LL  , TP = 33024  , DFF = 2816;
constexpr int NIN = 7184;
constexpr int NPROJ = 4864;
constexpr float EPS = 1e-6f;
constexpr int NSTEP = 65, SPL = 24, NSPLIT = 3;
constexpr int KF = 640;

constexpr size_t UU = (size_t)TP * 1024;
constexpr size_t W_WI1 = 0, W_WO1 = W_WI1 + (size_t)5632 * 1024 * 2, W_WI2 = W_WO1 + (size_t)1024 * 2816 * 2, W_WO2 = W_WI2 + (size_t)5632 * 1024 * 2,
                 W_WIN = W_WO2 + (size_t)1024 * 2816 * 2, W_WG = W_WIN + (size_t)NPROJ * 1024 * 2, W_WBR = W_WG + (size_t)3072 * 1024 * 2,
                 W_WOUT = W_WBR + (size_t)3072 * 512 * 2, W_END = W_WOUT + (size_t)1024 * 1024 * 2;
constexpr size_t S_C257 = W_END, S_TWL = S_C257 + (size_t)512 * KF * 2, S_HM = S_TWL + 33024, S_LOGIT = S_HM + (size_t)128 * 1024 * 4,
                 S_GL = S_LOGIT + (size_t)TP * 16 * 4, S_SSAVE = S_GL + 16896, S_BAR = S_SSAVE + (size_t)512 * 8 * 64 * 16, S_END = S_BAR + 16384;
constexpr size_t A0 = (S_END + 255) / 256 * 256;
constexpr size_t O_XN = A0, O_Y = A0 + 2 * UU, O_ACT = A0 + 4 * UU;
constexpr size_t O_BR = A0, O_QKV = A0 + 4 * UU, O_Z = A0 + 7 * UU, O_SC = A0 + 8 * UU, O_PQ = A0 + 11 * UU, O_AP = A0 + 8 * UU;
constexpr size_t DNI_SLOTS = (size_t)SPL * 64;
constexpr size_t O_WP = A0 + 8 * UU, O_QP = O_WP + DNI_SLOTS * 16384, O_KD = O_QP + DNI_SLOTS * 16384, O_UF = O_KD + DNI_SLOTS * 16384,
                 O_AT = O_UF + DNI_SLOTS * 16384, O_DNI_END = O_AT + DNI_SLOTS * 8192;
constexpr size_t O_O = (O_DNI_END + 255) / 256 * 256;
constexpr size_t O_XN2 = A0 + 3 * UU, O_GATE = A0 + 5 * UU, O_MG = A0 + 11 * UU;
constexpr size_t WS_NEED = O_O + 2 * UU;
static_assert(WS_NEED <= (size_t)536870912, "workspace");
static_assert(O_AP + (size_t)65536 * KF * 2 <= O_PQ, "A' overlaps PQ");
static_assert(O_O >= O_PQ || true, "");
static_assert(O_MG + 2 * UU <= WS_NEED + 2 * UU, "");

constexpr int LDS_BYTES = 132 * 1024;

#define DBG_CNT ((size_t)33554432)


struct Params { const float* in[17]; float* out; unsigned char* ws; int ph_lo, ph_hi; };

__device__ __forceinline__ float bf2f(unsigned v) { return __uint_as_float(v << 16); }
typedef __bf16 bf16x2_t __attribute__((ext_vector_type(2)));
typedef float f32x2_t __attribute__((ext_vector_type(2)));
__device__ __forceinline__ unsigned cvt_pk_bf16(float lo, float hi) { f32x2_t v = {lo, hi}; bf16x2_t b = __builtin_convertvector(v, bf16x2_t); return __builtin_bit_cast(unsigned, b); }
__device__ __forceinline__ bf16_t f2bf(float f) { return (bf16_t)(cvt_pk_bf16(f, 0.f) & 0xffffu); }
__device__ __forceinline__ void unpack8(const u32x4 v, float* f) {
    f[0] = __uint_as_float(v.x << 16); f[1] = __uint_as_float(v.x & 0xffff0000u); f[2] = __uint_as_float(v.y << 16); f[3] = __uint_as_float(v.y & 0xffff0000u);
    f[4] = __uint_as_float(v.z << 16); f[5] = __uint_as_float(v.z & 0xffff0000u); f[6] = __uint_as_float(v.w << 16); f[7] = __uint_as_float(v.w & 0xffff0000u); }
__device__ __forceinline__ u32x4 pack8(const float* f) { u32x4 w; w.x = cvt_pk_bf16(f[0], f[1]); w.y = cvt_pk_bf16(f[2], f[3]); w.z = cvt_pk_bf16(f[4], f[5]); w.w = cvt_pk_bf16(f[6], f[7]); return w; }
__device__ __forceinline__ int ltid() { int t = threadIdx.x; asm volatile("" : "+v"(t)); return t; }
__device__ __forceinline__ int lbid() { int t = blockIdx.x; asm volatile("" : "+s"(t)); return t; }
__device__ __forceinline__ int lgrid() { int t = gridDim.x; asm volatile("" : "+s"(t)); return t; }
__device__ __forceinline__ float wave_sum(float v) { for (int o = 32; o >= 1; o >>= 1) v += __shfl_xor(v, o); return v; }
__device__ __forceinline__ float sigmoidf_(float x) { return __builtin_amdgcn_rcpf(1.0f + __expf(-x)); }
__device__ __forceinline__ float siluf_(float x) { return x * __builtin_amdgcn_rcpf(1.0f + __expf(-x)); }

namespace pg8 {
constexpr int BM = 256, BK = 64, HALF = 128, HTB = HALF * BK * 2, STAGE_BYTES = 8 * HTB, NXCD = 8, WGM = 8;
__device__ __forceinline__ int lds_byte(int r, int c) { const int st = (r >> 4) * 2 + (c >> 5), rr = r & 15, cc = c & 31, ob = rr * 64 + cc * 2; return st * 1024 + (ob ^ (((ob >> 9) & 1) << 5)); }
__device__ __forceinline__ void stage_rc(int b, int& R, int& C) { const int st = b / 1024, sb = b % 1024, swz = sb ^ (((sb >> 9) & 1) << 5); R = (st >> 1) * 16 + swz / 64; C = (st & 1) * 32 + (swz % 64) / 2; }
__device__ __forceinline__ int perm32(int rho) { const int n = rho >> 4, i = rho & 15; return 8 * (i >> 2) + 4 * n + (i & 3); }
struct Unit { int pm, pn; };
struct Gemm { const bf16_t* A; const bf16_t* Bt; int M, N, K; int half_pm; };
struct StaticOrder {
    int nM, nN, nwg, G, c;
    __device__ void init(int M, int N, int G_, int c_) { nM = M / BM - 1; nN = N / BM; nwg = nM * nN; G = G_; c = c_; }
    __device__ bool next(int i, Unit& u) const {
        const long L = (long)i * G + c; if (L >= nwg + nN) return false;
        if (L >= nwg) { u.pm = nM; u.pn = (int)(L - nwg); return true; }
        int wgid = (int)L; { const int q = nwg / NXCD, r = nwg % NXCD, xcd = wgid % NXCD, off = wgid / NXCD; wgid = (xcd < r ? xcd * (q + 1) : r * (q + 1) + (xcd - r) * q) + off; }
        const int nig = WGM * nN, gid = wgid / nig, fm = gid * WGM, gsz = (nM - fm) < WGM ? (nM - fm) : WGM;
        u.pm = fm + ((wgid % nig) % gsz); u.pn = (wgid % nig) / gsz; return true;
    }
};
struct MergeOrder {
    int G, c;
    __device__ bool next(int i, Unit& u) const { const int L = (i / 3) * G + c; if (L >= 129 * 4) return false; const int j = i % 3; u.pm = j * 129 + (L >> 2); u.pn = j * 4 + (L & 3); return true; }
};

template <class Epi, class Sched>
__device__ __forceinline__ void gemm_phase(LAS unsigned char* lds, const Gemm g, const Sched& S, const Epi& E) {
    const int tid = ltid(), wid = __builtin_amdgcn_readfirstlane(tid >> 6), lane = tid & 63, wr = wid >> 2, wc = wid & 3, fr = lane & 15, fq = lane >> 4;
    const int K = g.K, nt = K / BK;
    unsigned voffA, voffB;
    { int R, C; stage_rc(tid * 16, R, C); const int Rb = Epi::PERM ? ((R & ~31) + perm32(R & 31)) : R;
        voffA = (unsigned)(R * K + C) * 2u; voffB = (unsigned)(Rb * K + C) * 2u; }
    const size_t r64 = (size_t)64 * K * 2;
    const size_t kstep = (size_t)(BK * 2);
    const size_t hstep = (size_t)HALF * K * 2;
    const size_t tstep = 2 * hstep;
    const unsigned ldsw = (unsigned)wid * 1024u;
    const int aoff = lds_byte(wr * 64 + fr, fq * 8), boff = lds_byte(wc * 32 + fr, fq * 8);
#define PG8_SA(b, h) (((b) * 2 + (h)) * HTB)
#define PG8_SB(b, h) ((4 + (b) * 2 + (h)) * HTB)
#define PG8_STAGE(bufoff, gbase, voff) do { _Pragma("unroll") for (int _i = 0; _i < 2; ++_i) \
        __builtin_amdgcn_global_load_lds((const unsigned*)((const char*)(gbase) + _i * r64 + (voff)), (LAS unsigned*)(lds + (bufoff) + ldsw + _i * 8192), 16, 0, 0); } while (0)
#define PG8_LDA(dst, b, h) do { _Pragma("unroll") for (int m = 0; m < 4; ++m) _Pragma("unroll") for (int k = 0; k < 2; ++k) dst[m][k] = *(const LAS bf16x8*)(lds + PG8_SA(b, h) + aoff + m * 2048 + k * 1024); } while (0)
#define PG8_LDB(dst, b, h) do { _Pragma("unroll") for (int n = 0; n < 2; ++n) _Pragma("unroll") for (int k = 0; k < 2; ++k) dst[n][k] = *(const LAS bf16x8*)(lds + PG8_SB(b, h) + boff + n * 2048 + k * 1024); } while (0)
#define PG8_MMA(ai, bj, At, Bt) do { __builtin_amdgcn_s_setprio(1); _Pragma("unroll") for (int m = 0; m < 4; ++m) _Pragma("unroll") for (int n = 0; n < 2; ++n) _Pragma("unroll") for (int k = 0; k < 2; ++k) \
        acc[ai][bj][m][n] = __builtin_amdgcn_mfma_f32_16x16x32_bf16(Bt[n][k], At[m][k], acc[ai][bj][m][n], 0, 0, 0); __builtin_amdgcn_s_setprio(0); } while (0)
#define PG8_WAIT_V(n) asm volatile("s_waitcnt vmcnt(" #n ")" ::: "memory")
#define PG8_WAIT_L(n) asm volatile("s_waitcnt lgkmcnt(" #n ")" ::: "memory")
#define PG8_BAR __builtin_amdgcn_s_barrier()
#define PG8_SCHED __builtin_amdgcn_sched_barrier(0)
    Unit cur, nxt; int ui = 0;
    if (!S.next(0, cur)) return;
    f32x4 acc[2][2][4][2];
#pragma unroll
    for (int a = 0; a < 2; ++a)
#pragma unroll
        for (int b = 0; b < 2; ++b)
#pragma unroll
            for (int m = 0; m < 4; ++m)
#pragma unroll
                for (int n = 0; n < 2; ++n) acc[a][b][m][n] = (f32x4){0.f, 0.f, 0.f, 0.f};
    bf16x8 At[4][2], B0[2][2], B1[2][2];
    const char* cA = (const char*)g.A + (size_t)cur.pm * tstep; const char* cB = (const char*)g.Bt + (size_t)cur.pn * tstep;
    PG8_STAGE(PG8_SB(0, 0), cB, voffB); PG8_STAGE(PG8_SA(0, 0), cA, voffA); PG8_STAGE(PG8_SB(0, 1), cB + hstep, voffB); PG8_STAGE(PG8_SA(0, 1), cA + hstep, voffA);
    if (wr == 1) PG8_BAR;
    PG8_WAIT_V(4); PG8_BAR;
    PG8_STAGE(PG8_SB(1, 0), cB + kstep, voffB); PG8_STAGE(PG8_SA(1, 0), cA + kstep, voffA); PG8_STAGE(PG8_SB(1, 1), cB + hstep + kstep, voffB);
    PG8_WAIT_V(6); PG8_BAR;
    for (;;) {
        const bool has_next = S.next(ui + 1, nxt);
        const bool halfc = cur.pm == g.half_pm;
        const char* nA = has_next ? (const char*)g.A + (size_t)nxt.pm * tstep : cA; const char* nB = has_next ? (const char*)g.Bt + (size_t)nxt.pn * tstep : cB;
        for (int t = 0; t < nt; t += 2) {
            const bool last = (t == nt - 2);
            const char* a1 = cA + (size_t)(t + 1) * kstep;
            const char* a2 = last ? nA : cA + (size_t)(t + 2) * kstep; const char* b2 = last ? nB : cB + (size_t)(t + 2) * kstep;
            const char* a3 = a2 + kstep; const char* b3 = b2 + kstep;
            PG8_LDB(B0, 0, 0); PG8_SCHED; PG8_LDA(At, 0, 0); PG8_STAGE(PG8_SA(1, 1), a1 + hstep, voffA);
            PG8_WAIT_L(8); PG8_BAR; PG8_WAIT_L(0); PG8_MMA(0, 0, At, B0); PG8_BAR; PG8_SCHED;
            PG8_LDB(B1, 0, 1); PG8_STAGE(PG8_SB(0, 0), b2, voffB);
            PG8_BAR; PG8_WAIT_L(0); PG8_MMA(0, 1, At, B1); PG8_BAR;
            PG8_LDA(At, 0, 1); PG8_STAGE(PG8_SA(0, 0), a2, voffA);
            PG8_BAR; PG8_WAIT_L(0); if (!halfc) PG8_MMA(1, 0, At, B0); PG8_BAR; PG8_SCHED;
            PG8_STAGE(PG8_SB(0, 1), b2 + hstep, voffB);
            PG8_WAIT_V(6); PG8_BAR; if (!halfc) PG8_MMA(1, 1, At, B1); PG8_BAR;
            PG8_LDB(B0, 1, 0); PG8_SCHED; PG8_LDA(At, 1, 0); PG8_STAGE(PG8_SA(0, 1), a2 + hstep, voffA);
            PG8_WAIT_L(8); PG8_BAR; PG8_WAIT_L(0); PG8_MMA(0, 0, At, B0); PG8_BAR; PG8_SCHED;
            PG8_LDB(B1, 1, 1); PG8_STAGE(PG8_SB(1, 0), b3, voffB);
            PG8_BAR; PG8_WAIT_L(0); PG8_MMA(0, 1, At, B1); PG8_BAR;
            PG8_LDA(At, 1, 1); PG8_STAGE(PG8_SA(1, 0), a3, voffA);
            PG8_BAR; PG8_WAIT_L(0); if (!halfc) PG8_MMA(1, 0, At, B0); PG8_BAR; PG8_SCHED;
            PG8_STAGE(PG8_SB(1, 1), b3 + hstep, voffB);
            PG8_WAIT_V(6); PG8_BAR; if (!halfc) PG8_MMA(1, 1, At, B1); PG8_BAR;
        }
        E(acc, cur, wr, wc, fr, fq);
        if (!has_next) break;
#pragma unroll
        for (int a = 0; a < 2; ++a)
#pragma unroll
            for (int b = 0; b < 2; ++b)
#pragma unroll
                for (int m = 0; m < 4; ++m)
#pragma unroll
                    for (int n = 0; n < 2; ++n) acc[a][b][m][n] = (f32x4){0.f, 0.f, 0.f, 0.f};
        cur = nxt; cA = nA; cB = nB; ++ui;
    }
    PG8_WAIT_V(0);
    if (wr == 0) PG8_BAR;
    PG8_BAR;
#undef PG8_SA
#undef PG8_SB
#undef PG8_STAGE
#undef PG8_LDA
#undef PG8_LDB
#undef PG8_MMA
#undef PG8_WAIT_V
#undef PG8_WAIT_L
#undef PG8_BAR
#undef PG8_SCHED
}

template <int ACT> struct EpiBf16 {
    static constexpr bool PERM = true;
    bf16_t* O; int ldc;
    __device__ __forceinline__ void operator()(const f32x4 (&acc)[2][2][4][2], const Unit& u, int wr, int wc, int fr, int fq) const {
        const int row0 = u.pm * BM + wr * 64 + fr, col0 = u.pn * BM + wc * 32 + 8 * fq;
#pragma unroll
        for (int ai = 0; ai < 2; ++ai)
#pragma unroll
            for (int m = 0; m < 4; ++m) { bf16_t* rowp = O + (size_t)(row0 + ai * HALF + m * 16) * ldc + col0;
#pragma unroll
                for (int bj = 0; bj < 2; ++bj) { f32x4 v0 = acc[ai][bj][m][0], v1 = acc[ai][bj][m][1];
                    if (ACT == 1) {
#pragma unroll
                        for (int j = 0; j < 4; ++j) { v0[j] = sigmoidf_(v0[j]); v1[j] = sigmoidf_(v1[j]); } }
                    u32x4 w; w.x = cvt_pk_bf16(v0[0], v0[1]); w.y = cvt_pk_bf16(v0[2], v0[3]); w.z = cvt_pk_bf16(v1[0], v1[1]); w.w = cvt_pk_bf16(v1[2], v1[3]);
                    *(u32x4*)(rowp + bj * HALF) = w; } }
    }
};
struct EpiSwiglu {
    static constexpr bool PERM = true;
    bf16_t* O;
    __device__ __forceinline__ void operator()(const f32x4 (&acc)[2][2][4][2], const Unit& u, int wr, int wc, int fr, int fq) const {
        const int row0 = u.pm * BM + wr * 64 + fr, col0 = u.pn * 128 + wc * 32 + 8 * fq;
#pragma unroll
        for (int ai = 0; ai < 2; ++ai)
#pragma unroll
            for (int m = 0; m < 4; ++m) { bf16_t* rowp = O + (size_t)(row0 + ai * HALF + m * 16) * DFF + col0;
                const f32x4 a0 = acc[ai][0][m][0], a1 = acc[ai][0][m][1], b0 = acc[ai][1][m][0], b1 = acc[ai][1][m][1];
                float v[8];
#pragma unroll
                for (int j = 0; j < 4; ++j) { v[j] = siluf_(a0[j]) * b0[j]; v[4 + j] = siluf_(a1[j]) * b1[j]; }
                *(u32x4*)rowp = pack8(v); }
    }
};
struct EpiInProj {
    static constexpr bool PERM = true;
    unsigned char* ws;
    __device__ __forceinline__ void operator()(const f32x4 (&acc)[2][2][4][2], const Unit& u, int wr, int wc, int fr, int fq) const {
        const int row0 = u.pm * BM + wr * 64 + fr, pn = u.pn;
        if (pn == 18) {
            if (wc == 0 && fq < 2) { float* Lg = (float*)(ws + S_LOGIT);
#pragma unroll
                for (int ai = 0; ai < 2; ++ai)
#pragma unroll
                    for (int m = 0; m < 4; ++m) { float* rp = Lg + (size_t)(row0 + ai * HALF + m * 16) * 16 + 8 * fq; *(f32x4*)rp = acc[ai][0][m][0]; *(f32x4*)(rp + 4) = acc[ai][0][m][1]; } }
            return; }
        bf16_t* base; int ld, cb;
        if (pn < 4) { base = (bf16_t*)(ws + O_PQ); ld = 1024; cb = pn * 256; }
        else if (pn < 10) { base = (bf16_t*)(ws + O_SC); ld = 1536; cb = (pn - 4) * 256; }
        else if (pn < 16) { base = (bf16_t*)(ws + O_QKV); ld = 1536; cb = (pn - 10) * 256; }
        else { base = (bf16_t*)(ws + O_Z); ld = 512; cb = (pn - 16) * 256; }
        const int col0 = cb + wc * 32 + 8 * fq;
#pragma unroll
        for (int ai = 0; ai < 2; ++ai)
#pragma unroll
            for (int m = 0; m < 4; ++m) { bf16_t* rowp = base + (size_t)(row0 + ai * HALF + m * 16) * ld + col0;
#pragma unroll
                for (int bj = 0; bj < 2; ++bj) { const f32x4 v0 = acc[ai][bj][m][0], v1 = acc[ai][bj][m][1];
                    u32x4 w; w.x = cvt_pk_bf16(v0[0], v0[1]); w.y = cvt_pk_bf16(v0[2], v0[3]); w.z = cvt_pk_bf16(v1[0], v1[1]); w.w = cvt_pk_bf16(v1[2], v1[3]);
                    *(u32x4*)(rowp + bj * HALF) = w; } }
    }
};
struct EpiFourier {
    static constexpr bool PERM = true;
    bf16_t* FM; float sc;
    __device__ __forceinline__ void operator()(const f32x4 (&acc)[2][2][4][2], const Unit& u, int wr, int wc, int fr, int fq) const {
        const int row0 = u.pm * BM + wr * 64 + fr;
        const int colt = u.pn * BM;
        const int b = colt >> 13, k1 = (colt >> 9) & 15, ch0 = (colt & 511) + wc * 32 + 8 * fq;
#pragma unroll
        for (int ai = 0; ai < 2; ++ai)
#pragma unroll
            for (int m = 0; m < 4; ++m) { const int k2 = row0 + ai * HALF + m * 16;
                if (k2 < 257) { bf16_t* rowp = FM + (size_t)(b * LL + k1 + 16 * k2) * 512 + ch0;
#pragma unroll
                    for (int bj = 0; bj < 2; ++bj) { const f32x4 v0 = acc[ai][bj][m][0] * sc, v1 = acc[ai][bj][m][1] * sc;
                        u32x4 w; w.x = cvt_pk_bf16(v0[0], v0[1]); w.y = cvt_pk_bf16(v0[2], v0[3]); w.z = cvt_pk_bf16(v1[0], v1[1]); w.w = cvt_pk_bf16(v1[2], v1[3]);
                        *(u32x4*)(rowp + bj * HALF) = w; } } }
    }
};
struct EpiMerge {
    static constexpr bool PERM = true;
    const bf16_t* GATE; bf16_t* MG; bf16_t* MGB;
    __device__ __forceinline__ void operator()(const f32x4 (&acc)[2][2][4][2], const Unit& u, int wr, int wc, int fr, int fq) const {
        const int j = u.pm / 129, pm = u.pm - j * 129, pn = u.pn & 3;
        const int row0 = pm * BM + wr * 64 + fr, col0 = pn * BM + wc * 32 + 8 * fq;
        const bf16_t* mold = (j == 1 ? MG : MGB); bf16_t* mnew = (j == 1 ? MGB : MG);
#pragma unroll
        for (int ai = 0; ai < 2; ++ai) {
            u32x4 gv[4][2], ov[4][2];
#pragma unroll
            for (int m = 0; m < 4; ++m)
#pragma unroll
                for (int bj = 0; bj < 2; ++bj) { const size_t r = (size_t)(row0 + ai * HALF + m * 16);
                    gv[m][bj] = *(const u32x4*)(GATE + r * 3072 + j * 1024 + col0 + bj * HALF);
                    if (j > 0) ov[m][bj] = *(const u32x4*)(mold + r * 1024 + col0 + bj * HALF); }
#pragma unroll
            for (int m = 0; m < 4; ++m)
#pragma unroll
                for (int bj = 0; bj < 2; ++bj) { const size_t r = (size_t)(row0 + ai * HALF + m * 16);
                    float g[8], v[8]; unpack8(gv[m][bj], g);
                    const f32x4 v0 = acc[ai][bj][m][0], v1 = acc[ai][bj][m][1];
#pragma unroll
                    for (int e = 0; e < 4; ++e) { v[e] = v0[e] * g[e]; v[4 + e] = v1[e] * g[4 + e]; }
                    if (j > 0) { float o[8]; unpack8(ov[m][bj], o);
#pragma unroll
                        for (int e = 0; e < 8; ++e) v[e] += o[e]; }
                    *(u32x4*)(mnew + r * 1024 + col0 + bj * HALF) = pack8(v); }
            asm volatile("" ::: "memory"); }
    }
};
}

__device__ void rpass(const Params& P, const bf16_t* Y, bool first_h, const float* gpost, float scale, const float* gpre, bf16_t* XN) {
    const int tid_ = ltid(); const int wave = __builtin_amdgcn_readfirstlane(tid_ >> 6), lane = tid_ & 63;
    float* hm = (float*)(P.ws + S_HM);
    for (int r = lbid() * 8 + wave; r < TT; r += lgrid() * 8) {
        const int b = r / LL, n = r - b * LL;
        const float* hin; float* hout;
        if (n < NMETA) { hout = hm + (size_t)(b * 16 + n) * 1024; hin = first_h ? P.in[1] + (size_t)n * 1024 : hout; }
        else { const size_t o = ((size_t)b * SEQ + (n - NMETA)) * 1024; hout = P.out + o; hin = first_h ? P.in[0] + o : hout; }
        float h[16];
        { const f32x4 a = *(const f32x4*)(hin + lane * 8), b4 = *(const f32x4*)(hin + lane * 8 + 4), c = *(const f32x4*)(hin + 512 + lane * 8), d = *(const f32x4*)(hin + 512 + lane * 8 + 4);
#pragma unroll
          for (int e = 0; e < 4; ++e) { h[e] = a[e]; h[4 + e] = b4[e]; h[8 + e] = c[e]; h[12 + e] = d[e]; } }
        if (Y) {
            float y[16]; unpack8(*(const u32x4*)(Y + (size_t)r * 1024 + lane * 8), y); unpack8(*(const u32x4*)(Y + (size_t)r * 1024 + 512 + lane * 8), y + 8);
            float ss = 0.f;
#pragma unroll
            for (int e = 0; e < 16; ++e) ss += y[e] * y[e];
            ss = wave_sum(ss); const float r1 = rsqrtf(ss * (1.0f / 1024.0f) + EPS) * scale;
#pragma unroll
            for (int e = 0; e < 8; ++e) { h[e] += y[e] * r1 * gpost[lane * 8 + e]; h[8 + e] += y[8 + e] * r1 * gpost[512 + lane * 8 + e]; }
            *(f32x4*)(hout + lane * 8) = (f32x4){h[0], h[1], h[2], h[3]}; *(f32x4*)(hout + lane * 8 + 4) = (f32x4){h[4], h[5], h[6], h[7]};
            *(f32x4*)(hout + 512 + lane * 8) = (f32x4){h[8], h[9], h[10], h[11]}; *(f32x4*)(hout + 512 + lane * 8 + 4) = (f32x4){h[12], h[13], h[14], h[15]};
        }
        if (gpre) {
            float ss = 0.f;
#pragma unroll
            for (int e = 0; e < 16; ++e) ss += h[e] * h[e];
            ss = wave_sum(ss); const float r2 = rsqrtf(ss * (1.0f / 1024.0f) + EPS);
            float o[16];
#pragma unroll
            for (int e = 0; e < 8; ++e) { o[e] = h[e] * r2 * gpre[lane * 8 + e]; o[8 + e] = h[8 + e] * r2 * gpre[512 + lane * 8 + e]; }
            *(u32x4*)(XN + (size_t)r * 1024 + lane * 8) = pack8(o); *(u32x4*)(XN + (size_t)r * 1024 + 512 + lane * 8) = pack8(o + 8);
        }
    }
}

template <class F>
__device__ void cvt_tiles(const float* src, int ld_src, int K, bf16_t* dst, int nrows, F srccol, unsigned char* smem) {
    float* lds = (float*)smem; const int tid = ltid();
    const int ntr = nrows / 64, ntk = K / 64, nt_ = ntr * ntk, G_ = lgrid();
    float pv[8];
    { const int t = lbid(); if (t < nt_) { const int tr = t % ntr, tk = t / ntr; const int c0 = srccol(tr * 64);
#pragma unroll
        for (int i = 0; i < 8; ++i) { const int kk = (tid >> 6) + 8 * i, cc = tid & 63; pv[i] = src[(size_t)(tk * 64 + kk) * ld_src + c0 + cc]; } } }
    for (int t = lbid(); t < nt_; t += G_) {
        const int tr = t % ntr, tk = t / ntr;
        __syncthreads();
#pragma unroll
        for (int i = 0; i < 8; ++i) { const int kk = (tid >> 6) + 8 * i, cc = tid & 63; lds[kk * 65 + cc] = pv[i]; }
        __syncthreads();
        { const int t2 = t + G_; if (t2 < nt_) { const int tr2 = t2 % ntr, tk2 = t2 / ntr; const int c2 = srccol(tr2 * 64);
#pragma unroll
            for (int i = 0; i < 8; ++i) { const int kk = (tid >> 6) + 8 * i, cc = tid & 63; pv[i] = src[(size_t)(tk2 * 64 + kk) * ld_src + c2 + cc]; } } }
        const int cc2 = tid >> 3, k8 = (tid & 7) * 8; float v[8];
#pragma unroll
        for (int e = 0; e < 8; ++e) v[e] = lds[(k8 + e) * 65 + cc2];
        *(u32x4*)(dst + (size_t)(tr * 64 + cc2) * K + tk * 64 + k8) = pack8(v);
    }
}
struct ColIdent { int off; __device__ int operator()(int r) const { return r + off; } };
struct ColSwiglu { __device__ int operator()(int r) const { const int pn = r >> 8, rem = r & 255; return (rem >> 7) * DFF + 128 * pn + (rem & 127); } };

__device__ void convert_weights(const Params& P, int l, unsigned char* smem) {
    unsigned char* ws = P.ws; const int tid = ltid();
    cvt_tiles(P.in[3] + (size_t)l * 1024 * 5632, 5632, 1024, (bf16_t*)(ws + W_WI1), 5632, ColSwiglu{}, smem);
    cvt_tiles(P.in[4] + (size_t)l * 2816 * 1024, 1024, 2816, (bf16_t*)(ws + W_WO1), 1024, ColIdent{0}, smem);
    cvt_tiles(P.in[5] + (size_t)l * 1024 * 5632, 5632, 1024, (bf16_t*)(ws + W_WI2), 5632, ColSwiglu{}, smem);
    cvt_tiles(P.in[6] + (size_t)l * 2816 * 1024, 1024, 2816, (bf16_t*)(ws + W_WO2), 1024, ColIdent{0}, smem);
    const float* win = P.in[7] + (size_t)l * 1024 * NIN;
    cvt_tiles(win, NIN, 1024, (bf16_t*)(ws + W_WIN) + (size_t)1024 * 1024, 3584, ColIdent{512}, smem);
    cvt_tiles(win, NIN, 1024, (bf16_t*)(ws + W_WG), 3072, ColIdent{4112}, smem);
    cvt_tiles(P.in[13] + (size_t)l * 512 * 1024, 1024, 512, (bf16_t*)(ws + W_WBR), 1024, ColIdent{0}, smem);
    cvt_tiles(P.in[14] + (size_t)l * 512 * 1024, 1024, 512, (bf16_t*)(ws + W_WBR) + (size_t)1024 * 512, 1024, ColIdent{0}, smem);
    cvt_tiles(P.in[15] + (size_t)l * 512 * 1024, 1024, 512, (bf16_t*)(ws + W_WBR) + (size_t)2048 * 512, 1024, ColIdent{0}, smem);
    cvt_tiles(P.in[16] + (size_t)l * 1024 * 1024, 1024, 1024, (bf16_t*)(ws + W_WOUT), 1024, ColIdent{0}, smem);
    { bf16_t* d = (bf16_t*)(ws + W_WIN) + (size_t)4608 * 1024;
      for (int i = lbid() * 512 + tid; i < 256 * 1024; i += lgrid() * 512) { const int rr = i >> 10, k = i & 1023; d[i] = rr < 16 ? f2bf(win[(size_t)k * NIN + 4096 + rr]) : (bf16_t)0; } }
    { float* Ws = (float*)smem; float* ct = Ws + 64 * 65; float* st = ct + 64;
      __syncthreads();
      if (tid < 64) { float s, c; sincospif((float)tid * (2.0f / 64.0f), &s, &c); ct[tid] = c; st[tid] = s; }
      bf16_t* dp = (bf16_t*)(ws + W_WIN); bf16_t* dq = dp + (size_t)512 * 1024;
      for (int it = lbid(); it < 8 * 16; it += lgrid()) { const int g = it >> 4, kt = it & 15;
          __syncthreads();
#pragma unroll
          for (int i = 0; i < 8; ++i) { const int kk = (tid >> 6) + 8 * i, cc = tid & 63; Ws[kk * 65 + cc] = win[(size_t)(kt * 64 + kk) * NIN + g * 64 + cc]; }
          __syncthreads();
          const int kk = tid & 63;
#pragma unroll 1
          for (int i = 0; i < 8; ++i) { const int cp = (tid >> 6) + 8 * i; float ap = 0.f, aq = 0.f;
#pragma unroll 4
              for (int c = 0; c < 64; ++c) { const float w = Ws[kk * 65 + c]; const int ph = (c * cp) & 63; ap += w * ct[ph]; aq += w * st[ph]; }
              dp[(size_t)(g * 64 + cp) * 1024 + kt * 64 + kk] = f2bf(ap); dq[(size_t)(g * 64 + cp) * 1024 + kt * 64 + kk] = f2bf(aq); }
      }
      __syncthreads(); }
}

__device__ void gen_tables(const Params& P) {
    unsigned char* ws = P.ws; const int gt = lbid() * 512 + ltid(), gs = lgrid() * 512;
    bf16_t* C = (bf16_t*)(ws + S_C257);
    for (int i = gt; i < 512 * KF; i += gs) { const int k2 = i / KF, kk = i - k2 * KF; const int ri = kk >= 320, n2 = kk - ri * 320; float v = 0.f;
        if (k2 < 257 && n2 < 257) { const int m = (k2 * n2) % 257; float s, c; sincospif((float)m * (2.0f / 257.0f), &s, &c); v = ri ? s : c; }
        C[i] = f2bf(v); }
    float* tw = (float*)(ws + S_TWL);
    for (int i = gt; i < LL; i += gs) { float s, c; sincospif((float)i * (2.0f / (float)LL), &s, &c); tw[2 * i] = c; tw[2 * i + 1] = -s; }
}

__device__ void sconv_pass(const Params& P, int l) {
    const int tid_ = ltid(); const int wave = __builtin_amdgcn_readfirstlane(tid_ >> 6), lane = tid_ & 63;
    const bf16_t* SC = (const bf16_t*)(P.ws + O_SC); bf16_t* SCO = (bf16_t*)(P.ws + O_BR) + (size_t)TP * 512;
    const float* w = P.in[8] + (size_t)l * 3 * 512;
    float w0[8], w1[8], w2[8];
#pragma unroll
    for (int e = 0; e < 8; ++e) { w0[e] = w[lane * 8 + e]; w1[e] = w[512 + lane * 8 + e]; w2[e] = w[1024 + lane * 8 + e]; }
    for (int r = lbid() * 8 + wave; r < TT; r += lgrid() * 8) {
        const int b = r / LL, n = r - b * LL; const bf16_t* rp = SC + (size_t)r * 1536 + lane * 8;
        float bb[8], c[8], h[8], acc[8]; unpack8(*(const u32x4*)rp, bb); unpack8(*(const u32x4*)(rp + 512), c); unpack8(*(const u32x4*)(rp + 1024), h);
#pragma unroll
        for (int e = 0; e < 8; ++e) acc[e] = w1[e] * c[e] * h[e];
        if (n > 0) { unpack8(*(const u32x4*)(rp - 1536 + 512), c); unpack8(*(const u32x4*)(rp - 1536 + 1024), h);
#pragma unroll
            for (int e = 0; e < 8; ++e) acc[e] += w0[e] * c[e] * h[e]; }
        if (n < LL - 1) { unpack8(*(const u32x4*)(rp + 1536 + 512), c); unpack8(*(const u32x4*)(rp + 1536 + 1024), h);
#pragma unroll
            for (int e = 0; e < 8; ++e) acc[e] += w2[e] * c[e] * h[e]; }
#pragma unroll
        for (int e = 0; e < 8; ++e) acc[e] *= bb[e];
        *(u32x4*)(SCO + (size_t)r * 512 + lane * 8) = pack8(acc);
    }
}

__device__ void fstep1(const Params& P, unsigned char* smem) {
    const int tid = ltid(), wave = __builtin_amdgcn_readfirstlane(tid >> 6), lane = tid & 63;
    const bf16_t* PQ = (const bf16_t*)(P.ws + O_PQ); bf16_t* AP = (bf16_t*)(P.ws + O_AP); const float* tw = (const float*)(P.ws + S_TWL);
    bf16_t* St = (bf16_t*)smem;
    for (int it = lbid(); it < 8 * 4 * 17; it += lgrid()) {
        const int b = it / 68, rem = it - b * 68, cht = rem / 17, n2t = rem - cht * 17;
        __syncthreads();
#pragma unroll 1
        for (int sub = 0; sub < 2; ++sub) {
            const int n2l = sub * 8 + wave, n2 = n2t * 16 + n2l;
            const int fr = lane & 15, fq = lane >> 4;
            if (n2 < 257) {
                float f0[8], f1[8];
#pragma unroll
                for (int j = 0; j < 8; ++j) { const int n = 257 * (8 * (fq & 1) + j) + n2; const int ph = (fr * n) % LL;
                    const float c_ = __hip_atomic_load(tw + 2 * ph, __ATOMIC_RELAXED, __HIP_MEMORY_SCOPE_AGENT), ms_ = __hip_atomic_load(tw + 2 * ph + 1, __ATOMIC_RELAXED, __HIP_MEMORY_SCOPE_AGENT);
                    f0[j] = (fq < 2) ? c_ : ms_; f1[j] = (fq < 2) ? ms_ : -c_; }
                const bf16x8 a0 = __builtin_bit_cast(bf16x8, pack8(f0)), a1 = __builtin_bit_cast(bf16x8, pack8(f1));
                const bf16_t* bp = PQ + (size_t)(b * LL + 257 * 8 * (fq & 1) + n2) * 1024 + (fq >> 1) * 512 + cht * 128 + fr;
#pragma unroll
                for (int ct = 0; ct < 8; ++ct) {
                    bf16x8 bf;
#pragma unroll
                    for (int j = 0; j < 8; ++j) bf[j] = (short)bp[(size_t)j * 257 * 1024 + ct * 16];
                    const f32x4 z = {0.f, 0.f, 0.f, 0.f};
                    const f32x4 c0 = __builtin_amdgcn_mfma_f32_16x16x32_bf16(a0, bf, z, 0, 0, 0), c1 = __builtin_amdgcn_mfma_f32_16x16x32_bf16(a1, bf, z, 0, 0, 0);
                    bf16_t* sp = St + ((4 * fq) * 128 + ct * 16 + fr) * 32 + n2l;
#pragma unroll
                    for (int rg = 0; rg < 4; ++rg) { sp[rg * 4096] = f2bf(c0[rg]); sp[rg * 4096 + 16] = f2bf(c1[rg]); }
                }
            } else {
                for (int q = lane; q < 4096; q += 64) St[q * 16 + n2l] = 0;
            }
        }
        __syncthreads();
#pragma unroll 2
        for (int q = tid; q < 8192; q += 512) { const int half = q & 1, ri = (q >> 1) & 1, chl = (q >> 2) & 127, k1 = q >> 9;
            const int n2c = n2t * 16 + half * 8;
            if (n2c < 320) { const u32x4 v = *(const u32x4*)(St + (size_t)q * 8);
                *(u32x4*)(AP + ((size_t)((b * 16 + k1) * 512 + cht * 128 + chl)) * KF + ri * 320 + n2c) = v; } }
        if (n2t == 16) {
            for (int q = tid; q < 16 * 128 * 2 * 6; q += 512) { const int c6 = q % 6, r2 = q / 6, ri = r2 & 1, chl = (r2 >> 1) & 127, k1 = r2 >> 8;
                *(u32x4*)(AP + ((size_t)((b * 16 + k1) * 512 + cht * 128 + chl)) * KF + ri * 320 + 272 + c6 * 8) = (u32x4){0u, 0u, 0u, 0u}; } }
    }
    __syncthreads();
}

#ifdef DBG_SEC
#define SEC_T(k) do { if (lbid() == 0 && tid == 0) { const unsigned long long _n = __builtin_amdgcn_s_memrealtime(); if (sec_prev_k == DBG_SEC) *(unsigned long long*)(smem + LDS_BYTES - 32) += _n - sec_prev_t; sec_prev_t = _n; sec_prev_k = (k); } } while (0)
#else
#define SEC_T(k) do {} while (0)
#endif
__device__ void dn_prep(const Params& P, int l, unsigned char* smem, int t0, int t1) {
#ifdef DBG_SEC
    unsigned long long sec_prev_t = __builtin_amdgcn_s_memrealtime(); int sec_prev_k = -1;
#endif
    const int tid = ltid(), wave = __builtin_amdgcn_readfirstlane(tid >> 6), lane = tid & 63, fr = lane & 15, fq = lane >> 4;
    unsigned char* ws = P.ws;
    const bf16_t* QKV = (const bf16_t*)(ws + O_QKV); const float* LG = (const float*)(ws + S_LOGIT);
    bf16_t* WP = (bf16_t*)(ws + O_WP); bf16_t* QP = (bf16_t*)(ws + O_QP); bf16_t* KD = (bf16_t*)(ws + O_KD); bf16_t* UF = (bf16_t*)(ws + O_UF); bf16_t* AT = (bf16_t*)(ws + O_AT);
    float* GL = (float*)(ws + S_GL);
    const float* cw = P.in[9] + (size_t)l * 3 * 1536;
    bf16_t* Qs = (bf16_t*)smem;
    bf16_t* Ks = Qs + 64 * 136;
    bf16_t* KT = Ks + 64 * 136;
    bf16_t* VT = KT + 128 * 72;
    bf16_t* T1 = VT + 128 * 72;
    bf16_t* T2 = T1 + 64 * 72;
    bf16_t* Rm = T2 + 64 * 72;
    bf16_t* Rt = Rm + 64 * 72;
    bf16_t* Pm = Rt + 64 * 72;
    float* gcs = (float*)(T2 + 64 * 72 + 2 * 64 * 68 * 2);
    float* bts = gcs + 64;
    float* cwl = bts + 64;
    bf16_t* Xr = T1;
    const int items = (t1 - t0) * 64;
    u32x4 x0[6], xb;
#define PREP_ISSUE(it_) do { const int _tl = (it_) >> 6, _bhd = (it_) & 63, _b = _bhd >> 3, _h = (_bhd >> 1) & 3, _dir = _bhd & 1; const int _nb = (_dir ? 64 - (t0 + _tl) : (t0 + _tl)) * 64 - 48; const u32x4 z4 = {0u, 0u, 0u, 0u}; \
        _Pragma("unroll") for (int rr = 0; rr < 6; ++rr) { const int task = tid + 512 * rr, i = task / 48, cg_ = task - i * 48; const int n = _nb + (_dir ? 63 - i : i); \
            x0[rr] = (n >= 0) ? *(const u32x4*)(QKV + (size_t)(_b * LL + n) * 1536 + (cg_ >> 4) * 512 + _h * 128 + (cg_ & 15) * 8) : z4; } \
        xb = z4; if (tid < 96) { const int which = tid / 48, cg_ = tid - which * 48; const int n = which ? _nb + 64 : _nb - 1; \
            if (n >= 0 && n < LL) xb = *(const u32x4*)(QKV + (size_t)(_b * LL + n) * 1536 + (cg_ >> 4) * 512 + _h * 128 + (cg_ & 15) * 8); } } while (0)
    for (int it = lbid(); it < items; it += lgrid()) {
        const int tl = it >> 6, bhd = it & 63, b = bhd >> 3, h = (bhd >> 1) & 3, dir = bhd & 1;
        const int t = t0 + tl, c = dir ? 64 - t : t; const size_t slot = (size_t)tl * 64 + bhd;
        PREP_ISSUE(it);
        __syncthreads();
        SEC_T(0);
        for (int q = tid; q < 1152; q += 512) { const int tap = q / 384, rem = q - tap * 384; cwl[q] = cw[tap * 1536 + (rem >> 7) * 512 + h * 128 + (rem & 127)]; }
#pragma unroll
        for (int rr = 0; rr < 6; ++rr) { const int task = tid + 512 * rr, i = task / 48, cg_ = task - i * 48; *(u32x4*)(Xr + ((dir ? 63 - i : i) + 1) * 384 + cg_ * 8) = x0[rr]; }
        if (tid < 96) { const int which = tid / 48, cg_ = tid - which * 48; *(u32x4*)(Xr + (which ? 65 : 0) * 384 + cg_ * 8) = xb; }
        __syncthreads();
#pragma unroll 1
        for (int rr = 0; rr < 6; ++rr) {
            const int task = tid + 512 * rr, i = task / 48, cg_ = task - i * 48, kind = cg_ >> 4, cgl = cg_ & 15;
            float v[8], x[8];
            const float* w1 = cwl + 384 + kind * 128 + cgl * 8;
            const bf16_t* xr = Xr + ((dir ? 63 - i : i) + 1) * 384 + cg_ * 8;
            unpack8(*(const u32x4*)xr, x);
#pragma unroll
            for (int e = 0; e < 8; ++e) v[e] = w1[e] * x[e];
            unpack8(*(const u32x4*)(xr - 384), x);
#pragma unroll
            for (int e = 0; e < 8; ++e) v[e] += w1[e - 384] * x[e];
            unpack8(*(const u32x4*)(xr + 384), x);
#pragma unroll
            for (int e = 0; e < 8; ++e) v[e] += w1[e + 384] * x[e];
#pragma unroll
            for (int e = 0; e < 8; ++e) v[e] = siluf_(v[e]);
            float ss = 0.f;
#pragma unroll
            for (int e = 0; e < 8; ++e) ss += v[e] * v[e];
            ss += __shfl_xor(ss, 1); ss += __shfl_xor(ss, 2); ss += __shfl_xor(ss, 4); ss += __shfl_xor(ss, 8);
            if (kind < 2) { const float inv = rsqrtf(ss + EPS) * (kind == 0 ? 0.08838834764831845f : 1.0f);
#pragma unroll
                for (int e = 0; e < 8; ++e) v[e] *= inv; }
            const u32x4 pk = pack8(v);
            const int isw = i ^ ((cgl & 7) << 3);
            if (kind == 0) *(u32x4*)(Qs + i * 136 + cgl * 8) = pk;
            else if (kind == 1) { *(u32x4*)(Ks + i * 136 + cgl * 8) = pk;
#pragma unroll
                for (int e = 0; e < 8; ++e) KT[(cgl * 8 + e) * 72 + isw] = f2bf(v[e]); }
            else {
#pragma unroll
                for (int e = 0; e < 8; ++e) VT[(cgl * 8 + e) * 72 + isw] = f2bf(v[e]); }
        }
        if (wave == 0) {
            const int i = lane, n = c * 64 + (dir ? 63 - i : i) - 48; float beta = 0.f, g = 0.f;
            if (n >= 0) { const float* lg = LG + (size_t)(b * LL + n) * 16; const float bl = lg[dir * 4 + h], al = lg[8 + dir * 4 + h];
                beta = 1.0f / (1.0f + expf(-bl));
                const float xx = al + P.in[11][l * 8 + dir * 4 + h]; const float sp = xx > 20.f ? xx : log1pf(expf(xx));
                g = -expf(P.in[10][l * 8 + dir * 4 + h]) * sp; }
#pragma unroll
            for (int o = 1; o < 64; o <<= 1) { const float tt = __shfl_up(g, o); if (lane >= o) g += tt; }
            gcs[i] = g; bts[i] = beta;
        }
        __syncthreads();
        SEC_T(1);
        if (wave < 4) {
            const int m = wave; f32x4 acc[4];
#pragma unroll
            for (int n = 0; n < 4; ++n) acc[n] = (f32x4){0.f, 0.f, 0.f, 0.f};
#pragma unroll
            for (int s = 0; s < 4; ++s) { const bf16x8 a = *(const bf16x8*)(Ks + (16 * m + fr) * 136 + 32 * s + 8 * fq);
#pragma unroll
                for (int n = 0; n < 4; ++n) { const bf16x8 bb = *(const bf16x8*)(Ks + (16 * n + fr) * 136 + 32 * s + 8 * fq); acc[n] = __builtin_amdgcn_mfma_f32_16x16x32_bf16(a, bb, acc[n], 0, 0, 0); } }
#pragma unroll
            for (int n = 0; n < 4; ++n) { const int i = 16 * n + fr, j0 = 16 * m + 4 * fq;
                float nv[4], pv_[4];
#pragma unroll
                for (int rg = 0; rg < 4; ++rg) { const int j = j0 + rg; const float mv = (i > j) ? bts[i] * acc[n][rg] * __expf(gcs[i] - gcs[j]) : 0.f;
                    nv[rg] = -mv; pv_[rg] = (i == j ? 1.f : 0.f) - mv; Rt[j * 72 + i] = f2bf(-mv); }
                u32x2 w; w.x = cvt_pk_bf16(nv[0], nv[1]); w.y = cvt_pk_bf16(nv[2], nv[3]); *(u32x2*)(Rm + i * 72 + j0) = w;
                w.x = cvt_pk_bf16(pv_[0], pv_[1]); w.y = cvt_pk_bf16(pv_[2], pv_[3]); *(u32x2*)(Pm + i * 72 + j0) = w; }
        } else {
            const int m = wave - 4; f32x4 acc[4];
#pragma unroll
            for (int n = 0; n < 4; ++n) acc[n] = (f32x4){0.f, 0.f, 0.f, 0.f};
#pragma unroll
            for (int s = 0; s < 4; ++s) { const bf16x8 qf = *(const bf16x8*)(Qs + (16 * m + fr) * 136 + 32 * s + 8 * fq);
#pragma unroll
                for (int n = 0; n < 4; ++n) { const bf16x8 kf = *(const bf16x8*)(Ks + (16 * n + fr) * 136 + 32 * s + 8 * fq); acc[n] = __builtin_amdgcn_mfma_f32_16x16x32_bf16(kf, qf, acc[n], 0, 0, 0); } }
            const int i = 16 * m + fr; const float gi = gcs[i];
#pragma unroll
            for (int s2 = 0; s2 < 2; ++s2) { float v[8];
#pragma unroll
                for (int e = 0; e < 8; ++e) { const int j = 32 * s2 + 16 * (e >> 2) + 4 * fq + (e & 3); v[e] = (i >= j) ? acc[2 * s2 + (e >> 2)][e & 3] * __expf(gi - gcs[j]) : 0.f; }
                *(u32x4*)(AT + slot * 4096 + i * 64 + (((4 * s2 + fq) ^ ((i >> 1) & 7)) << 3)) = pack8(v); }
        }
        __syncthreads();
        SEC_T(2);
        {
            const float glast = gcs[63];
            for (int task = tid; task < 2048; task += 512) {
                if (task < 1024) { const int i = task >> 4, s_ = (task >> 2) & 3, f4 = task & 3; const float sc = __expf(gcs[i]);
                    const u32x2 a = *(const u32x2*)(Qs + i * 136 + 32 * s_ + 4 * f4), bq = *(const u32x2*)(Qs + i * 136 + 32 * s_ + 16 + 4 * f4);
                    float v[8]; v[0] = bf2f(a.x & 0xffffu) * sc; v[1] = __uint_as_float(a.x & 0xffff0000u) * sc; v[2] = bf2f(a.y & 0xffffu) * sc; v[3] = __uint_as_float(a.y & 0xffff0000u) * sc;
                    v[4] = bf2f(bq.x & 0xffffu) * sc; v[5] = __uint_as_float(bq.x & 0xffff0000u) * sc; v[6] = bf2f(bq.y & 0xffffu) * sc; v[7] = __uint_as_float(bq.y & 0xffff0000u) * sc;
                    *(u32x4*)(QP + slot * 8192 + i * 128 + (((4 * s_ + f4) ^ (i & 15)) << 3)) = pack8(v);
                } else { const int tt = task - 1024, dk = tt >> 3, s2 = (tt >> 2) & 1, f4 = tt & 3; const int i0 = 32 * s2 + 4 * f4;
                    const int sw = ((dk >> 3) & 7) << 3; const u32x2 a = *(const u32x2*)(KT + dk * 72 + (i0 ^ sw)), bq = *(const u32x2*)(KT + dk * 72 + ((i0 + 16) ^ sw));
                    float v[8]; v[0] = bf2f(a.x & 0xffffu) * __expf(glast - gcs[i0]); v[1] = __uint_as_float(a.x & 0xffff0000u) * __expf(glast - gcs[i0 + 1]);
                    v[2] = bf2f(a.y & 0xffffu) * __expf(glast - gcs[i0 + 2]); v[3] = __uint_as_float(a.y & 0xffff0000u) * __expf(glast - gcs[i0 + 3]);
                    v[4] = bf2f(bq.x & 0xffffu) * __expf(glast - gcs[i0 + 16]); v[5] = __uint_as_float(bq.x & 0xffff0000u) * __expf(glast - gcs[i0 + 17]);
                    v[6] = bf2f(bq.y & 0xffffu) * __expf(glast - gcs[i0 + 18]); v[7] = __uint_as_float(bq.y & 0xffff0000u) * __expf(glast - gcs[i0 + 19]);
                    *(u32x4*)(KD + slot * 8192 + dk * 64 + (((4 * s2 + f4) ^ ((dk >> 1) & 7)) << 3)) = pack8(v); }
            }
            if (tid == 0) GL[slot] = __expf(glast);
            f32x4 accP[2];
#pragma unroll
            for (int e = 0; e < 2; ++e) { const int tt = 2 * wave + e, it_ = tt >> 2, jt = tt & 3;
                const u32x2 pw = *(const u32x2*)(Pm + (16 * it_ + fr) * 72 + 16 * jt + 4 * fq);
                accP[e] = (f32x4){__uint_as_float(pw.x << 16), __uint_as_float(pw.x & 0xffff0000u), __uint_as_float(pw.y << 16), __uint_as_float(pw.y & 0xffff0000u)}; }
#pragma unroll 1
            for (int rd = 0; rd < 6; ++rd) {
                f32x4 accR[2], accT[2];
#pragma unroll
                for (int e = 0; e < 2; ++e) { const int tt = 2 * wave + e, mt = tt >> 2, nt = tt & 3;
                    accR[e] = (f32x4){0.f, 0.f, 0.f, 0.f}; accT[e] = (f32x4){0.f, 0.f, 0.f, 0.f};
#pragma unroll
                    for (int s2 = 0; s2 < 2; ++s2) {
                        const bf16x8 rm = *(const bf16x8*)(Rm + (16 * mt + fr) * 72 + 32 * s2 + 8 * fq), rn = *(const bf16x8*)(Rm + (16 * nt + fr) * 72 + 32 * s2 + 8 * fq);
                        const bf16x8 tm = *(const bf16x8*)(Rt + (16 * mt + fr) * 72 + 32 * s2 + 8 * fq), tn = *(const bf16x8*)(Rt + (16 * nt + fr) * 72 + 32 * s2 + 8 * fq);
                        const bf16x8 pm_ = *(const bf16x8*)(Pm + (16 * mt + fr) * 72 + 32 * s2 + 8 * fq);
                        if (rd < 5) { accR[e] = __builtin_amdgcn_mfma_f32_16x16x32_bf16(rm, tn, accR[e], 0, 0, 0);
                                      accT[e] = __builtin_amdgcn_mfma_f32_16x16x32_bf16(tm, rn, accT[e], 0, 0, 0); }
                        if (rd > 0) accP[e] = __builtin_amdgcn_mfma_f32_16x16x32_bf16(tn, pm_, accP[e], 0, 0, 0);
                    } }
                __syncthreads();
                if (rd < 5) {
#pragma unroll
                    for (int e = 0; e < 2; ++e) { const int tt = 2 * wave + e, mt = tt >> 2, nt = tt & 3; u32x2 w;
                        w.x = cvt_pk_bf16(accR[e][0], accR[e][1]); w.y = cvt_pk_bf16(accR[e][2], accR[e][3]); *(u32x2*)(Rt + (16 * nt + fr) * 72 + 16 * mt + 4 * fq) = w;
                        w.x = cvt_pk_bf16(accT[e][0], accT[e][1]); w.y = cvt_pk_bf16(accT[e][2], accT[e][3]); *(u32x2*)(Rm + (16 * nt + fr) * 72 + 16 * mt + 4 * fq) = w;
                        if (rd > 0) { w.x = cvt_pk_bf16(accP[e][0], accP[e][1]); w.y = cvt_pk_bf16(accP[e][2], accP[e][3]); *(u32x2*)(Pm + (16 * mt + fr) * 72 + 16 * nt + 4 * fq) = w; } }
                    __syncthreads();
                }
            }
#pragma unroll
            for (int e = 0; e < 2; ++e) { const int tt = 2 * wave + e, mt = tt >> 2, nt = tt & 3; const int i = 16 * mt + fr, c0 = 16 * nt + 4 * fq; float v1[4], v2[4];
#pragma unroll
                for (int rg = 0; rg < 4; ++rg) { const float bc = bts[c0 + rg]; v1[rg] = accP[e][rg] * bc; v2[rg] = -accP[e][rg] * bc * __expf(gcs[c0 + rg]); }
                u32x2 w; w.x = cvt_pk_bf16(v1[0], v1[1]); w.y = cvt_pk_bf16(v1[2], v1[3]); *(u32x2*)(T1 + i * 72 + c0) = w;
                w.x = cvt_pk_bf16(v2[0], v2[1]); w.y = cvt_pk_bf16(v2[2], v2[3]); *(u32x2*)(T2 + i * 72 + c0) = w; }
        }
        __syncthreads();
        SEC_T(3);
#pragma unroll 1
        for (int nh = 0; nh < 2; ++nh) {
        if (wave < 4) {
            const int m = wave; f32x4 acc[4];
#pragma unroll
            for (int n = 0; n < 4; ++n) acc[n] = (f32x4){0.f, 0.f, 0.f, 0.f};
#pragma unroll
            for (int s2 = 0; s2 < 2; ++s2) { const bf16x8 a = *(const bf16x8*)(T1 + (16 * m + fr) * 72 + 32 * s2 + 8 * fq);
#pragma unroll
                for (int n = 0; n < 4; ++n) { const int d = 16 * (4 * nh + n) + fr; const bf16x8 bb = *(const bf16x8*)(VT + d * 72 + ((32 * s2 + 8 * fq) ^ (((d >> 3) & 7) << 3))); acc[n] = __builtin_amdgcn_mfma_f32_16x16x32_bf16(a, bb, acc[n], 0, 0, 0); } }
#pragma unroll
            for (int n = 0; n < 4; ++n) { u32x2 w; w.x = cvt_pk_bf16(acc[n][0], acc[n][1]); w.y = cvt_pk_bf16(acc[n][2], acc[n][3]);
                *(u32x2*)(UF + slot * 8192 + (((4 * nh + n) * 4 + m) * 64 + lane) * 4) = w; }
        } else {
            const int m = wave - 4; f32x4 acc[4];
#pragma unroll
            for (int n = 0; n < 4; ++n) acc[n] = (f32x4){0.f, 0.f, 0.f, 0.f};
#pragma unroll
            for (int s2 = 0; s2 < 2; ++s2) { const bf16x8 tf = *(const bf16x8*)(T2 + (16 * m + fr) * 72 + 32 * s2 + 8 * fq);
#pragma unroll
                for (int n = 0; n < 4; ++n) { const int d = 16 * (4 * nh + n) + fr; const bf16x8 kf = *(const bf16x8*)(KT + d * 72 + ((32 * s2 + 8 * fq) ^ (((d >> 3) & 7) << 3))); acc[n] = __builtin_amdgcn_mfma_f32_16x16x32_bf16(kf, tf, acc[n], 0, 0, 0); } }
            const int i = 16 * m + fr;
#pragma unroll
            for (int s = 0; s < 2; ++s) { u32x4 w; w.x = cvt_pk_bf16(acc[2 * s][0], acc[2 * s][1]); w.y = cvt_pk_bf16(acc[2 * s][2], acc[2 * s][3]);
                w.z = cvt_pk_bf16(acc[2 * s + 1][0], acc[2 * s + 1][1]); w.w = cvt_pk_bf16(acc[2 * s + 1][2], acc[2 * s + 1][3]);
                *(u32x4*)(WP + slot * 8192 + i * 128 + (((4 * (2 * nh + s) + fq) ^ (i & 15)) << 3)) = w; }
        }
        }
        SEC_T(4);
    }
    __syncthreads();
}

__device__ void dn_scan(const Params& P, unsigned char* smem, int t0, int t1) {
    if (lbid() >= 128) return;
    const int bhd = lbid() >> 1, half = lbid() & 1;
    const int tid = ltid(), wave = __builtin_amdgcn_readfirstlane(tid >> 6), lane = tid & 63, fr = lane & 15, fq = lane >> 4;
    unsigned char* ws = P.ws;
    const unsigned char* WPb = ws + O_WP; const unsigned char* QPb = ws + O_QP; const unsigned char* KDb = ws + O_KD; const unsigned char* ATb = ws + O_AT;
    const bf16_t* UF = (const bf16_t*)(ws + O_UF); const float* GL = (const float*)(ws + S_GL);
    bf16_t* OO = (bf16_t*)(ws + O_O); f32x4* SS = (f32x4*)(ws + S_SSAVE);
    const int b = bhd >> 3, h = (bhd >> 1) & 3, dir = bhd & 1;
    LAS unsigned char* lds = (LAS unsigned char*)smem;
    constexpr int BUFB = 57344;
#define SCAN_SRC(q_, slot_) ((q_) < 16 ? WPb + (slot_) * 16384 + (q_) * 1024 : (q_) < 32 ? QPb + (slot_) * 16384 + ((q_) - 16) * 1024 : (q_) < 48 ? KDb + (slot_) * 16384 + ((q_) - 32) * 1024 : ATb + (slot_) * 8192 + ((q_) - 48) * 1024)
#define SCAN_LOAD(tl_) do { const size_t _slot = (size_t)(tl_) * 64 + bhd; _Pragma("unroll") for (int _k = 0; _k < 14; ++_k) { const int _q = (wave - 4) * 14 + _k; rg_[_k] = *(const u32x4*)(SCAN_SRC(_q, _slot) + lane * 16); } } while (0)
#define SCAN_WRITE(buf_) do { _Pragma("unroll") for (int _k = 0; _k < 14; ++_k) { const int _q = (wave - 4) * 14 + _k; *(LAS u32x4*)(lds + (buf_) * BUFB + _q * 1024 + lane * 16) = rg_[_k]; } } while (0)
    constexpr int NN = 1; const bool cw_ = wave < 4; const int sl0 = half * 4 + (wave & 3);
    const int nst = t1 - t0;
    if (!cw_) {
        u32x4 rg_[14];
#define SCAN_LOAD(tl_) do { const size_t _slot = (size_t)(tl_) * 64 + bhd; _Pragma("unroll") for (int _k = 0; _k < 14; ++_k) { const int _q = (wave - 4) * 14 + _k; rg_[_k] = *(const u32x4*)(SCAN_SRC(_q, _slot) + lane * 16); } } while (0)
#define SCAN_WRITE(buf_) do { _Pragma("unroll") for (int _k = 0; _k < 14; ++_k) { const int _q = (wave - 4) * 14 + _k; *(LAS u32x4*)(lds + (buf_) * BUFB + _q * 1024 + lane * 16) = rg_[_k]; } } while (0)
        SCAN_LOAD(0); SCAN_WRITE(0); if (nst > 1) SCAN_LOAD(1);
#pragma unroll 1
        for (int tl = 0; tl < nst; ++tl) {
            __syncthreads();
            if (tl + 1 < nst) { SCAN_WRITE((tl + 1) & 1); if (tl + 2 < nst) SCAN_LOAD(tl + 2); }
        }
        asm volatile("s_waitcnt vmcnt(0)" ::: "memory");
        __syncthreads();
        return;
    }
    f32x4 S[8][NN];
#pragma unroll
    for (int t = 0; t < 8; ++t)
#pragma unroll
        for (int nn = 0; nn < NN; ++nn) S[t][nn] = (t0 == 0 || !cw_) ? (f32x4){0.f, 0.f, 0.f, 0.f} : SS[((size_t)(bhd * 8 + sl0 + nn) * 8 + t) * 64 + lane];
    u32x2 un[4][NN];
    if (cw_) {
#pragma unroll
        for (int m = 0; m < 4; ++m)
#pragma unroll
            for (int nn = 0; nn < NN; ++nn) un[m][nn] = *(const u32x2*)(UF + (size_t)bhd * 8192 + (((sl0 + nn) * 4 + m) * 64 + lane) * 4); }
    float gln = __hip_atomic_load(GL + bhd, __ATOMIC_RELAXED, __HIP_MEMORY_SCOPE_AGENT);
#pragma unroll 1
    for (int tl = 0; tl < nst; ++tl) {
        const size_t slot = (size_t)tl * 64 + bhd; const int t = t0 + tl, c = dir ? 64 - t : t;
        const LAS unsigned char* bw = lds + (tl & 1) * BUFB;
        __syncthreads();
        f32x4 av[4][NN], ao[4][NN];
#pragma unroll
        for (int m = 0; m < 4; ++m)
#pragma unroll
            for (int nn = 0; nn < NN; ++nn) { const u32x2 u = un[m][nn];
                av[m][nn] = (f32x4){__uint_as_float(u.x << 16), __uint_as_float(u.x & 0xffff0000u), __uint_as_float(u.y << 16), __uint_as_float(u.y & 0xffff0000u)}; ao[m][nn] = (f32x4){0.f, 0.f, 0.f, 0.f}; }
        const float gl = gln; if (tl + 1 < nst) gln = __hip_atomic_load(GL + slot + 64, __ATOMIC_RELAXED, __HIP_MEMORY_SCOPE_AGENT);
        if (tl + 1 < nst) {
#pragma unroll
            for (int m = 0; m < 4; ++m)
#pragma unroll
                for (int nn = 0; nn < NN; ++nn) un[m][nn] = *(const u32x2*)(UF + (slot + 64) * 8192 + (((sl0 + nn) * 4 + m) * 64 + lane) * 4); }
#pragma unroll
        for (int s = 0; s < 4; ++s) { bf16x8 Sb[NN];
#pragma unroll
            for (int nn = 0; nn < NN; ++nn) { u32x4 w; w.x = cvt_pk_bf16(S[2 * s][nn][0], S[2 * s][nn][1]); w.y = cvt_pk_bf16(S[2 * s][nn][2], S[2 * s][nn][3]); w.z = cvt_pk_bf16(S[2 * s + 1][nn][0], S[2 * s + 1][nn][1]); w.w = cvt_pk_bf16(S[2 * s + 1][nn][2], S[2 * s + 1][nn][3]);
                Sb[nn] = __builtin_bit_cast(bf16x8, w); }
#pragma unroll
            for (int m = 0; m < 4; ++m) { const bf16x8 wf = *(const LAS bf16x8*)(bw + (16 * m + fr) * 256 + (((4 * s + fq) ^ fr) << 4)); const bf16x8 qf = *(const LAS bf16x8*)(bw + 16384 + (16 * m + fr) * 256 + (((4 * s + fq) ^ fr) << 4));
                _Pragma("unroll") for (int nn = 0; nn < NN; ++nn) av[m][nn] = __builtin_amdgcn_mfma_f32_16x16x32_bf16(wf, Sb[nn], av[m][nn], 0, 0, 0);
                _Pragma("unroll") for (int nn = 0; nn < NN; ++nn) ao[m][nn] = __builtin_amdgcn_mfma_f32_16x16x32_bf16(qf, Sb[nn], ao[m][nn], 0, 0, 0); } }
        __builtin_amdgcn_sched_barrier(0);
        bf16x8 Vb[2][NN];
#pragma unroll
        for (int s2 = 0; s2 < 2; ++s2)
#pragma unroll
            for (int nn = 0; nn < NN; ++nn) { u32x4 w; w.x = cvt_pk_bf16(av[2 * s2][nn][0], av[2 * s2][nn][1]); w.y = cvt_pk_bf16(av[2 * s2][nn][2], av[2 * s2][nn][3]); w.z = cvt_pk_bf16(av[2 * s2 + 1][nn][0], av[2 * s2 + 1][nn][1]); w.w = cvt_pk_bf16(av[2 * s2 + 1][nn][2], av[2 * s2 + 1][nn][3]);
                Vb[s2][nn] = __builtin_bit_cast(bf16x8, w); }
#pragma unroll
        for (int m = 0; m < 4; ++m)
#pragma unroll
            for (int s2 = 0; s2 < 2; ++s2) { const int row = 16 * m + fr; const bf16x8 af = *(const LAS bf16x8*)(bw + 49152 + row * 128 + (((4 * s2 + fq) ^ ((row >> 1) & 7)) << 4));
                _Pragma("unroll") for (int nn = 0; nn < NN; ++nn) ao[m][nn] = __builtin_amdgcn_mfma_f32_16x16x32_bf16(af, Vb[s2][nn], ao[m][nn], 0, 0, 0); }
        __builtin_amdgcn_sched_barrier(0);
#pragma unroll
        for (int tt = 0; tt < 8; ++tt) { _Pragma("unroll") for (int nn = 0; nn < NN; ++nn) S[tt][nn] = S[tt][nn] * gl;
#pragma unroll
            for (int s2 = 0; s2 < 2; ++s2) { const int row = 16 * tt + fr; const bf16x8 kf = *(const LAS bf16x8*)(bw + 32768 + row * 128 + (((4 * s2 + fq) ^ ((row >> 1) & 7)) << 4));
                _Pragma("unroll") for (int nn = 0; nn < NN; ++nn) S[tt][nn] = __builtin_amdgcn_mfma_f32_16x16x32_bf16(kf, Vb[s2][nn], S[tt][nn], 0, 0, 0); } }
#pragma unroll
        for (int m = 0; m < 4; ++m)
#pragma unroll
            for (int rg = 0; rg < 4; ++rg) { const int i = 16 * m + 4 * fq + rg, n = c * 64 + (dir ? 63 - i : i) - 48;
                if (n >= 0) { bf16_t* op = OO + ((size_t)dir * TP + (size_t)b * LL + n) * 512 + h * 128 + sl0 * 16 + fr; _Pragma("unroll") for (int nn = 0; nn < NN; ++nn) op[16 * nn] = f2bf(ao[m][nn][rg]); } }
    }
#undef SCAN_SRC
#undef SCAN_LOAD
#undef SCAN_WRITE
    if (t1 < NSTEP && cw_) {
#pragma unroll
        for (int t = 0; t < 8; ++t)
#pragma unroll
            for (int nn = 0; nn < NN; ++nn) SS[((size_t)(bhd * 8 + sl0 + nn) * 8 + t) * 64 + lane] = S[t][nn]; }
    asm volatile("s_waitcnt vmcnt(0)" ::: "memory");
    __syncthreads();
}

__device__ void dn_out(const Params& P, int l) {
    const int tid_ = ltid(); const int wave = __builtin_amdgcn_readfirstlane(tid_ >> 6), lane = tid_ & 63;
    const bf16_t* OO = (const bf16_t*)(P.ws + O_O); const bf16_t* Z = (const bf16_t*)(P.ws + O_Z); bf16_t* DNO = (bf16_t*)(P.ws + O_BR) + (size_t)2 * TP * 512;
    const float* nw = P.in[12] + (size_t)l * 128; float g[8];
#pragma unroll
    for (int e = 0; e < 8; ++e) g[e] = nw[(lane & 15) * 8 + e];
    for (int r = lbid() * 8 + wave; r < TT; r += lgrid() * 8) {
        float a[8], bq[8], z[8]; unpack8(*(const u32x4*)(OO + (size_t)r * 512 + lane * 8), a); unpack8(*(const u32x4*)(OO + ((size_t)TP + r) * 512 + lane * 8), bq); unpack8(*(const u32x4*)(Z + (size_t)r * 512 + lane * 8), z);
        float ss = 0.f;
#pragma unroll
        for (int e = 0; e < 8; ++e) { a[e] += bq[e]; ss += a[e] * a[e]; }
        ss += __shfl_xor(ss, 1); ss += __shfl_xor(ss, 2); ss += __shfl_xor(ss, 4); ss += __shfl_xor(ss, 8);
        const float inv = rsqrtf(ss * (1.0f / 128.0f) + EPS);
#pragma unroll
        for (int e = 0; e < 8; ++e) a[e] = a[e] * inv * g[e] * siluf_(z[e]);
        *(u32x4*)(DNO + (size_t)r * 512 + lane * 8) = pack8(a);
    }
}


#define XB_TMO      128
#define XB_XCNT(j)  (256  + 64 * (j))
#define XB_XSUB(j)  (1280 + 64 * (j))
#define XB_XGEN(j)  (2304 + 64 * (j))
#define XB_TOP      3328
#define XB_TOPGEN   3392
#define XCD_BAR_WORDS 3456
#define XB_SPIN_CAP (1u << 22)
__device__ __forceinline__ unsigned xb_ld(unsigned* p)              { return __hip_atomic_load(p, __ATOMIC_RELAXED, __HIP_MEMORY_SCOPE_AGENT); }
__device__ __forceinline__ unsigned xb_add(unsigned* p, unsigned v) { return __hip_atomic_fetch_add(p, v, __ATOMIC_RELAXED, __HIP_MEMORY_SCOPE_AGENT); }
__device__ __forceinline__ unsigned xb_xcc_id() { return (unsigned)__builtin_amdgcn_s_getreg((3 << 11) | 20) & 0xFu; }
#define XB_SPIN(cond, bar) do { unsigned _sp = 0; while (cond) { __builtin_amdgcn_s_sleep(1); \
    if ((++_sp & 255u) == 0u) { if (xb_ld(&(bar)[XB_TMO])) break; if (_sp > XB_SPIN_CAP) { atomicAdd(&(bar)[XB_TMO], 1u); break; } } } } while (0)
struct XcdBarrier { unsigned* bar; unsigned x; volatile LAS unsigned* st; };
__device__ __forceinline__ XcdBarrier xcd_barrier_post(unsigned* bar, volatile LAS unsigned* st) {
    XcdBarrier b; b.bar = bar; b.x = xb_xcc_id(); b.st = st;
    if (threadIdx.x == 0) (void)xb_add(&bar[XB_XCNT(b.x)], 1u);
    return b;
}
__device__ __forceinline__ void xcd_barrier_complete(unsigned* bar, unsigned x, unsigned& nloc, unsigned& nx) {
    const unsigned G = gridDim.x * gridDim.y * gridDim.z;
    unsigned sum, cnt, mine, sp = 0u;
    for (;;) {
        sum = 0u; cnt = 0u; mine = 0u;
#pragma unroll
        for (unsigned j = 0; j < 16; ++j) { const unsigned c = xb_ld(&bar[XB_XCNT(j)]); sum += c; cnt += (c > 0u) ? 1u : 0u; mine = (j == x) ? c : mine; }
        if (sum == G) break;
        __builtin_amdgcn_s_sleep(1);
        if ((++sp & 255u) == 0u) { if (xb_ld(&bar[XB_TMO])) break; if (sp > XB_SPIN_CAP) { atomicAdd(&bar[XB_TMO], 1u); break; } }
    }
    nloc = mine > 0u ? mine : 1u; nx = cnt > 0u ? cnt : 1u;
}
__device__ __forceinline__ void xcd_barrier(const XcdBarrier& b) {
    asm volatile("s_waitcnt vmcnt(0)" ::: "memory");
    __syncthreads();
    if (threadIdx.x == 0) {
        unsigned* bar = b.bar;
        __builtin_amdgcn_s_waitcnt(0);
        unsigned nloc = b.st[0], nx = b.st[1];
        if (nloc == 0u) { xcd_barrier_complete(bar, b.x, nloc, nx); b.st[0] = nloc; b.st[1] = nx; }
        const unsigned old = xb_add(&bar[XB_XSUB(b.x)], 1u);
        const unsigned gen = old / nloc;
        if (old + 1u == (gen + 1u) * nloc) {
            __builtin_amdgcn_fence(__ATOMIC_RELEASE, "agent");
            asm volatile("s_waitcnt vmcnt(0)" ::: "memory");
            const unsigned og = xb_add(&bar[XB_TOP], 1u);
            const unsigned tg = og / nx;
            if (og + 1u == (tg + 1u) * nx) xb_add(&bar[XB_TOPGEN], 1u);
            else XB_SPIN(xb_ld(&bar[XB_TOPGEN]) == tg, bar);
            __builtin_amdgcn_fence(__ATOMIC_ACQUIRE, "agent");
            xb_add(&bar[XB_XGEN(b.x)], 1u);
            asm volatile("s_waitcnt vmcnt(0)" ::: "memory");
        } else {
            XB_SPIN(xb_ld(&bar[XB_XGEN(b.x)]) == gen, bar);
            __builtin_amdgcn_fence(__ATOMIC_ACQUIRE, "agent");
            asm volatile("s_waitcnt vmcnt(0)" ::: "memory");
        }
    }
    __syncthreads();
}
__device__ __forceinline__ int phase_cat(int ph) { const int p = ph % 22;
    return p == 0 ? 0 : (p == 1 || p == 2 || p == 19 || p == 20) ? 1 : (p == 3 || p == 18 || p == 21) ? 2 : p == 4 ? 3 : p == 5 ? 4 : p == 6 ? 5 : p == 7 ? 6 : (p == 8 || p == 10 || p == 12) ? 7 : (p == 9 || p == 11 || p == 13) ? 8 : p == 14 ? 9 : 10; }
#ifndef SKIP_GEMM
#define GEMM_CALL(a,b,c,d) pg8::gemm_phase(a,b,c,d)
#else
#define GEMM_CALL(a,b,c,d) (void)0
#endif
__global__ void __launch_bounds__(512, 2) fwd_kernel(Params P) {
    extern __shared__ __attribute__((aligned(16))) unsigned char smem[];
    cg::grid_group grid = cg::this_grid();
    unsigned char* ws = P.ws;
    LAS unsigned char* lds = (LAS unsigned char*)smem;
    int ph = 0;
    { volatile LAS unsigned* stw = (volatile LAS unsigned*)(lds + LDS_BYTES - 32); if (threadIdx.x < 8) stw[threadIdx.x] = 0u; }
    __syncthreads();
    XcdBarrier xbar = xcd_barrier_post((unsigned*)(ws + S_BAR), (volatile LAS unsigned*)(lds + LDS_BYTES - 16));
#ifdef DBG_CAT
    unsigned long long t_prev = __builtin_amdgcn_s_memrealtime(), t_acc = 0ull;
#define STAMP() do { const unsigned long long _n = __builtin_amdgcn_s_memrealtime(); if (phase_cat(ph) == DBG_CAT) t_acc += _n - t_prev; t_prev = _n; } while (0)
#else
#define STAMP() do {} while (0)
#endif
#define PHASE_BEGIN if (ph >= P.ph_lo && ph < P.ph_hi) { const int G = lgrid(), bx = lbid(); (void)G; (void)bx;
#define PHASE_END   if (ph + 1 < P.ph_hi) { if (ph == 0) { asm volatile("s_waitcnt vmcnt(0) lgkmcnt(0)" ::: "memory"); grid.sync(); __builtin_amdgcn_fence(__ATOMIC_ACQUIRE, "agent"); asm volatile("s_waitcnt vmcnt(0)" ::: "memory"); __syncthreads(); } else xcd_barrier(xbar); } STAMP(); } ++ph;
    for (ph = P.ph_lo; ph < P.ph_hi; ++ph) {
        const int l = ph / 22, p = ph - l * 22;
        const int G = lgrid(), bx = lbid();
        bf16_t* XN = (bf16_t*)(ws + O_XN); bf16_t* Y = (bf16_t*)(ws + O_Y); bf16_t* ACT = (bf16_t*)(ws + O_ACT);
        const float* ng = P.in[2] + (size_t)l * 6 * 1024;
        switch (p) {
        case 0:
#ifndef SKIP_CVT
            convert_weights(P, l, smem);
#endif
            if (l == 0) { gen_tables(P); rpass(P, nullptr, true, nullptr, 0.f, ng, XN); }
            break;
        case 1: case 19: { pg8::Gemm g{XN, (const bf16_t*)(ws + (p == 1 ? W_WI1 : W_WI2)), TP, 5632, 1024, 128}; pg8::StaticOrder S; S.init(TP, 5632, G, bx); pg8::EpiSwiglu E{ACT}; GEMM_CALL(lds, g, S, E); } break;
        case 2: case 20: { pg8::Gemm g{ACT, (const bf16_t*)(ws + (p == 2 ? W_WO1 : W_WO2)), TP, 1024, 2816, 128}; pg8::StaticOrder S; S.init(TP, 1024, G, bx); pg8::EpiBf16<0> E{Y, 1024}; GEMM_CALL(lds, g, S, E); } break;
        case 3: rpass(P, Y, l == 0, ng + 1024, 0.5f, ng + 2048, XN); break;
        case 4: { pg8::Gemm g{XN, (const bf16_t*)(ws + W_WIN), TP, NPROJ, 1024, 128}; pg8::StaticOrder S; S.init(TP, NPROJ, G, bx); pg8::EpiInProj E{ws}; GEMM_CALL(lds, g, S, E); } break;
        case 5: sconv_pass(P, l); break;
        case 6:
#ifndef SKIP_F1
            fstep1(P, smem);
#endif
            break;
        case 7: { pg8::Gemm g{(const bf16_t*)(ws + S_C257), (const bf16_t*)(ws + O_AP), 512, 65536, KF, 1}; pg8::StaticOrder S; S.init(512, 65536, G, bx);
                  pg8::EpiFourier E{(bf16_t*)(ws + O_BR), 0.001949317738791423f  }; GEMM_CALL(lds, g, S, E); } break;
        case 8: case 10: case 12: { const int t0 = ((p - 8) >> 1) * SPL, t1 = (t0 + SPL < NSTEP) ? t0 + SPL : NSTEP;
#ifndef SKIP_PREP
            dn_prep(P, l, smem, t0, t1);
#endif
            } break;
        case 9: case 11: case 13: { const int t0 = ((p - 9) >> 1) * SPL, t1 = (t0 + SPL < NSTEP) ? t0 + SPL : NSTEP;
#ifndef SKIP_SCAN
            dn_scan(P, smem, t0, t1);
#endif
            } break;
        case 14: dn_out(P, l); rpass(P, nullptr, false, nullptr, 0.f, ng + 2048, (bf16_t*)(ws + O_XN2)); break;
        case 15: { pg8::Gemm g{(const bf16_t*)(ws + O_XN2), (const bf16_t*)(ws + W_WG), TP, 3072, 1024, 128}; pg8::StaticOrder S; S.init(TP, 3072, G, bx); pg8::EpiBf16<1> E{(bf16_t*)(ws + O_GATE), 3072}; GEMM_CALL(lds, g, S, E); } break;
        case 16: { pg8::Gemm g{(const bf16_t*)(ws + O_BR), (const bf16_t*)(ws + W_WBR), 3 * TP, 3072, 512, -1}; pg8::MergeOrder S{G, bx}; pg8::EpiMerge E{(const bf16_t*)(ws + O_GATE), (bf16_t*)(ws + O_MG), (bf16_t*)(ws + O_XN2)}; GEMM_CALL(lds, g, S, E); } break;
        case 17: { pg8::Gemm g{(const bf16_t*)(ws + O_MG), (const bf16_t*)(ws + W_WOUT), TP, 1024, 1024, 128}; pg8::StaticOrder S; S.init(TP, 1024, G, bx); pg8::EpiBf16<0> E{Y, 1024}; GEMM_CALL(lds, g, S, E); } break;
        case 18: rpass(P, Y, false, ng + 3 * 1024, 1.0f, ng + 4 * 1024, XN); break;
        default: rpass(P, Y, false, ng + 5 * 1024, 0.5f, l == 0 ? P.in[2] + (size_t)6 * 1024 : nullptr, XN); break;
        }
        if (ph + 1 < P.ph_hi) {
            if (ph == 0) { asm volatile("s_waitcnt vmcnt(0) lgkmcnt(0)" ::: "memory"); grid.sync(); __builtin_amdgcn_fence(__ATOMIC_ACQUIRE, "agent"); asm volatile("s_waitcnt vmcnt(0)" ::: "memory"); __syncthreads(); }
            else xcd_barrier(xbar);
        }
        STAMP();
    }
#ifdef DBG_CAT
    if (lbid() == 0 && threadIdx.x == 0) { const unsigned long long t0 = __builtin_amdgcn_s_memrealtime(); while (__builtin_amdgcn_s_memrealtime() - t0 < t_acc + *(unsigned long long*)(smem + LDS_BYTES - 32)) __builtin_amdgcn_s_sleep(16); }
#endif
#ifdef DBG_FLUSH
    { asm volatile("s_waitcnt vmcnt(0) lgkmcnt(0)" ::: "memory"); grid.sync(); __builtin_amdgcn_fence(__ATOMIC_ACQUIRE, "agent"); asm volatile("s_waitcnt vmcnt(0)" ::: "memory");
      const f32x4* xs = (const f32x4*)P.in[0]; f32x4 a = {0.f, 0.f, 0.f, 0.f};
      for (size_t i = ltid(); i < (size_t)8388608; i += 512) a += xs[i];
      if (a[0] + a[1] + a[2] + a[3] == 1.2345e-30f) ((float*)(ws + S_GL))[4000] = 1.f; }
#endif
#ifdef DBG_OFF
    { asm volatile("s_waitcnt vmcnt(0) lgkmcnt(0)" ::: "memory"); grid.sync(); __builtin_amdgcn_fence(__ATOMIC_ACQUIRE, "agent"); asm volatile("s_waitcnt vmcnt(0)" ::: "memory");
      const bf16_t* src = (const bf16_t*)(ws + DBG_OFF);
      for (size_t i = (size_t)lbid() * 512 + ltid(); i < (size_t)33554432; i += (size_t)lgrid() * 512) P.out[i] = i < (size_t)DBG_CNT ? bf2f(src[i]) : 0.f; }
#endif
}

extern "C" void kernel_launch(void* const* d_in, const int* in_sizes, int n_in, void* d_out, int out_size, void* d_ws, size_t ws_size, hipStream_t stream) {
    static int grid = 0;
    if (grid == 0) {
        int dev = 0, cus = 0, per_cu = 0;
        hipGetDevice(&dev); hipDeviceGetAttribute(&cus, hipDeviceAttributeMultiprocessorCount, dev);
        hipFuncSetAttribute((const void*)fwd_kernel, hipFuncAttributeMaxDynamicSharedMemorySize, LDS_BYTES);
        hipOccupancyMaxActiveBlocksPerMultiprocessor(&per_cu, (const void*)fwd_kernel, 512, LDS_BYTES);
        if (per_cu < 1) { fprintf(stderr, "occupancy query says %d blocks/CU\n", per_cu); per_cu = 1; }
        grid = cus;
        if (ws_size < WS_NEED) fprintf(stderr, "workspace too small: %zu < %zu\n", ws_size, (size_t)WS_NEED);
    }
    Params p{};
    for (int i = 0; i < 17; ++i) p.in[i] = (const float*)d_in[i];
    p.out = (float*)d_out; p.ws = (unsigned char*)d_ws; p.ph_lo = 0; p.ph_hi = 44;
#ifdef DBG_PHI
    p.ph_hi = DBG_PHI;
#endif
    hipMemsetAsync((char*)d_ws + S_BAR, 0, 16384, stream);
    void* args[] = {&p};
    hipError_t e = hipLaunchCooperativeKernel((const void*)fwd_kernel, dim3(grid), dim3(512), args, LDS_BYTES, stream);
    if (e != hipSuccess) fprintf(stderr, "cooperative launch failed: %s (grid %d)\n", hipGetErrorString(e), grid);
}
```

```cpp
#include <hip/hip_runtime.h>
#include <hip/hip_cooperative_groups.h>
#include <cstdio>
namespace cg = cooperative_groups;

#define LAS __attribute__((address_space(3)))
typedef unsigned short bf16_t;
typedef short bf16x8 __attribute__((ext_vector_type(8)));
typedef float f32x4 __attribute__((ext_vector_type(4)));
typedef unsigned u32x4 __attribute__((ext_vector_type(4)));
typedef unsigned u32x2 __attribute__((ext_vector_type(2)));

constexpr int DM = 1024, NB = 8, SEQ = 4096, NMETA = 16, LL = 4112, TT = NB * LL  , TP = 33024  , DFF = 2816;
constexpr int NIN = 7184;
constexpr int NPROJ = 4864;
constexpr float EPS = 1e-6f;
constexpr int NSTEP = 65, SPL = 24, NSPLIT = 3;
constexpr int KF = 640;

constexpr size_t UU = (size_t)TP * 1024;
constexpr size_t W_WI1 = 0, W_WO1 = W_WI1 + (size_t)5632 * 1024 * 2, W_WI2 = W_WO1 + (size_t)1024 * 2816 * 2, W_WO2 = W_WI2 + (size_t)5632 * 1024 * 2,
                 W_WIN = W_WO2 + (size_t)1024 * 2816 * 2, W_WG = W_WIN + (size_t)NPROJ * 1024 * 2, W_WBR = W_WG + (size_t)3072 * 1024 * 2,
                 W_WOUT = W_WBR + (size_t)3072 * 512 * 2, W_END = W_WOUT + (size_t)1024 * 1024 * 2;
constexpr size_t S_C257 = W_END, S_TWL = S_C257 + (size_t)512 * KF * 2, S_HM = S_TWL + 33024, S_LOGIT = S_HM + (size_t)128 * 1024 * 4,
                 S_GL = S_LOGIT + (size_t)TP * 16 * 4, S_SSAVE = S_GL + 16896, S_BAR = S_SSAVE + (size_t)512 * 8 * 64 * 16, S_END = S_BAR + 16384;
constexpr size_t A0 = (S_END + 255) / 256 * 256;
constexpr size_t O_XN = A0, O_Y = A0 + 2 * UU, O_ACT = A0 + 4 * UU;
constexpr size_t O_BR = A0, O_QKV = A0 + 4 * UU, O_Z = A0 + 7 * UU, O_SC = A0 + 8 * UU, O_PQ = A0 + 11 * UU, O_AP = A0 + 8 * UU;
constexpr size_t DNI_SLOTS = (size_t)SPL * 64;
constexpr size_t O_WP = A0 + 8 * UU, O_QP = O_WP + DNI_SLOTS * 16384, O_KD = O_QP + DNI_SLOTS * 16384, O_UF = O_KD + DNI_SLOTS * 16384,
                 O_AT = O_UF + DNI_SLOTS * 16384, O_DNI_END = O_AT + DNI_SLOTS * 8192;
constexpr size_t O_O = (O_DNI_END + 255) / 256 * 256;
constexpr size_t O_XN2 = A0 + 3 * UU, O_GATE = A0 + 5 * UU, O_MG = A0 + 11 * UU;
constexpr size_t O_SLAB = (O_O + 2 * UU + 255) / 256 * 256;
constexpr size_t WS_NEED = O_SLAB + (size_t)44 * 65536 * 4;
static_assert(WS_NEED <= (size_t)536870912, "workspace");
static_assert(O_AP + (size_t)65536 * KF * 2 <= O_PQ, "A' overlaps PQ");
static_assert(O_O >= O_PQ || true, "");
static_assert(O_MG + 2 * UU <= WS_NEED + 2 * UU, "");

constexpr int LDS_BYTES = 132 * 1024;

#define DBG_CNT ((size_t)33554432)


struct Params { const float* in[17]; float* out; unsigned char* ws; int ph_lo, ph_hi; };

__device__ __forceinline__ float bf2f(unsigned v) { return __uint_as_float(v << 16); }
typedef __bf16 bf16x2_t __attribute__((ext_vector_type(2)));
typedef float f32x2_t __attribute__((ext_vector_type(2)));
__device__ __forceinline__ unsigned cvt_pk_bf16(float lo, float hi) { f32x2_t v = {lo, hi}; bf16x2_t b = __builtin_convertvector(v, bf16x2_t); return __builtin_bit_cast(unsigned, b); }
__device__ __forceinline__ bf16_t f2bf(float f) { return (bf16_t)(cvt_pk_bf16(f, 0.f) & 0xffffu); }
__device__ __forceinline__ void unpack8(const u32x4 v, float* f) {
    f[0] = __uint_as_float(v.x << 16); f[1] = __uint_as_float(v.x & 0xffff0000u); f[2] = __uint_as_float(v.y << 16); f[3] = __uint_as_float(v.y & 0xffff0000u);
    f[4] = __uint_as_float(v.z << 16); f[5] = __uint_as_float(v.z & 0xffff0000u); f[6] = __uint_as_float(v.w << 16); f[7] = __uint_as_float(v.w & 0xffff0000u); }
__device__ __forceinline__ u32x4 pack8(const float* f) { u32x4 w; w.x = cvt_pk_bf16(f[0], f[1]); w.y = cvt_pk_bf16(f[2], f[3]); w.z = cvt_pk_bf16(f[4], f[5]); w.w = cvt_pk_bf16(f[6], f[7]); return w; }
__device__ __forceinline__ int ltid() { int t = threadIdx.x; asm volatile("" : "+v"(t)); return t; }
__device__ __forceinline__ int lbid() { int t = blockIdx.x; asm volatile("" : "+s"(t)); return t; }
__device__ __forceinline__ int lgrid() { int t = gridDim.x; asm volatile("" : "+s"(t)); return t; }
__device__ __forceinline__ float wave_sum(float v) { for (int o = 32; o >= 1; o >>= 1) v += __shfl_xor(v, o); return v; }
__device__ __forceinline__ float sigmoidf_(float x) { return __builtin_amdgcn_rcpf(1.0f + __expf(-x)); }
__device__ __forceinline__ float siluf_(float x) { return x * __builtin_amdgcn_rcpf(1.0f + __expf(-x)); }

namespace pg8 {
constexpr int BM = 256, BK = 64, HALF = 128, HTB = HALF * BK * 2, STAGE_BYTES = 8 * HTB, NXCD = 8, WGM = 8;
__device__ __forceinline__ int lds_byte(int r, int c) { const int st = (r >> 4) * 2 + (c >> 5), rr = r & 15, cc = c & 31, ob = rr * 64 + cc * 2; return st * 1024 + (ob ^ (((ob >> 9) & 1) << 5)); }
__device__ __forceinline__ void stage_rc(int b, int& R, int& C) { const int st = b / 1024, sb = b % 1024, swz = sb ^ (((sb >> 9) & 1) << 5); R = (st >> 1) * 16 + swz / 64; C = (st & 1) * 32 + (swz % 64) / 2; }
__device__ __forceinline__ int perm32(int rho) { const int n = rho >> 4, i = rho & 15; return 8 * (i >> 2) + 4 * n + (i & 3); }
struct Unit { int pm, pn, ks; };
struct Gemm { const bf16_t* A; const bf16_t* Bt; int M, N, K; int half_pm; int KL; };
struct StaticOrder {
    int nM, nN, nwg, G, c, ntail;
    __device__ void init(int M, int N, int G_, int c_, bool tail = true) { nM = M / BM - 1; nN = N / BM; nwg = nM * nN; G = G_; c = c_; ntail = tail ? nN : 0; }
    __device__ bool next(int i, Unit& u) const {
        u.ks = 0;
        const long L = (long)i * G + c; if (L >= nwg + ntail) return false;
        if (L >= nwg) { u.pm = nM; u.pn = (int)(L - nwg); return true; }
        int wgid = (int)L; { const int q = nwg / NXCD, r = nwg % NXCD, xcd = wgid % NXCD, off = wgid / NXCD; wgid = (xcd < r ? xcd * (q + 1) : r * (q + 1) + (xcd - r) * q) + off; }
        const int nig = WGM * nN, gid = wgid / nig, fm = gid * WGM, gsz = (nM - fm) < WGM ? (nM - fm) : WGM;
        u.pm = fm + ((wgid % nig) % gsz); u.pn = (wgid % nig) / gsz; return true;
    }
};
struct MergeOrder {
    int G, c;
    __device__ bool next(int i, Unit& u) const { const int L = (i / 3) * G + c; if (L >= 129 * 4) return false; const int j = i % 3; u.pm = j * 129 + (L >> 2); u.pn = j * 4 + (L & 3); u.ks = 0; return true; }
};

struct TailOrder { int nS, c;
    __device__ bool next(int i, Unit& u) const { if (i > 0 || c >= 4 * nS) return false; u.pm = c / nS; u.ks = c - u.pm * nS; u.pn = 0; return true; } };

template <class Epi, class Sched>
__device__ __forceinline__ void gemm_phase(LAS unsigned char* lds, const Gemm g, const Sched& S, const Epi& E) {
    const int tid = ltid(), wid = __builtin_amdgcn_readfirstlane(tid >> 6), lane = tid & 63, wr = wid >> 2, wc = wid & 3, fr = lane & 15, fq = lane >> 4;
    const int K = g.K, nt = g.KL / BK;
    unsigned voffA, voffB;
    { int R, C; stage_rc(tid * 16, R, C); const int Rb = Epi::PERM ? ((R & ~31) + perm32(R & 31)) : R;
        voffA = (unsigned)(R * K + C) * 2u; voffB = (unsigned)(Rb * K + C) * 2u; }
    const size_t r64 = (size_t)64 * K * 2;
    const size_t kstep = (size_t)(BK * 2);
    const size_t hstep = (size_t)HALF * K * 2;
    const size_t tstep = 2 * hstep;
    const unsigned ldsw = (unsigned)wid * 1024u;
    const int aoff = lds_byte(wr * 64 + fr, fq * 8), boff = lds_byte(wc * 32 + fr, fq * 8);
#define PG8_SA(b, h) (((b) * 2 + (h)) * HTB)
#define PG8_SB(b, h) ((4 + (b) * 2 + (h)) * HTB)
#define PG8_STAGE(bufoff, gbase, voff) do { _Pragma("unroll") for (int _i = 0; _i < 2; ++_i) \
        __builtin_amdgcn_global_load_lds((const unsigned*)((const char*)(gbase) + _i * r64 + (voff)), (LAS unsigned*)(lds + (bufoff) + ldsw + _i * 8192), 16, 0, 0); } while (0)
#define PG8_LDA(dst, b, h) do { _Pragma("unroll") for (int m = 0; m < 4; ++m) _Pragma("unroll") for (int k = 0; k < 2; ++k) dst[m][k] = *(const LAS bf16x8*)(lds + PG8_SA(b, h) + aoff + m * 2048 + k * 1024); } while (0)
#define PG8_LDB(dst, b, h) do { _Pragma("unroll") for (int n = 0; n < 2; ++n) _Pragma("unroll") for (int k = 0; k < 2; ++k) dst[n][k] = *(const LAS bf16x8*)(lds + PG8_SB(b, h) + boff + n * 2048 + k * 1024); } while (0)
#define PG8_MMA(ai, bj, At, Bt) do { __builtin_amdgcn_s_setprio(1); _Pragma("unroll") for (int m = 0; m < 4; ++m) _Pragma("unroll") for (int n = 0; n < 2; ++n) _Pragma("unroll") for (int k = 0; k < 2; ++k) \
        acc[ai][bj][m][n] = __builtin_amdgcn_mfma_f32_16x16x32_bf16(Bt[n][k], At[m][k], acc[ai][bj][m][n], 0, 0, 0); __builtin_amdgcn_s_setprio(0); } while (0)
#define PG8_WAIT_V(n) asm volatile("s_waitcnt vmcnt(" #n ")" ::: "memory")
#define PG8_WAIT_L(n) asm volatile("s_waitcnt lgkmcnt(" #n ")" ::: "memory")
#define PG8_BAR __builtin_amdgcn_s_barrier()
#define PG8_SCHED __builtin_amdgcn_sched_barrier(0)
    Unit cur, nxt; int ui = 0;
    if (!S.next(0, cur)) return;
    f32x4 acc[2][2][4][2];
#pragma unroll
    for (int a = 0; a < 2; ++a)
#pragma unroll
        for (int b = 0; b < 2; ++b)
#pragma unroll
            for (int m = 0; m < 4; ++m)
#pragma unroll
                for (int n = 0; n < 2; ++n) acc[a][b][m][n] = (f32x4){0.f, 0.f, 0.f, 0.f};
    bf16x8 At[4][2], B0[2][2], B1[2][2];
    const char* cA = (const char*)g.A + (size_t)cur.pm * tstep + (size_t)cur.ks * g.KL * 2; const char* cB = (const char*)g.Bt + (size_t)cur.pn * tstep + (size_t)cur.ks * g.KL * 2;
    PG8_STAGE(PG8_SB(0, 0), cB, voffB); PG8_STAGE(PG8_SA(0, 0), cA, voffA); PG8_STAGE(PG8_SB(0, 1), cB + hstep, voffB); PG8_STAGE(PG8_SA(0, 1), cA + hstep, voffA);
    if (wr == 1) PG8_BAR;
    PG8_WAIT_V(4); PG8_BAR;
    PG8_STAGE(PG8_SB(1, 0), cB + kstep, voffB); PG8_STAGE(PG8_SA(1, 0), cA + kstep, voffA); PG8_STAGE(PG8_SB(1, 1), cB + hstep + kstep, voffB);
    PG8_WAIT_V(6); PG8_BAR;
    for (;;) {
        const bool has_next = S.next(ui + 1, nxt);
        const bool halfc = cur.pm == g.half_pm;
        const char* nA = has_next ? (const char*)g.A + (size_t)nxt.pm * tstep + (size_t)nxt.ks * g.KL * 2 : cA; const char* nB = has_next ? (const char*)g.Bt + (size_t)nxt.pn * tstep + (size_t)nxt.ks * g.KL * 2 : cB;
        for (int t = 0; t < nt; t += 2) {
            const bool last = (t == nt - 2);
            const char* a1 = cA + (size_t)(t + 1) * kstep;
            const char* a2 = last ? nA : cA + (size_t)(t + 2) * kstep; const char* b2 = last ? nB : cB + (size_t)(t + 2) * kstep;
            const char* a3 = a2 + kstep; const char* b3 = b2 + kstep;
            PG8_LDB(B0, 0, 0); PG8_SCHED; PG8_LDA(At, 0, 0); PG8_STAGE(PG8_SA(1, 1), a1 + hstep, voffA);
            PG8_WAIT_L(8); PG8_BAR; PG8_WAIT_L(0); PG8_MMA(0, 0, At, B0); PG8_BAR; PG8_SCHED;
            PG8_LDB(B1, 0, 1); PG8_STAGE(PG8_SB(0, 0), b2, voffB);
            PG8_BAR; PG8_WAIT_L(0); PG8_MMA(0, 1, At, B1); PG8_BAR;
            PG8_LDA(At, 0, 1); PG8_STAGE(PG8_SA(0, 0), a2, voffA);
            PG8_BAR; PG8_WAIT_L(0); if (!halfc) PG8_MMA(1, 0, At, B0); PG8_BAR; PG8_SCHED;
            PG8_STAGE(PG8_SB(0, 1), b2 + hstep, voffB);
            PG8_WAIT_V(6); PG8_BAR; if (!halfc) PG8_MMA(1, 1, At, B1); PG8_BAR;
            PG8_LDB(B0, 1, 0); PG8_SCHED; PG8_LDA(At, 1, 0); PG8_STAGE(PG8_SA(0, 1), a2 + hstep, voffA);
            PG8_WAIT_L(8); PG8_BAR; PG8_WAIT_L(0); PG8_MMA(0, 0, At, B0); PG8_BAR; PG8_SCHED;
            PG8_LDB(B1, 1, 1); PG8_STAGE(PG8_SB(1, 0), b3, voffB);
            PG8_BAR; PG8_WAIT_L(0); PG8_MMA(0, 1, At, B1); PG8_BAR;
            PG8_LDA(At, 1, 1); PG8_STAGE(PG8_SA(1, 0), a3, voffA);
            PG8_BAR; PG8_WAIT_L(0); if (!halfc) PG8_MMA(1, 0, At, B0); PG8_BAR; PG8_SCHED;
            PG8_STAGE(PG8_SB(1, 1), b3 + hstep, voffB);
            PG8_WAIT_V(6); PG8_BAR; if (!halfc) PG8_MMA(1, 1, At, B1); PG8_BAR;
        }
        E(acc, cur, wr, wc, fr, fq);
        if (!has_next) break;
#pragma unroll
        for (int a = 0; a < 2; ++a)
#pragma unroll
            for (int b = 0; b < 2; ++b)
#pragma unroll
                for (int m = 0; m < 4; ++m)
#pragma unroll
                    for (int n = 0; n < 2; ++n) acc[a][b][m][n] = (f32x4){0.f, 0.f, 0.f, 0.f};
        cur = nxt; cA = nA; cB = nB; ++ui;
    }
    PG8_WAIT_V(0);
    if (wr == 0) PG8_BAR;
    PG8_BAR;
#undef PG8_SA
#undef PG8_SB
#undef PG8_STAGE
#undef PG8_LDA
#undef PG8_LDB
#undef PG8_MMA
#undef PG8_WAIT_V
#undef PG8_WAIT_L
#undef PG8_BAR
#undef PG8_SCHED
}

template <int ACT> struct EpiBf16 {
    static constexpr bool PERM = true;
    bf16_t* O; int ldc;
    __device__ __forceinline__ void operator()(const f32x4 (&acc)[2][2][4][2], const Unit& u, int wr, int wc, int fr, int fq) const {
        const int row0 = u.pm * BM + wr * 64 + fr, col0 = u.pn * BM + wc * 32 + 8 * fq;
#pragma unroll
        for (int ai = 0; ai < 2; ++ai)
#pragma unroll
            for (int m = 0; m < 4; ++m) { bf16_t* rowp = O + (size_t)(row0 + ai * HALF + m * 16) * ldc + col0;
#pragma unroll
                for (int bj = 0; bj < 2; ++bj) { f32x4 v0 = acc[ai][bj][m][0], v1 = acc[ai][bj][m][1];
                    if (ACT == 1) {
#pragma unroll
                        for (int j = 0; j < 4; ++j) { v0[j] = sigmoidf_(v0[j]); v1[j] = sigmoidf_(v1[j]); } }
                    u32x4 w; w.x = cvt_pk_bf16(v0[0], v0[1]); w.y = cvt_pk_bf16(v0[2], v0[3]); w.z = cvt_pk_bf16(v1[0], v1[1]); w.w = cvt_pk_bf16(v1[2], v1[3]);
                    *(u32x4*)(rowp + bj * HALF) = w; } }
    }
};
struct EpiSlab {
    static constexpr bool PERM = true;
    float* slab; int nS;
    __device__ __forceinline__ void operator()(const f32x4 (&acc)[2][2][4][2], const Unit& u, int wr, int wc, int fr, int fq) const {
        float* sp = slab + ((size_t)u.ks * 128 + wc * 32 + 8 * fq) * 1024 + u.pm * 256 + wr * 64 + fr;
#pragma unroll
        for (int ai = 0; ai < 2; ++ai)
#pragma unroll
            for (int m = 0; m < 4; ++m) { float* rp = sp + ai * HALF + m * 16;
#pragma unroll
                for (int n = 0; n < 2; ++n)
#pragma unroll
                    for (int j = 0; j < 4; ++j) rp[(size_t)(4 * n + j) * 1024] = acc[ai][0][m][n][j]; }
    }
};
struct EpiSwiglu {
    static constexpr bool PERM = true;
    bf16_t* O;
    __device__ __forceinline__ void operator()(const f32x4 (&acc)[2][2][4][2], const Unit& u, int wr, int wc, int fr, int fq) const {
        const int row0 = u.pm * BM + wr * 64 + fr, col0 = u.pn * 128 + wc * 32 + 8 * fq;
#pragma unroll
        for (int ai = 0; ai < 2; ++ai)
#pragma unroll
            for (int m = 0; m < 4; ++m) { bf16_t* rowp = O + (size_t)(row0 + ai * HALF + m * 16) * DFF + col0;
                const f32x4 a0 = acc[ai][0][m][0], a1 = acc[ai][0][m][1], b0 = acc[ai][1][m][0], b1 = acc[ai][1][m][1];
                float v[8];
#pragma unroll
                for (int j = 0; j < 4; ++j) { v[j] = siluf_(a0[j]) * b0[j]; v[4 + j] = siluf_(a1[j]) * b1[j]; }
                *(u32x4*)rowp = pack8(v); }
    }
};
struct EpiInProj {
    static constexpr bool PERM = true;
    unsigned char* ws;
    __device__ __forceinline__ void operator()(const f32x4 (&acc)[2][2][4][2], const Unit& u, int wr, int wc, int fr, int fq) const {
        const int row0 = u.pm * BM + wr * 64 + fr, pn = u.pn;
        if (pn == 18) {
            if (wc == 0 && fq < 2) { float* Lg = (float*)(ws + S_LOGIT);
#pragma unroll
                for (int ai = 0; ai < 2; ++ai)
#pragma unroll
                    for (int m = 0; m < 4; ++m) { float* rp = Lg + (size_t)(row0 + ai * HALF + m * 16) * 16 + 8 * fq; *(f32x4*)rp = acc[ai][0][m][0]; *(f32x4*)(rp + 4) = acc[ai][0][m][1]; } }
            return; }
        bf16_t* base; int ld, cb;
        if (pn < 4) { base = (bf16_t*)(ws + O_PQ); ld = 1024; cb = pn * 256; }
        else if (pn < 10) { base = (bf16_t*)(ws + O_SC); ld = 1536; cb = (pn - 4) * 256; }
        else if (pn < 16) { base = (bf16_t*)(ws + O_QKV); ld = 1536; cb = (pn - 10) * 256; }
        else { base = (bf16_t*)(ws + O_Z); ld = 512; cb = (pn - 16) * 256; }
        const int col0 = cb + wc * 32 + 8 * fq;
#pragma unroll
        for (int ai = 0; ai < 2; ++ai)
#pragma unroll
            for (int m = 0; m < 4; ++m) { bf16_t* rowp = base + (size_t)(row0 + ai * HALF + m * 16) * ld + col0;
#pragma unroll
                for (int bj = 0; bj < 2; ++bj) { const f32x4 v0 = acc[ai][bj][m][0], v1 = acc[ai][bj][m][1];
                    u32x4 w; w.x = cvt_pk_bf16(v0[0], v0[1]); w.y = cvt_pk_bf16(v0[2], v0[3]); w.z = cvt_pk_bf16(v1[0], v1[1]); w.w = cvt_pk_bf16(v1[2], v1[3]);
                    *(u32x4*)(rowp + bj * HALF) = w; } }
    }
};
struct EpiFourier {
    static constexpr bool PERM = true;
    bf16_t* FM; float sc;
    __device__ __forceinline__ void operator()(const f32x4 (&acc)[2][2][4][2], const Unit& u, int wr, int wc, int fr, int fq) const {
        const int row0 = u.pm * BM + wr * 64 + fr;
        const int colt = u.pn * BM;
        const int b = colt >> 13, k1 = (colt >> 9) & 15, ch0 = (colt & 511) + wc * 32 + 8 * fq;
#pragma unroll
        for (int ai = 0; ai < 2; ++ai)
#pragma unroll
            for (int m = 0; m < 4; ++m) { const int k2 = row0 + ai * HALF + m * 16;
                if (k2 < 257) { bf16_t* rowp = FM + (size_t)(b * LL + k1 + 16 * k2) * 512 + ch0;
#pragma unroll
                    for (int bj = 0; bj < 2; ++bj) { const f32x4 v0 = acc[ai][bj][m][0] * sc, v1 = acc[ai][bj][m][1] * sc;
                        u32x4 w; w.x = cvt_pk_bf16(v0[0], v0[1]); w.y = cvt_pk_bf16(v0[2], v0[3]); w.z = cvt_pk_bf16(v1[0], v1[1]); w.w = cvt_pk_bf16(v1[2], v1[3]);
                        *(u32x4*)(rowp + bj * HALF) = w; } } }
    }
};
struct EpiMerge {
    static constexpr bool PERM = true;
    const bf16_t* GATE; bf16_t* MG; bf16_t* MGB;
    __device__ __forceinline__ void operator()(const f32x4 (&acc)[2][2][4][2], const Unit& u, int wr, int wc, int fr, int fq) const {
        const int j = u.pm / 129, pm = u.pm - j * 129, pn = u.pn & 3;
        const int row0 = pm * BM + wr * 64 + fr, col0 = pn * BM + wc * 32 + 8 * fq;
        const bf16_t* mold = (j == 1 ? MG : MGB); bf16_t* mnew = (j == 1 ? MGB : MG);
#pragma unroll
        for (int ai = 0; ai < 2; ++ai) {
            u32x4 gv[4][2], ov[4][2];
#pragma unroll
            for (int m = 0; m < 4; ++m)
#pragma unroll
                for (int bj = 0; bj < 2; ++bj) { const size_t r = (size_t)(row0 + ai * HALF + m * 16);
                    gv[m][bj] = *(const u32x4*)(GATE + r * 3072 + j * 1024 + col0 + bj * HALF);
                    if (j > 0) ov[m][bj] = *(const u32x4*)(mold + r * 1024 + col0 + bj * HALF); }
#pragma unroll
            for (int m = 0; m < 4; ++m)
#pragma unroll
                for (int bj = 0; bj < 2; ++bj) { const size_t r = (size_t)(row0 + ai * HALF + m * 16);
                    float g[8], v[8]; unpack8(gv[m][bj], g);
                    const f32x4 v0 = acc[ai][bj][m][0], v1 = acc[ai][bj][m][1];
#pragma unroll
                    for (int e = 0; e < 4; ++e) { v[e] = v0[e] * g[e]; v[4 + e] = v1[e] * g[4 + e]; }
                    if (j > 0) { float o[8]; unpack8(ov[m][bj], o);
#pragma unroll
                        for (int e = 0; e < 8; ++e) v[e] += o[e]; }
                    *(u32x4*)(mnew + r * 1024 + col0 + bj * HALF) = pack8(v); }
            asm volatile("" ::: "memory"); }
    }
};
}

__device__ void rpass(const Params& P, const bf16_t* Y, bool first_h, const float* gpost, float scale, const float* gpre, bf16_t* XN, const float* slab = nullptr, int nS = 0) {
    const int tid_ = ltid(); const int wave = __builtin_amdgcn_readfirstlane(tid_ >> 6), lane = tid_ & 63;
    float* hm = (float*)(P.ws + S_HM);
    for (int r = lbid() * 8 + wave; r < TT; r += lgrid() * 8) {
        const int b = r / LL, n = r - b * LL;
        const float* hin; float* hout;
        if (n < NMETA) { hout = hm + (size_t)(b * 16 + n) * 1024; hin = first_h ? P.in[1] + (size_t)n * 1024 : hout; }
        else { const size_t o = ((size_t)b * SEQ + (n - NMETA)) * 1024; hout = P.out + o; hin = first_h ? P.in[0] + o : hout; }
        float h[16];
        { const f32x4 a = *(const f32x4*)(hin + lane * 8), b4 = *(const f32x4*)(hin + lane * 8 + 4), c = *(const f32x4*)(hin + 512 + lane * 8), d = *(const f32x4*)(hin + 512 + lane * 8 + 4);
#pragma unroll
          for (int e = 0; e < 4; ++e) { h[e] = a[e]; h[4 + e] = b4[e]; h[8 + e] = c[e]; h[12 + e] = d[e]; } }
        if (Y) {
            float y[16];
            if (slab != nullptr && r >= 32768) {
                const float* sp = slab + (size_t)(r - 32768) * 1024 + lane * 8;
                f32x4 s0 = {0.f, 0.f, 0.f, 0.f}, s1 = s0, s2 = s0, s3 = s0;
#pragma unroll 1
                for (int ks = 0; ks < nS; ++ks) { s0 += *(const f32x4*)sp; s1 += *(const f32x4*)(sp + 4); s2 += *(const f32x4*)(sp + 512); s3 += *(const f32x4*)(sp + 516); sp += 131072; }
#pragma unroll
                for (int e = 0; e < 4; ++e) { y[e] = s0[e]; y[4 + e] = s1[e]; y[8 + e] = s2[e]; y[12 + e] = s3[e]; }
            } else { unpack8(*(const u32x4*)(Y + (size_t)r * 1024 + lane * 8), y); unpack8(*(const u32x4*)(Y + (size_t)r * 1024 + 512 + lane * 8), y + 8); }
            float ss = 0.f;
#pragma unroll
            for (int e = 0; e < 16; ++e) ss += y[e] * y[e];
            ss = wave_sum(ss); const float r1 = rsqrtf(ss * (1.0f / 1024.0f) + EPS) * scale;
#pragma unroll
            for (int e = 0; e < 8; ++e) { h[e] += y[e] * r1 * gpost[lane * 8 + e]; h[8 + e] += y[8 + e] * r1 * gpost[512 + lane * 8 + e]; }
            *(f32x4*)(hout + lane * 8) = (f32x4){h[0], h[1], h[2], h[3]}; *(f32x4*)(hout + lane * 8 + 4) = (f32x4){h[4], h[5], h[6], h[7]};
            *(f32x4*)(hout + 512 + lane * 8) = (f32x4){h[8], h[9], h[10], h[11]}; *(f32x4*)(hout + 512 + lane * 8 + 4) = (f32x4){h[12], h[13], h[14], h[15]};
        }
        if (gpre) {
            float ss = 0.f;
#pragma unroll
            for (int e = 0; e < 16; ++e) ss += h[e] * h[e];
            ss = wave_sum(ss); const float r2 = rsqrtf(ss * (1.0f / 1024.0f) + EPS);
            float o[16];
#pragma unroll
            for (int e = 0; e < 8; ++e) { o[e] = h[e] * r2 * gpre[lane * 8 + e]; o[8 + e] = h[8 + e] * r2 * gpre[512 + lane * 8 + e]; }
            *(u32x4*)(XN + (size_t)r * 1024 + lane * 8) = pack8(o); *(u32x4*)(XN + (size_t)r * 1024 + 512 + lane * 8) = pack8(o + 8);
        }
    }
}

template <class F>
__device__ void cvt_tiles(const float* src, int ld_src, int K, bf16_t* dst, int nrows, F srccol, unsigned char* smem) {
    float* lds = (float*)smem; const int tid = ltid();
    const int ntr = nrows / 64, ntk = K / 64, nt_ = ntr * ntk, G_ = lgrid();
    float pv[8];
    { const int t = lbid(); if (t < nt_) { const int tr = t % ntr, tk = t / ntr; const int c0 = srccol(tr * 64);
#pragma unroll
        for (int i = 0; i < 8; ++i) { const int kk = (tid >> 6) + 8 * i, cc = tid & 63; pv[i] = src[(size_t)(tk * 64 + kk) * ld_src + c0 + cc]; } } }
    for (int t = lbid(); t < nt_; t += G_) {
        const int tr = t % ntr, tk = t / ntr;
        __syncthreads();
#pragma unroll
        for (int i = 0; i < 8; ++i) { const int kk = (tid >> 6) + 8 * i, cc = tid & 63; lds[kk * 65 + cc] = pv[i]; }
        __syncthreads();
        { const int t2 = t + G_; if (t2 < nt_) { const int tr2 = t2 % ntr, tk2 = t2 / ntr; const int c2 = srccol(tr2 * 64);
#pragma unroll
            for (int i = 0; i < 8; ++i) { const int kk = (tid >> 6) + 8 * i, cc = tid & 63; pv[i] = src[(size_t)(tk2 * 64 + kk) * ld_src + c2 + cc]; } } }
        const int cc2 = tid >> 3, k8 = (tid & 7) * 8; float v[8];
#pragma unroll
        for (int e = 0; e < 8; ++e) v[e] = lds[(k8 + e) * 65 + cc2];
        *(u32x4*)(dst + (size_t)(tr * 64 + cc2) * K + tk * 64 + k8) = pack8(v);
    }
}
struct ColIdent { int off; __device__ int operator()(int r) const { return r + off; } };
struct ColSwiglu { __device__ int operator()(int r) const { const int pn = r >> 8, rem = r & 255; return (rem >> 7) * DFF + 128 * pn + (rem & 127); } };

__device__ void convert_weights(const Params& P, int l, unsigned char* smem) {
    unsigned char* ws = P.ws; const int tid = ltid();
    cvt_tiles(P.in[3] + (size_t)l * 1024 * 5632, 5632, 1024, (bf16_t*)(ws + W_WI1), 5632, ColSwiglu{}, smem);
    cvt_tiles(P.in[4] + (size_t)l * 2816 * 1024, 1024, 2816, (bf16_t*)(ws + W_WO1), 1024, ColIdent{0}, smem);
    cvt_tiles(P.in[5] + (size_t)l * 1024 * 5632, 5632, 1024, (bf16_t*)(ws + W_WI2), 5632, ColSwiglu{}, smem);
    cvt_tiles(P.in[6] + (size_t)l * 2816 * 1024, 1024, 2816, (bf16_t*)(ws + W_WO2), 1024, ColIdent{0}, smem);
    const float* win = P.in[7] + (size_t)l * 1024 * NIN;
    cvt_tiles(win, NIN, 1024, (bf16_t*)(ws + W_WIN) + (size_t)1024 * 1024, 3584, ColIdent{512}, smem);
    cvt_tiles(win, NIN, 1024, (bf16_t*)(ws + W_WG), 3072, ColIdent{4112}, smem);
    cvt_tiles(P.in[13] + (size_t)l * 512 * 1024, 1024, 512, (bf16_t*)(ws + W_WBR), 1024, ColIdent{0}, smem);
    cvt_tiles(P.in[14] + (size_t)l * 512 * 1024, 1024, 512, (bf16_t*)(ws + W_WBR) + (size_t)1024 * 512, 1024, ColIdent{0}, smem);
    cvt_tiles(P.in[15] + (size_t)l * 512 * 1024, 1024, 512, (bf16_t*)(ws + W_WBR) + (size_t)2048 * 512, 1024, ColIdent{0}, smem);
    cvt_tiles(P.in[16] + (size_t)l * 1024 * 1024, 1024, 1024, (bf16_t*)(ws + W_WOUT), 1024, ColIdent{0}, smem);
    { bf16_t* d = (bf16_t*)(ws + W_WIN) + (size_t)4608 * 1024;
      for (int i = lbid() * 512 + tid; i < 256 * 1024; i += lgrid() * 512) { const int rr = i >> 10, k = i & 1023; d[i] = rr < 16 ? f2bf(win[(size_t)k * NIN + 4096 + rr]) : (bf16_t)0; } }
    { float* Ws = (float*)smem; float* ct = Ws + 64 * 65; float* st = ct + 64;
      __syncthreads();
      if (tid < 64) { float s, c; sincospif((float)tid * (2.0f / 64.0f), &s, &c); ct[tid] = c; st[tid] = s; }
      bf16_t* dp = (bf16_t*)(ws + W_WIN); bf16_t* dq = dp + (size_t)512 * 1024;
      for (int it = lbid(); it < 8 * 16; it += lgrid()) { const int g = it >> 4, kt = it & 15;
          __syncthreads();
#pragma unroll
          for (int i = 0; i < 8; ++i) { const int kk = (tid >> 6) + 8 * i, cc = tid & 63; Ws[kk * 65 + cc] = win[(size_t)(kt * 64 + kk) * NIN + g * 64 + cc]; }
          __syncthreads();
          const int kk = tid & 63;
#pragma unroll 1
          for (int i = 0; i < 8; ++i) { const int cp = (tid >> 6) + 8 * i; float ap = 0.f, aq = 0.f;
#pragma unroll 4
              for (int c = 0; c < 64; ++c) { const float w = Ws[kk * 65 + c]; const int ph = (c * cp) & 63; ap += w * ct[ph]; aq += w * st[ph]; }
              dp[(size_t)(g * 64 + cp) * 1024 + kt * 64 + kk] = f2bf(ap); dq[(size_t)(g * 64 + cp) * 1024 + kt * 64 + kk] = f2bf(aq); }
      }
      __syncthreads(); }
}

__device__ void gen_tables(const Params& P) {
    unsigned char* ws = P.ws; const int gt = lbid() * 512 + ltid(), gs = lgrid() * 512;
    bf16_t* C = (bf16_t*)(ws + S_C257);
    for (int i = gt; i < 512 * KF; i += gs) { const int k2 = i / KF, kk = i - k2 * KF; const int ri = kk >= 320, n2 = kk - ri * 320; float v = 0.f;
        if (k2 < 257 && n2 < 257) { const int m = (k2 * n2) % 257; float s, c; sincospif((float)m * (2.0f / 257.0f), &s, &c); v = ri ? s : c; }
        C[i] = f2bf(v); }
    float* tw = (float*)(ws + S_TWL);
    for (int i = gt; i < LL; i += gs) { float s, c; sincospif((float)i * (2.0f / (float)LL), &s, &c); tw[2 * i] = c; tw[2 * i + 1] = -s; }
}

__device__ void sconv_pass(const Params& P, int l) {
    const int tid_ = ltid(); const int wave = __builtin_amdgcn_readfirstlane(tid_ >> 6), lane = tid_ & 63;
    const bf16_t* SC = (const bf16_t*)(P.ws + O_SC); bf16_t* SCO = (bf16_t*)(P.ws + O_BR) + (size_t)TP * 512;
    const float* w = P.in[8] + (size_t)l * 3 * 512;
    float w0[8], w1[8], w2[8];
#pragma unroll
    for (int e = 0; e < 8; ++e) { w0[e] = w[lane * 8 + e]; w1[e] = w[512 + lane * 8 + e]; w2[e] = w[1024 + lane * 8 + e]; }
    for (int r = lbid() * 8 + wave; r < TT; r += lgrid() * 8) {
        const int b = r / LL, n = r - b * LL; const bf16_t* rp = SC + (size_t)r * 1536 + lane * 8;
        float bb[8], c[8], h[8], acc[8]; unpack8(*(const u32x4*)rp, bb); unpack8(*(const u32x4*)(rp + 512), c); unpack8(*(const u32x4*)(rp + 1024), h);
#pragma unroll
        for (int e = 0; e < 8; ++e) acc[e] = w1[e] * c[e] * h[e];
        if (n > 0) { unpack8(*(const u32x4*)(rp - 1536 + 512), c); unpack8(*(const u32x4*)(rp - 1536 + 1024), h);
#pragma unroll
            for (int e = 0; e < 8; ++e) acc[e] += w0[e] * c[e] * h[e]; }
        if (n < LL - 1) { unpack8(*(const u32x4*)(rp + 1536 + 512), c); unpack8(*(const u32x4*)(rp + 1536 + 1024), h);
#pragma unroll
            for (int e = 0; e < 8; ++e) acc[e] += w2[e] * c[e] * h[e]; }
#pragma unroll
        for (int e = 0; e < 8; ++e) acc[e] *= bb[e];
        *(u32x4*)(SCO + (size_t)r * 512 + lane * 8) = pack8(acc);
    }
}

__device__ void fstep1(const Params& P, unsigned char* smem) {
    const int tid = ltid(), wave = __builtin_amdgcn_readfirstlane(tid >> 6), lane = tid & 63;
    const bf16_t* PQ = (const bf16_t*)(P.ws + O_PQ); bf16_t* AP = (bf16_t*)(P.ws + O_AP); const float* tw = (const float*)(P.ws + S_TWL);
    bf16_t* St = (bf16_t*)smem;
    for (int it = lbid(); it < 8 * 4 * 17; it += lgrid()) {
        const int b = it / 68, rem = it - b * 68, cht = rem / 17, n2t = rem - cht * 17;
        __syncthreads();
#pragma unroll 1
        for (int sub = 0; sub < 2; ++sub) {
            const int n2l = sub * 8 + wave, n2 = n2t * 16 + n2l;
            const int fr = lane & 15, fq = lane >> 4;
            if (n2 < 257) {
                float f0[8], f1[8];
#pragma unroll
                for (int j = 0; j < 8; ++j) { const int n = 257 * (8 * (fq & 1) + j) + n2; const int ph = (fr * n) % LL;
                    const float c_ = __hip_atomic_load(tw + 2 * ph, __ATOMIC_RELAXED, __HIP_MEMORY_SCOPE_AGENT), ms_ = __hip_atomic_load(tw + 2 * ph + 1, __ATOMIC_RELAXED, __HIP_MEMORY_SCOPE_AGENT);
                    f0[j] = (fq < 2) ? c_ : ms_; f1[j] = (fq < 2) ? ms_ : -c_; }
                const bf16x8 a0 = __builtin_bit_cast(bf16x8, pack8(f0)), a1 = __builtin_bit_cast(bf16x8, pack8(f1));
                const bf16_t* bp = PQ + (size_t)(b * LL + 257 * 8 * (fq & 1) + n2) * 1024 + (fq >> 1) * 512 + cht * 128 + fr;
#pragma unroll
                for (int ct = 0; ct < 8; ++ct) {
                    bf16x8 bf;
#pragma unroll
                    for (int j = 0; j < 8; ++j) bf[j] = (short)bp[(size_t)j * 257 * 1024 + ct * 16];
                    const f32x4 z = {0.f, 0.f, 0.f, 0.f};
                    const f32x4 c0 = __builtin_amdgcn_mfma_f32_16x16x32_bf16(a0, bf, z, 0, 0, 0), c1 = __builtin_amdgcn_mfma_f32_16x16x32_bf16(a1, bf, z, 0, 0, 0);
                    bf16_t* sp = St + ((4 * fq) * 128 + ct * 16 + fr) * 32 + n2l;
#pragma unroll
                    for (int rg = 0; rg < 4; ++rg) { sp[rg * 4096] = f2bf(c0[rg]); sp[rg * 4096 + 16] = f2bf(c1[rg]); }
                }
            } else {
                for (int q = lane; q < 4096; q += 64) St[q * 16 + n2l] = 0;
            }
        }
        __syncthreads();
#pragma unroll 2
        for (int q = tid; q < 8192; q += 512) { const int half = q & 1, ri = (q >> 1) & 1, chl = (q >> 2) & 127, k1 = q >> 9;
            const int n2c = n2t * 16 + half * 8;
            if (n2c < 320) { const u32x4 v = *(const u32x4*)(St + (size_t)q * 8);
                *(u32x4*)(AP + ((size_t)((b * 16 + k1) * 512 + cht * 128 + chl)) * KF + ri * 320 + n2c) = v; } }
        if (n2t == 16) {
            for (int q = tid; q < 16 * 128 * 2 * 6; q += 512) { const int c6 = q % 6, r2 = q / 6, ri = r2 & 1, chl = (r2 >> 1) & 127, k1 = r2 >> 8;
                *(u32x4*)(AP + ((size_t)((b * 16 + k1) * 512 + cht * 128 + chl)) * KF + ri * 320 + 272 + c6 * 8) = (u32x4){0u, 0u, 0u, 0u}; } }
    }
    __syncthreads();
}

#ifdef DBG_SEC
#define SEC_T(k) do { if (lbid() == 0 && tid == 0) { const unsigned long long _n = __builtin_amdgcn_s_memrealtime(); if (sec_prev_k == DBG_SEC) *(unsigned long long*)(smem + LDS_BYTES - 32) += _n - sec_prev_t; sec_prev_t = _n; sec_prev_k = (k); } } while (0)
#else
#define SEC_T(k) do {} while (0)
#endif
__device__ void dn_prep(const Params& P, int l, unsigned char* smem, int t0, int t1) {
#ifdef DBG_SEC
    unsigned long long sec_prev_t = __builtin_amdgcn_s_memrealtime(); int sec_prev_k = -1;
#endif
    const int tid = ltid(), wave = __builtin_amdgcn_readfirstlane(tid >> 6), lane = tid & 63, fr = lane & 15, fq = lane >> 4;
    unsigned char* ws = P.ws;
    const bf16_t* QKV = (const bf16_t*)(ws + O_QKV); const float* LG = (const float*)(ws + S_LOGIT);
    bf16_t* WP = (bf16_t*)(ws + O_WP); bf16_t* QP = (bf16_t*)(ws + O_QP); bf16_t* KD = (bf16_t*)(ws + O_KD); bf16_t* UF = (bf16_t*)(ws + O_UF); bf16_t* AT = (bf16_t*)(ws + O_AT);
    float* GL = (float*)(ws + S_GL);
    const float* cw = P.in[9] + (size_t)l * 3 * 1536;
    bf16_t* Qs = (bf16_t*)smem;
    bf16_t* Ks = Qs + 64 * 136;
    bf16_t* KT = Ks + 64 * 136;
    bf16_t* VT = KT + 128 * 72;
    bf16_t* T1 = VT + 128 * 72;
    bf16_t* T2 = T1 + 64 * 72;
    bf16_t* Rm = T2 + 64 * 72;
    bf16_t* Rt = Rm + 64 * 72;
    bf16_t* Pm = Rt + 64 * 72;
    float* gcs = (float*)(T2 + 64 * 72 + 2 * 64 * 68 * 2);
    float* bts = gcs + 64;
    float* cwl = bts + 64;
    bf16_t* Xr = T1;
    const int items = (t1 - t0) * 64;
    u32x4 x0[6], xb;
#define PREP_ISSUE(it_) do { const int _tl = (it_) >> 6, _bhd = (it_) & 63, _b = _bhd >> 3, _h = (_bhd >> 1) & 3, _dir = _bhd & 1; const int _nb = (_dir ? 64 - (t0 + _tl) : (t0 + _tl)) * 64 - 48; const u32x4 z4 = {0u, 0u, 0u, 0u}; \
        _Pragma("unroll") for (int rr = 0; rr < 6; ++rr) { const int task = tid + 512 * rr, i = task / 48, cg_ = task - i * 48; const int n = _nb + (_dir ? 63 - i : i); \
            x0[rr] = (n >= 0) ? *(const u32x4*)(QKV + (size_t)(_b * LL + n) * 1536 + (cg_ >> 4) * 512 + _h * 128 + (cg_ & 15) * 8) : z4; } \
        xb = z4; if (tid < 96) { const int which = tid / 48, cg_ = tid - which * 48; const int n = which ? _nb + 64 : _nb - 1; \
            if (n >= 0 && n < LL) xb = *(const u32x4*)(QKV + (size_t)(_b * LL + n) * 1536 + (cg_ >> 4) * 512 + _h * 128 + (cg_ & 15) * 8); } } while (0)
    for (int it = lbid(); it < items; it += lgrid()) {
        const int tl = it >> 6, bhd = it & 63, b = bhd >> 3, h = (bhd >> 1) & 3, dir = bhd & 1;
        const int t = t0 + tl, c = dir ? 64 - t : t; const size_t slot = (size_t)tl * 64 + bhd;
        PREP_ISSUE(it);
        __syncthreads();
        SEC_T(0);
        for (int q = tid; q < 1152; q += 512) { const int tap = q / 384, rem = q - tap * 384; cwl[q] = cw[tap * 1536 + (rem >> 7) * 512 + h * 128 + (rem & 127)]; }
#pragma unroll
        for (int rr = 0; rr < 6; ++rr) { const int task = tid + 512 * rr, i = task / 48, cg_ = task - i * 48; *(u32x4*)(Xr + ((dir ? 63 - i : i) + 1) * 384 + cg_ * 8) = x0[rr]; }
        if (tid < 96) { const int which = tid / 48, cg_ = tid - which * 48; *(u32x4*)(Xr + (which ? 65 : 0) * 384 + cg_ * 8) = xb; }
        __syncthreads();
#pragma unroll 1
        for (int rr = 0; rr < 6; ++rr) {
            const int task = tid + 512 * rr, i = task / 48, cg_ = task - i * 48, kind = cg_ >> 4, cgl = cg_ & 15;
            float v[8], x[8];
            const float* w1 = cwl + 384 + kind * 128 + cgl * 8;
            const bf16_t* xr = Xr + ((dir ? 63 - i : i) + 1) * 384 + cg_ * 8;
            unpack8(*(const u32x4*)xr, x);
#pragma unroll
            for (int e = 0; e < 8; ++e) v[e] = w1[e] * x[e];
            unpack8(*(const u32x4*)(xr - 384), x);
#pragma unroll
            for (int e = 0; e < 8; ++e) v[e] += w1[e - 384] * x[e];
            unpack8(*(const u32x4*)(xr + 384), x);
#pragma unroll
            for (int e = 0; e < 8; ++e) v[e] += w1[e + 384] * x[e];
#pragma unroll
            for (int e = 0; e < 8; ++e) v[e] = siluf_(v[e]);
            float ss = 0.f;
#pragma unroll
            for (int e = 0; e < 8; ++e) ss += v[e] * v[e];
            ss += __shfl_xor(ss, 1); ss += __shfl_xor(ss, 2); ss += __shfl_xor(ss, 4); ss += __shfl_xor(ss, 8);
            if (kind < 2) { const float inv = rsqrtf(ss + EPS) * (kind == 0 ? 0.08838834764831845f : 1.0f);
#pragma unroll
                for (int e = 0; e < 8; ++e) v[e] *= inv; }
            const u32x4 pk = pack8(v);
            const int isw = i ^ ((cgl & 7) << 3);
            if (kind == 0) *(u32x4*)(Qs + i * 136 + cgl * 8) = pk;
            else if (kind == 1) { *(u32x4*)(Ks + i * 136 + cgl * 8) = pk;
#pragma unroll
                for (int e = 0; e < 8; ++e) KT[(cgl * 8 + e) * 72 + isw] = f2bf(v[e]); }
            else {
#pragma unroll
                for (int e = 0; e < 8; ++e) VT[(cgl * 8 + e) * 72 + isw] = f2bf(v[e]); }
        }
        if (wave == 0) {
            const int i = lane, n = c * 64 + (dir ? 63 - i : i) - 48; float beta = 0.f, g = 0.f;
            if (n >= 0) { const float* lg = LG + (size_t)(b * LL + n) * 16; const float bl = lg[dir * 4 + h], al = lg[8 + dir * 4 + h];
                beta = 1.0f / (1.0f + expf(-bl));
                const float xx = al + P.in[11][l * 8 + dir * 4 + h]; const float sp = xx > 20.f ? xx : log1pf(expf(xx));
                g = -expf(P.in[10][l * 8 + dir * 4 + h]) * sp; }
#pragma unroll
            for (int o = 1; o < 64; o <<= 1) { const float tt = __shfl_up(g, o); if (lane >= o) g += tt; }
            gcs[i] = g; bts[i] = beta;
        }
        __syncthreads();
        SEC_T(1);
        if (wave < 4) {
            const int m = wave; f32x4 acc[4];
#pragma unroll
            for (int n = 0; n < 4; ++n) acc[n] = (f32x4){0.f, 0.f, 0.f, 0.f};
#pragma unroll
            for (int s = 0; s < 4; ++s) { const bf16x8 a = *(const bf16x8*)(Ks + (16 * m + fr) * 136 + 32 * s + 8 * fq);
#pragma unroll
                for (int n = 0; n < 4; ++n) { const bf16x8 bb = *(const bf16x8*)(Ks + (16 * n + fr) * 136 + 32 * s + 8 * fq); acc[n] = __builtin_amdgcn_mfma_f32_16x16x32_bf16(a, bb, acc[n], 0, 0, 0); } }
#pragma unroll
            for (int n = 0; n < 4; ++n) { const int i = 16 * n + fr, j0 = 16 * m + 4 * fq;
                float nv[4], pv_[4];
#pragma unroll
                for (int rg = 0; rg < 4; ++rg) { const int j = j0 + rg; const float mv = (i > j) ? bts[i] * acc[n][rg] * __expf(gcs[i] - gcs[j]) : 0.f;
                    nv[rg] = -mv; pv_[rg] = (i == j ? 1.f : 0.f) - mv; Rt[j * 72 + i] = f2bf(-mv); }
                u32x2 w; w.x = cvt_pk_bf16(nv[0], nv[1]); w.y = cvt_pk_bf16(nv[2], nv[3]); *(u32x2*)(Rm + i * 72 + j0) = w;
                w.x = cvt_pk_bf16(pv_[0], pv_[1]); w.y = cvt_pk_bf16(pv_[2], pv_[3]); *(u32x2*)(Pm + i * 72 + j0) = w; }
        } else {
            const int m = wave - 4; f32x4 acc[4];
#pragma unroll
            for (int n = 0; n < 4; ++n) acc[n] = (f32x4){0.f, 0.f, 0.f, 0.f};
#pragma unroll
            for (int s = 0; s < 4; ++s) { const bf16x8 qf = *(const bf16x8*)(Qs + (16 * m + fr) * 136 + 32 * s + 8 * fq);
#pragma unroll
                for (int n = 0; n < 4; ++n) { const bf16x8 kf = *(const bf16x8*)(Ks + (16 * n + fr) * 136 + 32 * s + 8 * fq); acc[n] = __builtin_amdgcn_mfma_f32_16x16x32_bf16(kf, qf, acc[n], 0, 0, 0); } }
            const int i = 16 * m + fr; const float gi = gcs[i];
#pragma unroll
            for (int s2 = 0; s2 < 2; ++s2) { float v[8];
#pragma unroll
                for (int e = 0; e < 8; ++e) { const int j = 32 * s2 + 16 * (e >> 2) + 4 * fq + (e & 3); v[e] = (i >= j) ? acc[2 * s2 + (e >> 2)][e & 3] * __expf(gi - gcs[j]) : 0.f; }
                *(u32x4*)(AT + slot * 4096 + i * 64 + (((4 * s2 + fq) ^ ((i >> 1) & 7)) << 3)) = pack8(v); }
        }
        __syncthreads();
        SEC_T(2);
        {
            const float glast = gcs[63];
            for (int task = tid; task < 2048; task += 512) {
                if (task < 1024) { const int i = task >> 4, s_ = (task >> 2) & 3, f4 = task & 3; const float sc = __expf(gcs[i]);
                    const u32x2 a = *(const u32x2*)(Qs + i * 136 + 32 * s_ + 4 * f4), bq = *(const u32x2*)(Qs + i * 136 + 32 * s_ + 16 + 4 * f4);
                    float v[8]; v[0] = bf2f(a.x & 0xffffu) * sc; v[1] = __uint_as_float(a.x & 0xffff0000u) * sc; v[2] = bf2f(a.y & 0xffffu) * sc; v[3] = __uint_as_float(a.y & 0xffff0000u) * sc;
                    v[4] = bf2f(bq.x & 0xffffu) * sc; v[5] = __uint_as_float(bq.x & 0xffff0000u) * sc; v[6] = bf2f(bq.y & 0xffffu) * sc; v[7] = __uint_as_float(bq.y & 0xffff0000u) * sc;
                    *(u32x4*)(QP + slot * 8192 + i * 128 + (((4 * s_ + f4) ^ (i & 15)) << 3)) = pack8(v);
                } else { const int tt = task - 1024, dk = tt >> 3, s2 = (tt >> 2) & 1, f4 = tt & 3; const int i0 = 32 * s2 + 4 * f4;
                    const int sw = ((dk >> 3) & 7) << 3; const u32x2 a = *(const u32x2*)(KT + dk * 72 + (i0 ^ sw)), bq = *(const u32x2*)(KT + dk * 72 + ((i0 + 16) ^ sw));
                    float v[8]; v[0] = bf2f(a.x & 0xffffu) * __expf(glast - gcs[i0]); v[1] = __uint_as_float(a.x & 0xffff0000u) * __expf(glast - gcs[i0 + 1]);
                    v[2] = bf2f(a.y & 0xffffu) * __expf(glast - gcs[i0 + 2]); v[3] = __uint_as_float(a.y & 0xffff0000u) * __expf(glast - gcs[i0 + 3]);
                    v[4] = bf2f(bq.x & 0xffffu) * __expf(glast - gcs[i0 + 16]); v[5] = __uint_as_float(bq.x & 0xffff0000u) * __expf(glast - gcs[i0 + 17]);
                    v[6] = bf2f(bq.y & 0xffffu) * __expf(glast - gcs[i0 + 18]); v[7] = __uint_as_float(bq.y & 0xffff0000u) * __expf(glast - gcs[i0 + 19]);
                    *(u32x4*)(KD + slot * 8192 + dk * 64 + (((4 * s2 + f4) ^ ((dk >> 1) & 7)) << 3)) = pack8(v); }
            }
            if (tid == 0) GL[slot] = __expf(glast);
            f32x4 accP[2];
#pragma unroll
            for (int e = 0; e < 2; ++e) { const int tt = 2 * wave + e, it_ = tt >> 2, jt = tt & 3;
                const u32x2 pw = *(const u32x2*)(Pm + (16 * it_ + fr) * 72 + 16 * jt + 4 * fq);
                accP[e] = (f32x4){__uint_as_float(pw.x << 16), __uint_as_float(pw.x & 0xffff0000u), __uint_as_float(pw.y << 16), __uint_as_float(pw.y & 0xffff0000u)}; }
#pragma unroll 1
            for (int rd = 0; rd < 6; ++rd) {
                f32x4 accR[2], accT[2];
#pragma unroll
                for (int e = 0; e < 2; ++e) { const int tt = 2 * wave + e, mt = tt >> 2, nt = tt & 3;
                    accR[e] = (f32x4){0.f, 0.f, 0.f, 0.f}; accT[e] = (f32x4){0.f, 0.f, 0.f, 0.f};
#pragma unroll
                    for (int s2 = 0; s2 < 2; ++s2) {
                        const bf16x8 rm = *(const bf16x8*)(Rm + (16 * mt + fr) * 72 + 32 * s2 + 8 * fq), rn = *(const bf16x8*)(Rm + (16 * nt + fr) * 72 + 32 * s2 + 8 * fq);
                        const bf16x8 tm = *(const bf16x8*)(Rt + (16 * mt + fr) * 72 + 32 * s2 + 8 * fq), tn = *(const bf16x8*)(Rt + (16 * nt + fr) * 72 + 32 * s2 + 8 * fq);
                        const bf16x8 pm_ = *(const bf16x8*)(Pm + (16 * mt + fr) * 72 + 32 * s2 + 8 * fq);
                        if (rd < 5) { accR[e] = __builtin_amdgcn_mfma_f32_16x16x32_bf16(rm, tn, accR[e], 0, 0, 0);
                                      accT[e] = __builtin_amdgcn_mfma_f32_16x16x32_bf16(tm, rn, accT[e], 0, 0, 0); }
                        if (rd > 0) accP[e] = __builtin_amdgcn_mfma_f32_16x16x32_bf16(tn, pm_, accP[e], 0, 0, 0);
                    } }
                __syncthreads();
                if (rd < 5) {
#pragma unroll
                    for (int e = 0; e < 2; ++e) { const int tt = 2 * wave + e, mt = tt >> 2, nt = tt & 3; u32x2 w;
                        w.x = cvt_pk_bf16(accR[e][0], accR[e][1]); w.y = cvt_pk_bf16(accR[e][2], accR[e][3]); *(u32x2*)(Rt + (16 * nt + fr) * 72 + 16 * mt + 4 * fq) = w;
                        w.x = cvt_pk_bf16(accT[e][0], accT[e][1]); w.y = cvt_pk_bf16(accT[e][2], accT[e][3]); *(u32x2*)(Rm + (16 * nt + fr) * 72 + 16 * mt + 4 * fq) = w;
                        if (rd > 0) { w.x = cvt_pk_bf16(accP[e][0], accP[e][1]); w.y = cvt_pk_bf16(accP[e][2], accP[e][3]); *(u32x2*)(Pm + (16 * mt + fr) * 72 + 16 * nt + 4 * fq) = w; } }
                    __syncthreads();
                }
            }
#pragma unroll
            for (int e = 0; e < 2; ++e) { const int tt = 2 * wave + e, mt = tt >> 2, nt = tt & 3; const int i = 16 * mt + fr, c0 = 16 * nt + 4 * fq; float v1[4], v2[4];
#pragma unroll
                for (int rg = 0; rg < 4; ++rg) { const float bc = bts[c0 + rg]; v1[rg] = accP[e][rg] * bc; v2[rg] = -accP[e][rg] * bc * __expf(gcs[c0 + rg]); }
                u32x2 w; w.x = cvt_pk_bf16(v1[0], v1[1]); w.y = cvt_pk_bf16(v1[2], v1[3]); *(u32x2*)(T1 + i * 72 + c0) = w;
                w.x = cvt_pk_bf16(v2[0], v2[1]); w.y = cvt_pk_bf16(v2[2], v2[3]); *(u32x2*)(T2 + i * 72 + c0) = w; }
        }
        __syncthreads();
        SEC_T(3);
#pragma unroll 1
        for (int nh = 0; nh < 2; ++nh) {
        if (wave < 4) {
            const int m = wave; f32x4 acc[4];
#pragma unroll
            for (int n = 0; n < 4; ++n) acc[n] = (f32x4){0.f, 0.f, 0.f, 0.f};
#pragma unroll
            for (int s2 = 0; s2 < 2; ++s2) { const bf16x8 a = *(const bf16x8*)(T1 + (16 * m + fr) * 72 + 32 * s2 + 8 * fq);
#pragma unroll
                for (int n = 0; n < 4; ++n) { const int d = 16 * (4 * nh + n) + fr; const bf16x8 bb = *(const bf16x8*)(VT + d * 72 + ((32 * s2 + 8 * fq) ^ (((d >> 3) & 7) << 3))); acc[n] = __builtin_amdgcn_mfma_f32_16x16x32_bf16(a, bb, acc[n], 0, 0, 0); } }
#pragma unroll
            for (int n = 0; n < 4; ++n) { u32x2 w; w.x = cvt_pk_bf16(acc[n][0], acc[n][1]); w.y = cvt_pk_bf16(acc[n][2], acc[n][3]);
                *(u32x2*)(UF + slot * 8192 + (((4 * nh + n) * 4 + m) * 64 + lane) * 4) = w; }
        } else {
            const int m = wave - 4; f32x4 acc[4];
#pragma unroll
            for (int n = 0; n < 4; ++n) acc[n] = (f32x4){0.f, 0.f, 0.f, 0.f};
#pragma unroll
            for (int s2 = 0; s2 < 2; ++s2) { const bf16x8 tf = *(const bf16x8*)(T2 + (16 * m + fr) * 72 + 32 * s2 + 8 * fq);
#pragma unroll
                for (int n = 0; n < 4; ++n) { const int d = 16 * (4 * nh + n) + fr; const bf16x8 kf = *(const bf16x8*)(KT + d * 72 + ((32 * s2 + 8 * fq) ^ (((d >> 3) & 7) << 3))); acc[n] = __builtin_amdgcn_mfma_f32_16x16x32_bf16(kf, tf, acc[n], 0, 0, 0); } }
            const int i = 16 * m + fr;
#pragma unroll
            for (int s = 0; s < 2; ++s) { u32x4 w; w.x = cvt_pk_bf16(acc[2 * s][0], acc[2 * s][1]); w.y = cvt_pk_bf16(acc[2 * s][2], acc[2 * s][3]);
                w.z = cvt_pk_bf16(acc[2 * s + 1][0], acc[2 * s + 1][1]); w.w = cvt_pk_bf16(acc[2 * s + 1][2], acc[2 * s + 1][3]);
                *(u32x4*)(WP + slot * 8192 + i * 128 + (((4 * (2 * nh + s) + fq) ^ (i & 15)) << 3)) = w; }
        }
        }
        SEC_T(4);
    }
    __syncthreads();
}

__device__ void dn_scan(const Params& P, unsigned char* smem, int t0, int t1) {
    if (lbid() >= 128) return;
    const int bhd = lbid() >> 1, half = lbid() & 1;
    const int tid = ltid(), wave = __builtin_amdgcn_readfirstlane(tid >> 6), lane = tid & 63, fr = lane & 15, fq = lane >> 4;
    unsigned char* ws = P.ws;
    const unsigned char* WPb = ws + O_WP; const unsigned char* QPb = ws + O_QP; const unsigned char* KDb = ws + O_KD; const unsigned char* ATb = ws + O_AT;
    const bf16_t* UF = (const bf16_t*)(ws + O_UF); const float* GL = (const float*)(ws + S_GL);
    bf16_t* OO = (bf16_t*)(ws + O_O); f32x4* SS = (f32x4*)(ws + S_SSAVE);
    const int b = bhd >> 3, h = (bhd >> 1) & 3, dir = bhd & 1;
    LAS unsigned char* lds = (LAS unsigned char*)smem;
    constexpr int BUFB = 57344;
#define SCAN_SRC(q_, slot_) ((q_) < 16 ? WPb + (slot_) * 16384 + (q_) * 1024 : (q_) < 32 ? QPb + (slot_) * 16384 + ((q_) - 16) * 1024 : (q_) < 48 ? KDb + (slot_) * 16384 + ((q_) - 32) * 1024 : ATb + (slot_) * 8192 + ((q_) - 48) * 1024)
#define SCAN_LOAD(tl_) do { const size_t _slot = (size_t)(tl_) * 64 + bhd; _Pragma("unroll") for (int _k = 0; _k < 14; ++_k) { const int _q = (wave - 4) * 14 + _k; rg_[_k] = *(const u32x4*)(SCAN_SRC(_q, _slot) + lane * 16); } } while (0)
#define SCAN_WRITE(buf_) do { _Pragma("unroll") for (int _k = 0; _k < 14; ++_k) { const int _q = (wave - 4) * 14 + _k; *(LAS u32x4*)(lds + (buf_) * BUFB + _q * 1024 + lane * 16) = rg_[_k]; } } while (0)
    constexpr int NN = 1; const bool cw_ = wave < 4; const int sl0 = half * 4 + (wave & 3);
    const int nst = t1 - t0;
    if (!cw_) {
        u32x4 rg_[14];
#define SCAN_LOAD(tl_) do { const size_t _slot = (size_t)(tl_) * 64 + bhd; _Pragma("unroll") for (int _k = 0; _k < 14; ++_k) { const int _q = (wave - 4) * 14 + _k; rg_[_k] = *(const u32x4*)(SCAN_SRC(_q, _slot) + lane * 16); } } while (0)
#define SCAN_WRITE(buf_) do { _Pragma("unroll") for (int _k = 0; _k < 14; ++_k) { const int _q = (wave - 4) * 14 + _k; *(LAS u32x4*)(lds + (buf_) * BUFB + _q * 1024 + lane * 16) = rg_[_k]; } } while (0)
        SCAN_LOAD(0); SCAN_WRITE(0); if (nst > 1) SCAN_LOAD(1);
#pragma unroll 1
        for (int tl = 0; tl < nst; ++tl) {
            __syncthreads();
            if (tl + 1 < nst) { SCAN_WRITE((tl + 1) & 1); if (tl + 2 < nst) SCAN_LOAD(tl + 2); }
        }
        asm volatile("s_waitcnt vmcnt(0)" ::: "memory");
        __syncthreads();
        return;
    }
    f32x4 S[8][NN];
#pragma unroll
    for (int t = 0; t < 8; ++t)
#pragma unroll
        for (int nn = 0; nn < NN; ++nn) S[t][nn] = (t0 == 0 || !cw_) ? (f32x4){0.f, 0.f, 0.f, 0.f} : SS[((size_t)(bhd * 8 + sl0 + nn) * 8 + t) * 64 + lane];
    u32x2 un[4][NN];
    if (cw_) {
#pragma unroll
        for (int m = 0; m < 4; ++m)
#pragma unroll
            for (int nn = 0; nn < NN; ++nn) un[m][nn] = *(const u32x2*)(UF + (size_t)bhd * 8192 + (((sl0 + nn) * 4 + m) * 64 + lane) * 4); }
    float gln = __hip_atomic_load(GL + bhd, __ATOMIC_RELAXED, __HIP_MEMORY_SCOPE_AGENT);
#pragma unroll 1
    for (int tl = 0; tl < nst; ++tl) {
        const size_t slot = (size_t)tl * 64 + bhd; const int t = t0 + tl, c = dir ? 64 - t : t;
        const LAS unsigned char* bw = lds + (tl & 1) * BUFB;
        __syncthreads();
        f32x4 av[4][NN], ao[4][NN];
#pragma unroll
        for (int m = 0; m < 4; ++m)
#pragma unroll
            for (int nn = 0; nn < NN; ++nn) { const u32x2 u = un[m][nn];
                av[m][nn] = (f32x4){__uint_as_float(u.x << 16), __uint_as_float(u.x & 0xffff0000u), __uint_as_float(u.y << 16), __uint_as_float(u.y & 0xffff0000u)}; ao[m][nn] = (f32x4){0.f, 0.f, 0.f, 0.f}; }
        const float gl = gln; if (tl + 1 < nst) gln = __hip_atomic_load(GL + slot + 64, __ATOMIC_RELAXED, __HIP_MEMORY_SCOPE_AGENT);
        if (tl + 1 < nst) {
#pragma unroll
            for (int m = 0; m < 4; ++m)
#pragma unroll
                for (int nn = 0; nn < NN; ++nn) un[m][nn] = *(const u32x2*)(UF + (slot + 64) * 8192 + (((sl0 + nn) * 4 + m) * 64 + lane) * 4); }
#pragma unroll
        for (int s = 0; s < 4; ++s) { bf16x8 Sb[NN];
#pragma unroll
            for (int nn = 0; nn < NN; ++nn) { u32x4 w; w.x = cvt_pk_bf16(S[2 * s][nn][0], S[2 * s][nn][1]); w.y = cvt_pk_bf16(S[2 * s][nn][2], S[2 * s][nn][3]); w.z = cvt_pk_bf16(S[2 * s + 1][nn][0], S[2 * s + 1][nn][1]); w.w = cvt_pk_bf16(S[2 * s + 1][nn][2], S[2 * s + 1][nn][3]);
                Sb[nn] = __builtin_bit_cast(bf16x8, w); }
#pragma unroll
            for (int m = 0; m < 4; ++m) { const bf16x8 wf = *(const LAS bf16x8*)(bw + (16 * m + fr) * 256 + (((4 * s + fq) ^ fr) << 4)); const bf16x8 qf = *(const LAS bf16x8*)(bw + 16384 + (16 * m + fr) * 256 + (((4 * s + fq) ^ fr) << 4));
                _Pragma("unroll") for (int nn = 0; nn < NN; ++nn) av[m][nn] = __builtin_amdgcn_mfma_f32_16x16x32_bf16(wf, Sb[nn], av[m][nn], 0, 0, 0);
                _Pragma("unroll") for (int nn = 0; nn < NN; ++nn) ao[m][nn] = __builtin_amdgcn_mfma_f32_16x16x32_bf16(qf, Sb[nn], ao[m][nn], 0, 0, 0); } }
        __builtin_amdgcn_sched_barrier(0);
        bf16x8 Vb[2][NN];
#pragma unroll
        for (int s2 = 0; s2 < 2; ++s2)
#pragma unroll
            for (int nn = 0; nn < NN; ++nn) { u32x4 w; w.x = cvt_pk_bf16(av[2 * s2][nn][0], av[2 * s2][nn][1]); w.y = cvt_pk_bf16(av[2 * s2][nn][2], av[2 * s2][nn][3]); w.z = cvt_pk_bf16(av[2 * s2 + 1][nn][0], av[2 * s2 + 1][nn][1]); w.w = cvt_pk_bf16(av[2 * s2 + 1][nn][2], av[2 * s2 + 1][nn][3]);
                Vb[s2][nn] = __builtin_bit_cast(bf16x8, w); }
#pragma unroll
        for (int m = 0; m < 4; ++m)
#pragma unroll
            for (int s2 = 0; s2 < 2; ++s2) { const int row = 16 * m + fr; const bf16x8 af = *(const LAS bf16x8*)(bw + 49152 + row * 128 + (((4 * s2 + fq) ^ ((row >> 1) & 7)) << 4));
                _Pragma("unroll") for (int nn = 0; nn < NN; ++nn) ao[m][nn] = __builtin_amdgcn_mfma_f32_16x16x32_bf16(af, Vb[s2][nn], ao[m][nn], 0, 0, 0); }
        __builtin_amdgcn_sched_barrier(0);
#pragma unroll
        for (int tt = 0; tt < 8; ++tt) { _Pragma("unroll") for (int nn = 0; nn < NN; ++nn) S[tt][nn] = S[tt][nn] * gl;
#pragma unroll
            for (int s2 = 0; s2 < 2; ++s2) { const int row = 16 * tt + fr; const bf16x8 kf = *(const LAS bf16x8*)(bw + 32768 + row * 128 + (((4 * s2 + fq) ^ ((row >> 1) & 7)) << 4));
                _Pragma("unroll") for (int nn = 0; nn < NN; ++nn) S[tt][nn] = __builtin_amdgcn_mfma_f32_16x16x32_bf16(kf, Vb[s2][nn], S[tt][nn], 0, 0, 0); } }
#pragma unroll
        for (int m = 0; m < 4; ++m)
#pragma unroll
            for (int rg = 0; rg < 4; ++rg) { const int i = 16 * m + 4 * fq + rg, n = c * 64 + (dir ? 63 - i : i) - 48;
                if (n >= 0) { bf16_t* op = OO + ((size_t)dir * TP + (size_t)b * LL + n) * 512 + h * 128 + sl0 * 16 + fr; _Pragma("unroll") for (int nn = 0; nn < NN; ++nn) op[16 * nn] = f2bf(ao[m][nn][rg]); } }
    }
#undef SCAN_SRC
#undef SCAN_LOAD
#undef SCAN_WRITE
    if (t1 < NSTEP && cw_) {
#pragma unroll
        for (int t = 0; t < 8; ++t)
#pragma unroll
            for (int nn = 0; nn < NN; ++nn) SS[((size_t)(bhd * 8 + sl0 + nn) * 8 + t) * 64 + lane] = S[t][nn]; }
    asm volatile("s_waitcnt vmcnt(0)" ::: "memory");
    __syncthreads();
}

__device__ void dn_out(const Params& P, int l) {
    const int tid_ = ltid(); const int wave = __builtin_amdgcn_readfirstlane(tid_ >> 6), lane = tid_ & 63;
    const bf16_t* OO = (const bf16_t*)(P.ws + O_O); const bf16_t* Z = (const bf16_t*)(P.ws + O_Z); bf16_t* DNO = (bf16_t*)(P.ws + O_BR) + (size_t)2 * TP * 512;
    const float* nw = P.in[12] + (size_t)l * 128; float g[8];
#pragma unroll
    for (int e = 0; e < 8; ++e) g[e] = nw[(lane & 15) * 8 + e];
    for (int r = lbid() * 8 + wave; r < TT; r += lgrid() * 8) {
        float a[8], bq[8], z[8]; unpack8(*(const u32x4*)(OO + (size_t)r * 512 + lane * 8), a); unpack8(*(const u32x4*)(OO + ((size_t)TP + r) * 512 + lane * 8), bq); unpack8(*(const u32x4*)(Z + (size_t)r * 512 + lane * 8), z);
        float ss = 0.f;
#pragma unroll
        for (int e = 0; e < 8; ++e) { a[e] += bq[e]; ss += a[e] * a[e]; }
        ss += __shfl_xor(ss, 1); ss += __shfl_xor(ss, 2); ss += __shfl_xor(ss, 4); ss += __shfl_xor(ss, 8);
        const float inv = rsqrtf(ss * (1.0f / 128.0f) + EPS);
#pragma unroll
        for (int e = 0; e < 8; ++e) a[e] = a[e] * inv * g[e] * siluf_(z[e]);
        *(u32x4*)(DNO + (size_t)r * 512 + lane * 8) = pack8(a);
    }
}


#define XB_TMO      128
#define XB_XCNT(j)  (256  + 64 * (j))
#define XB_XSUB(j)  (1280 + 64 * (j))
#define XB_XGEN(j)  (2304 + 64 * (j))
#define XB_TOP      3328
#define XB_TOPGEN   3392
#define XCD_BAR_WORDS 3456
#define XB_SPIN_CAP (1u << 22)
__device__ __forceinline__ unsigned xb_ld(unsigned* p)              { return __hip_atomic_load(p, __ATOMIC_RELAXED, __HIP_MEMORY_SCOPE_AGENT); }
__device__ __forceinline__ unsigned xb_add(unsigned* p, unsigned v) { return __hip_atomic_fetch_add(p, v, __ATOMIC_RELAXED, __HIP_MEMORY_SCOPE_AGENT); }
__device__ __forceinline__ unsigned xb_xcc_id() { return (unsigned)__builtin_amdgcn_s_getreg((3 << 11) | 20) & 0xFu; }
#define XB_SPIN(cond, bar) do { unsigned _sp = 0; while (cond) { __builtin_amdgcn_s_sleep(1); \
    if ((++_sp & 255u) == 0u) { if (xb_ld(&(bar)[XB_TMO])) break; if (_sp > XB_SPIN_CAP) { atomicAdd(&(bar)[XB_TMO], 1u); break; } } } } while (0)
struct XcdBarrier { unsigned* bar; unsigned x; volatile LAS unsigned* st; };
__device__ __forceinline__ XcdBarrier xcd_barrier_post(unsigned* bar, volatile LAS unsigned* st) {
    XcdBarrier b; b.bar = bar; b.x = xb_xcc_id(); b.st = st;
    if (threadIdx.x == 0) (void)xb_add(&bar[XB_XCNT(b.x)], 1u);
    return b;
}
__device__ __forceinline__ void xcd_barrier_complete(unsigned* bar, unsigned x, unsigned& nloc, unsigned& nx) {
    const unsigned G = gridDim.x * gridDim.y * gridDim.z;
    unsigned sum, cnt, mine, sp = 0u;
    for (;;) {
        sum = 0u; cnt = 0u; mine = 0u;
#pragma unroll
        for (unsigned j = 0; j < 16; ++j) { const unsigned c = xb_ld(&bar[XB_XCNT(j)]); sum += c; cnt += (c > 0u) ? 1u : 0u; mine = (j == x) ? c : mine; }
        if (sum == G) break;
        __builtin_amdgcn_s_sleep(1);
        if ((++sp & 255u) == 0u) { if (xb_ld(&bar[XB_TMO])) break; if (sp > XB_SPIN_CAP) { atomicAdd(&bar[XB_TMO], 1u); break; } }
    }
    nloc = mine > 0u ? mine : 1u; nx = cnt > 0u ? cnt : 1u;
}
__device__ __forceinline__ void xcd_barrier(const XcdBarrier& b) {
    asm volatile("s_waitcnt vmcnt(0)" ::: "memory");
    __syncthreads();
    if (threadIdx.x == 0) {
        unsigned* bar = b.bar;
        __builtin_amdgcn_s_waitcnt(0);
        unsigned nloc = b.st[0], nx = b.st[1];
        if (nloc == 0u) { xcd_barrier_complete(bar, b.x, nloc, nx); b.st[0] = nloc; b.st[1] = nx; }
        const unsigned old = xb_add(&bar[XB_XSUB(b.x)], 1u);
        const unsigned gen = old / nloc;
        if (old + 1u == (gen + 1u) * nloc) {
            __builtin_amdgcn_fence(__ATOMIC_RELEASE, "agent");
            asm volatile("s_waitcnt vmcnt(0)" ::: "memory");
            const unsigned og = xb_add(&bar[XB_TOP], 1u);
            const unsigned tg = og / nx;
            if (og + 1u == (tg + 1u) * nx) xb_add(&bar[XB_TOPGEN], 1u);
            else XB_SPIN(xb_ld(&bar[XB_TOPGEN]) == tg, bar);
            __builtin_amdgcn_fence(__ATOMIC_ACQUIRE, "agent");
            xb_add(&bar[XB_XGEN(b.x)], 1u);
            asm volatile("s_waitcnt vmcnt(0)" ::: "memory");
        } else {
            XB_SPIN(xb_ld(&bar[XB_XGEN(b.x)]) == gen, bar);
            __builtin_amdgcn_fence(__ATOMIC_ACQUIRE, "agent");
            asm volatile("s_waitcnt vmcnt(0)" ::: "memory");
        }
    }
    __syncthreads();
}
__device__ __forceinline__ int phase_cat(int ph) { const int p = ph % 22;
    return p == 0 ? 0 : (p == 1 || p == 2 || p == 19 || p == 20) ? 1 : (p == 3 || p == 18 || p == 21) ? 2 : p == 4 ? 3 : p == 5 ? 4 : p == 6 ? 5 : p == 7 ? 6 : (p == 8 || p == 10 || p == 12) ? 7 : (p == 9 || p == 11 || p == 13) ? 8 : p == 14 ? 9 : 10; }
#ifndef SKIP_GEMM
#define GEMM_CALL(a,b,c,d) pg8::gemm_phase(a,b,c,d)
#else
#define GEMM_CALL(a,b,c,d) (void)0
#endif
__global__ void __launch_bounds__(512, 2) fwd_kernel(Params P) {
    extern __shared__ __attribute__((aligned(16))) unsigned char smem[];
    cg::grid_group grid = cg::this_grid();
    unsigned char* ws = P.ws;
    LAS unsigned char* lds = (LAS unsigned char*)smem;
    int ph = 0;
    { volatile LAS unsigned* stw = (volatile LAS unsigned*)(lds + LDS_BYTES - 32); if (threadIdx.x < 8) stw[threadIdx.x] = 0u; }
    __syncthreads();
    XcdBarrier xbar = xcd_barrier_post((unsigned*)(ws + S_BAR), (volatile LAS unsigned*)(lds + LDS_BYTES - 16));
#ifdef DBG_CAT
    unsigned long long t_prev = __builtin_amdgcn_s_memrealtime(), t_acc = 0ull;
#define STAMP() do { const unsigned long long _n = __builtin_amdgcn_s_memrealtime(); if (phase_cat(ph) == DBG_CAT) t_acc += _n - t_prev; t_prev = _n; } while (0)
#else
#define STAMP() do {} while (0)
#endif
#define PHASE_BEGIN if (ph >= P.ph_lo && ph < P.ph_hi) { const int G = lgrid(), bx = lbid(); (void)G; (void)bx;
#define PHASE_END   if (ph + 1 < P.ph_hi) { if (ph == 0) { asm volatile("s_waitcnt vmcnt(0) lgkmcnt(0)" ::: "memory"); grid.sync(); __builtin_amdgcn_fence(__ATOMIC_ACQUIRE, "agent"); asm volatile("s_waitcnt vmcnt(0)" ::: "memory"); __syncthreads(); } else xcd_barrier(xbar); } STAMP(); } ++ph;
    for (ph = P.ph_lo; ph < P.ph_hi; ++ph) {
        const int l = ph / 22, p = ph - l * 22;
        const int G = lgrid(), bx = lbid();
        bf16_t* XN = (bf16_t*)(ws + O_XN); bf16_t* Y = (bf16_t*)(ws + O_Y); bf16_t* ACT = (bf16_t*)(ws + O_ACT);
        const float* ng = P.in[2] + (size_t)l * 6 * 1024;
        switch (p) {
        case 0:
#ifndef SKIP_CVT
            convert_weights(P, l, smem);
#endif
            if (l == 0) { gen_tables(P); rpass(P, nullptr, true, nullptr, 0.f, ng, XN); }
            break;
        case 1: case 19: { pg8::Gemm g{XN, (const bf16_t*)(ws + (p == 1 ? W_WI1 : W_WI2)), TP, 5632, 1024, 128, 1024}; pg8::StaticOrder S; S.init(TP, 5632, G, bx); pg8::EpiSwiglu E{ACT}; GEMM_CALL(lds, g, S, E); } break;
        case 2: case 20: case 17: {
            const bool dn = (p != 17); const int Kx = dn ? 2816 : 1024, nS = dn ? 11 : 4;
            const bf16_t* W = (const bf16_t*)(ws + (p == 2 ? W_WO1 : p == 20 ? W_WO2 : W_WOUT)); const bf16_t* Ax = dn ? ACT : (const bf16_t*)(ws + O_MG);
            { pg8::Gemm g{Ax, W, TP, 1024, Kx, 128, Kx}; pg8::StaticOrder S; S.init(TP, 1024, G, bx, false); pg8::EpiBf16<0> E{Y, 1024}; GEMM_CALL(lds, g, S, E); }
            { pg8::Gemm g{W, Ax + (size_t)32768 * Kx, 1024, 256, Kx, -1, 256}; pg8::TailOrder S{nS, bx}; pg8::EpiSlab E{(float*)(ws + O_SLAB), nS}; GEMM_CALL(lds, g, S, E); } } break;
        case 3: rpass(P, Y, l == 0, ng + 1024, 0.5f, ng + 2048, XN, (const float*)(ws + O_SLAB), 11); break;
        case 4: { pg8::Gemm g{XN, (const bf16_t*)(ws + W_WIN), TP, NPROJ, 1024, 128, 1024}; pg8::StaticOrder S; S.init(TP, NPROJ, G, bx); pg8::EpiInProj E{ws}; GEMM_CALL(lds, g, S, E); } break;
        case 5: sconv_pass(P, l); break;
        case 6:
#ifndef SKIP_F1
            fstep1(P, smem);
#endif
            break;
        case 7: { pg8::Gemm g{(const bf16_t*)(ws + S_C257), (const bf16_t*)(ws + O_AP), 512, 65536, KF, 1, KF}; pg8::StaticOrder S; S.init(512, 65536, G, bx);
                  pg8::EpiFourier E{(bf16_t*)(ws + O_BR), 0.001949317738791423f  }; GEMM_CALL(lds, g, S, E); } break;
        case 8: case 10: case 12: { const int t0 = ((p - 8) >> 1) * SPL, t1 = (t0 + SPL < NSTEP) ? t0 + SPL : NSTEP;
#ifndef SKIP_PREP
            dn_prep(P, l, smem, t0, t1);
#endif
            } break;
        case 9: case 11: case 13: { const int t0 = ((p - 9) >> 1) * SPL, t1 = (t0 + SPL < NSTEP) ? t0 + SPL : NSTEP;
#ifndef SKIP_SCAN
            dn_scan(P, smem, t0, t1);
#endif
            } break;
        case 14: dn_out(P, l); rpass(P, nullptr, false, nullptr, 0.f, ng + 2048, (bf16_t*)(ws + O_XN2)); break;
        case 15: { pg8::Gemm g{(const bf16_t*)(ws + O_XN2), (const bf16_t*)(ws + W_WG), TP, 3072, 1024, 128, 1024}; pg8::StaticOrder S; S.init(TP, 3072, G, bx); pg8::EpiBf16<1> E{(bf16_t*)(ws + O_GATE), 3072}; GEMM_CALL(lds, g, S, E); } break;
        case 16: { pg8::Gemm g{(const bf16_t*)(ws + O_BR), (const bf16_t*)(ws + W_WBR), 3 * TP, 3072, 512, -1, 512}; pg8::MergeOrder S{G, bx}; pg8::EpiMerge E{(const bf16_t*)(ws + O_GATE), (bf16_t*)(ws + O_MG), (bf16_t*)(ws + O_XN2)}; GEMM_CALL(lds, g, S, E); } break;
        case 18: rpass(P, Y, false, ng + 3 * 1024, 1.0f, ng + 4 * 1024, XN, (const float*)(ws + O_SLAB), 4); break;
        default: rpass(P, Y, false, ng + 5 * 1024, 0.5f, l == 0 ? P.in[2] + (size_t)6 * 1024 : nullptr, XN, (const float*)(ws + O_SLAB), 11); break;
        }
        if (ph + 1 < P.ph_hi) {
            if (ph == 0) { asm volatile("s_waitcnt vmcnt(0) lgkmcnt(0)" ::: "memory"); grid.sync(); __builtin_amdgcn_fence(__ATOMIC_ACQUIRE, "agent"); asm volatile("s_waitcnt vmcnt(0)" ::: "memory"); __syncthreads(); }
            else xcd_barrier(xbar);
        }
        STAMP();
    }
#ifdef DBG_CAT
    if (lbid() == 0 && threadIdx.x == 0) { const unsigned long long t0 = __builtin_amdgcn_s_memrealtime(); while (__builtin_amdgcn_s_memrealtime() - t0 < t_acc + *(unsigned long long*)(smem + LDS_BYTES - 32)) __builtin_amdgcn_s_sleep(16); }
#endif
#ifdef DBG_FLUSH
    { asm volatile("s_waitcnt vmcnt(0) lgkmcnt(0)" ::: "memory"); grid.sync(); __builtin_amdgcn_fence(__ATOMIC_ACQUIRE, "agent"); asm volatile("s_waitcnt vmcnt(0)" ::: "memory");
      const f32x4* xs = (const f32x4*)P.in[0]; f32x4 a = {0.f, 0.f, 0.f, 0.f};
      for (size_t i = ltid(); i < (size_t)8388608; i += 512) a += xs[i];
      if (a[0] + a[1] + a[2] + a[3] == 1.2345e-30f) ((float*)(ws + S_GL))[4000] = 1.f; }
#endif
#ifdef DBG_OFF
    { asm volatile("s_waitcnt vmcnt(0) lgkmcnt(0)" ::: "memory"); grid.sync(); __builtin_amdgcn_fence(__ATOMIC_ACQUIRE, "agent"); asm volatile("s_waitcnt vmcnt(0)" ::: "memory");
      const bf16_t* src = (const bf16_t*)(ws + DBG_OFF);
      for (size_t i = (size_t)lbid() * 512 + ltid(); i < (size_t)33554432; i += (size_t)lgrid() * 512) P.out[i] = i < (size_t)DBG_CNT ? bf2f(src[i]) : 0.f; }
#endif
}

extern "C" void kernel_launch(void* const* d_in, const int* in_sizes, int n_in, void* d_out, int out_size, void* d_ws, size_t ws_size, hipStream_t stream) {
    static int grid = 0;
    if (grid == 0) {
        int dev = 0, cus = 0, per_cu = 0;
        hipGetDevice(&dev); hipDeviceGetAttribute(&cus, hipDeviceAttributeMultiprocessorCount, dev);
        hipFuncSetAttribute((const void*)fwd_kernel, hipFuncAttributeMaxDynamicSharedMemorySize, LDS_BYTES);
        hipOccupancyMaxActiveBlocksPerMultiprocessor(&per_cu, (const void*)fwd_kernel, 512, LDS_BYTES);
        if (per_cu < 1) { fprintf(stderr, "occupancy query says %d blocks/CU\n", per_cu); per_cu = 1; }
        grid = cus;
        if (ws_size < WS_NEED) fprintf(stderr, "workspace too small: %zu < %zu\n", ws_size, (size_t)WS_NEED);
    }
    Params p{};
    for (int i = 0; i < 17; ++i) p.in[i] = (const float*)d_in[i];
    p.out = (float*)d_out; p.ws = (unsigned char*)d_ws; p.ph_lo = 0; p.ph_hi = 44;
#ifdef DBG_PHI
    p.ph_hi = DBG_PHI;
#endif
    hipMemsetAsync((char*)d_ws + S_BAR, 0, 16384, stream);
    void* args[] = {&p};
    hipError_t e = hipLaunchCooperativeKernel((const void*)fwd_kernel, dim3(grid), dim3(512), args, LDS_BYTES, stream);
    if (e != hipSuccess) fprintf(stderr, "cooperative launch failed: %s (grid %d)\n", hipGetErrorString(e), grid);
}
```

```cpp
#include <hip/hip_runtime.h>
#include <hip/hip_cooperative_groups.h>
#include <cstdio>
namespace cg = cooperative_groups;

#define LAS __attribute__((address_space(3)))
typedef unsigned short bf16_t;
typedef short bf16x8 __attribute__((ext_vector_type(8)));
typedef float f32x4 __attribute__((ext_vector_type(4)));
typedef unsigned u32x4 __attribute__((ext_vector_type(4)));
typedef unsigned u32x2 __attribute__((ext_vector_type(2)));

constexpr int DM = 1024, NB = 8, SEQ = 4096, NMETA = 16, LL = 4112, TT = NB * LL  , TP = 33024  , DFF = 2816;
constexpr int NIN = 7184;
constexpr int NPROJ = 4864;
constexpr float EPS = 1e-6f;
constexpr int NSTEP = 65, SPL = 24, NSPLIT = 3;
constexpr int KF = 640;

constexpr size_t UU = (size_t)TP * 1024;
constexpr size_t W_WI1 = 0, W_WO1 = W_WI1 + (size_t)5632 * 1024 * 2, W_WI2 = W_WO1 + (size_t)1024 * 2816 * 2, W_WO2 = W_WI2 + (size_t)5632 * 1024 * 2,
                 W_WIN = W_WO2 + (size_t)1024 * 2816 * 2, W_WG = W_WIN + (size_t)NPROJ * 1024 * 2, W_WBR = W_WG + (size_t)3072 * 1024 * 2,
                 W_WOUT = W_WBR + (size_t)3072 * 512 * 2, W_END = W_WOUT + (size_t)1024 * 1024 * 2;
constexpr size_t S_C257 = W_END, S_TWL = S_C257 + (size_t)512 * KF * 2, S_HM = S_TWL + 33024, S_LOGIT = S_HM + (size_t)128 * 1024 * 4,
                 S_GL = S_LOGIT + (size_t)TP * 16 * 4, S_SSAVE = S_GL + 16896, S_BAR = S_SSAVE + (size_t)512 * 8 * 64 * 16, S_END = S_BAR + 16384;
constexpr size_t A0 = (S_END + 255) / 256 * 256;
constexpr size_t O_XN = A0, O_Y = A0 + 2 * UU, O_ACT = A0 + 4 * UU;
constexpr size_t O_BR = A0, O_QKV = A0 + 4 * UU, O_Z = A0 + 7 * UU, O_SC = A0 + 8 * UU, O_PQ = A0 + 11 * UU, O_AP = A0 + 8 * UU;
constexpr size_t DNI_SLOTS = (size_t)SPL * 64;
constexpr size_t O_WP = A0 + 8 * UU, O_QP = O_WP + DNI_SLOTS * 16384, O_KD = O_QP + DNI_SLOTS * 16384, O_UF = O_KD + DNI_SLOTS * 16384,
                 O_AT = O_UF + DNI_SLOTS * 16384, O_DNI_END = O_AT + DNI_SLOTS * 8192;
constexpr size_t O_O = (O_DNI_END + 255) / 256 * 256;
constexpr size_t O_XN2 = A0 + 3 * UU, O_GATE = A0 + 5 * UU, O_MG = A0 + 11 * UU;
constexpr size_t O_SLAB = (O_O + 2 * UU + 255) / 256 * 256;
constexpr size_t WS_NEED = O_SLAB + (size_t)44 * 65536 * 4;
static_assert(WS_NEED <= (size_t)536870912, "workspace");
static_assert(O_AP + (size_t)65536 * KF * 2 <= O_PQ, "A' overlaps PQ");
static_assert(O_O >= O_PQ || true, "");
static_assert(O_MG + 2 * UU <= WS_NEED + 2 * UU, "");

constexpr int LDS_BYTES = 132 * 1024;

#define DBG_CNT ((size_t)33554432)


struct Params { const float* in[17]; float* out; unsigned char* ws; int ph_lo, ph_hi; };

__device__ __forceinline__ float bf2f(unsigned v) { return __uint_as_float(v << 16); }
typedef __bf16 bf16x2_t __attribute__((ext_vector_type(2)));
typedef float f32x2_t __attribute__((ext_vector_type(2)));
__device__ __forceinline__ unsigned cvt_pk_bf16(float lo, float hi) { f32x2_t v = {lo, hi}; bf16x2_t b = __builtin_convertvector(v, bf16x2_t); return __builtin_bit_cast(unsigned, b); }
__device__ __forceinline__ bf16_t f2bf(float f) { return (bf16_t)(cvt_pk_bf16(f, 0.f) & 0xffffu); }
__device__ __forceinline__ void unpack8(const u32x4 v, float* f) {
    f[0] = __uint_as_float(v.x << 16); f[1] = __uint_as_float(v.x & 0xffff0000u); f[2] = __uint_as_float(v.y << 16); f[3] = __uint_as_float(v.y & 0xffff0000u);
    f[4] = __uint_as_float(v.z << 16); f[5] = __uint_as_float(v.z & 0xffff0000u); f[6] = __uint_as_float(v.w << 16); f[7] = __uint_as_float(v.w & 0xffff0000u); }
__device__ __forceinline__ u32x4 pack8(const float* f) { u32x4 w; w.x = cvt_pk_bf16(f[0], f[1]); w.y = cvt_pk_bf16(f[2], f[3]); w.z = cvt_pk_bf16(f[4], f[5]); w.w = cvt_pk_bf16(f[6], f[7]); return w; }
__device__ __forceinline__ int ltid() { int t = threadIdx.x; asm volatile("" : "+v"(t)); return t; }
__device__ __forceinline__ int lbid() { int t = blockIdx.x; asm volatile("" : "+s"(t)); return t; }
__device__ __forceinline__ int lgrid() { int t = gridDim.x; asm volatile("" : "+s"(t)); return t; }
__device__ __forceinline__ float wave_sum(float v) { for (int o = 32; o >= 1; o >>= 1) v += __shfl_xor(v, o); return v; }
__device__ __forceinline__ float sigmoidf_(float x) { return __builtin_amdgcn_rcpf(1.0f + __expf(-x)); }
__device__ __forceinline__ float siluf_(float x) { return x * __builtin_amdgcn_rcpf(1.0f + __expf(-x)); }

namespace pg8 {
constexpr int BM = 256, BK = 64, HALF = 128, HTB = HALF * BK * 2, STAGE_BYTES = 8 * HTB, NXCD = 8, WGM = 8;
__device__ __forceinline__ int lds_byte(int r, int c) { const int st = (r >> 4) * 2 + (c >> 5), rr = r & 15, cc = c & 31, ob = rr * 64 + cc * 2; return st * 1024 + (ob ^ (((ob >> 9) & 1) << 5)); }
__device__ __forceinline__ void stage_rc(int b, int& R, int& C) { const int st = b / 1024, sb = b % 1024, swz = sb ^ (((sb >> 9) & 1) << 5); R = (st >> 1) * 16 + swz / 64; C = (st & 1) * 32 + (swz % 64) / 2; }
__device__ __forceinline__ int perm32(int rho) { const int n = rho >> 4, i = rho & 15; return 8 * (i >> 2) + 4 * n + (i & 3); }
struct Unit { int pm, pn, ks; };
struct Gemm { const bf16_t* A; const bf16_t* Bt; int M, N, K; int half_pm; int KL; };
struct StaticOrder {
    int nM, nN, nwg, G, c, ntail;
    __device__ void init(int M, int N, int G_, int c_, bool tail = true) { nM = M / BM - 1; nN = N / BM; nwg = nM * nN; G = G_; c = c_; ntail = tail ? nN : 0; }
    __device__ bool next(int i, Unit& u) const {
        u.ks = 0;
        const long L = (long)i * G + c; if (L >= nwg + ntail) return false;
        if (L >= nwg) { u.pm = nM; u.pn = (int)(L - nwg); return true; }
        int wgid = (int)L; { const int q = nwg / NXCD, r = nwg % NXCD, xcd = wgid % NXCD, off = wgid / NXCD; wgid = (xcd < r ? xcd * (q + 1) : r * (q + 1) + (xcd - r) * q) + off; }
        const int nig = WGM * nN, gid = wgid / nig, fm = gid * WGM, gsz = (nM - fm) < WGM ? (nM - fm) : WGM;
        u.pm = fm + ((wgid % nig) % gsz); u.pn = (wgid % nig) / gsz; return true;
    }
};
struct MergeOrder {
    int G, c;
    __device__ bool next(int i, Unit& u) const { const int L = (i / 3) * G + c; if (L >= 129 * 4) return false; const int j = i % 3; u.pm = j * 129 + (L >> 2); u.pn = j * 4 + (L & 3); u.ks = 0; return true; }
};

struct TailOrder { int nS, c;
    __device__ bool next(int i, Unit& u) const { if (i > 0 || c >= 4 * nS) return false; u.pm = c / nS; u.ks = c - u.pm * nS; u.pn = 0; return true; } };

template <class Epi, class Sched>
__device__ __forceinline__ void gemm_phase(LAS unsigned char* lds, const Gemm g, const Sched& S, const Epi& E) {
    const int tid = ltid(), wid = __builtin_amdgcn_readfirstlane(tid >> 6), lane = tid & 63, wr = wid >> 2, wc = wid & 3, fr = lane & 15, fq = lane >> 4;
    const int K = g.K, nt = g.KL / BK;
    unsigned voffA, voffB;
    { int R, C; stage_rc(tid * 16, R, C); const int Rb = Epi::PERM ? ((R & ~31) + perm32(R & 31)) : R;
        voffA = (unsigned)(R * K + C) * 2u; voffB = (unsigned)(Rb * K + C) * 2u; }
    const size_t r64 = (size_t)64 * K * 2;
    const size_t kstep = (size_t)(BK * 2);
    const size_t hstep = (size_t)HALF * K * 2;
    const size_t tstep = 2 * hstep;
    const unsigned ldsw = (unsigned)wid * 1024u;
    const int aoff = lds_byte(wr * 64 + fr, fq * 8), boff = lds_byte(wc * 32 + fr, fq * 8);
#define PG8_SA(b, h) (((b) * 2 + (h)) * HTB)
#define PG8_SB(b, h) ((4 + (b) * 2 + (h)) * HTB)
#define PG8_STAGE(bufoff, gbase, voff) do { _Pragma("unroll") for (int _i = 0; _i < 2; ++_i) \
        __builtin_amdgcn_global_load_lds((const unsigned*)((const char*)(gbase) + _i * r64 + (voff)), (LAS unsigned*)(lds + (bufoff) + ldsw + _i * 8192), 16, 0, 0); } while (0)
#define PG8_LDA(dst, b, h) do { _Pragma("unroll") for (int m = 0; m < 4; ++m) _Pragma("unroll") for (int k = 0; k < 2; ++k) dst[m][k] = *(const LAS bf16x8*)(lds + PG8_SA(b, h) + aoff + m * 2048 + k * 1024); } while (0)
#define PG8_LDB(dst, b, h) do { _Pragma("unroll") for (int n = 0; n < 2; ++n) _Pragma("unroll") for (int k = 0; k < 2; ++k) dst[n][k] = *(const LAS bf16x8*)(lds + PG8_SB(b, h) + boff + n * 2048 + k * 1024); } while (0)
#define PG8_MMA(ai, bj, At, Bt) do { __builtin_amdgcn_s_setprio(1); _Pragma("unroll") for (int m = 0; m < 4; ++m) _Pragma("unroll") for (int n = 0; n < 2; ++n) _Pragma("unroll") for (int k = 0; k < 2; ++k) \
        acc[ai][bj][m][n] = __builtin_amdgcn_mfma_f32_16x16x32_bf16(Bt[n][k], At[m][k], acc[ai][bj][m][n], 0, 0, 0); __builtin_amdgcn_s_setprio(0); } while (0)
#define PG8_WAIT_V(n) asm volatile("s_waitcnt vmcnt(" #n ")" ::: "memory")
#define PG8_WAIT_L(n) asm volatile("s_waitcnt lgkmcnt(" #n ")" ::: "memory")
#define PG8_BAR __builtin_amdgcn_s_barrier()
#define PG8_SCHED __builtin_amdgcn_sched_barrier(0)
    Unit cur, nxt; int ui = 0;
    if (!S.next(0, cur)) return;
    f32x4 acc[2][2][4][2];
#pragma unroll
    for (int a = 0; a < 2; ++a)
#pragma unroll
        for (int b = 0; b < 2; ++b)
#pragma unroll
            for (int m = 0; m < 4; ++m)
#pragma unroll
                for (int n = 0; n < 2; ++n) acc[a][b][m][n] = (f32x4){0.f, 0.f, 0.f, 0.f};
    bf16x8 At[4][2], B0[2][2], B1[2][2];
    const char* cA = (const char*)g.A + (size_t)cur.pm * tstep + (size_t)cur.ks * g.KL * 2; const char* cB = (const char*)g.Bt + (size_t)cur.pn * tstep + (size_t)cur.ks * g.KL * 2;
    PG8_STAGE(PG8_SB(0, 0), cB, voffB); PG8_STAGE(PG8_SB(0, 1), cB + hstep, voffB); PG8_STAGE(PG8_SA(0, 0), cA, voffA); PG8_STAGE(PG8_SA(0, 1), cA + hstep, voffA);
    if (wr == 1) PG8_BAR;
    PG8_WAIT_V(2); PG8_BAR;
    PG8_STAGE(PG8_SB(1, 0), cB + kstep, voffB); PG8_STAGE(PG8_SA(1, 0), cA + kstep, voffA); PG8_STAGE(PG8_SB(1, 1), cB + hstep + kstep, voffB);
    PG8_WAIT_V(6); PG8_BAR;
    for (;;) {
        const bool has_next = S.next(ui + 1, nxt);
        const char* nA = has_next ? (const char*)g.A + (size_t)nxt.pm * tstep + (size_t)nxt.ks * g.KL * 2 : cA; const char* nB = has_next ? (const char*)g.Bt + (size_t)nxt.pn * tstep + (size_t)nxt.ks * g.KL * 2 : cB;
        for (int t = 0; t < nt; t += 2) {
            const bool last = (t == nt - 2);
            const char* a1 = cA + (size_t)(t + 1) * kstep;
            const char* a2 = last ? nA : cA + (size_t)(t + 2) * kstep; const char* b2 = last ? nB : cB + (size_t)(t + 2) * kstep;
            const char* a3 = a2 + kstep; const char* b3 = b2 + kstep;
            PG8_LDB(B0, 0, 0); PG8_LDB(B1, 0, 1); PG8_SCHED; PG8_LDA(At, 0, 0); PG8_STAGE(PG8_SA(1, 1), a1 + hstep, voffA);
            PG8_WAIT_V(8); PG8_WAIT_L(0); PG8_BAR; PG8_MMA(0, 0, At, B0); PG8_MMA(0, 1, At, B1); PG8_BAR; PG8_SCHED;
            PG8_LDA(At, 0, 1); PG8_STAGE(PG8_SB(0, 0), b2, voffB); PG8_STAGE(PG8_SB(0, 1), b2 + hstep, voffB); PG8_STAGE(PG8_SA(0, 0), a2, voffA);
            PG8_WAIT_V(8); PG8_WAIT_L(0); PG8_BAR; PG8_MMA(1, 0, At, B0); PG8_MMA(1, 1, At, B1); PG8_BAR; PG8_SCHED;
            PG8_LDB(B0, 1, 0); PG8_LDB(B1, 1, 1); PG8_SCHED; PG8_LDA(At, 1, 0); PG8_STAGE(PG8_SA(0, 1), a2 + hstep, voffA);
            PG8_WAIT_V(8); PG8_WAIT_L(0); PG8_BAR; PG8_MMA(0, 0, At, B0); PG8_MMA(0, 1, At, B1); PG8_BAR; PG8_SCHED;
            PG8_LDA(At, 1, 1); PG8_STAGE(PG8_SB(1, 0), b3, voffB); PG8_STAGE(PG8_SB(1, 1), b3 + hstep, voffB); PG8_STAGE(PG8_SA(1, 0), a3, voffA);
            PG8_WAIT_V(8); PG8_WAIT_L(0); PG8_BAR; PG8_MMA(1, 0, At, B0); PG8_MMA(1, 1, At, B1); PG8_BAR; PG8_SCHED;
        }
        if (wr == 0) PG8_BAR;
        E(acc, cur, wr, wc, fr, fq);
        if (!has_next) break;
#pragma unroll
        for (int a = 0; a < 2; ++a)
#pragma unroll
            for (int b = 0; b < 2; ++b)
#pragma unroll
                for (int m = 0; m < 4; ++m)
#pragma unroll
                    for (int n = 0; n < 2; ++n) acc[a][b][m][n] = (f32x4){0.f, 0.f, 0.f, 0.f};
        cur = nxt; cA = nA; cB = nB; ++ui;
        if (wr == 1) PG8_BAR;
    }
    PG8_WAIT_V(0);
    PG8_BAR;
#undef PG8_SA
#undef PG8_SB
#undef PG8_STAGE
#undef PG8_LDA
#undef PG8_LDB
#undef PG8_MMA
#undef PG8_WAIT_V
#undef PG8_WAIT_L
#undef PG8_BAR
#undef PG8_SCHED
}

template <int ACT> struct EpiBf16 {
    static constexpr bool PERM = true;
    bf16_t* O; int ldc;
    __device__ __forceinline__ void operator()(const f32x4 (&acc)[2][2][4][2], const Unit& u, int wr, int wc, int fr, int fq) const {
        const int row0 = u.pm * BM + wr * 64 + fr, col0 = u.pn * BM + wc * 32 + 8 * fq;
#pragma unroll
        for (int ai = 0; ai < 2; ++ai)
#pragma unroll
            for (int m = 0; m < 4; ++m) { bf16_t* rowp = O + (size_t)(row0 + ai * HALF + m * 16) * ldc + col0;
#pragma unroll
                for (int bj = 0; bj < 2; ++bj) { f32x4 v0 = acc[ai][bj][m][0], v1 = acc[ai][bj][m][1];
                    if (ACT == 1) {
#pragma unroll
                        for (int j = 0; j < 4; ++j) { v0[j] = sigmoidf_(v0[j]); v1[j] = sigmoidf_(v1[j]); } }
                    u32x4 w; w.x = cvt_pk_bf16(v0[0], v0[1]); w.y = cvt_pk_bf16(v0[2], v0[3]); w.z = cvt_pk_bf16(v1[0], v1[1]); w.w = cvt_pk_bf16(v1[2], v1[3]);
                    *(u32x4*)(rowp + bj * HALF) = w; } }
    }
};
struct EpiSlab {
    static constexpr bool PERM = true;
    float* slab; int nS;
    __device__ __forceinline__ void operator()(const f32x4 (&acc)[2][2][4][2], const Unit& u, int wr, int wc, int fr, int fq) const {
        float* sp = slab + ((size_t)u.ks * 128 + wc * 32 + 8 * fq) * 1024 + u.pm * 256 + wr * 64 + fr;
#pragma unroll
        for (int ai = 0; ai < 2; ++ai)
#pragma unroll
            for (int m = 0; m < 4; ++m) { float* rp = sp + ai * HALF + m * 16;
#pragma unroll
                for (int n = 0; n < 2; ++n)
#pragma unroll
                    for (int j = 0; j < 4; ++j) rp[(size_t)(4 * n + j) * 1024] = acc[ai][0][m][n][j]; }
    }
};
struct EpiSwiglu {
    static constexpr bool PERM = true;
    bf16_t* O;
    __device__ __forceinline__ void operator()(const f32x4 (&acc)[2][2][4][2], const Unit& u, int wr, int wc, int fr, int fq) const {
        const int row0 = u.pm * BM + wr * 64 + fr, col0 = u.pn * 128 + wc * 32 + 8 * fq;
#pragma unroll
        for (int ai = 0; ai < 2; ++ai)
#pragma unroll
            for (int m = 0; m < 4; ++m) { bf16_t* rowp = O + (size_t)(row0 + ai * HALF + m * 16) * DFF + col0;
                const f32x4 a0 = acc[ai][0][m][0], a1 = acc[ai][0][m][1], b0 = acc[ai][1][m][0], b1 = acc[ai][1][m][1];
                float v[8];
#pragma unroll
                for (int j = 0; j < 4; ++j) { v[j] = siluf_(a0[j]) * b0[j]; v[4 + j] = siluf_(a1[j]) * b1[j]; }
                *(u32x4*)rowp = pack8(v); }
    }
};
struct EpiInProj {
    static constexpr bool PERM = true;
    unsigned char* ws;
    __device__ __forceinline__ void operator()(const f32x4 (&acc)[2][2][4][2], const Unit& u, int wr, int wc, int fr, int fq) const {
        const int row0 = u.pm * BM + wr * 64 + fr, pn = u.pn;
        if (pn == 18) {
            if (wc == 0 && fq < 2) { float* Lg = (float*)(ws + S_LOGIT);
#pragma unroll
                for (int ai = 0; ai < 2; ++ai)
#pragma unroll
                    for (int m = 0; m < 4; ++m) { float* rp = Lg + (size_t)(row0 + ai * HALF + m * 16) * 16 + 8 * fq; *(f32x4*)rp = acc[ai][0][m][0]; *(f32x4*)(rp + 4) = acc[ai][0][m][1]; } }
            return; }
        bf16_t* base; int ld, cb;
        if (pn < 4) { base = (bf16_t*)(ws + O_PQ); ld = 1024; cb = pn * 256; }
        else if (pn < 10) { base = (bf16_t*)(ws + O_SC); ld = 1536; cb = (pn - 4) * 256; }
        else if (pn < 16) { base = (bf16_t*)(ws + O_QKV); ld = 1536; cb = (pn - 10) * 256; }
        else { base = (bf16_t*)(ws + O_Z); ld = 512; cb = (pn - 16) * 256; }
        const int col0 = cb + wc * 32 + 8 * fq;
#pragma unroll
        for (int ai = 0; ai < 2; ++ai)
#pragma unroll
            for (int m = 0; m < 4; ++m) { bf16_t* rowp = base + (size_t)(row0 + ai * HALF + m * 16) * ld + col0;
#pragma unroll
                for (int bj = 0; bj < 2; ++bj) { const f32x4 v0 = acc[ai][bj][m][0], v1 = acc[ai][bj][m][1];
                    u32x4 w; w.x = cvt_pk_bf16(v0[0], v0[1]); w.y = cvt_pk_bf16(v0[2], v0[3]); w.z = cvt_pk_bf16(v1[0], v1[1]); w.w = cvt_pk_bf16(v1[2], v1[3]);
                    *(u32x4*)(rowp + bj * HALF) = w; } }
    }
};
struct EpiFourier {
    static constexpr bool PERM = true;
    bf16_t* FM; float sc;
    __device__ __forceinline__ void operator()(const f32x4 (&acc)[2][2][4][2], const Unit& u, int wr, int wc, int fr, int fq) const {
        const int row0 = u.pm * BM + wr * 64 + fr;
        const int colt = u.pn * BM;
        const int b = colt >> 13, k1 = (colt >> 9) & 15, ch0 = (colt & 511) + wc * 32 + 8 * fq;
#pragma unroll
        for (int ai = 0; ai < 2; ++ai)
#pragma unroll
            for (int m = 0; m < 4; ++m) { const int k2 = row0 + ai * HALF + m * 16;
                if (k2 < 257) { bf16_t* rowp = FM + (size_t)(b * LL + k1 + 16 * k2) * 512 + ch0;
#pragma unroll
                    for (int bj = 0; bj < 2; ++bj) { const f32x4 v0 = acc[ai][bj][m][0] * sc, v1 = acc[ai][bj][m][1] * sc;
                        u32x4 w; w.x = cvt_pk_bf16(v0[0], v0[1]); w.y = cvt_pk_bf16(v0[2], v0[3]); w.z = cvt_pk_bf16(v1[0], v1[1]); w.w = cvt_pk_bf16(v1[2], v1[3]);
                        *(u32x4*)(rowp + bj * HALF) = w; } } }
    }
};
struct EpiMerge {
    static constexpr bool PERM = true;
    const bf16_t* GATE; bf16_t* MG; bf16_t* MGB;
    __device__ __forceinline__ void operator()(const f32x4 (&acc)[2][2][4][2], const Unit& u, int wr, int wc, int fr, int fq) const {
        const int j = u.pm / 129, pm = u.pm - j * 129, pn = u.pn & 3;
        const int row0 = pm * BM + wr * 64 + fr, col0 = pn * BM + wc * 32 + 8 * fq;
        const bf16_t* mold = (j == 1 ? MG : MGB); bf16_t* mnew = (j == 1 ? MGB : MG);
#pragma unroll
        for (int ai = 0; ai < 2; ++ai) {
            u32x4 gv[4][2], ov[4][2];
#pragma unroll
            for (int m = 0; m < 4; ++m)
#pragma unroll
                for (int bj = 0; bj < 2; ++bj) { const size_t r = (size_t)(row0 + ai * HALF + m * 16);
                    gv[m][bj] = *(const u32x4*)(GATE + r * 3072 + j * 1024 + col0 + bj * HALF);
                    if (j > 0) ov[m][bj] = *(const u32x4*)(mold + r * 1024 + col0 + bj * HALF); }
#pragma unroll
            for (int m = 0; m < 4; ++m)
#pragma unroll
                for (int bj = 0; bj < 2; ++bj) { const size_t r = (size_t)(row0 + ai * HALF + m * 16);
                    float g[8], v[8]; unpack8(gv[m][bj], g);
                    const f32x4 v0 = acc[ai][bj][m][0], v1 = acc[ai][bj][m][1];
#pragma unroll
                    for (int e = 0; e < 4; ++e) { v[e] = v0[e] * g[e]; v[4 + e] = v1[e] * g[4 + e]; }
                    if (j > 0) { float o[8]; unpack8(ov[m][bj], o);
#pragma unroll
                        for (int e = 0; e < 8; ++e) v[e] += o[e]; }
                    *(u32x4*)(mnew + r * 1024 + col0 + bj * HALF) = pack8(v); }
            asm volatile("" ::: "memory"); }
    }
};
}

__device__ void rpass(const Params& P, const bf16_t* Y, bool first_h, const float* gpost, float scale, const float* gpre, bf16_t* XN, const float* slab = nullptr, int nS = 0) {
    const int tid_ = ltid(); const int wave = __builtin_amdgcn_readfirstlane(tid_ >> 6), lane = tid_ & 63;
    float* hm = (float*)(P.ws + S_HM);
    for (int r = lbid() * 8 + wave; r < TT; r += lgrid() * 8) {
        const int b = r / LL, n = r - b * LL;
        const float* hin; float* hout;
        if (n < NMETA) { hout = hm + (size_t)(b * 16 + n) * 1024; hin = first_h ? P.in[1] + (size_t)n * 1024 : hout; }
        else { const size_t o = ((size_t)b * SEQ + (n - NMETA)) * 1024; hout = P.out + o; hin = first_h ? P.in[0] + o : hout; }
        float h[16];
        { const f32x4 a = *(const f32x4*)(hin + lane * 8), b4 = *(const f32x4*)(hin + lane * 8 + 4), c = *(const f32x4*)(hin + 512 + lane * 8), d = *(const f32x4*)(hin + 512 + lane * 8 + 4);
#pragma unroll
          for (int e = 0; e < 4; ++e) { h[e] = a[e]; h[4 + e] = b4[e]; h[8 + e] = c[e]; h[12 + e] = d[e]; } }
        if (Y) {
            float y[16];
            if (slab != nullptr && r >= 32768) {
                const float* sp = slab + (size_t)(r - 32768) * 1024 + lane * 8;
                f32x4 s0 = {0.f, 0.f, 0.f, 0.f}, s1 = s0, s2 = s0, s3 = s0;
#pragma unroll 1
                for (int ks = 0; ks < nS; ++ks) { s0 += *(const f32x4*)sp; s1 += *(const f32x4*)(sp + 4); s2 += *(const f32x4*)(sp + 512); s3 += *(const f32x4*)(sp + 516); sp += 131072; }
#pragma unroll
                for (int e = 0; e < 4; ++e) { y[e] = s0[e]; y[4 + e] = s1[e]; y[8 + e] = s2[e]; y[12 + e] = s3[e]; }
            } else { unpack8(*(const u32x4*)(Y + (size_t)r * 1024 + lane * 8), y); unpack8(*(const u32x4*)(Y + (size_t)r * 1024 + 512 + lane * 8), y + 8); }
            float ss = 0.f;
#pragma unroll
            for (int e = 0; e < 16; ++e) ss += y[e] * y[e];
            ss = wave_sum(ss); const float r1 = rsqrtf(ss * (1.0f / 1024.0f) + EPS) * scale;
#pragma unroll
            for (int e = 0; e < 8; ++e) { h[e] += y[e] * r1 * gpost[lane * 8 + e]; h[8 + e] += y[8 + e] * r1 * gpost[512 + lane * 8 + e]; }
            *(f32x4*)(hout + lane * 8) = (f32x4){h[0], h[1], h[2], h[3]}; *(f32x4*)(hout + lane * 8 + 4) = (f32x4){h[4], h[5], h[6], h[7]};
            *(f32x4*)(hout + 512 + lane * 8) = (f32x4){h[8], h[9], h[10], h[11]}; *(f32x4*)(hout + 512 + lane * 8 + 4) = (f32x4){h[12], h[13], h[14], h[15]};
        }
        if (gpre) {
            float ss = 0.f;
#pragma unroll
            for (int e = 0; e < 16; ++e) ss += h[e] * h[e];
            ss = wave_sum(ss); const float r2 = rsqrtf(ss * (1.0f / 1024.0f) + EPS);
            float o[16];
#pragma unroll
            for (int e = 0; e < 8; ++e) { o[e] = h[e] * r2 * gpre[lane * 8 + e]; o[8 + e] = h[8 + e] * r2 * gpre[512 + lane * 8 + e]; }
            *(u32x4*)(XN + (size_t)r * 1024 + lane * 8) = pack8(o); *(u32x4*)(XN + (size_t)r * 1024 + 512 + lane * 8) = pack8(o + 8);
        }
    }
}

template <class F>
__device__ void cvt_tiles(const float* src, int ld_src, int K, bf16_t* dst, int nrows, F srccol, unsigned char* smem) {
    float* lds = (float*)smem; const int tid = ltid();
    const int ntr = nrows / 64, ntk = K / 64, nt_ = ntr * ntk, G_ = lgrid();
    float pv[8];
    { const int t = lbid(); if (t < nt_) { const int tr = t % ntr, tk = t / ntr; const int c0 = srccol(tr * 64);
#pragma unroll
        for (int i = 0; i < 8; ++i) { const int kk = (tid >> 6) + 8 * i, cc = tid & 63; pv[i] = src[(size_t)(tk * 64 + kk) * ld_src + c0 + cc]; } } }
    for (int t = lbid(); t < nt_; t += G_) {
        const int tr = t % ntr, tk = t / ntr;
        __syncthreads();
#pragma unroll
        for (int i = 0; i < 8; ++i) { const int kk = (tid >> 6) + 8 * i, cc = tid & 63; lds[kk * 65 + cc] = pv[i]; }
        __syncthreads();
        { const int t2 = t + G_; if (t2 < nt_) { const int tr2 = t2 % ntr, tk2 = t2 / ntr; const int c2 = srccol(tr2 * 64);
#pragma unroll
            for (int i = 0; i < 8; ++i) { const int kk = (tid >> 6) + 8 * i, cc = tid & 63; pv[i] = src[(size_t)(tk2 * 64 + kk) * ld_src + c2 + cc]; } } }
        const int cc2 = tid >> 3, k8 = (tid & 7) * 8; float v[8];
#pragma unroll
        for (int e = 0; e < 8; ++e) v[e] = lds[(k8 + e) * 65 + cc2];
        *(u32x4*)(dst + (size_t)(tr * 64 + cc2) * K + tk * 64 + k8) = pack8(v);
    }
}
struct ColIdent { int off; __device__ int operator()(int r) const { return r + off; } };
struct ColSwiglu { __device__ int operator()(int r) const { const int pn = r >> 8, rem = r & 255; return (rem >> 7) * DFF + 128 * pn + (rem & 127); } };

__device__ void convert_weights(const Params& P, int l, unsigned char* smem) {
    unsigned char* ws = P.ws; const int tid = ltid();
    cvt_tiles(P.in[3] + (size_t)l * 1024 * 5632, 5632, 1024, (bf16_t*)(ws + W_WI1), 5632, ColSwiglu{}, smem);
    cvt_tiles(P.in[4] + (size_t)l * 2816 * 1024, 1024, 2816, (bf16_t*)(ws + W_WO1), 1024, ColIdent{0}, smem);
    cvt_tiles(P.in[5] + (size_t)l * 1024 * 5632, 5632, 1024, (bf16_t*)(ws + W_WI2), 5632, ColSwiglu{}, smem);
    cvt_tiles(P.in[6] + (size_t)l * 2816 * 1024, 1024, 2816, (bf16_t*)(ws + W_WO2), 1024, ColIdent{0}, smem);
    const float* win = P.in[7] + (size_t)l * 1024 * NIN;
    cvt_tiles(win, NIN, 1024, (bf16_t*)(ws + W_WIN) + (size_t)1024 * 1024, 3584, ColIdent{512}, smem);
    cvt_tiles(win, NIN, 1024, (bf16_t*)(ws + W_WG), 3072, ColIdent{4112}, smem);
    cvt_tiles(P.in[13] + (size_t)l * 512 * 1024, 1024, 512, (bf16_t*)(ws + W_WBR), 1024, ColIdent{0}, smem);
    cvt_tiles(P.in[14] + (size_t)l * 512 * 1024, 1024, 512, (bf16_t*)(ws + W_WBR) + (size_t)1024 * 512, 1024, ColIdent{0}, smem);
    cvt_tiles(P.in[15] + (size_t)l * 512 * 1024, 1024, 512, (bf16_t*)(ws + W_WBR) + (size_t)2048 * 512, 1024, ColIdent{0}, smem);
    cvt_tiles(P.in[16] + (size_t)l * 1024 * 1024, 1024, 1024, (bf16_t*)(ws + W_WOUT), 1024, ColIdent{0}, smem);
    { bf16_t* d = (bf16_t*)(ws + W_WIN) + (size_t)4608 * 1024;
      for (int i = lbid() * 512 + tid; i < 256 * 1024; i += lgrid() * 512) { const int rr = i >> 10, k = i & 1023; d[i] = rr < 16 ? f2bf(win[(size_t)k * NIN + 4096 + rr]) : (bf16_t)0; } }
    { float* Ws = (float*)smem; float* ct = Ws + 64 * 65; float* st = ct + 64;
      __syncthreads();
      if (tid < 64) { float s, c; sincospif((float)tid * (2.0f / 64.0f), &s, &c); ct[tid] = c; st[tid] = s; }
      bf16_t* dp = (bf16_t*)(ws + W_WIN); bf16_t* dq = dp + (size_t)512 * 1024;
      for (int it = lbid(); it < 8 * 16; it += lgrid()) { const int g = it >> 4, kt = it & 15;
          __syncthreads();
#pragma unroll
          for (int i = 0; i < 8; ++i) { const int kk = (tid >> 6) + 8 * i, cc = tid & 63; Ws[kk * 65 + cc] = win[(size_t)(kt * 64 + kk) * NIN + g * 64 + cc]; }
          __syncthreads();
          const int kk = tid & 63;
#pragma unroll 1
          for (int i = 0; i < 8; ++i) { const int cp = (tid >> 6) + 8 * i; float ap = 0.f, aq = 0.f;
#pragma unroll 4
              for (int c = 0; c < 64; ++c) { const float w = Ws[kk * 65 + c]; const int ph = (c * cp) & 63; ap += w * ct[ph]; aq += w * st[ph]; }
              dp[(size_t)(g * 64 + cp) * 1024 + kt * 64 + kk] = f2bf(ap); dq[(size_t)(g * 64 + cp) * 1024 + kt * 64 + kk] = f2bf(aq); }
      }
      __syncthreads(); }
}

__device__ void gen_tables(const Params& P) {
    unsigned char* ws = P.ws; const int gt = lbid() * 512 + ltid(), gs = lgrid() * 512;
    bf16_t* C = (bf16_t*)(ws + S_C257);
    for (int i = gt; i < 512 * KF; i += gs) { const int k2 = i / KF, kk = i - k2 * KF; const int ri = kk >= 320, n2 = kk - ri * 320; float v = 0.f;
        if (k2 < 257 && n2 < 257) { const int m = (k2 * n2) % 257; float s, c; sincospif((float)m * (2.0f / 257.0f), &s, &c); v = ri ? s : c; }
        C[i] = f2bf(v); }
    float* tw = (float*)(ws + S_TWL);
    for (int i = gt; i < LL; i += gs) { float s, c; sincospif((float)i * (2.0f / (float)LL), &s, &c); tw[2 * i] = c; tw[2 * i + 1] = -s; }
}

__device__ void sconv_pass(const Params& P, int l) {
    const int tid_ = ltid(); const int wave = __builtin_amdgcn_readfirstlane(tid_ >> 6), lane = tid_ & 63;
    const bf16_t* SC = (const bf16_t*)(P.ws + O_SC); bf16_t* SCO = (bf16_t*)(P.ws + O_BR) + (size_t)TP * 512;
    const float* w = P.in[8] + (size_t)l * 3 * 512;
    float w0[8], w1[8], w2[8];
#pragma unroll
    for (int e = 0; e < 8; ++e) { w0[e] = w[lane * 8 + e]; w1[e] = w[512 + lane * 8 + e]; w2[e] = w[1024 + lane * 8 + e]; }
    for (int r = lbid() * 8 + wave; r < TT; r += lgrid() * 8) {
        const int b = r / LL, n = r - b * LL; const bf16_t* rp = SC + (size_t)r * 1536 + lane * 8;
        float bb[8], c[8], h[8], acc[8]; unpack8(*(const u32x4*)rp, bb); unpack8(*(const u32x4*)(rp + 512), c); unpack8(*(const u32x4*)(rp + 1024), h);
#pragma unroll
        for (int e = 0; e < 8; ++e) acc[e] = w1[e] * c[e] * h[e];
        if (n > 0) { unpack8(*(const u32x4*)(rp - 1536 + 512), c); unpack8(*(const u32x4*)(rp - 1536 + 1024), h);
#pragma unroll
            for (int e = 0; e < 8; ++e) acc[e] += w0[e] * c[e] * h[e]; }
        if (n < LL - 1) { unpack8(*(const u32x4*)(rp + 1536 + 512), c); unpack8(*(const u32x4*)(rp + 1536 + 1024), h);
#pragma unroll
            for (int e = 0; e < 8; ++e) acc[e] += w2[e] * c[e] * h[e]; }
#pragma unroll
        for (int e = 0; e < 8; ++e) acc[e] *= bb[e];
        *(u32x4*)(SCO + (size_t)r * 512 + lane * 8) = pack8(acc);
    }
}

__device__ void fstep1(const Params& P, unsigned char* smem) {
    const int tid = ltid(), wave = __builtin_amdgcn_readfirstlane(tid >> 6), lane = tid & 63;
    const bf16_t* PQ = (const bf16_t*)(P.ws + O_PQ); bf16_t* AP = (bf16_t*)(P.ws + O_AP); const float* tw = (const float*)(P.ws + S_TWL);
    bf16_t* St = (bf16_t*)smem;
    for (int it = lbid(); it < 8 * 4 * 17; it += lgrid()) {
        const int b = it / 68, rem = it - b * 68, cht = rem / 17, n2t = rem - cht * 17;
        __syncthreads();
#pragma unroll 1
        for (int sub = 0; sub < 2; ++sub) {
            const int n2l = sub * 8 + wave, n2 = n2t * 16 + n2l;
            const int fr = lane & 15, fq = lane >> 4;
            if (n2 < 257) {
                float f0[8], f1[8];
#pragma unroll
                for (int j = 0; j < 8; ++j) { const int n = 257 * (8 * (fq & 1) + j) + n2; const int ph = (fr * n) % LL;
                    const float c_ = __hip_atomic_load(tw + 2 * ph, __ATOMIC_RELAXED, __HIP_MEMORY_SCOPE_AGENT), ms_ = __hip_atomic_load(tw + 2 * ph + 1, __ATOMIC_RELAXED, __HIP_MEMORY_SCOPE_AGENT);
                    f0[j] = (fq < 2) ? c_ : ms_; f1[j] = (fq < 2) ? ms_ : -c_; }
                const bf16x8 a0 = __builtin_bit_cast(bf16x8, pack8(f0)), a1 = __builtin_bit_cast(bf16x8, pack8(f1));
                const bf16_t* bp = PQ + (size_t)(b * LL + 257 * 8 * (fq & 1) + n2) * 1024 + (fq >> 1) * 512 + cht * 128 + fr;
#pragma unroll
                for (int ct = 0; ct < 8; ++ct) {
                    bf16x8 bf;
#pragma unroll
                    for (int j = 0; j < 8; ++j) bf[j] = (short)bp[(size_t)j * 257 * 1024 + ct * 16];
                    const f32x4 z = {0.f, 0.f, 0.f, 0.f};
                    const f32x4 c0 = __builtin_amdgcn_mfma_f32_16x16x32_bf16(a0, bf, z, 0, 0, 0), c1 = __builtin_amdgcn_mfma_f32_16x16x32_bf16(a1, bf, z, 0, 0, 0);
                    bf16_t* sp = St + ((4 * fq) * 128 + ct * 16 + fr) * 32 + n2l;
#pragma unroll
                    for (int rg = 0; rg < 4; ++rg) { sp[rg * 4096] = f2bf(c0[rg]); sp[rg * 4096 + 16] = f2bf(c1[rg]); }
                }
            } else {
                for (int q = lane; q < 4096; q += 64) St[q * 16 + n2l] = 0;
            }
        }
        __syncthreads();
#pragma unroll 2
        for (int q = tid; q < 8192; q += 512) { const int half = q & 1, ri = (q >> 1) & 1, chl = (q >> 2) & 127, k1 = q >> 9;
            const int n2c = n2t * 16 + half * 8;
            if (n2c < 320) { const u32x4 v = *(const u32x4*)(St + (size_t)q * 8);
                *(u32x4*)(AP + ((size_t)((b * 16 + k1) * 512 + cht * 128 + chl)) * KF + ri * 320 + n2c) = v; } }
        if (n2t == 16) {
            for (int q = tid; q < 16 * 128 * 2 * 6; q += 512) { const int c6 = q % 6, r2 = q / 6, ri = r2 & 1, chl = (r2 >> 1) & 127, k1 = r2 >> 8;
                *(u32x4*)(AP + ((size_t)((b * 16 + k1) * 512 + cht * 128 + chl)) * KF + ri * 320 + 272 + c6 * 8) = (u32x4){0u, 0u, 0u, 0u}; } }
    }
    __syncthreads();
}

#ifdef DBG_SEC
#define SEC_T(k) do { if (lbid() == 0 && tid == 0) { const unsigned long long _n = __builtin_amdgcn_s_memrealtime(); if (sec_prev_k == DBG_SEC) *(unsigned long long*)(smem + LDS_BYTES - 32) += _n - sec_prev_t; sec_prev_t = _n; sec_prev_k = (k); } } while (0)
#else
#define SEC_T(k) do {} while (0)
#endif
__device__ void dn_prep(const Params& P, int l, unsigned char* smem, int t0, int t1) {
#ifdef DBG_SEC
    unsigned long long sec_prev_t = __builtin_amdgcn_s_memrealtime(); int sec_prev_k = -1;
#endif
    const int tid = ltid(), wave = __builtin_amdgcn_readfirstlane(tid >> 6), lane = tid & 63, fr = lane & 15, fq = lane >> 4;
    unsigned char* ws = P.ws;
    const bf16_t* QKV = (const bf16_t*)(ws + O_QKV); const float* LG = (const float*)(ws + S_LOGIT);
    bf16_t* WP = (bf16_t*)(ws + O_WP); bf16_t* QP = (bf16_t*)(ws + O_QP); bf16_t* KD = (bf16_t*)(ws + O_KD); bf16_t* UF = (bf16_t*)(ws + O_UF); bf16_t* AT = (bf16_t*)(ws + O_AT);
    float* GL = (float*)(ws + S_GL);
    const float* cw = P.in[9] + (size_t)l * 3 * 1536;
    bf16_t* Qs = (bf16_t*)smem;
    bf16_t* Ks = Qs + 64 * 136;
    bf16_t* KT = Ks + 64 * 136;
    bf16_t* VT = KT + 128 * 72;
    bf16_t* T1 = VT + 128 * 72;
    bf16_t* T2 = T1 + 64 * 72;
    bf16_t* Rm = T2 + 64 * 72;
    bf16_t* Rt = Rm + 64 * 72;
    bf16_t* Pm = Rt + 64 * 72;
    float* gcs = (float*)(T2 + 64 * 72 + 2 * 64 * 68 * 2);
    float* bts = gcs + 64;
    float* cwl = bts + 64;
    bf16_t* Xr = T1;
    const int items = (t1 - t0) * 64;
    u32x4 x0[6], xb;
#define PREP_ISSUE(it_) do { const int _tl = (it_) >> 6, _bhd = (it_) & 63, _b = _bhd >> 3, _h = (_bhd >> 1) & 3, _dir = _bhd & 1; const int _nb = (_dir ? 64 - (t0 + _tl) : (t0 + _tl)) * 64 - 48; const u32x4 z4 = {0u, 0u, 0u, 0u}; \
        _Pragma("unroll") for (int rr = 0; rr < 6; ++rr) { const int task = tid + 512 * rr, i = task / 48, cg_ = task - i * 48; const int n = _nb + (_dir ? 63 - i : i); \
            x0[rr] = (n >= 0) ? *(const u32x4*)(QKV + (size_t)(_b * LL + n) * 1536 + (cg_ >> 4) * 512 + _h * 128 + (cg_ & 15) * 8) : z4; } \
        xb = z4; if (tid < 96) { const int which = tid / 48, cg_ = tid - which * 48; const int n = which ? _nb + 64 : _nb - 1; \
            if (n >= 0 && n < LL) xb = *(const u32x4*)(QKV + (size_t)(_b * LL + n) * 1536 + (cg_ >> 4) * 512 + _h * 128 + (cg_ & 15) * 8); } } while (0)
    for (int it = lbid(); it < items; it += lgrid()) {
        const int tl = it >> 6, bhd = it & 63, b = bhd >> 3, h = (bhd >> 1) & 3, dir = bhd & 1;
        const int t = t0 + tl, c = dir ? 64 - t : t; const size_t slot = (size_t)tl * 64 + bhd;
        PREP_ISSUE(it);
        __syncthreads();
        SEC_T(0);
        for (int q = tid; q < 1152; q += 512) { const int tap = q / 384, rem = q - tap * 384; cwl[q] = cw[tap * 1536 + (rem >> 7) * 512 + h * 128 + (rem & 127)]; }
#pragma unroll
        for (int rr = 0; rr < 6; ++rr) { const int task = tid + 512 * rr, i = task / 48, cg_ = task - i * 48; *(u32x4*)(Xr + ((dir ? 63 - i : i) + 1) * 384 + cg_ * 8) = x0[rr]; }
        if (tid < 96) { const int which = tid / 48, cg_ = tid - which * 48; *(u32x4*)(Xr + (which ? 65 : 0) * 384 + cg_ * 8) = xb; }
        __syncthreads();
#pragma unroll 1
        for (int rr = 0; rr < 6; ++rr) {
            const int task = tid + 512 * rr, i = task / 48, cg_ = task - i * 48, kind = cg_ >> 4, cgl = cg_ & 15;
            float v[8], x[8];
            const float* w1 = cwl + 384 + kind * 128 + cgl * 8;
            const bf16_t* xr = Xr + ((dir ? 63 - i : i) + 1) * 384 + cg_ * 8;
            unpack8(*(const u32x4*)xr, x);
#pragma unroll
            for (int e = 0; e < 8; ++e) v[e] = w1[e] * x[e];
            unpack8(*(const u32x4*)(xr - 384), x);
#pragma unroll
            for (int e = 0; e < 8; ++e) v[e] += w1[e - 384] * x[e];
            unpack8(*(const u32x4*)(xr + 384), x);
#pragma unroll
            for (int e = 0; e < 8; ++e) v[e] += w1[e + 384] * x[e];
#pragma unroll
            for (int e = 0; e < 8; ++e) v[e] = siluf_(v[e]);
            float ss = 0.f;
#pragma unroll
            for (int e = 0; e < 8; ++e) ss += v[e] * v[e];
            ss += __shfl_xor(ss, 1); ss += __shfl_xor(ss, 2); ss += __shfl_xor(ss, 4); ss += __shfl_xor(ss, 8);
            if (kind < 2) { const float inv = rsqrtf(ss + EPS) * (kind == 0 ? 0.08838834764831845f : 1.0f);
#pragma unroll
                for (int e = 0; e < 8; ++e) v[e] *= inv; }
            const u32x4 pk = pack8(v);
            const int isw = i ^ ((cgl & 7) << 3);
            if (kind == 0) *(u32x4*)(Qs + i * 136 + cgl * 8) = pk;
            else if (kind == 1) { *(u32x4*)(Ks + i * 136 + cgl * 8) = pk;
#pragma unroll
                for (int e = 0; e < 8; ++e) KT[(cgl * 8 + e) * 72 + isw] = f2bf(v[e]); }
            else {
#pragma unroll
                for (int e = 0; e < 8; ++e) VT[(cgl * 8 + e) * 72 + isw] = f2bf(v[e]); }
        }
        if (wave == 0) {
            const int i = lane, n = c * 64 + (dir ? 63 - i : i) - 48; float beta = 0.f, g = 0.f;
            if (n >= 0) { const float* lg = LG + (size_t)(b * LL + n) * 16; const float bl = lg[dir * 4 + h], al = lg[8 + dir * 4 + h];
                beta = 1.0f / (1.0f + expf(-bl));
                const float xx = al + P.in[11][l * 8 + dir * 4 + h]; const float sp = xx > 20.f ? xx : log1pf(expf(xx));
                g = -expf(P.in[10][l * 8 + dir * 4 + h]) * sp; }
#pragma unroll
            for (int o = 1; o < 64; o <<= 1) { const float tt = __shfl_up(g, o); if (lane >= o) g += tt; }
            gcs[i] = g; bts[i] = beta;
        }
        __syncthreads();
        SEC_T(1);
        if (wave < 4) {
            const int m = wave; f32x4 acc[4];
#pragma unroll
            for (int n = 0; n < 4; ++n) acc[n] = (f32x4){0.f, 0.f, 0.f, 0.f};
#pragma unroll
            for (int s = 0; s < 4; ++s) { const bf16x8 a = *(const bf16x8*)(Ks + (16 * m + fr) * 136 + 32 * s + 8 * fq);
#pragma unroll
                for (int n = 0; n < 4; ++n) { const bf16x8 bb = *(const bf16x8*)(Ks + (16 * n + fr) * 136 + 32 * s + 8 * fq); acc[n] = __builtin_amdgcn_mfma_f32_16x16x32_bf16(a, bb, acc[n], 0, 0, 0); } }
#pragma unroll
            for (int n = 0; n < 4; ++n) { const int i = 16 * n + fr, j0 = 16 * m + 4 * fq;
                float nv[4], pv_[4];
#pragma unroll
                for (int rg = 0; rg < 4; ++rg) { const int j = j0 + rg; const float mv = (i > j) ? bts[i] * acc[n][rg] * __expf(gcs[i] - gcs[j]) : 0.f;
                    nv[rg] = -mv; pv_[rg] = (i == j ? 1.f : 0.f) - mv; Rt[j * 72 + i] = f2bf(-mv); }
                u32x2 w; w.x = cvt_pk_bf16(nv[0], nv[1]); w.y = cvt_pk_bf16(nv[2], nv[3]); *(u32x2*)(Rm + i * 72 + j0) = w;
                w.x = cvt_pk_bf16(pv_[0], pv_[1]); w.y = cvt_pk_bf16(pv_[2], pv_[3]); *(u32x2*)(Pm + i * 72 + j0) = w; }
        } else {
            const int m = wave - 4; f32x4 acc[4];
#pragma unroll
            for (int n = 0; n < 4; ++n) acc[n] = (f32x4){0.f, 0.f, 0.f, 0.f};
#pragma unroll
            for (int s = 0; s < 4; ++s) { const bf16x8 qf = *(const bf16x8*)(Qs + (16 * m + fr) * 136 + 32 * s + 8 * fq);
#pragma unroll
                for (int n = 0; n < 4; ++n) { const bf16x8 kf = *(const bf16x8*)(Ks + (16 * n + fr) * 136 + 32 * s + 8 * fq); acc[n] = __builtin_amdgcn_mfma_f32_16x16x32_bf16(kf, qf, acc[n], 0, 0, 0); } }
            const int i = 16 * m + fr; const float gi = gcs[i];
#pragma unroll
            for (int s2 = 0; s2 < 2; ++s2) { float v[8];
#pragma unroll
                for (int e = 0; e < 8; ++e) { const int j = 32 * s2 + 16 * (e >> 2) + 4 * fq + (e & 3); v[e] = (i >= j) ? acc[2 * s2 + (e >> 2)][e & 3] * __expf(gi - gcs[j]) : 0.f; }
                *(u32x4*)(AT + slot * 4096 + i * 64 + (((4 * s2 + fq) ^ ((i >> 1) & 7)) << 3)) = pack8(v); }
        }
        __syncthreads();
        SEC_T(2);
        {
            const float glast = gcs[63];
            for (int task = tid; task < 2048; task += 512) {
                if (task < 1024) { const int i = task >> 4, s_ = (task >> 2) & 3, f4 = task & 3; const float sc = __expf(gcs[i]);
                    const u32x2 a = *(const u32x2*)(Qs + i * 136 + 32 * s_ + 4 * f4), bq = *(const u32x2*)(Qs + i * 136 + 32 * s_ + 16 + 4 * f4);
                    float v[8]; v[0] = bf2f(a.x & 0xffffu) * sc; v[1] = __uint_as_float(a.x & 0xffff0000u) * sc; v[2] = bf2f(a.y & 0xffffu) * sc; v[3] = __uint_as_float(a.y & 0xffff0000u) * sc;
                    v[4] = bf2f(bq.x & 0xffffu) * sc; v[5] = __uint_as_float(bq.x & 0xffff0000u) * sc; v[6] = bf2f(bq.y & 0xffffu) * sc; v[7] = __uint_as_float(bq.y & 0xffff0000u) * sc;
                    *(u32x4*)(QP + slot * 8192 + i * 128 + (((4 * s_ + f4) ^ (i & 15)) << 3)) = pack8(v);
                } else { const int tt = task - 1024, dk = tt >> 3, s2 = (tt >> 2) & 1, f4 = tt & 3; const int i0 = 32 * s2 + 4 * f4;
                    const int sw = ((dk >> 3) & 7) << 3; const u32x2 a = *(const u32x2*)(KT + dk * 72 + (i0 ^ sw)), bq = *(const u32x2*)(KT + dk * 72 + ((i0 + 16) ^ sw));
                    float v[8]; v[0] = bf2f(a.x & 0xffffu) * __expf(glast - gcs[i0]); v[1] = __uint_as_float(a.x & 0xffff0000u) * __expf(glast - gcs[i0 + 1]);
                    v[2] = bf2f(a.y & 0xffffu) * __expf(glast - gcs[i0 + 2]); v[3] = __uint_as_float(a.y & 0xffff0000u) * __expf(glast - gcs[i0 + 3]);
                    v[4] = bf2f(bq.x & 0xffffu) * __expf(glast - gcs[i0 + 16]); v[5] = __uint_as_float(bq.x & 0xffff0000u) * __expf(glast - gcs[i0 + 17]);
                    v[6] = bf2f(bq.y & 0xffffu) * __expf(glast - gcs[i0 + 18]); v[7] = __uint_as_float(bq.y & 0xffff0000u) * __expf(glast - gcs[i0 + 19]);
                    *(u32x4*)(KD + slot * 8192 + dk * 64 + (((4 * s2 + f4) ^ ((dk >> 1) & 7)) << 3)) = pack8(v); }
            }
            if (tid == 0) GL[slot] = __expf(glast);
            f32x4 accP[2];
#pragma unroll
            for (int e = 0; e < 2; ++e) { const int tt = 2 * wave + e, it_ = tt >> 2, jt = tt & 3;
                const u32x2 pw = *(const u32x2*)(Pm + (16 * it_ + fr) * 72 + 16 * jt + 4 * fq);
                accP[e] = (f32x4){__uint_as_float(pw.x << 16), __uint_as_float(pw.x & 0xffff0000u), __uint_as_float(pw.y << 16), __uint_as_float(pw.y & 0xffff0000u)}; }
#pragma unroll 1
            for (int rd = 0; rd < 6; ++rd) {
                f32x4 accR[2], accT[2];
#pragma unroll
                for (int e = 0; e < 2; ++e) { const int tt = 2 * wave + e, mt = tt >> 2, nt = tt & 3;
                    accR[e] = (f32x4){0.f, 0.f, 0.f, 0.f}; accT[e] = (f32x4){0.f, 0.f, 0.f, 0.f};
#pragma unroll
                    for (int s2 = 0; s2 < 2; ++s2) {
                        const bf16x8 rm = *(const bf16x8*)(Rm + (16 * mt + fr) * 72 + 32 * s2 + 8 * fq), rn = *(const bf16x8*)(Rm + (16 * nt + fr) * 72 + 32 * s2 + 8 * fq);
                        const bf16x8 tm = *(const bf16x8*)(Rt + (16 * mt + fr) * 72 + 32 * s2 + 8 * fq), tn = *(const bf16x8*)(Rt + (16 * nt + fr) * 72 + 32 * s2 + 8 * fq);
                        const bf16x8 pm_ = *(const bf16x8*)(Pm + (16 * mt + fr) * 72 + 32 * s2 + 8 * fq);
                        if (rd < 5) { accR[e] = __builtin_amdgcn_mfma_f32_16x16x32_bf16(rm, tn, accR[e], 0, 0, 0);
                                      accT[e] = __builtin_amdgcn_mfma_f32_16x16x32_bf16(tm, rn, accT[e], 0, 0, 0); }
                        if (rd > 0) accP[e] = __builtin_amdgcn_mfma_f32_16x16x32_bf16(tn, pm_, accP[e], 0, 0, 0);
                    } }
                __syncthreads();
                if (rd < 5) {
#pragma unroll
                    for (int e = 0; e < 2; ++e) { const int tt = 2 * wave + e, mt = tt >> 2, nt = tt & 3; u32x2 w;
                        w.x = cvt_pk_bf16(accR[e][0], accR[e][1]); w.y = cvt_pk_bf16(accR[e][2], accR[e][3]); *(u32x2*)(Rt + (16 * nt + fr) * 72 + 16 * mt + 4 * fq) = w;
                        w.x = cvt_pk_bf16(accT[e][0], accT[e][1]); w.y = cvt_pk_bf16(accT[e][2], accT[e][3]); *(u32x2*)(Rm + (16 * nt + fr) * 72 + 16 * mt + 4 * fq) = w;
                        if (rd > 0) { w.x = cvt_pk_bf16(accP[e][0], accP[e][1]); w.y = cvt_pk_bf16(accP[e][2], accP[e][3]); *(u32x2*)(Pm + (16 * mt + fr) * 72 + 16 * nt + 4 * fq) = w; } }
                    __syncthreads();
                }
            }
#pragma unroll
            for (int e = 0; e < 2; ++e) { const int tt = 2 * wave + e, mt = tt >> 2, nt = tt & 3; const int i = 16 * mt + fr, c0 = 16 * nt + 4 * fq; float v1[4], v2[4];
#pragma unroll
                for (int rg = 0; rg < 4; ++rg) { const float bc = bts[c0 + rg]; v1[rg] = accP[e][rg] * bc; v2[rg] = -accP[e][rg] * bc * __expf(gcs[c0 + rg]); }
                u32x2 w; w.x = cvt_pk_bf16(v1[0], v1[1]); w.y = cvt_pk_bf16(v1[2], v1[3]); *(u32x2*)(T1 + i * 72 + c0) = w;
                w.x = cvt_pk_bf16(v2[0], v2[1]); w.y = cvt_pk_bf16(v2[2], v2[3]); *(u32x2*)(T2 + i * 72 + c0) = w; }
        }
        __syncthreads();
        SEC_T(3);
#pragma unroll 1
        for (int nh = 0; nh < 2; ++nh) {
        if (wave < 4) {
            const int m = wave; f32x4 acc[4];
#pragma unroll
            for (int n = 0; n < 4; ++n) acc[n] = (f32x4){0.f, 0.f, 0.f, 0.f};
#pragma unroll
            for (int s2 = 0; s2 < 2; ++s2) { const bf16x8 a = *(const bf16x8*)(T1 + (16 * m + fr) * 72 + 32 * s2 + 8 * fq);
#pragma unroll
                for (int n = 0; n < 4; ++n) { const int d = 16 * (4 * nh + n) + fr; const bf16x8 bb = *(const bf16x8*)(VT + d * 72 + ((32 * s2 + 8 * fq) ^ (((d >> 3) & 7) << 3))); acc[n] = __builtin_amdgcn_mfma_f32_16x16x32_bf16(a, bb, acc[n], 0, 0, 0); } }
#pragma unroll
            for (int n = 0; n < 4; ++n) { u32x2 w; w.x = cvt_pk_bf16(acc[n][0], acc[n][1]); w.y = cvt_pk_bf16(acc[n][2], acc[n][3]);
                *(u32x2*)(UF + slot * 8192 + (((4 * nh + n) * 4 + m) * 64 + lane) * 4) = w; }
        } else {
            const int m = wave - 4; f32x4 acc[4];
#pragma unroll
            for (int n = 0; n < 4; ++n) acc[n] = (f32x4){0.f, 0.f, 0.f, 0.f};
#pragma unroll
            for (int s2 = 0; s2 < 2; ++s2) { const bf16x8 tf = *(const bf16x8*)(T2 + (16 * m + fr) * 72 + 32 * s2 + 8 * fq);
#pragma unroll
                for (int n = 0; n < 4; ++n) { const int d = 16 * (4 * nh + n) + fr; const bf16x8 kf = *(const bf16x8*)(KT + d * 72 + ((32 * s2 + 8 * fq) ^ (((d >> 3) & 7) << 3))); acc[n] = __builtin_amdgcn_mfma_f32_16x16x32_bf16(kf, tf, acc[n], 0, 0, 0); } }
            const int i = 16 * m + fr;
#pragma unroll
            for (int s = 0; s < 2; ++s) { u32x4 w; w.x = cvt_pk_bf16(acc[2 * s][0], acc[2 * s][1]); w.y = cvt_pk_bf16(acc[2 * s][2], acc[2 * s][3]);
                w.z = cvt_pk_bf16(acc[2 * s + 1][0], acc[2 * s + 1][1]); w.w = cvt_pk_bf16(acc[2 * s + 1][2], acc[2 * s + 1][3]);
                *(u32x4*)(WP + slot * 8192 + i * 128 + (((4 * (2 * nh + s) + fq) ^ (i & 15)) << 3)) = w; }
        }
        }
        SEC_T(4);
    }
    __syncthreads();
}

__device__ void dn_scan(const Params& P, unsigned char* smem, int t0, int t1) {
    if (lbid() >= 128) return;
    const int bhd = lbid() >> 1, half = lbid() & 1;
    const int tid = ltid(), wave = __builtin_amdgcn_readfirstlane(tid >> 6), lane = tid & 63, fr = lane & 15, fq = lane >> 4;
    unsigned char* ws = P.ws;
    const unsigned char* WPb = ws + O_WP; const unsigned char* QPb = ws + O_QP; const unsigned char* KDb = ws + O_KD; const unsigned char* ATb = ws + O_AT;
    const bf16_t* UF = (const bf16_t*)(ws + O_UF); const float* GL = (const float*)(ws + S_GL);
    bf16_t* OO = (bf16_t*)(ws + O_O); f32x4* SS = (f32x4*)(ws + S_SSAVE);
    const int b = bhd >> 3, h = (bhd >> 1) & 3, dir = bhd & 1;
    LAS unsigned char* lds = (LAS unsigned char*)smem;
    constexpr int BUFB = 57344;
#define SCAN_SRC(q_, slot_) ((q_) < 16 ? WPb + (slot_) * 16384 + (q_) * 1024 : (q_) < 32 ? QPb + (slot_) * 16384 + ((q_) - 16) * 1024 : (q_) < 48 ? KDb + (slot_) * 16384 + ((q_) - 32) * 1024 : ATb + (slot_) * 8192 + ((q_) - 48) * 1024)
#define SCAN_LOAD(tl_) do { const size_t _slot = (size_t)(tl_) * 64 + bhd; _Pragma("unroll") for (int _k = 0; _k < 14; ++_k) { const int _q = (wave - 4) * 14 + _k; rg_[_k] = *(const u32x4*)(SCAN_SRC(_q, _slot) + lane * 16); } } while (0)
#define SCAN_WRITE(buf_) do { _Pragma("unroll") for (int _k = 0; _k < 14; ++_k) { const int _q = (wave - 4) * 14 + _k; *(LAS u32x4*)(lds + (buf_) * BUFB + _q * 1024 + lane * 16) = rg_[_k]; } } while (0)
    constexpr int NN = 1; const bool cw_ = wave < 4; const int sl0 = half * 4 + (wave & 3);
    const int nst = t1 - t0;
    if (!cw_) {
        u32x4 rg_[14];
#define SCAN_LOAD(tl_) do { const size_t _slot = (size_t)(tl_) * 64 + bhd; _Pragma("unroll") for (int _k = 0; _k < 14; ++_k) { const int _q = (wave - 4) * 14 + _k; rg_[_k] = *(const u32x4*)(SCAN_SRC(_q, _slot) + lane * 16); } } while (0)
#define SCAN_WRITE(buf_) do { _Pragma("unroll") for (int _k = 0; _k < 14; ++_k) { const int _q = (wave - 4) * 14 + _k; *(LAS u32x4*)(lds + (buf_) * BUFB + _q * 1024 + lane * 16) = rg_[_k]; } } while (0)
        SCAN_LOAD(0); SCAN_WRITE(0); if (nst > 1) SCAN_LOAD(1);
#pragma unroll 1
        for (int tl = 0; tl < nst; ++tl) {
            __syncthreads();
            if (tl + 1 < nst) { SCAN_WRITE((tl + 1) & 1); if (tl + 2 < nst) SCAN_LOAD(tl + 2); }
        }
        asm volatile("s_waitcnt vmcnt(0)" ::: "memory");
        __syncthreads();
        return;
    }
    f32x4 S[8][NN];
#pragma unroll
    for (int t = 0; t < 8; ++t)
#pragma unroll
        for (int nn = 0; nn < NN; ++nn) S[t][nn] = (t0 == 0 || !cw_) ? (f32x4){0.f, 0.f, 0.f, 0.f} : SS[((size_t)(bhd * 8 + sl0 + nn) * 8 + t) * 64 + lane];
    u32x2 un[4][NN];
    if (cw_) {
#pragma unroll
        for (int m = 0; m < 4; ++m)
#pragma unroll
            for (int nn = 0; nn < NN; ++nn) un[m][nn] = *(const u32x2*)(UF + (size_t)bhd * 8192 + (((sl0 + nn) * 4 + m) * 64 + lane) * 4); }
    float gln = __hip_atomic_load(GL + bhd, __ATOMIC_RELAXED, __HIP_MEMORY_SCOPE_AGENT);
#pragma unroll 1
    for (int tl = 0; tl < nst; ++tl) {
        const size_t slot = (size_t)tl * 64 + bhd; const int t = t0 + tl, c = dir ? 64 - t : t;
        const LAS unsigned char* bw = lds + (tl & 1) * BUFB;
        __syncthreads();
        f32x4 av[4][NN], ao[4][NN];
#pragma unroll
        for (int m = 0; m < 4; ++m)
#pragma unroll
            for (int nn = 0; nn < NN; ++nn) { const u32x2 u = un[m][nn];
                av[m][nn] = (f32x4){__uint_as_float(u.x << 16), __uint_as_float(u.x & 0xffff0000u), __uint_as_float(u.y << 16), __uint_as_float(u.y & 0xffff0000u)}; ao[m][nn] = (f32x4){0.f, 0.f, 0.f, 0.f}; }
        const float gl = gln; if (tl + 1 < nst) gln = __hip_atomic_load(GL + slot + 64, __ATOMIC_RELAXED, __HIP_MEMORY_SCOPE_AGENT);
        if (tl + 1 < nst) {
#pragma unroll
            for (int m = 0; m < 4; ++m)
#pragma unroll
                for (int nn = 0; nn < NN; ++nn) un[m][nn] = *(const u32x2*)(UF + (slot + 64) * 8192 + (((sl0 + nn) * 4 + m) * 64 + lane) * 4); }
#pragma unroll
        for (int s = 0; s < 4; ++s) { bf16x8 Sb[NN];
#pragma unroll
            for (int nn = 0; nn < NN; ++nn) { u32x4 w; w.x = cvt_pk_bf16(S[2 * s][nn][0], S[2 * s][nn][1]); w.y = cvt_pk_bf16(S[2 * s][nn][2], S[2 * s][nn][3]); w.z = cvt_pk_bf16(S[2 * s + 1][nn][0], S[2 * s + 1][nn][1]); w.w = cvt_pk_bf16(S[2 * s + 1][nn][2], S[2 * s + 1][nn][3]);
                Sb[nn] = __builtin_bit_cast(bf16x8, w); }
#pragma unroll
            for (int m = 0; m < 4; ++m) { const bf16x8 wf = *(const LAS bf16x8*)(bw + (16 * m + fr) * 256 + (((4 * s + fq) ^ fr) << 4)); const bf16x8 qf = *(const LAS bf16x8*)(bw + 16384 + (16 * m + fr) * 256 + (((4 * s + fq) ^ fr) << 4));
                _Pragma("unroll") for (int nn = 0; nn < NN; ++nn) av[m][nn] = __builtin_amdgcn_mfma_f32_16x16x32_bf16(wf, Sb[nn], av[m][nn], 0, 0, 0);
                _Pragma("unroll") for (int nn = 0; nn < NN; ++nn) ao[m][nn] = __builtin_amdgcn_mfma_f32_16x16x32_bf16(qf, Sb[nn], ao[m][nn], 0, 0, 0); } }
        __builtin_amdgcn_sched_barrier(0);
        bf16x8 Vb[2][NN];
#pragma unroll
        for (int s2 = 0; s2 < 2; ++s2)
#pragma unroll
            for (int nn = 0; nn < NN; ++nn) { u32x4 w; w.x = cvt_pk_bf16(av[2 * s2][nn][0], av[2 * s2][nn][1]); w.y = cvt_pk_bf16(av[2 * s2][nn][2], av[2 * s2][nn][3]); w.z = cvt_pk_bf16(av[2 * s2 + 1][nn][0], av[2 * s2 + 1][nn][1]); w.w = cvt_pk_bf16(av[2 * s2 + 1][nn][2], av[2 * s2 + 1][nn][3]);
                Vb[s2][nn] = __builtin_bit_cast(bf16x8, w); }
#pragma unroll
        for (int m = 0; m < 4; ++m)
#pragma unroll
            for (int s2 = 0; s2 < 2; ++s2) { const int row = 16 * m + fr; const bf16x8 af = *(const LAS bf16x8*)(bw + 49152 + row * 128 + (((4 * s2 + fq) ^ ((row >> 1) & 7)) << 4));
                _Pragma("unroll") for (int nn = 0; nn < NN; ++nn) ao[m][nn] = __builtin_amdgcn_mfma_f32_16x16x32_bf16(af, Vb[s2][nn], ao[m][nn], 0, 0, 0); }
        __builtin_amdgcn_sched_barrier(0);
#pragma unroll
        for (int tt = 0; tt < 8; ++tt) { _Pragma("unroll") for (int nn = 0; nn < NN; ++nn) S[tt][nn] = S[tt][nn] * gl;
#pragma unroll
            for (int s2 = 0; s2 < 2; ++s2) { const int row = 16 * tt + fr; const bf16x8 kf = *(const LAS bf16x8*)(bw + 32768 + row * 128 + (((4 * s2 + fq) ^ ((row >> 1) & 7)) << 4));
                _Pragma("unroll") for (int nn = 0; nn < NN; ++nn) S[tt][nn] = __builtin_amdgcn_mfma_f32_16x16x32_bf16(kf, Vb[s2][nn], S[tt][nn], 0, 0, 0); } }
#pragma unroll
        for (int m = 0; m < 4; ++m)
#pragma unroll
            for (int rg = 0; rg < 4; ++rg) { const int i = 16 * m + 4 * fq + rg, n = c * 64 + (dir ? 63 - i : i) - 48;
                if (n >= 0) { bf16_t* op = OO + ((size_t)dir * TP + (size_t)b * LL + n) * 512 + h * 128 + sl0 * 16 + fr; _Pragma("unroll") for (int nn = 0; nn < NN; ++nn) op[16 * nn] = f2bf(ao[m][nn][rg]); } }
    }
#undef SCAN_SRC
#undef SCAN_LOAD
#undef SCAN_WRITE
    if (t1 < NSTEP && cw_) {
#pragma unroll
        for (int t = 0; t < 8; ++t)
#pragma unroll
            for (int nn = 0; nn < NN; ++nn) SS[((size_t)(bhd * 8 + sl0 + nn) * 8 + t) * 64 + lane] = S[t][nn]; }
    asm volatile("s_waitcnt vmcnt(0)" ::: "memory");
    __syncthreads();
}

__device__ void dn_out(const Params& P, int l) {
    const int tid_ = ltid(); const int wave = __builtin_amdgcn_readfirstlane(tid_ >> 6), lane = tid_ & 63;
    const bf16_t* OO = (const bf16_t*)(P.ws + O_O); const bf16_t* Z = (const bf16_t*)(P.ws + O_Z); bf16_t* DNO = (bf16_t*)(P.ws + O_BR) + (size_t)2 * TP * 512;
    const float* nw = P.in[12] + (size_t)l * 128; float g[8];
#pragma unroll
    for (int e = 0; e < 8; ++e) g[e] = nw[(lane & 15) * 8 + e];
    for (int r = lbid() * 8 + wave; r < TT; r += lgrid() * 8) {
        float a[8], bq[8], z[8]; unpack8(*(const u32x4*)(OO + (size_t)r * 512 + lane * 8), a); unpack8(*(const u32x4*)(OO + ((size_t)TP + r) * 512 + lane * 8), bq); unpack8(*(const u32x4*)(Z + (size_t)r * 512 + lane * 8), z);
        float ss = 0.f;
#pragma unroll
        for (int e = 0; e < 8; ++e) { a[e] += bq[e]; ss += a[e] * a[e]; }
        ss += __shfl_xor(ss, 1); ss += __shfl_xor(ss, 2); ss += __shfl_xor(ss, 4); ss += __shfl_xor(ss, 8);
        const float inv = rsqrtf(ss * (1.0f / 128.0f) + EPS);
#pragma unroll
        for (int e = 0; e < 8; ++e) a[e] = a[e] * inv * g[e] * siluf_(z[e]);
        *(u32x4*)(DNO + (size_t)r * 512 + lane * 8) = pack8(a);
    }
}


#define XB_TMO      128
#define XB_XCNT(j)  (256  + 64 * (j))
#define XB_XSUB(j)  (1280 + 64 * (j))
#define XB_XGEN(j)  (2304 + 64 * (j))
#define XB_TOP      3328
#define XB_TOPGEN   3392
#define XCD_BAR_WORDS 3456
#define XB_SPIN_CAP (1u << 22)
__device__ __forceinline__ unsigned xb_ld(unsigned* p)              { return __hip_atomic_load(p, __ATOMIC_RELAXED, __HIP_MEMORY_SCOPE_AGENT); }
__device__ __forceinline__ unsigned xb_add(unsigned* p, unsigned v) { return __hip_atomic_fetch_add(p, v, __ATOMIC_RELAXED, __HIP_MEMORY_SCOPE_AGENT); }
__device__ __forceinline__ unsigned xb_xcc_id() { return (unsigned)__builtin_amdgcn_s_getreg((3 << 11) | 20) & 0xFu; }
#define XB_SPIN(cond, bar) do { unsigned _sp = 0; while (cond) { __builtin_amdgcn_s_sleep(1); \
    if ((++_sp & 255u) == 0u) { if (xb_ld(&(bar)[XB_TMO])) break; if (_sp > XB_SPIN_CAP) { atomicAdd(&(bar)[XB_TMO], 1u); break; } } } } while (0)
struct XcdBarrier { unsigned* bar; unsigned x; volatile LAS unsigned* st; };
__device__ __forceinline__ XcdBarrier xcd_barrier_post(unsigned* bar, volatile LAS unsigned* st) {
    XcdBarrier b; b.bar = bar; b.x = xb_xcc_id(); b.st = st;
    if (threadIdx.x == 0) (void)xb_add(&bar[XB_XCNT(b.x)], 1u);
    return b;
}
__device__ __forceinline__ void xcd_barrier_complete(unsigned* bar, unsigned x, unsigned& nloc, unsigned& nx) {
    const unsigned G = gridDim.x * gridDim.y * gridDim.z;
    unsigned sum, cnt, mine, sp = 0u;
    for (;;) {
        sum = 0u; cnt = 0u; mine = 0u;
#pragma unroll
        for (unsigned j = 0; j < 16; ++j) { const unsigned c = xb_ld(&bar[XB_XCNT(j)]); sum += c; cnt += (c > 0u) ? 1u : 0u; mine = (j == x) ? c : mine; }
        if (sum == G) break;
        __builtin_amdgcn_s_sleep(1);
        if ((++sp & 255u) == 0u) { if (xb_ld(&bar[XB_TMO])) break; if (sp > XB_SPIN_CAP) { atomicAdd(&bar[XB_TMO], 1u); break; } }
    }
    nloc = mine > 0u ? mine : 1u; nx = cnt > 0u ? cnt : 1u;
}
__device__ __forceinline__ void xcd_barrier(const XcdBarrier& b) {
    asm volatile("s_waitcnt vmcnt(0)" ::: "memory");
    __syncthreads();
    if (threadIdx.x == 0) {
        unsigned* bar = b.bar;
        __builtin_amdgcn_s_waitcnt(0);
        unsigned nloc = b.st[0], nx = b.st[1];
        if (nloc == 0u) { xcd_barrier_complete(bar, b.x, nloc, nx); b.st[0] = nloc; b.st[1] = nx; }
        const unsigned old = xb_add(&bar[XB_XSUB(b.x)], 1u);
        const unsigned gen = old / nloc;
        if (old + 1u == (gen + 1u) * nloc) {
            __builtin_amdgcn_fence(__ATOMIC_RELEASE, "agent");
            asm volatile("s_waitcnt vmcnt(0)" ::: "memory");
            const unsigned og = xb_add(&bar[XB_TOP], 1u);
            const unsigned tg = og / nx;
            if (og + 1u == (tg + 1u) * nx) xb_add(&bar[XB_TOPGEN], 1u);
            else XB_SPIN(xb_ld(&bar[XB_TOPGEN]) == tg, bar);
            __builtin_amdgcn_fence(__ATOMIC_ACQUIRE, "agent");
            xb_add(&bar[XB_XGEN(b.x)], 1u);
            asm volatile("s_waitcnt vmcnt(0)" ::: "memory");
        } else {
            XB_SPIN(xb_ld(&bar[XB_XGEN(b.x)]) == gen, bar);
            __builtin_amdgcn_fence(__ATOMIC_ACQUIRE, "agent");
            asm volatile("s_waitcnt vmcnt(0)" ::: "memory");
        }
    }
    __syncthreads();
}
__device__ __forceinline__ int phase_cat(int ph) { const int p = ph % 22;
    return p == 0 ? 0 : (p == 1 || p == 2 || p == 19 || p == 20) ? 1 : (p == 3 || p == 18 || p == 21) ? 2 : p == 4 ? 3 : p == 5 ? 4 : p == 6 ? 5 : p == 7 ? 6 : (p == 8 || p == 10 || p == 12) ? 7 : (p == 9 || p == 11 || p == 13) ? 8 : p == 14 ? 9 : 10; }
#ifndef SKIP_GEMM
#define GEMM_CALL(a,b,c,d) pg8::gemm_phase(a,b,c,d)
#else
#define GEMM_CALL(a,b,c,d) (void)0
#endif
__global__ void __launch_bounds__(512, 2) fwd_kernel(Params P) {
    extern __shared__ __attribute__((aligned(16))) unsigned char smem[];
    cg::grid_group grid = cg::this_grid();
    unsigned char* ws = P.ws;
    LAS unsigned char* lds = (LAS unsigned char*)smem;
    int ph = 0;
    { volatile LAS unsigned* stw = (volatile LAS unsigned*)(lds + LDS_BYTES - 32); if (threadIdx.x < 8) stw[threadIdx.x] = 0u; }
    __syncthreads();
    XcdBarrier xbar = xcd_barrier_post((unsigned*)(ws + S_BAR), (volatile LAS unsigned*)(lds + LDS_BYTES - 16));
#ifdef DBG_CAT
    unsigned long long t_prev = __builtin_amdgcn_s_memrealtime(), t_acc = 0ull;
#define STAMP() do { const unsigned long long _n = __builtin_amdgcn_s_memrealtime(); if (phase_cat(ph) == DBG_CAT) t_acc += _n - t_prev; t_prev = _n; } while (0)
#else
#define STAMP() do {} while (0)
#endif
#define PHASE_BEGIN if (ph >= P.ph_lo && ph < P.ph_hi) { const int G = lgrid(), bx = lbid(); (void)G; (void)bx;
#define PHASE_END   if (ph + 1 < P.ph_hi) { if (ph == 0) { asm volatile("s_waitcnt vmcnt(0) lgkmcnt(0)" ::: "memory"); grid.sync(); __builtin_amdgcn_fence(__ATOMIC_ACQUIRE, "agent"); asm volatile("s_waitcnt vmcnt(0)" ::: "memory"); __syncthreads(); } else xcd_barrier(xbar); } STAMP(); } ++ph;
    for (ph = P.ph_lo; ph < P.ph_hi; ++ph) {
        const int l = ph / 22, p = ph - l * 22;
        const int G = lgrid(), bx = lbid();
        bf16_t* XN = (bf16_t*)(ws + O_XN); bf16_t* Y = (bf16_t*)(ws + O_Y); bf16_t* ACT = (bf16_t*)(ws + O_ACT);
        const float* ng = P.in[2] + (size_t)l * 6 * 1024;
        switch (p) {
        case 0:
#ifndef SKIP_CVT
            convert_weights(P, l, smem);
#endif
            if (l == 0) { gen_tables(P); rpass(P, nullptr, true, nullptr, 0.f, ng, XN); }
            break;
        case 1: case 19: { pg8::Gemm g{XN, (const bf16_t*)(ws + (p == 1 ? W_WI1 : W_WI2)), TP, 5632, 1024, 128, 1024}; pg8::StaticOrder S; S.init(TP, 5632, G, bx); pg8::EpiSwiglu E{ACT}; GEMM_CALL(lds, g, S, E); } break;
        case 2: case 20: case 17: {
            const bool dn = (p != 17); const int Kx = dn ? 2816 : 1024, nS = dn ? 11 : 4;
            const bf16_t* W = (const bf16_t*)(ws + (p == 2 ? W_WO1 : p == 20 ? W_WO2 : W_WOUT)); const bf16_t* Ax = dn ? ACT : (const bf16_t*)(ws + O_MG);
            { pg8::Gemm g{Ax, W, TP, 1024, Kx, 128, Kx}; pg8::StaticOrder S; S.init(TP, 1024, G, bx, false); pg8::EpiBf16<0> E{Y, 1024}; GEMM_CALL(lds, g, S, E); }
            { pg8::Gemm g{W, Ax + (size_t)32768 * Kx, 1024, 256, Kx, -1, 256}; pg8::TailOrder S{nS, bx}; pg8::EpiSlab E{(float*)(ws + O_SLAB), nS}; GEMM_CALL(lds, g, S, E); } } break;
        case 3: rpass(P, Y, l == 0, ng + 1024, 0.5f, ng + 2048, XN, (const float*)(ws + O_SLAB), 11); break;
        case 4: { pg8::Gemm g{XN, (const bf16_t*)(ws + W_WIN), TP, NPROJ, 1024, 128, 1024}; pg8::StaticOrder S; S.init(TP, NPROJ, G, bx); pg8::EpiInProj E{ws}; GEMM_CALL(lds, g, S, E); } break;
        case 5: sconv_pass(P, l); break;
        case 6:
#ifndef SKIP_F1
            fstep1(P, smem);
#endif
            break;
        case 7: { pg8::Gemm g{(const bf16_t*)(ws + S_C257), (const bf16_t*)(ws + O_AP), 512, 65536, KF, 1, KF}; pg8::StaticOrder S; S.init(512, 65536, G, bx);
                  pg8::EpiFourier E{(bf16_t*)(ws + O_BR), 0.001949317738791423f  }; GEMM_CALL(lds, g, S, E); } break;
        case 8: case 10: case 12: { const int t0 = ((p - 8) >> 1) * SPL, t1 = (t0 + SPL < NSTEP) ? t0 + SPL : NSTEP;
#ifndef SKIP_PREP
            dn_prep(P, l, smem, t0, t1);
#endif
            } break;
        case 9: case 11: case 13: { const int t0 = ((p - 9) >> 1) * SPL, t1 = (t0 + SPL < NSTEP) ? t0 + SPL : NSTEP;
#ifndef SKIP_SCAN
            dn_scan(P, smem, t0, t1);
#endif
            } break;
        case 14: dn_out(P, l); rpass(P, nullptr, false, nullptr, 0.f, ng + 2048, (bf16_t*)(ws + O_XN2)); break;
        case 15: { pg8::Gemm g{(const bf16_t*)(ws + O_XN2), (const bf16_t*)(ws + W_WG), TP, 3072, 1024, 128, 1024}; pg8::StaticOrder S; S.init(TP, 3072, G, bx); pg8::EpiBf16<1> E{(bf16_t*)(ws + O_GATE), 3072}; GEMM_CALL(lds, g, S, E); } break;
        case 16: { pg8::Gemm g{(const bf16_t*)(ws + O_BR), (const bf16_t*)(ws + W_WBR), 3 * TP, 3072, 512, -1, 512}; pg8::MergeOrder S{G, bx}; pg8::EpiMerge E{(const bf16_t*)(ws + O_GATE), (bf16_t*)(ws + O_MG), (bf16_t*)(ws + O_XN2)}; GEMM_CALL(lds, g, S, E); } break;
        case 18: rpass(P, Y, false, ng + 3 * 1024, 1.0f, ng + 4 * 1024, XN, (const float*)(ws + O_SLAB), 4); break;
        default: rpass(P, Y, false, ng + 5 * 1024, 0.5f, l == 0 ? P.in[2] + (size_t)6 * 1024 : nullptr, XN, (const float*)(ws + O_SLAB), 11); break;
        }
        if (ph + 1 < P.ph_hi) {
            if (ph == 0) { asm volatile("s_waitcnt vmcnt(0) lgkmcnt(0)" ::: "memory"); grid.sync(); __builtin_amdgcn_fence(__ATOMIC_ACQUIRE, "agent"); asm volatile("s_waitcnt vmcnt(0)" ::: "memory"); __syncthreads(); }
            else xcd_barrier(xbar);
        }
        STAMP();
    }
#ifdef DBG_CAT
    if (lbid() == 0 && threadIdx.x == 0) { const unsigned long long t0 = __builtin_amdgcn_s_memrealtime(); while (__builtin_amdgcn_s_memrealtime() - t0 < t_acc + *(unsigned long long*)(smem + LDS_BYTES - 32)) __builtin_amdgcn_s_sleep(16); }
#endif
#ifdef DBG_FLUSH
    { asm volatile("s_waitcnt vmcnt(0) lgkmcnt(0)" ::: "memory"); grid.sync(); __builtin_amdgcn_fence(__ATOMIC_ACQUIRE, "agent"); asm volatile("s_waitcnt vmcnt(0)" ::: "memory");
      const f32x4* xs = (const f32x4*)P.in[0]; f32x4 a = {0.f, 0.f, 0.f, 0.f};
      for (size_t i = ltid(); i < (size_t)8388608; i += 512) a += xs[i];
      if (a[0] + a[1] + a[2] + a[3] == 1.2345e-30f) ((float*)(ws + S_GL))[4000] = 1.f; }
#endif
#ifdef DBG_OFF
    { asm volatile("s_waitcnt vmcnt(0) lgkmcnt(0)" ::: "memory"); grid.sync(); __builtin_amdgcn_fence(__ATOMIC_ACQUIRE, "agent"); asm volatile("s_waitcnt vmcnt(0)" ::: "memory");
      const bf16_t* src = (const bf16_t*)(ws + DBG_OFF);
      for (size_t i = (size_t)lbid() * 512 + ltid(); i < (size_t)33554432; i += (size_t)lgrid() * 512) P.out[i] = i < (size_t)DBG_CNT ? bf2f(src[i]) : 0.f; }
#endif
}

extern "C" void kernel_launch(void* const* d_in, const int* in_sizes, int n_in, void* d_out, int out_size, void* d_ws, size_t ws_size, hipStream_t stream) {
    static int grid = 0;
    if (grid == 0) {
        int dev = 0, cus = 0, per_cu = 0;
        hipGetDevice(&dev); hipDeviceGetAttribute(&cus, hipDeviceAttributeMultiprocessorCount, dev);
        hipFuncSetAttribute((const void*)fwd_kernel, hipFuncAttributeMaxDynamicSharedMemorySize, LDS_BYTES);
        hipOccupancyMaxActiveBlocksPerMultiprocessor(&per_cu, (const void*)fwd_kernel, 512, LDS_BYTES);
        if (per_cu < 1) { fprintf(stderr, "occupancy query says %d blocks/CU\n", per_cu); per_cu = 1; }
        grid = cus;
        if (ws_size < WS_NEED) fprintf(stderr, "workspace too small: %zu < %zu\n", ws_size, (size_t)WS_NEED);
    }
    Params p{};
    for (int i = 0; i < 17; ++i) p.in[i] = (const float*)d_in[i];
    p.out = (float*)d_out; p.ws = (unsigned char*)d_ws; p.ph_lo = 0; p.ph_hi = 44;
#ifdef DBG_PHI
    p.ph_hi = DBG_PHI;
#endif
    hipMemsetAsync((char*)d_ws + S_BAR, 0, 16384, stream);
    void* args[] = {&p};
    hipError_t e = hipLaunchCooperativeKernel((const void*)fwd_kernel, dim3(grid), dim3(512), args, LDS_BYTES, stream);
    if (e != hipSuccess) fprintf(stderr, "cooperative launch failed: %s (grid %d)\n", hipGetErrorString(e), grid);
}
```

```cpp
#include <hip/hip_runtime.h>
#include <hip/hip_cooperative_groups.h>
#include <cstdio>
namespace cg = cooperative_groups;

#define LAS __attribute__((address_space(3)))
typedef unsigned short bf16_t;
typedef short bf16x8 __attribute__((ext_vector_type(8)));
typedef float f32x4 __attribute__((ext_vector_type(4)));
typedef unsigned u32x4 __attribute__((ext_vector_type(4)));
typedef unsigned u32x2 __attribute__((ext_vector_type(2)));

constexpr int DM = 1024, NB = 8, SEQ = 4096, NMETA = 16, LL = 4112, TT = NB * LL  , TP = 33024  , DFF = 2816;
constexpr int NIN = 7184;
constexpr int NPROJ = 4864;
constexpr float EPS = 1e-6f;
constexpr int NSTEP = 65, SPL = 24, NSPLIT = 3;
constexpr int KF = 640;

constexpr size_t UU = (size_t)TP * 1024;
constexpr size_t W_WI1 = 0, W_WO1 = W_WI1 + (size_t)5632 * 1024 * 2, W_WI2 = W_WO1 + (size_t)1024 * 2816 * 2, W_WO2 = W_WI2 + (size_t)5632 * 1024 * 2,
                 W_WIN = W_WO2 + (size_t)1024 * 2816 * 2, W_WG = W_WIN + (size_t)NPROJ * 1024 * 2, W_WBR = W_WG + (size_t)3072 * 1024 * 2,
                 W_WOUT = W_WBR + (size_t)3072 * 512 * 2, W_END = W_WOUT + (size_t)1024 * 1024 * 2;
constexpr size_t S_C257 = W_END, S_TWL = S_C257 + (size_t)512 * KF * 2, S_HM = S_TWL + 33024, S_LOGIT = S_HM + (size_t)128 * 1024 * 4,
                 S_GL = S_LOGIT + (size_t)TP * 16 * 4, S_SSAVE = S_GL + 16896, S_BAR = S_SSAVE + (size_t)512 * 8 * 64 * 16, S_END = S_BAR + 16384;
constexpr size_t A0 = (S_END + 255) / 256 * 256;
constexpr size_t O_XN = A0, O_Y = A0 + 2 * UU, O_ACT = A0 + 4 * UU;
constexpr size_t O_BR = A0, O_QKV = A0 + 4 * UU, O_Z = A0 + 7 * UU, O_SC = A0 + 8 * UU, O_PQ = A0 + 11 * UU, O_AP = A0 + 8 * UU;
constexpr size_t DNI_SLOTS = (size_t)SPL * 64;
constexpr size_t O_WP = A0 + 8 * UU, O_QP = O_WP + DNI_SLOTS * 16384, O_KD = O_QP + DNI_SLOTS * 16384, O_UF = O_KD + DNI_SLOTS * 16384,
                 O_AT = O_UF + DNI_SLOTS * 16384, O_DNI_END = O_AT + DNI_SLOTS * 8192;
constexpr size_t O_O = (O_DNI_END + 255) / 256 * 256;
constexpr size_t O_XN2 = A0 + 3 * UU, O_GATE = A0 + 5 * UU, O_MG = A0 + 11 * UU;
constexpr size_t O_SLAB = (O_O + 2 * UU + 255) / 256 * 256;
constexpr size_t WS_NEED = O_SLAB + (size_t)44 * 65536 * 4;
static_assert(WS_NEED <= (size_t)536870912, "workspace");
static_assert(O_AP + (size_t)65536 * KF * 2 <= O_PQ, "A' overlaps PQ");
static_assert(O_O >= O_PQ || true, "");
static_assert(O_MG + 2 * UU <= WS_NEED + 2 * UU, "");

constexpr int LDS_BYTES = 132 * 1024;

#define DBG_CNT ((size_t)33554432)


struct Params { const float* in[17]; float* out; unsigned char* ws; int ph_lo, ph_hi; };

__device__ __forceinline__ float bf2f(unsigned v) { return __uint_as_float(v << 16); }
typedef __bf16 bf16x2_t __attribute__((ext_vector_type(2)));
typedef float f32x2_t __attribute__((ext_vector_type(2)));
__device__ __forceinline__ unsigned cvt_pk_bf16(float lo, float hi) { f32x2_t v = {lo, hi}; bf16x2_t b = __builtin_convertvector(v, bf16x2_t); return __builtin_bit_cast(unsigned, b); }
__device__ __forceinline__ bf16_t f2bf(float f) { return (bf16_t)(cvt_pk_bf16(f, 0.f) & 0xffffu); }
__device__ __forceinline__ void unpack8(const u32x4 v, float* f) {
    f[0] = __uint_as_float(v.x << 16); f[1] = __uint_as_float(v.x & 0xffff0000u); f[2] = __uint_as_float(v.y << 16); f[3] = __uint_as_float(v.y & 0xffff0000u);
    f[4] = __uint_as_float(v.z << 16); f[5] = __uint_as_float(v.z & 0xffff0000u); f[6] = __uint_as_float(v.w << 16); f[7] = __uint_as_float(v.w & 0xffff0000u); }
__device__ __forceinline__ u32x4 pack8(const float* f) { u32x4 w; w.x = cvt_pk_bf16(f[0], f[1]); w.y = cvt_pk_bf16(f[2], f[3]); w.z = cvt_pk_bf16(f[4], f[5]); w.w = cvt_pk_bf16(f[6], f[7]); return w; }
__device__ __forceinline__ int ltid() { int t = threadIdx.x; asm volatile("" : "+v"(t)); return t; }
__device__ __forceinline__ int lbid() { int t = blockIdx.x; asm volatile("" : "+s"(t)); return t; }
__device__ __forceinline__ int lgrid() { int t = gridDim.x; asm volatile("" : "+s"(t)); return t; }
__device__ __forceinline__ float wave_sum(float v) { for (int o = 32; o >= 1; o >>= 1) v += __shfl_xor(v, o); return v; }
__device__ __forceinline__ float sigmoidf_(float x) { return __builtin_amdgcn_rcpf(1.0f + __expf(-x)); }
__device__ __forceinline__ float siluf_(float x) { return x * __builtin_amdgcn_rcpf(1.0f + __expf(-x)); }

namespace pg8 {
constexpr int BM = 256, BK = 64, HALF = 128, HTB = HALF * BK * 2, STAGE_BYTES = 8 * HTB, NXCD = 8, WGM = 8;
__device__ __forceinline__ int lds_byte(int r, int c) { const int st = (r >> 4) * 2 + (c >> 5), rr = r & 15, cc = c & 31, ob = rr * 64 + cc * 2; return st * 1024 + (ob ^ (((ob >> 9) & 1) << 5)); }
__device__ __forceinline__ void stage_rc(int b, int& R, int& C) { const int st = b / 1024, sb = b % 1024, swz = sb ^ (((sb >> 9) & 1) << 5); R = (st >> 1) * 16 + swz / 64; C = (st & 1) * 32 + (swz % 64) / 2; }
__device__ __forceinline__ int perm32(int rho) { const int n = rho >> 4, i = rho & 15; return 8 * (i >> 2) + 4 * n + (i & 3); }
struct Unit { int pm, pn, ks; };
struct Gemm { const bf16_t* A; const bf16_t* Bt; int M, N, K; int half_pm; int KL; };
struct StaticOrder {
    int nM, nN, nwg, G, c, ntail;
    __device__ void init(int M, int N, int G_, int c_, bool tail = true) { nM = M / BM - 1; nN = N / BM; nwg = nM * nN; G = G_; c = c_; ntail = tail ? nN : 0; }
    __device__ bool next(int i, Unit& u) const {
        u.ks = 0;
        const long L = (long)i * G + c; if (L >= nwg + ntail) return false;
        if (L >= nwg) { u.pm = nM; u.pn = (int)(L - nwg); return true; }
        int wgid = (int)L; { const int q = nwg / NXCD, r = nwg % NXCD, xcd = wgid % NXCD, off = wgid / NXCD; wgid = (xcd < r ? xcd * (q + 1) : r * (q + 1) + (xcd - r) * q) + off; }
        const int nig = WGM * nN, gid = wgid / nig, fm = gid * WGM, gsz = (nM - fm) < WGM ? (nM - fm) : WGM;
        u.pm = fm + ((wgid % nig) % gsz); u.pn = (wgid % nig) / gsz; return true;
    }
};
struct MergeOrder {
    int G, c;
    __device__ bool next(int i, Unit& u) const { const int L = (i / 3) * G + c; if (L >= 129 * 4) return false; const int j = i % 3; u.pm = j * 129 + (L >> 2); u.pn = j * 4 + (L & 3); u.ks = 0; return true; }
};

struct TailOrder { int nS, c;
    __device__ bool next(int i, Unit& u) const { if (i > 0 || c >= 4 * nS) return false; u.pm = c / nS; u.ks = c - u.pm * nS; u.pn = 0; return true; } };

template <class Epi, class Sched>
__device__ __forceinline__ void gemm_phase(LAS unsigned char* lds, const Gemm g, const Sched& S, const Epi& E) {
    const int tid = ltid(), wid = __builtin_amdgcn_readfirstlane(tid >> 6), lane = tid & 63, wr = wid >> 2, wc = wid & 3, fr = lane & 15, fq = lane >> 4;
    const int K = g.K, nt = g.KL / BK;
    unsigned voffA, voffB;
    { int R, C; stage_rc(tid * 16, R, C); const int Rb = Epi::PERM ? ((R & ~31) + perm32(R & 31)) : R;
        voffA = (unsigned)(R * K + C) * 2u; voffB = (unsigned)(Rb * K + C) * 2u; }
    const size_t r64 = (size_t)64 * K * 2;
    const size_t kstep = (size_t)(BK * 2);
    const size_t hstep = (size_t)HALF * K * 2;
    const size_t tstep = 2 * hstep;
    const unsigned ldsw = (unsigned)wid * 1024u;
    const int aoff = lds_byte(wr * 64 + fr, fq * 8), boff = lds_byte(wc * 32 + fr, fq * 8);
#define PG8_SA(b, h) (((b) * 2 + (h)) * HTB)
#define PG8_SB(b, h) ((4 + (b) * 2 + (h)) * HTB)
#define PG8_STAGE(bufoff, gbase, voff) do { _Pragma("unroll") for (int _i = 0; _i < 2; ++_i) \
        __builtin_amdgcn_global_load_lds((const unsigned*)((const char*)(gbase) + _i * r64 + (voff)), (LAS unsigned*)(lds + (bufoff) + ldsw + _i * 8192), 16, 0, 0); } while (0)
#define PG8_LDA(dst, b, h) do { _Pragma("unroll") for (int m = 0; m < 4; ++m) _Pragma("unroll") for (int k = 0; k < 2; ++k) dst[m][k] = *(const LAS bf16x8*)(lds + PG8_SA(b, h) + aoff + m * 2048 + k * 1024); } while (0)
#define PG8_LDB(dst, b, h) do { _Pragma("unroll") for (int n = 0; n < 2; ++n) _Pragma("unroll") for (int k = 0; k < 2; ++k) dst[n][k] = *(const LAS bf16x8*)(lds + PG8_SB(b, h) + boff + n * 2048 + k * 1024); } while (0)
#define PG8_MMA(ai, bj, At, Bt) do { __builtin_amdgcn_s_setprio(1); _Pragma("unroll") for (int m = 0; m < 4; ++m) _Pragma("unroll") for (int n = 0; n < 2; ++n) _Pragma("unroll") for (int k = 0; k < 2; ++k) \
        acc[ai][bj][m][n] = __builtin_amdgcn_mfma_f32_16x16x32_bf16(Bt[n][k], At[m][k], acc[ai][bj][m][n], 0, 0, 0); __builtin_amdgcn_s_setprio(0); } while (0)
#define PG8_WAIT_V(n) asm volatile("s_waitcnt vmcnt(" #n ")" ::: "memory")
#define PG8_WAIT_L(n) asm volatile("s_waitcnt lgkmcnt(" #n ")" ::: "memory")
#define PG8_BAR __builtin_amdgcn_s_barrier()
#define PG8_SCHED __builtin_amdgcn_sched_barrier(0)
    Unit cur, nxt; int ui = 0;
    if (!S.next(0, cur)) return;
    f32x4 acc[2][2][4][2];
#pragma unroll
    for (int a = 0; a < 2; ++a)
#pragma unroll
        for (int b = 0; b < 2; ++b)
#pragma unroll
            for (int m = 0; m < 4; ++m)
#pragma unroll
                for (int n = 0; n < 2; ++n) acc[a][b][m][n] = (f32x4){0.f, 0.f, 0.f, 0.f};
    bf16x8 At[4][2], B0[2][2], B1[2][2];
    const char* cA = (const char*)g.A + (size_t)cur.pm * tstep + (size_t)cur.ks * g.KL * 2; const char* cB = (const char*)g.Bt + (size_t)cur.pn * tstep + (size_t)cur.ks * g.KL * 2;
    PG8_STAGE(PG8_SB(0, 0), cB, voffB); PG8_STAGE(PG8_SB(0, 1), cB + hstep, voffB); PG8_STAGE(PG8_SA(0, 0), cA, voffA); PG8_STAGE(PG8_SA(0, 1), cA + hstep, voffA);
    if (wr == 1) PG8_BAR;
    PG8_WAIT_V(2); PG8_BAR;
    PG8_STAGE(PG8_SB(1, 0), cB + kstep, voffB); PG8_STAGE(PG8_SA(1, 0), cA + kstep, voffA); PG8_STAGE(PG8_SB(1, 1), cB + hstep + kstep, voffB);
    PG8_WAIT_V(6); PG8_BAR;
    for (;;) {
        const bool has_next = S.next(ui + 1, nxt);
        const char* nA = has_next ? (const char*)g.A + (size_t)nxt.pm * tstep + (size_t)nxt.ks * g.KL * 2 : cA; const char* nB = has_next ? (const char*)g.Bt + (size_t)nxt.pn * tstep + (size_t)nxt.ks * g.KL * 2 : cB;
        for (int t = 0; t < nt; t += 2) {
            const bool last = (t == nt - 2);
            const char* a1 = cA + (size_t)(t + 1) * kstep;
            const char* a2 = last ? nA : cA + (size_t)(t + 2) * kstep; const char* b2 = last ? nB : cB + (size_t)(t + 2) * kstep;
            const char* a3 = a2 + kstep; const char* b3 = b2 + kstep;
            PG8_LDB(B0, 0, 0); PG8_LDB(B1, 0, 1); PG8_SCHED; PG8_LDA(At, 0, 0); PG8_STAGE(PG8_SA(1, 1), a1 + hstep, voffA);
            PG8_WAIT_V(8); PG8_WAIT_L(0); PG8_BAR; PG8_MMA(0, 0, At, B0); PG8_MMA(0, 1, At, B1); PG8_BAR; PG8_SCHED;
            PG8_LDA(At, 0, 1); PG8_STAGE(PG8_SB(0, 0), b2, voffB); PG8_STAGE(PG8_SB(0, 1), b2 + hstep, voffB); PG8_STAGE(PG8_SA(0, 0), a2, voffA);
            PG8_WAIT_V(8); PG8_WAIT_L(0); PG8_BAR; PG8_MMA(1, 0, At, B0); PG8_MMA(1, 1, At, B1); PG8_BAR; PG8_SCHED;
            PG8_LDB(B0, 1, 0); PG8_LDB(B1, 1, 1); PG8_SCHED; PG8_LDA(At, 1, 0); PG8_STAGE(PG8_SA(0, 1), a2 + hstep, voffA);
            PG8_WAIT_V(8); PG8_WAIT_L(0); PG8_BAR; PG8_MMA(0, 0, At, B0); PG8_MMA(0, 1, At, B1); PG8_BAR; PG8_SCHED;
            PG8_LDA(At, 1, 1); PG8_STAGE(PG8_SB(1, 0), b3, voffB); PG8_STAGE(PG8_SB(1, 1), b3 + hstep, voffB); PG8_STAGE(PG8_SA(1, 0), a3, voffA);
            PG8_WAIT_V(8); PG8_WAIT_L(0); PG8_BAR; PG8_MMA(1, 0, At, B0); PG8_MMA(1, 1, At, B1); PG8_BAR; PG8_SCHED;
        }
        if (wr == 0) PG8_BAR;
        E(acc, cur, wr, wc, fr, fq);
        if (!has_next) break;
#pragma unroll
        for (int a = 0; a < 2; ++a)
#pragma unroll
            for (int b = 0; b < 2; ++b)
#pragma unroll
                for (int m = 0; m < 4; ++m)
#pragma unroll
                    for (int n = 0; n < 2; ++n) acc[a][b][m][n] = (f32x4){0.f, 0.f, 0.f, 0.f};
        cur = nxt; cA = nA; cB = nB; ++ui;
        if (wr == 1) PG8_BAR;
    }
    PG8_WAIT_V(0);
    PG8_BAR;
#undef PG8_SA
#undef PG8_SB
#undef PG8_STAGE
#undef PG8_LDA
#undef PG8_LDB
#undef PG8_MMA
#undef PG8_WAIT_V
#undef PG8_WAIT_L
#undef PG8_BAR
#undef PG8_SCHED
}

template <int ACT> struct EpiBf16 {
    static constexpr bool PERM = true;
    bf16_t* O; int ldc;
    __device__ __forceinline__ void operator()(const f32x4 (&acc)[2][2][4][2], const Unit& u, int wr, int wc, int fr, int fq) const {
        const int row0 = u.pm * BM + wr * 64 + fr, col0 = u.pn * BM + wc * 32 + 8 * fq;
#pragma unroll
        for (int ai = 0; ai < 2; ++ai)
#pragma unroll
            for (int m = 0; m < 4; ++m) { bf16_t* rowp = O + (size_t)(row0 + ai * HALF + m * 16) * ldc + col0;
#pragma unroll
                for (int bj = 0; bj < 2; ++bj) { f32x4 v0 = acc[ai][bj][m][0], v1 = acc[ai][bj][m][1];
                    if (ACT == 1) {
#pragma unroll
                        for (int j = 0; j < 4; ++j) { v0[j] = sigmoidf_(v0[j]); v1[j] = sigmoidf_(v1[j]); } }
                    u32x4 w; w.x = cvt_pk_bf16(v0[0], v0[1]); w.y = cvt_pk_bf16(v0[2], v0[3]); w.z = cvt_pk_bf16(v1[0], v1[1]); w.w = cvt_pk_bf16(v1[2], v1[3]);
                    *(u32x4*)(rowp + bj * HALF) = w; } }
    }
};
struct EpiSlab {
    static constexpr bool PERM = true;
    float* slab; int nS;
    __device__ __forceinline__ void operator()(const f32x4 (&acc)[2][2][4][2], const Unit& u, int wr, int wc, int fr, int fq) const {
        float* sp = slab + ((size_t)u.ks * 128 + wc * 32 + 8 * fq) * 1024 + u.pm * 256 + wr * 64 + fr;
#pragma unroll
        for (int ai = 0; ai < 2; ++ai)
#pragma unroll
            for (int m = 0; m < 4; ++m) { float* rp = sp + ai * HALF + m * 16;
#pragma unroll
                for (int n = 0; n < 2; ++n)
#pragma unroll
                    for (int j = 0; j < 4; ++j) rp[(size_t)(4 * n + j) * 1024] = acc[ai][0][m][n][j]; }
    }
};
struct EpiSwiglu {
    static constexpr bool PERM = true;
    bf16_t* O;
    __device__ __forceinline__ void operator()(const f32x4 (&acc)[2][2][4][2], const Unit& u, int wr, int wc, int fr, int fq) const {
        const int row0 = u.pm * BM + wr * 64 + fr, col0 = u.pn * 128 + wc * 32 + 8 * fq;
#pragma unroll
        for (int ai = 0; ai < 2; ++ai)
#pragma unroll
            for (int m = 0; m < 4; ++m) { bf16_t* rowp = O + (size_t)(row0 + ai * HALF + m * 16) * DFF + col0;
                const f32x4 a0 = acc[ai][0][m][0], a1 = acc[ai][0][m][1], b0 = acc[ai][1][m][0], b1 = acc[ai][1][m][1];
                float v[8];
#pragma unroll
                for (int j = 0; j < 4; ++j) { v[j] = siluf_(a0[j]) * b0[j]; v[4 + j] = siluf_(a1[j]) * b1[j]; }
                *(u32x4*)rowp = pack8(v); }
    }
};
struct EpiInProj {
    static constexpr bool PERM = true;
    unsigned char* ws;
    __device__ __forceinline__ void operator()(const f32x4 (&acc)[2][2][4][2], const Unit& u, int wr, int wc, int fr, int fq) const {
        const int row0 = u.pm * BM + wr * 64 + fr, pn = u.pn;
        if (pn == 18) {
            if (wc == 0 && fq < 2) { float* Lg = (float*)(ws + S_LOGIT);
#pragma unroll
                for (int ai = 0; ai < 2; ++ai)
#pragma unroll
                    for (int m = 0; m < 4; ++m) { float* rp = Lg + (size_t)(row0 + ai * HALF + m * 16) * 16 + 8 * fq; *(f32x4*)rp = acc[ai][0][m][0]; *(f32x4*)(rp + 4) = acc[ai][0][m][1]; } }
            return; }
        bf16_t* base; int ld, cb;
        if (pn < 4) { base = (bf16_t*)(ws + O_PQ); ld = 1024; cb = pn * 256; }
        else if (pn < 10) { base = (bf16_t*)(ws + O_SC); ld = 1536; cb = (pn - 4) * 256; }
        else if (pn < 16) { base = (bf16_t*)(ws + O_QKV); ld = 1536; cb = (pn - 10) * 256; }
        else { base = (bf16_t*)(ws + O_Z); ld = 512; cb = (pn - 16) * 256; }
        const int col0 = cb + wc * 32 + 8 * fq;
#pragma unroll
        for (int ai = 0; ai < 2; ++ai)
#pragma unroll
            for (int m = 0; m < 4; ++m) { bf16_t* rowp = base + (size_t)(row0 + ai * HALF + m * 16) * ld + col0;
#pragma unroll
                for (int bj = 0; bj < 2; ++bj) { const f32x4 v0 = acc[ai][bj][m][0], v1 = acc[ai][bj][m][1];
                    u32x4 w; w.x = cvt_pk_bf16(v0[0], v0[1]); w.y = cvt_pk_bf16(v0[2], v0[3]); w.z = cvt_pk_bf16(v1[0], v1[1]); w.w = cvt_pk_bf16(v1[2], v1[3]);
                    *(u32x4*)(rowp + bj * HALF) = w; } }
    }
};
struct EpiFourier {
    static constexpr bool PERM = true;
    bf16_t* FM; float sc;
    __device__ __forceinline__ void operator()(const f32x4 (&acc)[2][2][4][2], const Unit& u, int wr, int wc, int fr, int fq) const {
        const int row0 = u.pm * BM + wr * 64 + fr;
        const int colt = u.pn * BM;
        const int b = colt >> 13, k1 = (colt >> 9) & 15, ch0 = (colt & 511) + wc * 32 + 8 * fq;
#pragma unroll
        for (int ai = 0; ai < 2; ++ai)
#pragma unroll
            for (int m = 0; m < 4; ++m) { const int k2 = row0 + ai * HALF + m * 16;
                if (k2 < 257) { bf16_t* rowp = FM + (size_t)(b * LL + k1 + 16 * k2) * 512 + ch0;
#pragma unroll
                    for (int bj = 0; bj < 2; ++bj) { const f32x4 v0 = acc[ai][bj][m][0] * sc, v1 = acc[ai][bj][m][1] * sc;
                        u32x4 w; w.x = cvt_pk_bf16(v0[0], v0[1]); w.y = cvt_pk_bf16(v0[2], v0[3]); w.z = cvt_pk_bf16(v1[0], v1[1]); w.w = cvt_pk_bf16(v1[2], v1[3]);
                        *(u32x4*)(rowp + bj * HALF) = w; } } }
    }
};
struct EpiMerge {
    static constexpr bool PERM = true;
    const bf16_t* GATE; bf16_t* MG; bf16_t* MGB;
    __device__ __forceinline__ void operator()(const f32x4 (&acc)[2][2][4][2], const Unit& u, int wr, int wc, int fr, int fq) const {
        const int j = u.pm / 129, pm = u.pm - j * 129, pn = u.pn & 3;
        const int row0 = pm * BM + wr * 64 + fr, col0 = pn * BM + wc * 32 + 8 * fq;
        const bf16_t* mold = (j == 1 ? MG : MGB); bf16_t* mnew = (j == 1 ? MGB : MG);
#pragma unroll
        for (int ai = 0; ai < 2; ++ai) {
            u32x4 gv[4][2], ov[4][2];
#pragma unroll
            for (int m = 0; m < 4; ++m)
#pragma unroll
                for (int bj = 0; bj < 2; ++bj) { const size_t r = (size_t)(row0 + ai * HALF + m * 16);
                    gv[m][bj] = *(const u32x4*)(GATE + r * 3072 + j * 1024 + col0 + bj * HALF);
                    if (j > 0) ov[m][bj] = *(const u32x4*)(mold + r * 1024 + col0 + bj * HALF); }
#pragma unroll
            for (int m = 0; m < 4; ++m)
#pragma unroll
                for (int bj = 0; bj < 2; ++bj) { const size_t r = (size_t)(row0 + ai * HALF + m * 16);
                    float g[8], v[8]; unpack8(gv[m][bj], g);
                    const f32x4 v0 = acc[ai][bj][m][0], v1 = acc[ai][bj][m][1];
#pragma unroll
                    for (int e = 0; e < 4; ++e) { v[e] = v0[e] * g[e]; v[4 + e] = v1[e] * g[4 + e]; }
                    if (j > 0) { float o[8]; unpack8(ov[m][bj], o);
#pragma unroll
                        for (int e = 0; e < 8; ++e) v[e] += o[e]; }
                    *(u32x4*)(mnew + r * 1024 + col0 + bj * HALF) = pack8(v); }
            asm volatile("" ::: "memory"); }
    }
};
}

__device__ void rpass(const Params& P, const bf16_t* Y, bool first_h, const float* gpost, float scale, const float* gpre, bf16_t* XN, const float* slab = nullptr, int nS = 0) {
    const int tid_ = ltid(); const int wave = __builtin_amdgcn_readfirstlane(tid_ >> 6), lane = tid_ & 63;
    float* hm = (float*)(P.ws + S_HM);
    for (int r = lbid() * 8 + wave; r < TT; r += lgrid() * 8) {
        const int b = r / LL, n = r - b * LL;
        const float* hin; float* hout;
        if (n < NMETA) { hout = hm + (size_t)(b * 16 + n) * 1024; hin = first_h ? P.in[1] + (size_t)n * 1024 : hout; }
        else { const size_t o = ((size_t)b * SEQ + (n - NMETA)) * 1024; hout = P.out + o; hin = first_h ? P.in[0] + o : hout; }
        float h[16];
        { const f32x4 a = *(const f32x4*)(hin + lane * 8), b4 = *(const f32x4*)(hin + lane * 8 + 4), c = *(const f32x4*)(hin + 512 + lane * 8), d = *(const f32x4*)(hin + 512 + lane * 8 + 4);
#pragma unroll
          for (int e = 0; e < 4; ++e) { h[e] = a[e]; h[4 + e] = b4[e]; h[8 + e] = c[e]; h[12 + e] = d[e]; } }
        if (Y) {
            float y[16];
            if (slab != nullptr && r >= 32768) {
                const float* sp = slab + (size_t)(r - 32768) * 1024 + lane * 8;
                f32x4 s0 = {0.f, 0.f, 0.f, 0.f}, s1 = s0, s2 = s0, s3 = s0;
#pragma unroll 1
                for (int ks = 0; ks < nS; ++ks) { s0 += *(const f32x4*)sp; s1 += *(const f32x4*)(sp + 4); s2 += *(const f32x4*)(sp + 512); s3 += *(const f32x4*)(sp + 516); sp += 131072; }
#pragma unroll
                for (int e = 0; e < 4; ++e) { y[e] = s0[e]; y[4 + e] = s1[e]; y[8 + e] = s2[e]; y[12 + e] = s3[e]; }
            } else { unpack8(*(const u32x4*)(Y + (size_t)r * 1024 + lane * 8), y); unpack8(*(const u32x4*)(Y + (size_t)r * 1024 + 512 + lane * 8), y + 8); }
            float ss = 0.f;
#pragma unroll
            for (int e = 0; e < 16; ++e) ss += y[e] * y[e];
            ss = wave_sum(ss); const float r1 = rsqrtf(ss * (1.0f / 1024.0f) + EPS) * scale;
#pragma unroll
            for (int e = 0; e < 8; ++e) { h[e] += y[e] * r1 * gpost[lane * 8 + e]; h[8 + e] += y[8 + e] * r1 * gpost[512 + lane * 8 + e]; }
            *(f32x4*)(hout + lane * 8) = (f32x4){h[0], h[1], h[2], h[3]}; *(f32x4*)(hout + lane * 8 + 4) = (f32x4){h[4], h[5], h[6], h[7]};
            *(f32x4*)(hout + 512 + lane * 8) = (f32x4){h[8], h[9], h[10], h[11]}; *(f32x4*)(hout + 512 + lane * 8 + 4) = (f32x4){h[12], h[13], h[14], h[15]};
        }
        if (gpre) {
            float ss = 0.f;
#pragma unroll
            for (int e = 0; e < 16; ++e) ss += h[e] * h[e];
            ss = wave_sum(ss); const float r2 = rsqrtf(ss * (1.0f / 1024.0f) + EPS);
            float o[16];
#pragma unroll
            for (int e = 0; e < 8; ++e) { o[e] = h[e] * r2 * gpre[lane * 8 + e]; o[8 + e] = h[8 + e] * r2 * gpre[512 + lane * 8 + e]; }
            *(u32x4*)(XN + (size_t)r * 1024 + lane * 8) = pack8(o); *(u32x4*)(XN + (size_t)r * 1024 + 512 + lane * 8) = pack8(o + 8);
        }
    }
}

template <class F>
__device__ void cvt_tiles(const float* src, int ld_src, int K, bf16_t* dst, int nrows, F srccol, unsigned char* smem) {
    float* lds = (float*)smem; const int tid = ltid();
    const int ntr = nrows / 64, ntk = K / 64, nt_ = ntr * ntk, G_ = lgrid();
    float pv[8];
    { const int t = lbid(); if (t < nt_) { const int tr = t % ntr, tk = t / ntr; const int c0 = srccol(tr * 64);
#pragma unroll
        for (int i = 0; i < 8; ++i) { const int kk = (tid >> 6) + 8 * i, cc = tid & 63; pv[i] = src[(size_t)(tk * 64 + kk) * ld_src + c0 + cc]; } } }
    for (int t = lbid(); t < nt_; t += G_) {
        const int tr = t % ntr, tk = t / ntr;
        __syncthreads();
#pragma unroll
        for (int i = 0; i < 8; ++i) { const int kk = (tid >> 6) + 8 * i, cc = tid & 63; lds[kk * 65 + cc] = pv[i]; }
        __syncthreads();
        { const int t2 = t + G_; if (t2 < nt_) { const int tr2 = t2 % ntr, tk2 = t2 / ntr; const int c2 = srccol(tr2 * 64);
#pragma unroll
            for (int i = 0; i < 8; ++i) { const int kk = (tid >> 6) + 8 * i, cc = tid & 63; pv[i] = src[(size_t)(tk2 * 64 + kk) * ld_src + c2 + cc]; } } }
        const int cc2 = tid >> 3, k8 = (tid & 7) * 8; float v[8];
#pragma unroll
        for (int e = 0; e < 8; ++e) v[e] = lds[(k8 + e) * 65 + cc2];
        *(u32x4*)(dst + (size_t)(tr * 64 + cc2) * K + tk * 64 + k8) = pack8(v);
    }
}
struct ColIdent { int off; __device__ int operator()(int r) const { return r + off; } };
struct ColSwiglu { __device__ int operator()(int r) const { const int pn = r >> 8, rem = r & 255; return (rem >> 7) * DFF + 128 * pn + (rem & 127); } };

__device__ void convert_weights(const Params& P, int l, unsigned char* smem) {
    unsigned char* ws = P.ws; const int tid = ltid();
    cvt_tiles(P.in[3] + (size_t)l * 1024 * 5632, 5632, 1024, (bf16_t*)(ws + W_WI1), 5632, ColSwiglu{}, smem);
    cvt_tiles(P.in[4] + (size_t)l * 2816 * 1024, 1024, 2816, (bf16_t*)(ws + W_WO1), 1024, ColIdent{0}, smem);
    cvt_tiles(P.in[5] + (size_t)l * 1024 * 5632, 5632, 1024, (bf16_t*)(ws + W_WI2), 5632, ColSwiglu{}, smem);
    cvt_tiles(P.in[6] + (size_t)l * 2816 * 1024, 1024, 2816, (bf16_t*)(ws + W_WO2), 1024, ColIdent{0}, smem);
    const float* win = P.in[7] + (size_t)l * 1024 * NIN;
    cvt_tiles(win, NIN, 1024, (bf16_t*)(ws + W_WIN) + (size_t)1024 * 1024, 3584, ColIdent{512}, smem);
    cvt_tiles(win, NIN, 1024, (bf16_t*)(ws + W_WG), 3072, ColIdent{4112}, smem);
    cvt_tiles(P.in[13] + (size_t)l * 512 * 1024, 1024, 512, (bf16_t*)(ws + W_WBR), 1024, ColIdent{0}, smem);
    cvt_tiles(P.in[14] + (size_t)l * 512 * 1024, 1024, 512, (bf16_t*)(ws + W_WBR) + (size_t)1024 * 512, 1024, ColIdent{0}, smem);
    cvt_tiles(P.in[15] + (size_t)l * 512 * 1024, 1024, 512, (bf16_t*)(ws + W_WBR) + (size_t)2048 * 512, 1024, ColIdent{0}, smem);
    cvt_tiles(P.in[16] + (size_t)l * 1024 * 1024, 1024, 1024, (bf16_t*)(ws + W_WOUT), 1024, ColIdent{0}, smem);
    { bf16_t* d = (bf16_t*)(ws + W_WIN) + (size_t)4608 * 1024;
      for (int i = lbid() * 512 + tid; i < 256 * 1024; i += lgrid() * 512) { const int rr = i >> 10, k = i & 1023; d[i] = rr < 16 ? f2bf(win[(size_t)k * NIN + 4096 + rr]) : (bf16_t)0; } }
    { float* Ws = (float*)smem; float* ct = Ws + 64 * 65; float* st = ct + 64;
      __syncthreads();
      if (tid < 64) { float s, c; sincospif((float)tid * (2.0f / 64.0f), &s, &c); ct[tid] = c; st[tid] = s; }
      bf16_t* dp = (bf16_t*)(ws + W_WIN); bf16_t* dq = dp + (size_t)512 * 1024;
      for (int it = lbid(); it < 8 * 16; it += lgrid()) { const int g = it >> 4, kt = it & 15;
          __syncthreads();
#pragma unroll
          for (int i = 0; i < 8; ++i) { const int kk = (tid >> 6) + 8 * i, cc = tid & 63; Ws[kk * 65 + cc] = win[(size_t)(kt * 64 + kk) * NIN + g * 64 + cc]; }
          __syncthreads();
          const int kk = tid & 63;
#pragma unroll 1
          for (int i = 0; i < 8; ++i) { const int cp = (tid >> 6) + 8 * i; float ap = 0.f, aq = 0.f;
#pragma unroll 4
              for (int c = 0; c < 64; ++c) { const float w = Ws[kk * 65 + c]; const int ph = (c * cp) & 63; ap += w * ct[ph]; aq += w * st[ph]; }
              dp[(size_t)(g * 64 + cp) * 1024 + kt * 64 + kk] = f2bf(ap); dq[(size_t)(g * 64 + cp) * 1024 + kt * 64 + kk] = f2bf(aq); }
      }
      __syncthreads(); }
}

__device__ void gen_tables(const Params& P) {
    unsigned char* ws = P.ws; const int gt = lbid() * 512 + ltid(), gs = lgrid() * 512;
    bf16_t* C = (bf16_t*)(ws + S_C257);
    for (int i = gt; i < 512 * KF; i += gs) { const int k2 = i / KF, kk = i - k2 * KF; const int ri = kk >= 320, n2 = kk - ri * 320; float v = 0.f;
        if (k2 < 257 && n2 < 257) { const int m = (k2 * n2) % 257; float s, c; sincospif((float)m * (2.0f / 257.0f), &s, &c); v = ri ? s : c; }
        C[i] = f2bf(v); }
    float* tw = (float*)(ws + S_TWL);
    for (int i = gt; i < LL; i += gs) { float s, c; sincospif((float)i * (2.0f / (float)LL), &s, &c); tw[2 * i] = c; tw[2 * i + 1] = -s; }
}

__device__ void sconv_pass(const Params& P, int l) {
    const int tid_ = ltid(); const int wave = __builtin_amdgcn_readfirstlane(tid_ >> 6), lane = tid_ & 63;
    const bf16_t* SC = (const bf16_t*)(P.ws + O_SC); bf16_t* SCO = (bf16_t*)(P.ws + O_BR) + (size_t)TP * 512;
    const float* w = P.in[8] + (size_t)l * 3 * 512;
    float w0[8], w1[8], w2[8];
#pragma unroll
    for (int e = 0; e < 8; ++e) { w0[e] = w[lane * 8 + e]; w1[e] = w[512 + lane * 8 + e]; w2[e] = w[1024 + lane * 8 + e]; }
    for (int r = lbid() * 8 + wave; r < TT; r += lgrid() * 8) {
        const int b = r / LL, n = r - b * LL; const bf16_t* rp = SC + (size_t)r * 1536 + lane * 8;
        float bb[8], c[8], h[8], acc[8]; unpack8(*(const u32x4*)rp, bb); unpack8(*(const u32x4*)(rp + 512), c); unpack8(*(const u32x4*)(rp + 1024), h);
#pragma unroll
        for (int e = 0; e < 8; ++e) acc[e] = w1[e] * c[e] * h[e];
        if (n > 0) { unpack8(*(const u32x4*)(rp - 1536 + 512), c); unpack8(*(const u32x4*)(rp - 1536 + 1024), h);
#pragma unroll
            for (int e = 0; e < 8; ++e) acc[e] += w0[e] * c[e] * h[e]; }
        if (n < LL - 1) { unpack8(*(const u32x4*)(rp + 1536 + 512), c); unpack8(*(const u32x4*)(rp + 1536 + 1024), h);
#pragma unroll
            for (int e = 0; e < 8; ++e) acc[e] += w2[e] * c[e] * h[e]; }
#pragma unroll
        for (int e = 0; e < 8; ++e) acc[e] *= bb[e];
        *(u32x4*)(SCO + (size_t)r * 512 + lane * 8) = pack8(acc);
    }
}

__device__ void fstep1(const Params& P, unsigned char* smem) {
    const int tid = ltid(), wave = __builtin_amdgcn_readfirstlane(tid >> 6), lane = tid & 63;
    const bf16_t* PQ = (const bf16_t*)(P.ws + O_PQ); bf16_t* AP = (bf16_t*)(P.ws + O_AP); const float* tw = (const float*)(P.ws + S_TWL);
    bf16_t* St = (bf16_t*)smem;
    for (int it = lbid(); it < 8 * 4 * 17; it += lgrid()) {
        const int b = it / 68, rem = it - b * 68, cht = rem / 17, n2t = rem - cht * 17;
        __syncthreads();
#pragma unroll 1
        for (int sub = 0; sub < 2; ++sub) {
            const int n2l = sub * 8 + wave, n2 = n2t * 16 + n2l;
            const int fr = lane & 15, fq = lane >> 4;
            if (n2 < 257) {
                float f0[8], f1[8];
#pragma unroll
                for (int j = 0; j < 8; ++j) { const int n = 257 * (8 * (fq & 1) + j) + n2; const int ph = (fr * n) % LL;
                    const float c_ = __hip_atomic_load(tw + 2 * ph, __ATOMIC_RELAXED, __HIP_MEMORY_SCOPE_AGENT), ms_ = __hip_atomic_load(tw + 2 * ph + 1, __ATOMIC_RELAXED, __HIP_MEMORY_SCOPE_AGENT);
                    f0[j] = (fq < 2) ? c_ : ms_; f1[j] = (fq < 2) ? ms_ : -c_; }
                const bf16x8 a0 = __builtin_bit_cast(bf16x8, pack8(f0)), a1 = __builtin_bit_cast(bf16x8, pack8(f1));
                const bf16_t* bp = PQ + (size_t)(b * LL + 257 * 8 * (fq & 1) + n2) * 1024 + (fq >> 1) * 512 + cht * 128 + fr;
#pragma unroll
                for (int ct = 0; ct < 8; ++ct) {
                    bf16x8 bf;
#pragma unroll
                    for (int j = 0; j < 8; ++j) bf[j] = (short)bp[(size_t)j * 257 * 1024 + ct * 16];
                    const f32x4 z = {0.f, 0.f, 0.f, 0.f};
                    const f32x4 c0 = __builtin_amdgcn_mfma_f32_16x16x32_bf16(a0, bf, z, 0, 0, 0), c1 = __builtin_amdgcn_mfma_f32_16x16x32_bf16(a1, bf, z, 0, 0, 0);
                    bf16_t* sp = St + ((4 * fq) * 128 + ct * 16 + fr) * 32 + n2l;
#pragma unroll
                    for (int rg = 0; rg < 4; ++rg) { sp[rg * 4096] = f2bf(c0[rg]); sp[rg * 4096 + 16] = f2bf(c1[rg]); }
                }
            } else {
                for (int q = lane; q < 4096; q += 64) St[q * 16 + n2l] = 0;
            }
        }
        __syncthreads();
#pragma unroll 2
        for (int q = tid; q < 8192; q += 512) { const int half = q & 1, ri = (q >> 1) & 1, chl = (q >> 2) & 127, k1 = q >> 9;
            const int n2c = n2t * 16 + half * 8;
            if (n2c < 320) { const u32x4 v = *(const u32x4*)(St + (size_t)q * 8);
                *(u32x4*)(AP + ((size_t)((b * 16 + k1) * 512 + cht * 128 + chl)) * KF + ri * 320 + n2c) = v; } }
        if (n2t == 16) {
            for (int q = tid; q < 16 * 128 * 2 * 6; q += 512) { const int c6 = q % 6, r2 = q / 6, ri = r2 & 1, chl = (r2 >> 1) & 127, k1 = r2 >> 8;
                *(u32x4*)(AP + ((size_t)((b * 16 + k1) * 512 + cht * 128 + chl)) * KF + ri * 320 + 272 + c6 * 8) = (u32x4){0u, 0u, 0u, 0u}; } }
    }
    __syncthreads();
}

#ifdef DBG_SEC
#define SEC_T(k) do { if (lbid() == 0 && tid == 0) { const unsigned long long _n = __builtin_amdgcn_s_memrealtime(); if (sec_prev_k == DBG_SEC) *(unsigned long long*)(smem + LDS_BYTES - 32) += _n - sec_prev_t; sec_prev_t = _n; sec_prev_k = (k); } } while (0)
#else
#define SEC_T(k) do {} while (0)
#endif
__device__ void dn_prep(const Params& P, int l, unsigned char* smem, int t0, int t1) {
#ifdef DBG_SEC
    unsigned long long sec_prev_t = __builtin_amdgcn_s_memrealtime(); int sec_prev_k = -1;
#endif
    const int tid = ltid(), wave = __builtin_amdgcn_readfirstlane(tid >> 6), lane = tid & 63, fr = lane & 15, fq = lane >> 4;
    unsigned char* ws = P.ws;
    const bf16_t* QKV = (const bf16_t*)(ws + O_QKV); const float* LG = (const float*)(ws + S_LOGIT);
    bf16_t* WP = (bf16_t*)(ws + O_WP); bf16_t* QP = (bf16_t*)(ws + O_QP); bf16_t* KD = (bf16_t*)(ws + O_KD); bf16_t* UF = (bf16_t*)(ws + O_UF); bf16_t* AT = (bf16_t*)(ws + O_AT);
    float* GL = (float*)(ws + S_GL);
    const float* cw = P.in[9] + (size_t)l * 3 * 1536;
    bf16_t* Qs = (bf16_t*)smem;
    bf16_t* Ks = Qs + 64 * 136;
    bf16_t* KT = Ks + 64 * 136;
    bf16_t* VT = KT + 128 * 72;
    bf16_t* T1 = VT + 128 * 72;
    bf16_t* T2 = T1 + 64 * 72;
    bf16_t* Rm = T2 + 64 * 72;
    bf16_t* Rt = Rm + 64 * 72;
    bf16_t* Pm = Rt + 64 * 72;
    float* gcs = (float*)(T2 + 64 * 72 + 2 * 64 * 68 * 2);
    float* bts = gcs + 64;
    float* cwl = bts + 64;
    bf16_t* Xr = T1;
    const int items = (t1 - t0) * 64;
    u32x4 x0[6], xb;
#define PREP_ISSUE(it_) do { const int _tl = (it_) >> 6, _bhd = (it_) & 63, _b = _bhd >> 3, _h = (_bhd >> 1) & 3, _dir = _bhd & 1; const int _nb = (_dir ? 64 - (t0 + _tl) : (t0 + _tl)) * 64 - 48; const u32x4 z4 = {0u, 0u, 0u, 0u}; \
        _Pragma("unroll") for (int rr = 0; rr < 6; ++rr) { const int task = tid + 512 * rr, i = task / 48, cg_ = task - i * 48; const int n = _nb + (_dir ? 63 - i : i); \
            x0[rr] = (n >= 0) ? *(const u32x4*)(QKV + (size_t)(_b * LL + n) * 1536 + (cg_ >> 4) * 512 + _h * 128 + (cg_ & 15) * 8) : z4; } \
        xb = z4; if (tid < 96) { const int which = tid / 48, cg_ = tid - which * 48; const int n = which ? _nb + 64 : _nb - 1; \
            if (n >= 0 && n < LL) xb = *(const u32x4*)(QKV + (size_t)(_b * LL + n) * 1536 + (cg_ >> 4) * 512 + _h * 128 + (cg_ & 15) * 8); } } while (0)
    for (int it = lbid(); it < items; it += lgrid()) {
        const int tl = it >> 6, bhd = it & 63, b = bhd >> 3, h = (bhd >> 1) & 3, dir = bhd & 1;
        const int t = t0 + tl, c = dir ? 64 - t : t; const size_t slot = (size_t)tl * 64 + bhd;
        PREP_ISSUE(it);
        __syncthreads();
        SEC_T(0);
        for (int q = tid; q < 1152; q += 512) { const int tap = q / 384, rem = q - tap * 384; cwl[q] = cw[tap * 1536 + (rem >> 7) * 512 + h * 128 + (rem & 127)]; }
#pragma unroll
        for (int rr = 0; rr < 6; ++rr) { const int task = tid + 512 * rr, i = task / 48, cg_ = task - i * 48; *(u32x4*)(Xr + ((dir ? 63 - i : i) + 1) * 384 + cg_ * 8) = x0[rr]; }
        if (tid < 96) { const int which = tid / 48, cg_ = tid - which * 48; *(u32x4*)(Xr + (which ? 65 : 0) * 384 + cg_ * 8) = xb; }
        __syncthreads();
#pragma unroll 1
        for (int rr = 0; rr < 6; ++rr) {
            const int task = tid + 512 * rr, i = task / 48, cg_ = task - i * 48, kind = cg_ >> 4, cgl = cg_ & 15;
            float v[8], x[8];
            const float* w1 = cwl + 384 + kind * 128 + cgl * 8;
            const bf16_t* xr = Xr + ((dir ? 63 - i : i) + 1) * 384 + cg_ * 8;
            unpack8(*(const u32x4*)xr, x);
#pragma unroll
            for (int e = 0; e < 8; ++e) v[e] = w1[e] * x[e];
            unpack8(*(const u32x4*)(xr - 384), x);
#pragma unroll
            for (int e = 0; e < 8; ++e) v[e] += w1[e - 384] * x[e];
            unpack8(*(const u32x4*)(xr + 384), x);
#pragma unroll
            for (int e = 0; e < 8; ++e) v[e] += w1[e + 384] * x[e];
#pragma unroll
            for (int e = 0; e < 8; ++e) v[e] = siluf_(v[e]);
            float ss = 0.f;
#pragma unroll
            for (int e = 0; e < 8; ++e) ss += v[e] * v[e];
            ss += __shfl_xor(ss, 1); ss += __shfl_xor(ss, 2); ss += __shfl_xor(ss, 4); ss += __shfl_xor(ss, 8);
            if (kind < 2) { const float inv = rsqrtf(ss + EPS) * (kind == 0 ? 0.08838834764831845f : 1.0f);
#pragma unroll
                for (int e = 0; e < 8; ++e) v[e] *= inv; }
            const u32x4 pk = pack8(v);
            const int isw = i ^ ((cgl & 7) << 3);
            if (kind == 0) *(u32x4*)(Qs + i * 136 + cgl * 8) = pk;
            else if (kind == 1) { *(u32x4*)(Ks + i * 136 + cgl * 8) = pk;
#pragma unroll
                for (int e = 0; e < 8; ++e) KT[(cgl * 8 + e) * 72 + isw] = f2bf(v[e]); }
            else {
#pragma unroll
                for (int e = 0; e < 8; ++e) VT[(cgl * 8 + e) * 72 + isw] = f2bf(v[e]); }
        }
        if (wave == 0) {
            const int i = lane, n = c * 64 + (dir ? 63 - i : i) - 48; float beta = 0.f, g = 0.f;
            if (n >= 0) { const float* lg = LG + (size_t)(b * LL + n) * 16; const float bl = lg[dir * 4 + h], al = lg[8 + dir * 4 + h];
                beta = 1.0f / (1.0f + expf(-bl));
                const float xx = al + P.in[11][l * 8 + dir * 4 + h]; const float sp = xx > 20.f ? xx : log1pf(expf(xx));
                g = -expf(P.in[10][l * 8 + dir * 4 + h]) * sp; }
#pragma unroll
            for (int o = 1; o < 64; o <<= 1) { const float tt = __shfl_up(g, o); if (lane >= o) g += tt; }
            gcs[i] = g; bts[i] = beta;
        }
        __syncthreads();
        SEC_T(1);
        if (wave < 4) {
            const int m = wave; f32x4 acc[4];
#pragma unroll
            for (int n = 0; n < 4; ++n) acc[n] = (f32x4){0.f, 0.f, 0.f, 0.f};
#pragma unroll
            for (int s = 0; s < 4; ++s) { const bf16x8 a = *(const bf16x8*)(Ks + (16 * m + fr) * 136 + 32 * s + 8 * fq);
#pragma unroll
                for (int n = 0; n < 4; ++n) { const bf16x8 bb = *(const bf16x8*)(Ks + (16 * n + fr) * 136 + 32 * s + 8 * fq); acc[n] = __builtin_amdgcn_mfma_f32_16x16x32_bf16(a, bb, acc[n], 0, 0, 0); } }
#pragma unroll
            for (int n = 0; n < 4; ++n) { const int i = 16 * n + fr, j0 = 16 * m + 4 * fq;
                float nv[4], pv_[4];
#pragma unroll
                for (int rg = 0; rg < 4; ++rg) { const int j = j0 + rg; const float mv = (i > j) ? bts[i] * acc[n][rg] * __expf(gcs[i] - gcs[j]) : 0.f;
                    nv[rg] = -mv; pv_[rg] = (i == j ? 1.f : 0.f) - mv; Rt[j * 72 + i] = f2bf(-mv); }
                u32x2 w; w.x = cvt_pk_bf16(nv[0], nv[1]); w.y = cvt_pk_bf16(nv[2], nv[3]); *(u32x2*)(Rm + i * 72 + j0) = w;
                w.x = cvt_pk_bf16(pv_[0], pv_[1]); w.y = cvt_pk_bf16(pv_[2], pv_[3]); *(u32x2*)(Pm + i * 72 + j0) = w; }
        } else {
            const int m = wave - 4; f32x4 acc[4];
#pragma unroll
            for (int n = 0; n < 4; ++n) acc[n] = (f32x4){0.f, 0.f, 0.f, 0.f};
#pragma unroll
            for (int s = 0; s < 4; ++s) { const bf16x8 qf = *(const bf16x8*)(Qs + (16 * m + fr) * 136 + 32 * s + 8 * fq);
#pragma unroll
                for (int n = 0; n < 4; ++n) { const bf16x8 kf = *(const bf16x8*)(Ks + (16 * n + fr) * 136 + 32 * s + 8 * fq); acc[n] = __builtin_amdgcn_mfma_f32_16x16x32_bf16(kf, qf, acc[n], 0, 0, 0); } }
            const int i = 16 * m + fr; const float gi = gcs[i];
#pragma unroll
            for (int s2 = 0; s2 < 2; ++s2) { float v[8];
#pragma unroll
                for (int e = 0; e < 8; ++e) { const int j = 32 * s2 + 16 * (e >> 2) + 4 * fq + (e & 3); v[e] = (i >= j) ? acc[2 * s2 + (e >> 2)][e & 3] * __expf(gi - gcs[j]) : 0.f; }
                *(u32x4*)(AT + slot * 4096 + i * 64 + (((4 * s2 + fq) ^ ((i >> 1) & 7)) << 3)) = pack8(v); }
        }
        __syncthreads();
        SEC_T(2);
        {
            const float glast = gcs[63];
            for (int task = tid; task < 2048; task += 512) {
                if (task < 1024) { const int i = task >> 4, s_ = (task >> 2) & 3, f4 = task & 3; const float sc = __expf(gcs[i]);
                    const u32x2 a = *(const u32x2*)(Qs + i * 136 + 32 * s_ + 4 * f4), bq = *(const u32x2*)(Qs + i * 136 + 32 * s_ + 16 + 4 * f4);
                    float v[8]; v[0] = bf2f(a.x & 0xffffu) * sc; v[1] = __uint_as_float(a.x & 0xffff0000u) * sc; v[2] = bf2f(a.y & 0xffffu) * sc; v[3] = __uint_as_float(a.y & 0xffff0000u) * sc;
                    v[4] = bf2f(bq.x & 0xffffu) * sc; v[5] = __uint_as_float(bq.x & 0xffff0000u) * sc; v[6] = bf2f(bq.y & 0xffffu) * sc; v[7] = __uint_as_float(bq.y & 0xffff0000u) * sc;
                    *(u32x4*)(QP + slot * 8192 + i * 128 + (((4 * s_ + f4) ^ (i & 15)) << 3)) = pack8(v);
                } else { const int tt = task - 1024, dk = tt >> 3, s2 = (tt >> 2) & 1, f4 = tt & 3; const int i0 = 32 * s2 + 4 * f4;
                    const int sw = ((dk >> 3) & 7) << 3; const u32x2 a = *(const u32x2*)(KT + dk * 72 + (i0 ^ sw)), bq = *(const u32x2*)(KT + dk * 72 + ((i0 + 16) ^ sw));
                    float v[8]; v[0] = bf2f(a.x & 0xffffu) * __expf(glast - gcs[i0]); v[1] = __uint_as_float(a.x & 0xffff0000u) * __expf(glast - gcs[i0 + 1]);
                    v[2] = bf2f(a.y & 0xffffu) * __expf(glast - gcs[i0 + 2]); v[3] = __uint_as_float(a.y & 0xffff0000u) * __expf(glast - gcs[i0 + 3]);
                    v[4] = bf2f(bq.x & 0xffffu) * __expf(glast - gcs[i0 + 16]); v[5] = __uint_as_float(bq.x & 0xffff0000u) * __expf(glast - gcs[i0 + 17]);
                    v[6] = bf2f(bq.y & 0xffffu) * __expf(glast - gcs[i0 + 18]); v[7] = __uint_as_float(bq.y & 0xffff0000u) * __expf(glast - gcs[i0 + 19]);
                    *(u32x4*)(KD + slot * 8192 + dk * 64 + (((4 * s2 + f4) ^ ((dk >> 1) & 7)) << 3)) = pack8(v); }
            }
            if (tid == 0) GL[slot] = __expf(glast);
            f32x4 accP[2];
#pragma unroll
            for (int e = 0; e < 2; ++e) { const int tt = 2 * wave + e, it_ = tt >> 2, jt = tt & 3;
                const u32x2 pw = *(const u32x2*)(Pm + (16 * it_ + fr) * 72 + 16 * jt + 4 * fq);
                accP[e] = (f32x4){__uint_as_float(pw.x << 16), __uint_as_float(pw.x & 0xffff0000u), __uint_as_float(pw.y << 16), __uint_as_float(pw.y & 0xffff0000u)}; }
#pragma unroll 1
            for (int rd = 0; rd < 6; ++rd) {
                f32x4 accR[2], accT[2];
#pragma unroll
                for (int e = 0; e < 2; ++e) { const int tt = 2 * wave + e, mt = tt >> 2, nt = tt & 3;
                    accR[e] = (f32x4){0.f, 0.f, 0.f, 0.f}; accT[e] = (f32x4){0.f, 0.f, 0.f, 0.f};
#pragma unroll
                    for (int s2 = 0; s2 < 2; ++s2) {
                        const bf16x8 rm = *(const bf16x8*)(Rm + (16 * mt + fr) * 72 + 32 * s2 + 8 * fq), rn = *(const bf16x8*)(Rm + (16 * nt + fr) * 72 + 32 * s2 + 8 * fq);
                        const bf16x8 tm = *(const bf16x8*)(Rt + (16 * mt + fr) * 72 + 32 * s2 + 8 * fq), tn = *(const bf16x8*)(Rt + (16 * nt + fr) * 72 + 32 * s2 + 8 * fq);
                        const bf16x8 pm_ = *(const bf16x8*)(Pm + (16 * mt + fr) * 72 + 32 * s2 + 8 * fq);
                        if (rd < 5) { accR[e] = __builtin_amdgcn_mfma_f32_16x16x32_bf16(rm, tn, accR[e], 0, 0, 0);
                                      accT[e] = __builtin_amdgcn_mfma_f32_16x16x32_bf16(tm, rn, accT[e], 0, 0, 0); }
                        if (rd > 0) accP[e] = __builtin_amdgcn_mfma_f32_16x16x32_bf16(tn, pm_, accP[e], 0, 0, 0);
                    } }
                __syncthreads();
                if (rd < 5) {
#pragma unroll
                    for (int e = 0; e < 2; ++e) { const int tt = 2 * wave + e, mt = tt >> 2, nt = tt & 3; u32x2 w;
                        w.x = cvt_pk_bf16(accR[e][0], accR[e][1]); w.y = cvt_pk_bf16(accR[e][2], accR[e][3]); *(u32x2*)(Rt + (16 * nt + fr) * 72 + 16 * mt + 4 * fq) = w;
                        w.x = cvt_pk_bf16(accT[e][0], accT[e][1]); w.y = cvt_pk_bf16(accT[e][2], accT[e][3]); *(u32x2*)(Rm + (16 * nt + fr) * 72 + 16 * mt + 4 * fq) = w;
                        if (rd > 0) { w.x = cvt_pk_bf16(accP[e][0], accP[e][1]); w.y = cvt_pk_bf16(accP[e][2], accP[e][3]); *(u32x2*)(Pm + (16 * mt + fr) * 72 + 16 * nt + 4 * fq) = w; } }
                    __syncthreads();
                }
            }
#pragma unroll
            for (int e = 0; e < 2; ++e) { const int tt = 2 * wave + e, mt = tt >> 2, nt = tt & 3; const int i = 16 * mt + fr, c0 = 16 * nt + 4 * fq; float v1[4], v2[4];
#pragma unroll
                for (int rg = 0; rg < 4; ++rg) { const float bc = bts[c0 + rg]; v1[rg] = accP[e][rg] * bc; v2[rg] = -accP[e][rg] * bc * __expf(gcs[c0 + rg]); }
                u32x2 w; w.x = cvt_pk_bf16(v1[0], v1[1]); w.y = cvt_pk_bf16(v1[2], v1[3]); *(u32x2*)(T1 + i * 72 + c0) = w;
                w.x = cvt_pk_bf16(v2[0], v2[1]); w.y = cvt_pk_bf16(v2[2], v2[3]); *(u32x2*)(T2 + i * 72 + c0) = w; }
        }
        __syncthreads();
        SEC_T(3);
#pragma unroll 1
        for (int nh = 0; nh < 2; ++nh) {
        if (wave < 4) {
            const int m = wave; f32x4 acc[4];
#pragma unroll
            for (int n = 0; n < 4; ++n) acc[n] = (f32x4){0.f, 0.f, 0.f, 0.f};
#pragma unroll
            for (int s2 = 0; s2 < 2; ++s2) { const bf16x8 a = *(const bf16x8*)(T1 + (16 * m + fr) * 72 + 32 * s2 + 8 * fq);
#pragma unroll
                for (int n = 0; n < 4; ++n) { const int d = 16 * (4 * nh + n) + fr; const bf16x8 bb = *(const bf16x8*)(VT + d * 72 + ((32 * s2 + 8 * fq) ^ (((d >> 3) & 7) << 3))); acc[n] = __builtin_amdgcn_mfma_f32_16x16x32_bf16(a, bb, acc[n], 0, 0, 0); } }
#pragma unroll
            for (int n = 0; n < 4; ++n) { u32x2 w; w.x = cvt_pk_bf16(acc[n][0], acc[n][1]); w.y = cvt_pk_bf16(acc[n][2], acc[n][3]);
                *(u32x2*)(UF + slot * 8192 + (((4 * nh + n) * 4 + m) * 64 + lane) * 4) = w; }
        } else {
            const int m = wave - 4; f32x4 acc[4];
#pragma unroll
            for (int n = 0; n < 4; ++n) acc[n] = (f32x4){0.f, 0.f, 0.f, 0.f};
#pragma unroll
            for (int s2 = 0; s2 < 2; ++s2) { const bf16x8 tf = *(const bf16x8*)(T2 + (16 * m + fr) * 72 + 32 * s2 + 8 * fq);
#pragma unroll
                for (int n = 0; n < 4; ++n) { const int d = 16 * (4 * nh + n) + fr; const bf16x8 kf = *(const bf16x8*)(KT + d * 72 + ((32 * s2 + 8 * fq) ^ (((d >> 3) & 7) << 3))); acc[n] = __builtin_amdgcn_mfma_f32_16x16x32_bf16(kf, tf, acc[n], 0, 0, 0); } }
            const int i = 16 * m + fr;
#pragma unroll
            for (int s = 0; s < 2; ++s) { u32x4 w; w.x = cvt_pk_bf16(acc[2 * s][0], acc[2 * s][1]); w.y = cvt_pk_bf16(acc[2 * s][2], acc[2 * s][3]);
                w.z = cvt_pk_bf16(acc[2 * s + 1][0], acc[2 * s + 1][1]); w.w = cvt_pk_bf16(acc[2 * s + 1][2], acc[2 * s + 1][3]);
                *(u32x4*)(WP + slot * 8192 + i * 128 + (((4 * (2 * nh + s) + fq) ^ (i & 15)) << 3)) = w; }
        }
        }
        SEC_T(4);
    }
    __syncthreads();
}

__device__ void dn_scan(const Params& P, unsigned char* smem, int t0, int t1) {
    if (lbid() >= 128) return;
    const int bhd = lbid() >> 1, half = lbid() & 1;
    const int tid = ltid(), wave = __builtin_amdgcn_readfirstlane(tid >> 6), lane = tid & 63, fr = lane & 15, fq = lane >> 4;
    unsigned char* ws = P.ws;
    const unsigned char* WPb = ws + O_WP; const unsigned char* QPb = ws + O_QP; const unsigned char* KDb = ws + O_KD; const unsigned char* ATb = ws + O_AT;
    const bf16_t* UF = (const bf16_t*)(ws + O_UF); const float* GL = (const float*)(ws + S_GL);
    bf16_t* OO = (bf16_t*)(ws + O_O); f32x4* SS = (f32x4*)(ws + S_SSAVE);
    const int b = bhd >> 3, h = (bhd >> 1) & 3, dir = bhd & 1;
    LAS unsigned char* lds = (LAS unsigned char*)smem;
    constexpr int BUFB = 57344;
#define SCAN_SRC(q_, slot_) ((q_) < 16 ? WPb + (slot_) * 16384 + (q_) * 1024 : (q_) < 32 ? QPb + (slot_) * 16384 + ((q_) - 16) * 1024 : (q_) < 48 ? KDb + (slot_) * 16384 + ((q_) - 32) * 1024 : ATb + (slot_) * 8192 + ((q_) - 48) * 1024)
#define SCAN_LOAD(tl_) do { const size_t _slot = (size_t)(tl_) * 64 + bhd; _Pragma("unroll") for (int _k = 0; _k < 14; ++_k) { const int _q = (wave - 4) * 14 + _k; rg_[_k] = *(const u32x4*)(SCAN_SRC(_q, _slot) + lane * 16); } } while (0)
#define SCAN_WRITE(buf_) do { _Pragma("unroll") for (int _k = 0; _k < 14; ++_k) { const int _q = (wave - 4) * 14 + _k; *(LAS u32x4*)(lds + (buf_) * BUFB + _q * 1024 + lane * 16) = rg_[_k]; } } while (0)
    constexpr int NN = 1; const bool cw_ = wave < 4; const int sl0 = half * 4 + (wave & 3);
    const int nst = t1 - t0;
    if (!cw_) {
        u32x4 rg_[14];
#define SCAN_LOAD(tl_) do { const size_t _slot = (size_t)(tl_) * 64 + bhd; _Pragma("unroll") for (int _k = 0; _k < 14; ++_k) { const int _q = (wave - 4) * 14 + _k; rg_[_k] = *(const u32x4*)(SCAN_SRC(_q, _slot) + lane * 16); } } while (0)
#define SCAN_WRITE(buf_) do { _Pragma("unroll") for (int _k = 0; _k < 14; ++_k) { const int _q = (wave - 4) * 14 + _k; *(LAS u32x4*)(lds + (buf_) * BUFB + _q * 1024 + lane * 16) = rg_[_k]; } } while (0)
        SCAN_LOAD(0); SCAN_WRITE(0); if (nst > 1) SCAN_LOAD(1);
#pragma unroll 1
        for (int tl = 0; tl < nst; ++tl) {
            __syncthreads();
            if (tl + 1 < nst) { SCAN_WRITE((tl + 1) & 1); if (tl + 2 < nst) SCAN_LOAD(tl + 2); }
        }
        asm volatile("s_waitcnt vmcnt(0)" ::: "memory");
        __syncthreads();
        return;
    }
    f32x4 S[8][NN];
#pragma unroll
    for (int t = 0; t < 8; ++t)
#pragma unroll
        for (int nn = 0; nn < NN; ++nn) S[t][nn] = (t0 == 0 || !cw_) ? (f32x4){0.f, 0.f, 0.f, 0.f} : SS[((size_t)(bhd * 8 + sl0 + nn) * 8 + t) * 64 + lane];
    u32x2 un[4][NN];
    if (cw_) {
#pragma unroll
        for (int m = 0; m < 4; ++m)
#pragma unroll
            for (int nn = 0; nn < NN; ++nn) un[m][nn] = *(const u32x2*)(UF + (size_t)bhd * 8192 + (((sl0 + nn) * 4 + m) * 64 + lane) * 4); }
    float gln = __hip_atomic_load(GL + bhd, __ATOMIC_RELAXED, __HIP_MEMORY_SCOPE_AGENT);
#pragma unroll 1
    for (int tl = 0; tl < nst; ++tl) {
        const size_t slot = (size_t)tl * 64 + bhd; const int t = t0 + tl, c = dir ? 64 - t : t;
        const LAS unsigned char* bw = lds + (tl & 1) * BUFB;
        __syncthreads();
        f32x4 av[4][NN], ao[4][NN];
#pragma unroll
        for (int m = 0; m < 4; ++m)
#pragma unroll
            for (int nn = 0; nn < NN; ++nn) { const u32x2 u = un[m][nn];
                av[m][nn] = (f32x4){__uint_as_float(u.x << 16), __uint_as_float(u.x & 0xffff0000u), __uint_as_float(u.y << 16), __uint_as_float(u.y & 0xffff0000u)}; ao[m][nn] = (f32x4){0.f, 0.f, 0.f, 0.f}; }
        const float gl = gln; if (tl + 1 < nst) gln = __hip_atomic_load(GL + slot + 64, __ATOMIC_RELAXED, __HIP_MEMORY_SCOPE_AGENT);
        if (tl + 1 < nst) {
#pragma unroll
            for (int m = 0; m < 4; ++m)
#pragma unroll
                for (int nn = 0; nn < NN; ++nn) un[m][nn] = *(const u32x2*)(UF + (slot + 64) * 8192 + (((sl0 + nn) * 4 + m) * 64 + lane) * 4); }
#pragma unroll
        for (int s = 0; s < 4; ++s) { bf16x8 Sb[NN];
#pragma unroll
            for (int nn = 0; nn < NN; ++nn) { u32x4 w; w.x = cvt_pk_bf16(S[2 * s][nn][0], S[2 * s][nn][1]); w.y = cvt_pk_bf16(S[2 * s][nn][2], S[2 * s][nn][3]); w.z = cvt_pk_bf16(S[2 * s + 1][nn][0], S[2 * s + 1][nn][1]); w.w = cvt_pk_bf16(S[2 * s + 1][nn][2], S[2 * s + 1][nn][3]);
                Sb[nn] = __builtin_bit_cast(bf16x8, w); }
#pragma unroll
            for (int m = 0; m < 4; ++m) { const bf16x8 wf = *(const LAS bf16x8*)(bw + (16 * m + fr) * 256 + (((4 * s + fq) ^ fr) << 4)); const bf16x8 qf = *(const LAS bf16x8*)(bw + 16384 + (16 * m + fr) * 256 + (((4 * s + fq) ^ fr) << 4));
                _Pragma("unroll") for (int nn = 0; nn < NN; ++nn) av[m][nn] = __builtin_amdgcn_mfma_f32_16x16x32_bf16(wf, Sb[nn], av[m][nn], 0, 0, 0);
                _Pragma("unroll") for (int nn = 0; nn < NN; ++nn) ao[m][nn] = __builtin_amdgcn_mfma_f32_16x16x32_bf16(qf, Sb[nn], ao[m][nn], 0, 0, 0); } }
        __builtin_amdgcn_sched_barrier(0);
        bf16x8 Vb[2][NN];
#pragma unroll
        for (int s2 = 0; s2 < 2; ++s2)
#pragma unroll
            for (int nn = 0; nn < NN; ++nn) { u32x4 w; w.x = cvt_pk_bf16(av[2 * s2][nn][0], av[2 * s2][nn][1]); w.y = cvt_pk_bf16(av[2 * s2][nn][2], av[2 * s2][nn][3]); w.z = cvt_pk_bf16(av[2 * s2 + 1][nn][0], av[2 * s2 + 1][nn][1]); w.w = cvt_pk_bf16(av[2 * s2 + 1][nn][2], av[2 * s2 + 1][nn][3]);
                Vb[s2][nn] = __builtin_bit_cast(bf16x8, w); }
#pragma unroll
        for (int m = 0; m < 4; ++m)
#pragma unroll
            for (int s2 = 0; s2 < 2; ++s2) { const int row = 16 * m + fr; const bf16x8 af = *(const LAS bf16x8*)(bw + 49152 + row * 128 + (((4 * s2 + fq) ^ ((row >> 1) & 7)) << 4));
                _Pragma("unroll") for (int nn = 0; nn < NN; ++nn) ao[m][nn] = __builtin_amdgcn_mfma_f32_16x16x32_bf16(af, Vb[s2][nn], ao[m][nn], 0, 0, 0); }
        __builtin_amdgcn_sched_barrier(0);
#pragma unroll
        for (int tt = 0; tt < 8; ++tt) { _Pragma("unroll") for (int nn = 0; nn < NN; ++nn) S[tt][nn] = S[tt][nn] * gl;
#pragma unroll
            for (int s2 = 0; s2 < 2; ++s2) { const int row = 16 * tt + fr; const bf16x8 kf = *(const LAS bf16x8*)(bw + 32768 + row * 128 + (((4 * s2 + fq) ^ ((row >> 1) & 7)) << 4));
                _Pragma("unroll") for (int nn = 0; nn < NN; ++nn) S[tt][nn] = __builtin_amdgcn_mfma_f32_16x16x32_bf16(kf, Vb[s2][nn], S[tt][nn], 0, 0, 0); } }
#pragma unroll
        for (int m = 0; m < 4; ++m)
#pragma unroll
            for (int rg = 0; rg < 4; ++rg) { const int i = 16 * m + 4 * fq + rg, n = c * 64 + (dir ? 63 - i : i) - 48;
                if (n >= 0) { bf16_t* op = OO + ((size_t)dir * TP + (size_t)b * LL + n) * 512 + h * 128 + sl0 * 16 + fr; _Pragma("unroll") for (int nn = 0; nn < NN; ++nn) op[16 * nn] = f2bf(ao[m][nn][rg]); } }
    }
#undef SCAN_SRC
#undef SCAN_LOAD
#undef SCAN_WRITE
    if (t1 < NSTEP && cw_) {
#pragma unroll
        for (int t = 0; t < 8; ++t)
#pragma unroll
            for (int nn = 0; nn < NN; ++nn) SS[((size_t)(bhd * 8 + sl0 + nn) * 8 + t) * 64 + lane] = S[t][nn]; }
    asm volatile("s_waitcnt vmcnt(0)" ::: "memory");
    __syncthreads();
}

__device__ void dn_out(const Params& P, int l) {
    const int tid_ = ltid(); const int wave = __builtin_amdgcn_readfirstlane(tid_ >> 6), lane = tid_ & 63;
    const bf16_t* OO = (const bf16_t*)(P.ws + O_O); const bf16_t* Z = (const bf16_t*)(P.ws + O_Z); bf16_t* DNO = (bf16_t*)(P.ws + O_BR) + (size_t)2 * TP * 512;
    const float* nw = P.in[12] + (size_t)l * 128; float g[8];
#pragma unroll
    for (int e = 0; e < 8; ++e) g[e] = nw[(lane & 15) * 8 + e];
    for (int r = lbid() * 8 + wave; r < TT; r += lgrid() * 8) {
        float a[8], bq[8], z[8]; unpack8(*(const u32x4*)(OO + (size_t)r * 512 + lane * 8), a); unpack8(*(const u32x4*)(OO + ((size_t)TP + r) * 512 + lane * 8), bq); unpack8(*(const u32x4*)(Z + (size_t)r * 512 + lane * 8), z);
        float ss = 0.f;
#pragma unroll
        for (int e = 0; e < 8; ++e) { a[e] += bq[e]; ss += a[e] * a[e]; }
        ss += __shfl_xor(ss, 1); ss += __shfl_xor(ss, 2); ss += __shfl_xor(ss, 4); ss += __shfl_xor(ss, 8);
        const float inv = rsqrtf(ss * (1.0f / 128.0f) + EPS);
#pragma unroll
        for (int e = 0; e < 8; ++e) a[e] = a[e] * inv * g[e] * siluf_(z[e]);
        *(u32x4*)(DNO + (size_t)r * 512 + lane * 8) = pack8(a);
    }
}


#define XB_TMO      128
#define XB_XCNT(j)  (256  + 64 * (j))
#define XB_XSUB(j)  (1280 + 64 * (j))
#define XB_XGEN(j)  (2304 + 64 * (j))
#define XB_TOP      3328
#define XB_TOPGEN   3392
#define XCD_BAR_WORDS 3456
#define XB_SPIN_CAP (1u << 22)
__device__ __forceinline__ unsigned xb_ld(unsigned* p)              { return __hip_atomic_load(p, __ATOMIC_RELAXED, __HIP_MEMORY_SCOPE_AGENT); }
__device__ __forceinline__ unsigned xb_add(unsigned* p, unsigned v) { return __hip_atomic_fetch_add(p, v, __ATOMIC_RELAXED, __HIP_MEMORY_SCOPE_AGENT); }
__device__ __forceinline__ unsigned xb_xcc_id() { return (unsigned)__builtin_amdgcn_s_getreg((3 << 11) | 20) & 0xFu; }
#define XB_SPIN(cond, bar) do { unsigned _sp = 0; while (cond) { __builtin_amdgcn_s_sleep(1); \
    if ((++_sp & 255u) == 0u) { if (xb_ld(&(bar)[XB_TMO])) break; if (_sp > XB_SPIN_CAP) { atomicAdd(&(bar)[XB_TMO], 1u); break; } } } } while (0)
struct XcdBarrier { unsigned* bar; unsigned x; volatile LAS unsigned* st; };
__device__ __forceinline__ XcdBarrier xcd_barrier_post(unsigned* bar, volatile LAS unsigned* st) {
    XcdBarrier b; b.bar = bar; b.x = xb_xcc_id(); b.st = st;
    if (threadIdx.x == 0) (void)xb_add(&bar[XB_XCNT(b.x)], 1u);
    return b;
}
__device__ __forceinline__ void xcd_barrier_complete(unsigned* bar, unsigned x, unsigned& nloc, unsigned& nx) {
    const unsigned G = gridDim.x * gridDim.y * gridDim.z;
    unsigned sum, cnt, mine, sp = 0u;
    for (;;) {
        sum = 0u; cnt = 0u; mine = 0u;
#pragma unroll
        for (unsigned j = 0; j < 16; ++j) { const unsigned c = xb_ld(&bar[XB_XCNT(j)]); sum += c; cnt += (c > 0u) ? 1u : 0u; mine = (j == x) ? c : mine; }
        if (sum == G) break;
        __builtin_amdgcn_s_sleep(1);
        if ((++sp & 255u) == 0u) { if (xb_ld(&bar[XB_TMO])) break; if (sp > XB_SPIN_CAP) { atomicAdd(&bar[XB_TMO], 1u); break; } }
    }
    nloc = mine > 0u ? mine : 1u; nx = cnt > 0u ? cnt : 1u;
}
__device__ __forceinline__ void xcd_barrier(const XcdBarrier& b) {
    asm volatile("s_waitcnt vmcnt(0)" ::: "memory");
    __syncthreads();
    if (threadIdx.x == 0) {
        unsigned* bar = b.bar;
        __builtin_amdgcn_s_waitcnt(0);
        unsigned nloc = b.st[0], nx = b.st[1];
        if (nloc == 0u) { xcd_barrier_complete(bar, b.x, nloc, nx); b.st[0] = nloc; b.st[1] = nx; }
        const unsigned old = xb_add(&bar[XB_XSUB(b.x)], 1u);
        const unsigned gen = old / nloc;
        if (old + 1u == (gen + 1u) * nloc) {
            __builtin_amdgcn_fence(__ATOMIC_RELEASE, "agent");
            asm volatile("s_waitcnt vmcnt(0)" ::: "memory");
            const unsigned og = xb_add(&bar[XB_TOP], 1u);
            const unsigned tg = og / nx;
            if (og + 1u == (tg + 1u) * nx) xb_add(&bar[XB_TOPGEN], 1u);
            else XB_SPIN(xb_ld(&bar[XB_TOPGEN]) == tg, bar);
            __builtin_amdgcn_fence(__ATOMIC_ACQUIRE, "agent");
            xb_add(&bar[XB_XGEN(b.x)], 1u);
            asm volatile("s_waitcnt vmcnt(0)" ::: "memory");
        } else {
            XB_SPIN(xb_ld(&bar[XB_XGEN(b.x)]) == gen, bar);
            __builtin_amdgcn_fence(__ATOMIC_ACQUIRE, "agent");
            asm volatile("s_waitcnt vmcnt(0)" ::: "memory");
        }
    }
    __syncthreads();
}
__device__ __forceinline__ int phase_cat(int ph) { const int p = ph % 22;
    return p == 0 ? 0 : (p == 1 || p == 2 || p == 19 || p == 20) ? 1 : (p == 3 || p == 18 || p == 21) ? 2 : p == 4 ? 3 : p == 5 ? 4 : p == 6 ? 5 : p == 7 ? 6 : (p == 8 || p == 10 || p == 12) ? 7 : (p == 9 || p == 11 || p == 13) ? 8 : p == 14 ? 9 : 10; }
#ifndef SKIP_GEMM
#define GEMM_CALL(a,b,c,d) pg8::gemm_phase(a,b,c,d)
#else
#define GEMM_CALL(a,b,c,d) (void)0
#endif
__global__ void __launch_bounds__(512, 2) fwd_kernel(Params P) {
    extern __shared__ __attribute__((aligned(16))) unsigned char smem[];
    cg::grid_group grid = cg::this_grid();
    unsigned char* ws = P.ws;
    LAS unsigned char* lds = (LAS unsigned char*)smem;
    int ph = 0;
    { volatile LAS unsigned* stw = (volatile LAS unsigned*)(lds + LDS_BYTES - 32); if (threadIdx.x < 8) stw[threadIdx.x] = 0u; }
    __syncthreads();
    XcdBarrier xbar = xcd_barrier_post((unsigned*)(ws + S_BAR), (volatile LAS unsigned*)(lds + LDS_BYTES - 16));
#ifdef DBG_CAT
    unsigned long long t_prev = __builtin_amdgcn_s_memrealtime(), t_acc = 0ull;
#define STAMP() do { const unsigned long long _n = __builtin_amdgcn_s_memrealtime(); if (phase_cat(ph) == DBG_CAT) t_acc += _n - t_prev; t_prev = _n; } while (0)
#else
#define STAMP() do {} while (0)
#endif
#define PHASE_BEGIN if (ph >= P.ph_lo && ph < P.ph_hi) { const int G = lgrid(), bx = lbid(); (void)G; (void)bx;
#define PHASE_END   if (ph + 1 < P.ph_hi) { if (ph == 0) { asm volatile("s_waitcnt vmcnt(0) lgkmcnt(0)" ::: "memory"); grid.sync(); __builtin_amdgcn_fence(__ATOMIC_ACQUIRE, "agent"); asm volatile("s_waitcnt vmcnt(0)" ::: "memory"); __syncthreads(); } else xcd_barrier(xbar); } STAMP(); } ++ph;
    for (ph = P.ph_lo; ph < P.ph_hi; ++ph) {
        const int l = ph / 22, p = ph - l * 22;
        const int G = lgrid(), bx = lbid();
        bf16_t* XN = (bf16_t*)(ws + O_XN); bf16_t* Y = (bf16_t*)(ws + O_Y); bf16_t* ACT = (bf16_t*)(ws + O_ACT);
        const float* ng = P.in[2] + (size_t)l * 6 * 1024;
        switch (p) {
        case 0:
#ifndef SKIP_CVT
            convert_weights(P, l, smem);
#endif
            if (l == 0) { gen_tables(P); rpass(P, nullptr, true, nullptr, 0.f, ng, XN); }
            break;
        case 1: case 19: { pg8::Gemm g{XN, (const bf16_t*)(ws + (p == 1 ? W_WI1 : W_WI2)), TP, 5632, 1024, 128, 1024}; pg8::StaticOrder S; S.init(TP, 5632, G, bx); pg8::EpiSwiglu E{ACT}; GEMM_CALL(lds, g, S, E); } break;
        case 2: case 20: case 17: {
            const bool dn = (p != 17); const int Kx = dn ? 2816 : 1024, nS = dn ? 11 : 4;
            const bf16_t* W = (const bf16_t*)(ws + (p == 2 ? W_WO1 : p == 20 ? W_WO2 : W_WOUT)); const bf16_t* Ax = dn ? ACT : (const bf16_t*)(ws + O_MG);
            { pg8::Gemm g{Ax, W, TP, 1024, Kx, 128, Kx}; pg8::StaticOrder S; S.init(TP, 1024, G, bx, false); pg8::EpiBf16<0> E{Y, 1024}; GEMM_CALL(lds, g, S, E); }
            { pg8::Gemm g{W, Ax + (size_t)32768 * Kx, 1024, 256, Kx, -1, 256}; pg8::TailOrder S{nS, bx}; pg8::EpiSlab E{(float*)(ws + O_SLAB), nS}; GEMM_CALL(lds, g, S, E); } } break;
        case 3: rpass(P, Y, l == 0, ng + 1024, 0.5f, ng + 2048, XN, (const float*)(ws + O_SLAB), 11); break;
        case 4: { pg8::Gemm g{XN, (const bf16_t*)(ws + W_WIN), TP, NPROJ, 1024, 128, 1024}; pg8::StaticOrder S; S.init(TP, NPROJ, G, bx); pg8::EpiInProj E{ws}; GEMM_CALL(lds, g, S, E); } break;
        case 5: sconv_pass(P, l); break;
        case 6:
#ifndef SKIP_F1
            fstep1(P, smem);
#endif
            break;
        case 7: { pg8::Gemm g{(const bf16_t*)(ws + S_C257), (const bf16_t*)(ws + O_AP), 512, 65536, KF, 1, KF}; pg8::StaticOrder S; S.init(512, 65536, G, bx);
                  pg8::EpiFourier E{(bf16_t*)(ws + O_BR), 0.001949317738791423f  }; GEMM_CALL(lds, g, S, E); } break;
        case 8: case 10: case 12: { const int t0 = ((p - 8) >> 1) * SPL, t1 = (t0 + SPL < NSTEP) ? t0 + SPL : NSTEP;
#ifndef SKIP_PREP
            dn_prep(P, l, smem, t0, t1);
#endif
            } break;
        case 9: case 11: case 13: { const int t0 = ((p - 9) >> 1) * SPL, t1 = (t0 + SPL < NSTEP) ? t0 + SPL : NSTEP;
#ifndef SKIP_SCAN
            dn_scan(P, smem, t0, t1);
#endif
            } break;
        case 14: dn_out(P, l); rpass(P, nullptr, false, nullptr, 0.f, ng + 2048, (bf16_t*)(ws + O_XN2)); break;
        case 15: { pg8::Gemm g{(const bf16_t*)(ws + O_XN2), (const bf16_t*)(ws + W_WG), TP, 3072, 1024, 128, 1024}; pg8::StaticOrder S; S.init(TP, 3072, G, bx); pg8::EpiBf16<1> E{(bf16_t*)(ws + O_GATE), 3072}; GEMM_CALL(lds, g, S, E); } break;
        case 16: { pg8::Gemm g{(const bf16_t*)(ws + O_BR), (const bf16_t*)(ws + W_WBR), 3 * TP, 3072, 512, -1, 512}; pg8::MergeOrder S{G, bx}; pg8::EpiMerge E{(const bf16_t*)(ws + O_GATE), (bf16_t*)(ws + O_MG), (bf16_t*)(ws + O_XN2)}; GEMM_CALL(lds, g, S, E); } break;
        case 18: rpass(P, Y, false, ng + 3 * 1024, 1.0f, ng + 4 * 1024, XN, (const float*)(ws + O_SLAB), 4); break;
        default: rpass(P, Y, false, ng + 5 * 1024, 0.5f, l == 0 ? P.in[2] + (size_t)6 * 1024 : nullptr, XN, (const float*)(ws + O_SLAB), 11); break;
        }
        if (ph + 1 < P.ph_hi) {
            if (P.ph_lo < 0) grid.sync();
            xcd_barrier(xbar);
        }
        STAMP();
    }
#ifdef DBG_CAT
    if (lbid() == 0 && threadIdx.x == 0) { const unsigned long long t0 = __builtin_amdgcn_s_memrealtime(); while (__builtin_amdgcn_s_memrealtime() - t0 < t_acc + *(unsigned long long*)(smem + LDS_BYTES - 32)) __builtin_amdgcn_s_sleep(16); }
#endif
#ifdef DBG_FLUSH
    { asm volatile("s_waitcnt vmcnt(0) lgkmcnt(0)" ::: "memory"); grid.sync(); __builtin_amdgcn_fence(__ATOMIC_ACQUIRE, "agent"); asm volatile("s_waitcnt vmcnt(0)" ::: "memory");
      const f32x4* xs = (const f32x4*)P.in[0]; f32x4 a = {0.f, 0.f, 0.f, 0.f};
      for (size_t i = ltid(); i < (size_t)8388608; i += 512) a += xs[i];
      if (a[0] + a[1] + a[2] + a[3] == 1.2345e-30f) ((float*)(ws + S_GL))[4000] = 1.f; }
#endif
#ifdef DBG_OFF
    { asm volatile("s_waitcnt vmcnt(0) lgkmcnt(0)" ::: "memory"); grid.sync(); __builtin_amdgcn_fence(__ATOMIC_ACQUIRE, "agent"); asm volatile("s_waitcnt vmcnt(0)" ::: "memory");
      const bf16_t* src = (const bf16_t*)(ws + DBG_OFF);
      for (size_t i = (size_t)lbid() * 512 + ltid(); i < (size_t)33554432; i += (size_t)lgrid() * 512) P.out[i] = i < (size_t)DBG_CNT ? bf2f(src[i]) : 0.f; }
#endif
}

extern "C" void kernel_launch(void* const* d_in, const int* in_sizes, int n_in, void* d_out, int out_size, void* d_ws, size_t ws_size, hipStream_t stream) {
    static int grid = 0;
    if (grid == 0) {
        int dev = 0, cus = 0, per_cu = 0;
        hipGetDevice(&dev); hipDeviceGetAttribute(&cus, hipDeviceAttributeMultiprocessorCount, dev);
        hipFuncSetAttribute((const void*)fwd_kernel, hipFuncAttributeMaxDynamicSharedMemorySize, LDS_BYTES);
        hipOccupancyMaxActiveBlocksPerMultiprocessor(&per_cu, (const void*)fwd_kernel, 512, LDS_BYTES);
        if (per_cu < 1) { fprintf(stderr, "occupancy query says %d blocks/CU\n", per_cu); per_cu = 1; }
        grid = cus;
        if (ws_size < WS_NEED) fprintf(stderr, "workspace too small: %zu < %zu\n", ws_size, (size_t)WS_NEED);
    }
    Params p{};
    for (int i = 0; i < 17; ++i) p.in[i] = (const float*)d_in[i];
    p.out = (float*)d_out; p.ws = (unsigned char*)d_ws; p.ph_lo = 0; p.ph_hi = 44;
#ifdef DBG_PHI
    p.ph_hi = DBG_PHI;
#endif
    hipMemsetAsync((char*)d_ws + S_BAR, 0, 16384, stream);
    void* args[] = {&p};
    hipError_t e = hipLaunchCooperativeKernel((const void*)fwd_kernel, dim3(grid), dim3(512), args, LDS_BYTES, stream);
    if (e != hipSuccess) fprintf(stderr, "cooperative launch failed: %s (grid %d)\n", hipGetErrorString(e), grid);
}
```

```cpp
#include <hip/hip_runtime.h>
#include <hip/hip_cooperative_groups.h>
#include <cstdio>
namespace cg = cooperative_groups;

#define LAS __attribute__((address_space(3)))
typedef unsigned short bf16_t;
typedef short bf16x8 __attribute__((ext_vector_type(8)));
typedef float f32x4 __attribute__((ext_vector_type(4)));
typedef unsigned u32x4 __attribute__((ext_vector_type(4)));
typedef unsigned u32x2 __attribute__((ext_vector_type(2)));

constexpr int DM = 1024, NB = 8, SEQ = 4096, NMETA = 16, LL = 4112, TT = NB * LL  , TP = 33024  , DFF = 2816;
constexpr int NIN = 7184;
constexpr int NPROJ = 4864;
constexpr float EPS = 1e-6f;
constexpr int NSTEP = 65, SPL = 24, NSPLIT = 3;
constexpr int KF = 640;

constexpr size_t UU = (size_t)TP * 1024;
constexpr size_t W_WI1 = 0, W_WO1 = W_WI1 + (size_t)5632 * 1024 * 2, W_WI2 = W_WO1 + (size_t)1024 * 2816 * 2, W_WO2 = W_WI2 + (size_t)5632 * 1024 * 2,
                 W_WIN = W_WO2 + (size_t)1024 * 2816 * 2, W_WG = W_WIN + (size_t)NPROJ * 1024 * 2, W_WBR = W_WG + (size_t)3072 * 1024 * 2,
                 W_WOUT = W_WBR + (size_t)3072 * 512 * 2, W_END = W_WOUT + (size_t)1024 * 1024 * 2;
constexpr size_t S_C257 = W_END, S_TWL = S_C257 + (size_t)512 * KF * 2, S_HM = S_TWL + 33024, S_LOGIT = S_HM + (size_t)128 * 1024 * 4,
                 S_GL = S_LOGIT + (size_t)TP * 16 * 4, S_SSAVE = S_GL + 16896, S_BAR = S_SSAVE + (size_t)512 * 8 * 64 * 16, S_END = S_BAR + 16384;
constexpr size_t A0 = (S_END + 255) / 256 * 256;
constexpr size_t O_XN = A0, O_Y = A0 + 2 * UU, O_ACT = A0 + 4 * UU;
constexpr size_t O_BR = A0, O_QKV = A0 + 4 * UU, O_Z = A0 + 7 * UU, O_SC = A0 + 8 * UU, O_PQ = A0 + 11 * UU, O_AP = A0 + 8 * UU;
constexpr size_t DNI_SLOTS = (size_t)SPL * 64;
constexpr size_t O_WP = A0 + 8 * UU, O_QP = O_WP + DNI_SLOTS * 16384, O_KD = O_QP + DNI_SLOTS * 16384, O_UF = O_KD + DNI_SLOTS * 16384,
                 O_AT = O_UF + DNI_SLOTS * 16384, O_DNI_END = O_AT + DNI_SLOTS * 8192;
constexpr size_t O_O = (O_DNI_END + 255) / 256 * 256;
constexpr size_t O_XN2 = A0 + 3 * UU, O_GATE = A0 + 5 * UU, O_MG = A0 + 11 * UU;
constexpr size_t O_SLAB = (O_O + 2 * UU + 255) / 256 * 256;
constexpr size_t WS_NEED = O_SLAB + (size_t)44 * 65536 * 4;
static_assert(WS_NEED <= (size_t)536870912, "workspace");
static_assert(O_AP + (size_t)65536 * KF * 2 <= O_PQ, "A' overlaps PQ");
static_assert(O_O >= O_PQ || true, "");
static_assert(O_MG + 2 * UU <= WS_NEED + 2 * UU, "");

constexpr int LDS_BYTES = 132 * 1024;

#define DBG_CNT ((size_t)33554432)


struct Params { const float* in[17]; float* out; unsigned char* ws; int ph_lo, ph_hi; };

__device__ __forceinline__ float bf2f(unsigned v) { return __uint_as_float(v << 16); }
typedef __bf16 bf16x2_t __attribute__((ext_vector_type(2)));
typedef float f32x2_t __attribute__((ext_vector_type(2)));
__device__ __forceinline__ unsigned cvt_pk_bf16(float lo, float hi) { f32x2_t v = {lo, hi}; bf16x2_t b = __builtin_convertvector(v, bf16x2_t); return __builtin_bit_cast(unsigned, b); }
__device__ __forceinline__ bf16_t f2bf(float f) { return (bf16_t)(cvt_pk_bf16(f, 0.f) & 0xffffu); }
__device__ __forceinline__ void unpack8(const u32x4 v, float* f) {
    f[0] = __uint_as_float(v.x << 16); f[1] = __uint_as_float(v.x & 0xffff0000u); f[2] = __uint_as_float(v.y << 16); f[3] = __uint_as_float(v.y & 0xffff0000u);
    f[4] = __uint_as_float(v.z << 16); f[5] = __uint_as_float(v.z & 0xffff0000u); f[6] = __uint_as_float(v.w << 16); f[7] = __uint_as_float(v.w & 0xffff0000u); }
__device__ __forceinline__ u32x4 pack8(const float* f) { u32x4 w; w.x = cvt_pk_bf16(f[0], f[1]); w.y = cvt_pk_bf16(f[2], f[3]); w.z = cvt_pk_bf16(f[4], f[5]); w.w = cvt_pk_bf16(f[6], f[7]); return w; }
__device__ __forceinline__ int ltid() { int t = threadIdx.x; asm volatile("" : "+v"(t)); return t; }
__device__ __forceinline__ int lbid() { int t = blockIdx.x; asm volatile("" : "+s"(t)); return t; }
__device__ __forceinline__ int lgrid() { int t = gridDim.x; asm volatile("" : "+s"(t)); return t; }
__device__ __forceinline__ float wave_sum(float v) { for (int o = 32; o >= 1; o >>= 1) v += __shfl_xor(v, o); return v; }
__device__ __forceinline__ float sigmoidf_(float x) { return __builtin_amdgcn_rcpf(1.0f + __expf(-x)); }
__device__ __forceinline__ float siluf_(float x) { return x * __builtin_amdgcn_rcpf(1.0f + __expf(-x)); }

namespace pg8 {
constexpr int BM = 256, BK = 64, HALF = 128, HTB = HALF * BK * 2, STAGE_BYTES = 8 * HTB, NXCD = 8, WGM = 8;
__device__ __forceinline__ int lds_byte(int r, int c) { const int st = (r >> 4) * 2 + (c >> 5), rr = r & 15, cc = c & 31, ob = rr * 64 + cc * 2; return st * 1024 + (ob ^ (((ob >> 9) & 1) << 5)); }
__device__ __forceinline__ void stage_rc(int b, int& R, int& C) { const int st = b / 1024, sb = b % 1024, swz = sb ^ (((sb >> 9) & 1) << 5); R = (st >> 1) * 16 + swz / 64; C = (st & 1) * 32 + (swz % 64) / 2; }
__device__ __forceinline__ int perm32(int rho) { const int n = rho >> 4, i = rho & 15; return 8 * (i >> 2) + 4 * n + (i & 3); }
struct Unit { int pm, pn, ks; };
struct Gemm { const bf16_t* A; const bf16_t* Bt; int M, N, K; int half_pm; int KL; };
struct StaticOrder {
    int nM, nN, nwg, G, c, ntail;
    __device__ void init(int M, int N, int G_, int c_, bool tail = true) { nM = M / BM - 1; nN = N / BM; nwg = nM * nN; G = G_; c = c_; ntail = tail ? nN : 0; }
    __device__ bool next(int i, Unit& u) const {
        u.ks = 0;
        const long L = (long)i * G + c; if (L >= nwg + ntail) return false;
        if (L >= nwg) { u.pm = nM; u.pn = (int)(L - nwg); return true; }
        int wgid = (int)L; { const int q = nwg / NXCD, r = nwg % NXCD, xcd = wgid % NXCD, off = wgid / NXCD; wgid = (xcd < r ? xcd * (q + 1) : r * (q + 1) + (xcd - r) * q) + off; }
        const int nig = WGM * nN, gid = wgid / nig, fm = gid * WGM, gsz = (nM - fm) < WGM ? (nM - fm) : WGM;
        u.pm = fm + ((wgid % nig) % gsz); u.pn = (wgid % nig) / gsz; return true;
    }
};
struct MergeOrder {
    int G, c;
    __device__ bool next(int i, Unit& u) const { const int L = (i / 3) * G + c; if (L >= 129 * 4) return false; const int j = i % 3; u.pm = j * 129 + (L >> 2); u.pn = j * 4 + (L & 3); u.ks = 0; return true; }
};

struct TailOrder { int nS, c;
    __device__ bool next(int i, Unit& u) const { if (i > 0 || c >= 4 * nS) return false; u.pm = c / nS; u.ks = c - u.pm * nS; u.pn = 0; return true; } };

template <class Epi, class Sched>
__device__ __forceinline__ void gemm_phase(LAS unsigned char* lds, const Gemm g, const Sched& S, const Epi& E) {
    const int tid = ltid(), wid = __builtin_amdgcn_readfirstlane(tid >> 6), lane = tid & 63, wr = wid >> 2, wc = wid & 3, fr = lane & 15, fq = lane >> 4;
    const int K = g.K, nt = g.KL / BK;
    unsigned voffA, voffB;
    { int R, C; stage_rc(tid * 16, R, C); const int Rb = Epi::PERM ? ((R & ~31) + perm32(R & 31)) : R;
        voffA = (unsigned)(R * K + C) * 2u; voffB = (unsigned)(Rb * K + C) * 2u; }
    const size_t r64 = (size_t)64 * K * 2;
    const size_t kstep = (size_t)(BK * 2);
    const size_t hstep = (size_t)HALF * K * 2;
    const size_t tstep = 2 * hstep;
    const unsigned ldsw = (unsigned)wid * 1024u;
    const int aoff = lds_byte(wr * 64 + fr, fq * 8), boff = lds_byte(wc * 32 + fr, fq * 8);
#define PG8_SA(b, h) (((b) * 2 + (h)) * HTB)
#define PG8_SB(b, h) ((4 + (b) * 2 + (h)) * HTB)
#define PG8_STAGE(bufoff, gbase, voff) do { _Pragma("unroll") for (int _i = 0; _i < 2; ++_i) \
        __builtin_amdgcn_global_load_lds((const unsigned*)((const char*)(gbase) + _i * r64 + (voff)), (LAS unsigned*)(lds + (bufoff) + ldsw + _i * 8192), 16, 0, 0); } while (0)
#define PG8_LDA(dst, b, h) do { _Pragma("unroll") for (int m = 0; m < 4; ++m) _Pragma("unroll") for (int k = 0; k < 2; ++k) dst[m][k] = *(const LAS bf16x8*)(lds + PG8_SA(b, h) + aoff + m * 2048 + k * 1024); } while (0)
#define PG8_LDB(dst, b, h) do { _Pragma("unroll") for (int n = 0; n < 2; ++n) _Pragma("unroll") for (int k = 0; k < 2; ++k) dst[n][k] = *(const LAS bf16x8*)(lds + PG8_SB(b, h) + boff + n * 2048 + k * 1024); } while (0)
#define PG8_MMA(ai, bj, At, Bt) do { __builtin_amdgcn_s_setprio(1); _Pragma("unroll") for (int m = 0; m < 4; ++m) _Pragma("unroll") for (int n = 0; n < 2; ++n) _Pragma("unroll") for (int k = 0; k < 2; ++k) \
        acc[ai][bj][m][n] = __builtin_amdgcn_mfma_f32_16x16x32_bf16(Bt[n][k], At[m][k], acc[ai][bj][m][n], 0, 0, 0); __builtin_amdgcn_s_setprio(0); } while (0)
#define PG8_WAIT_V(n) asm volatile("s_waitcnt vmcnt(" #n ")" ::: "memory")
#define PG8_WAIT_L(n) asm volatile("s_waitcnt lgkmcnt(" #n ")" ::: "memory")
#define PG8_BAR __builtin_amdgcn_s_barrier()
#define PG8_SCHED __builtin_amdgcn_sched_barrier(0)
    Unit cur, nxt; int ui = 0;
    if (!S.next(0, cur)) return;
    f32x4 acc[2][2][4][2];
#pragma unroll
    for (int a = 0; a < 2; ++a)
#pragma unroll
        for (int b = 0; b < 2; ++b)
#pragma unroll
            for (int m = 0; m < 4; ++m)
#pragma unroll
                for (int n = 0; n < 2; ++n) acc[a][b][m][n] = (f32x4){0.f, 0.f, 0.f, 0.f};
    bf16x8 At[4][2], B0[2][2], B1[2][2];
    const char* cA = (const char*)g.A + (size_t)cur.pm * tstep + (size_t)cur.ks * g.KL * 2; const char* cB = (const char*)g.Bt + (size_t)cur.pn * tstep + (size_t)cur.ks * g.KL * 2;
    PG8_STAGE(PG8_SB(0, 0), cB, voffB); PG8_STAGE(PG8_SB(0, 1), cB + hstep, voffB); PG8_STAGE(PG8_SA(0, 0), cA, voffA); PG8_STAGE(PG8_SA(0, 1), cA + hstep, voffA);
    if (wr == 1) PG8_BAR;
    PG8_WAIT_V(2); PG8_BAR;
    PG8_STAGE(PG8_SB(1, 0), cB + kstep, voffB); PG8_STAGE(PG8_SA(1, 0), cA + kstep, voffA); PG8_STAGE(PG8_SB(1, 1), cB + hstep + kstep, voffB);
    PG8_WAIT_V(6); PG8_BAR;
    for (;;) {
        const bool has_next = S.next(ui + 1, nxt);
        const char* nA = has_next ? (const char*)g.A + (size_t)nxt.pm * tstep + (size_t)nxt.ks * g.KL * 2 : cA; const char* nB = has_next ? (const char*)g.Bt + (size_t)nxt.pn * tstep + (size_t)nxt.ks * g.KL * 2 : cB;
        for (int t = 0; t < nt; t += 2) {
            const bool last = (t == nt - 2);
            const char* a1 = cA + (size_t)(t + 1) * kstep;
            const char* a2 = last ? nA : cA + (size_t)(t + 2) * kstep; const char* b2 = last ? nB : cB + (size_t)(t + 2) * kstep;
            const char* a3 = a2 + kstep; const char* b3 = b2 + kstep;
            PG8_LDB(B0, 0, 0); PG8_LDB(B1, 0, 1); PG8_SCHED; PG8_LDA(At, 0, 0); PG8_STAGE(PG8_SA(1, 1), a1 + hstep, voffA);
            PG8_WAIT_V(8); PG8_WAIT_L(0); PG8_BAR; PG8_MMA(0, 0, At, B0); PG8_MMA(0, 1, At, B1); PG8_BAR; PG8_SCHED;
            PG8_LDA(At, 0, 1); PG8_STAGE(PG8_SB(0, 0), b2, voffB); PG8_STAGE(PG8_SB(0, 1), b2 + hstep, voffB); PG8_STAGE(PG8_SA(0, 0), a2, voffA);
            PG8_WAIT_V(8); PG8_WAIT_L(0); PG8_BAR; PG8_MMA(1, 0, At, B0); PG8_MMA(1, 1, At, B1); PG8_BAR; PG8_SCHED;
            PG8_LDB(B0, 1, 0); PG8_LDB(B1, 1, 1); PG8_SCHED; PG8_LDA(At, 1, 0); PG8_STAGE(PG8_SA(0, 1), a2 + hstep, voffA);
            PG8_WAIT_V(8); PG8_WAIT_L(0); PG8_BAR; PG8_MMA(0, 0, At, B0); PG8_MMA(0, 1, At, B1); PG8_BAR; PG8_SCHED;
            PG8_LDA(At, 1, 1); PG8_STAGE(PG8_SB(1, 0), b3, voffB); PG8_STAGE(PG8_SB(1, 1), b3 + hstep, voffB); PG8_STAGE(PG8_SA(1, 0), a3, voffA);
            PG8_WAIT_V(8); PG8_WAIT_L(0); PG8_BAR; PG8_MMA(1, 0, At, B0); PG8_MMA(1, 1, At, B1); PG8_BAR; PG8_SCHED;
        }
        if (wr == 0) PG8_BAR;
        E(acc, cur, wr, wc, fr, fq);
        if (!has_next) break;
#pragma unroll
        for (int a = 0; a < 2; ++a)
#pragma unroll
            for (int b = 0; b < 2; ++b)
#pragma unroll
                for (int m = 0; m < 4; ++m)
#pragma unroll
                    for (int n = 0; n < 2; ++n) acc[a][b][m][n] = (f32x4){0.f, 0.f, 0.f, 0.f};
        cur = nxt; cA = nA; cB = nB; ++ui;
        if (wr == 1) PG8_BAR;
    }
    PG8_WAIT_V(0);
    PG8_BAR;
#undef PG8_SA
#undef PG8_SB
#undef PG8_STAGE
#undef PG8_LDA
#undef PG8_LDB
#undef PG8_MMA
#undef PG8_WAIT_V
#undef PG8_WAIT_L
#undef PG8_BAR
#undef PG8_SCHED
}

template <int ACT> struct EpiBf16 {
    static constexpr bool PERM = true;
    bf16_t* O; int ldc;
    __device__ __forceinline__ void operator()(const f32x4 (&acc)[2][2][4][2], const Unit& u, int wr, int wc, int fr, int fq) const {
        const int row0 = u.pm * BM + wr * 64 + fr, col0 = u.pn * BM + wc * 32 + 8 * fq;
#pragma unroll
        for (int ai = 0; ai < 2; ++ai)
#pragma unroll
            for (int m = 0; m < 4; ++m) { bf16_t* rowp = O + (size_t)(row0 + ai * HALF + m * 16) * ldc + col0;
#pragma unroll
                for (int bj = 0; bj < 2; ++bj) { f32x4 v0 = acc[ai][bj][m][0], v1 = acc[ai][bj][m][1];
                    if (ACT == 1) {
#pragma unroll
                        for (int j = 0; j < 4; ++j) { v0[j] = sigmoidf_(v0[j]); v1[j] = sigmoidf_(v1[j]); } }
                    u32x4 w; w.x = cvt_pk_bf16(v0[0], v0[1]); w.y = cvt_pk_bf16(v0[2], v0[3]); w.z = cvt_pk_bf16(v1[0], v1[1]); w.w = cvt_pk_bf16(v1[2], v1[3]);
                    *(u32x4*)(rowp + bj * HALF) = w; } }
    }
};
struct EpiSlab {
    static constexpr bool PERM = true;
    float* slab; int nS;
    __device__ __forceinline__ void operator()(const f32x4 (&acc)[2][2][4][2], const Unit& u, int wr, int wc, int fr, int fq) const {
        float* sp = slab + ((size_t)u.ks * 128 + wc * 32 + 8 * fq) * 1024 + u.pm * 256 + wr * 64 + fr;
#pragma unroll
        for (int ai = 0; ai < 2; ++ai)
#pragma unroll
            for (int m = 0; m < 4; ++m) { float* rp = sp + ai * HALF + m * 16;
#pragma unroll
                for (int n = 0; n < 2; ++n)
#pragma unroll
                    for (int j = 0; j < 4; ++j) rp[(size_t)(4 * n + j) * 1024] = acc[ai][0][m][n][j]; }
    }
};
struct EpiSwiglu {
    static constexpr bool PERM = true;
    bf16_t* O;
    __device__ __forceinline__ void operator()(const f32x4 (&acc)[2][2][4][2], const Unit& u, int wr, int wc, int fr, int fq) const {
        const int row0 = u.pm * BM + wr * 64 + fr, col0 = u.pn * 128 + wc * 32 + 8 * fq;
#pragma unroll
        for (int ai = 0; ai < 2; ++ai)
#pragma unroll
            for (int m = 0; m < 4; ++m) { bf16_t* rowp = O + (size_t)(row0 + ai * HALF + m * 16) * DFF + col0;
                const f32x4 a0 = acc[ai][0][m][0], a1 = acc[ai][0][m][1], b0 = acc[ai][1][m][0], b1 = acc[ai][1][m][1];
                float v[8];
#pragma unroll
                for (int j = 0; j < 4; ++j) { v[j] = siluf_(a0[j]) * b0[j]; v[4 + j] = siluf_(a1[j]) * b1[j]; }
                *(u32x4*)rowp = pack8(v); }
    }
};
struct EpiInProj {
    static constexpr bool PERM = true;
    unsigned char* ws;
    __device__ __forceinline__ void operator()(const f32x4 (&acc)[2][2][4][2], const Unit& u, int wr, int wc, int fr, int fq) const {
        const int row0 = u.pm * BM + wr * 64 + fr, pn = u.pn;
        if (pn == 18) {
            if (wc == 0 && fq < 2) { float* Lg = (float*)(ws + S_LOGIT);
#pragma unroll
                for (int ai = 0; ai < 2; ++ai)
#pragma unroll
                    for (int m = 0; m < 4; ++m) { float* rp = Lg + (size_t)(row0 + ai * HALF + m * 16) * 16 + 8 * fq; *(f32x4*)rp = acc[ai][0][m][0]; *(f32x4*)(rp + 4) = acc[ai][0][m][1]; } }
            return; }
        bf16_t* base; int ld, cb;
        if (pn < 4) { base = (bf16_t*)(ws + O_PQ); ld = 1024; cb = pn * 256; }
        else if (pn < 10) { base = (bf16_t*)(ws + O_SC); ld = 1536; cb = (pn - 4) * 256; }
        else if (pn < 16) { base = (bf16_t*)(ws + O_QKV); ld = 1536; cb = (pn - 10) * 256; }
        else { base = (bf16_t*)(ws + O_Z); ld = 512; cb = (pn - 16) * 256; }
        const int col0 = cb + wc * 32 + 8 * fq;
#pragma unroll
        for (int ai = 0; ai < 2; ++ai)
#pragma unroll
            for (int m = 0; m < 4; ++m) { bf16_t* rowp = base + (size_t)(row0 + ai * HALF + m * 16) * ld + col0;
#pragma unroll
                for (int bj = 0; bj < 2; ++bj) { const f32x4 v0 = acc[ai][bj][m][0], v1 = acc[ai][bj][m][1];
                    u32x4 w; w.x = cvt_pk_bf16(v0[0], v0[1]); w.y = cvt_pk_bf16(v0[2], v0[3]); w.z = cvt_pk_bf16(v1[0], v1[1]); w.w = cvt_pk_bf16(v1[2], v1[3]);
                    *(u32x4*)(rowp + bj * HALF) = w; } }
    }
};
struct EpiFourier {
    static constexpr bool PERM = true;
    bf16_t* FM; float sc;
    __device__ __forceinline__ void operator()(const f32x4 (&acc)[2][2][4][2], const Unit& u, int wr, int wc, int fr, int fq) const {
        const int row0 = u.pm * BM + wr * 64 + fr;
        const int colt = u.pn * BM;
        const int b = colt >> 13, k1 = (colt >> 9) & 15, ch0 = (colt & 511) + wc * 32 + 8 * fq;
#pragma unroll
        for (int ai = 0; ai < 2; ++ai)
#pragma unroll
            for (int m = 0; m < 4; ++m) { const int k2 = row0 + ai * HALF + m * 16;
                if (k2 < 257) { bf16_t* rowp = FM + (size_t)(b * LL + k1 + 16 * k2) * 512 + ch0;
#pragma unroll
                    for (int bj = 0; bj < 2; ++bj) { const f32x4 v0 = acc[ai][bj][m][0] * sc, v1 = acc[ai][bj][m][1] * sc;
                        u32x4 w; w.x = cvt_pk_bf16(v0[0], v0[1]); w.y = cvt_pk_bf16(v0[2], v0[3]); w.z = cvt_pk_bf16(v1[0], v1[1]); w.w = cvt_pk_bf16(v1[2], v1[3]);
                        *(u32x4*)(rowp + bj * HALF) = w; } } }
    }
};
struct EpiMerge {
    static constexpr bool PERM = true;
    const bf16_t* GATE; bf16_t* MG; bf16_t* MGB;
    __device__ __forceinline__ void operator()(const f32x4 (&acc)[2][2][4][2], const Unit& u, int wr, int wc, int fr, int fq) const {
        const int j = u.pm / 129, pm = u.pm - j * 129, pn = u.pn & 3;
        const int row0 = pm * BM + wr * 64 + fr, col0 = pn * BM + wc * 32 + 8 * fq;
        const bf16_t* mold = (j == 1 ? MG : MGB); bf16_t* mnew = (j == 1 ? MGB : MG);
#pragma unroll
        for (int ai = 0; ai < 2; ++ai) {
            u32x4 gv[4][2], ov[4][2];
#pragma unroll
            for (int m = 0; m < 4; ++m)
#pragma unroll
                for (int bj = 0; bj < 2; ++bj) { const size_t r = (size_t)(row0 + ai * HALF + m * 16);
                    gv[m][bj] = *(const u32x4*)(GATE + r * 3072 + j * 1024 + col0 + bj * HALF);
                    if (j > 0) ov[m][bj] = *(const u32x4*)(mold + r * 1024 + col0 + bj * HALF); }
#pragma unroll
            for (int m = 0; m < 4; ++m)
#pragma unroll
                for (int bj = 0; bj < 2; ++bj) { const size_t r = (size_t)(row0 + ai * HALF + m * 16);
                    float g[8], v[8]; unpack8(gv[m][bj], g);
                    const f32x4 v0 = acc[ai][bj][m][0], v1 = acc[ai][bj][m][1];
#pragma unroll
                    for (int e = 0; e < 4; ++e) { v[e] = v0[e] * g[e]; v[4 + e] = v1[e] * g[4 + e]; }
                    if (j > 0) { float o[8]; unpack8(ov[m][bj], o);
#pragma unroll
                        for (int e = 0; e < 8; ++e) v[e] += o[e]; }
                    *(u32x4*)(mnew + r * 1024 + col0 + bj * HALF) = pack8(v); }
            asm volatile("" ::: "memory"); }
    }
};
}

__device__ void rpass(const Params& P, const bf16_t* Y, bool first_h, const float* gpost, float scale, const float* gpre, bf16_t* XN, const float* slab = nullptr, int nS = 0) {
    const int tid_ = ltid(); const int wave = __builtin_amdgcn_readfirstlane(tid_ >> 6), lane = tid_ & 63;
    float* hm = (float*)(P.ws + S_HM);
    for (int r = lbid() * 8 + wave; r < TT; r += lgrid() * 8) {
        const int b = r / LL, n = r - b * LL;
        const float* hin; float* hout;
        if (n < NMETA) { hout = hm + (size_t)(b * 16 + n) * 1024; hin = first_h ? P.in[1] + (size_t)n * 1024 : hout; }
        else { const size_t o = ((size_t)b * SEQ + (n - NMETA)) * 1024; hout = P.out + o; hin = first_h ? P.in[0] + o : hout; }
        float h[16];
        { const f32x4 a = *(const f32x4*)(hin + lane * 8), b4 = *(const f32x4*)(hin + lane * 8 + 4), c = *(const f32x4*)(hin + 512 + lane * 8), d = *(const f32x4*)(hin + 512 + lane * 8 + 4);
#pragma unroll
          for (int e = 0; e < 4; ++e) { h[e] = a[e]; h[4 + e] = b4[e]; h[8 + e] = c[e]; h[12 + e] = d[e]; } }
        if (Y) {
            float y[16];
            if (slab != nullptr && r >= 32768) {
                const float* sp = slab + (size_t)(r - 32768) * 1024 + lane * 8;
                f32x4 s0 = {0.f, 0.f, 0.f, 0.f}, s1 = s0, s2 = s0, s3 = s0;
#pragma unroll 1
                for (int ks = 0; ks < nS; ++ks) { s0 += *(const f32x4*)sp; s1 += *(const f32x4*)(sp + 4); s2 += *(const f32x4*)(sp + 512); s3 += *(const f32x4*)(sp + 516); sp += 131072; }
#pragma unroll
                for (int e = 0; e < 4; ++e) { y[e] = s0[e]; y[4 + e] = s1[e]; y[8 + e] = s2[e]; y[12 + e] = s3[e]; }
            } else { unpack8(*(const u32x4*)(Y + (size_t)r * 1024 + lane * 8), y); unpack8(*(const u32x4*)(Y + (size_t)r * 1024 + 512 + lane * 8), y + 8); }
            float ss = 0.f;
#pragma unroll
            for (int e = 0; e < 16; ++e) ss += y[e] * y[e];
            ss = wave_sum(ss); const float r1 = rsqrtf(ss * (1.0f / 1024.0f) + EPS) * scale;
#pragma unroll
            for (int e = 0; e < 8; ++e) { h[e] += y[e] * r1 * gpost[lane * 8 + e]; h[8 + e] += y[8 + e] * r1 * gpost[512 + lane * 8 + e]; }
            *(f32x4*)(hout + lane * 8) = (f32x4){h[0], h[1], h[2], h[3]}; *(f32x4*)(hout + lane * 8 + 4) = (f32x4){h[4], h[5], h[6], h[7]};
            *(f32x4*)(hout + 512 + lane * 8) = (f32x4){h[8], h[9], h[10], h[11]}; *(f32x4*)(hout + 512 + lane * 8 + 4) = (f32x4){h[12], h[13], h[14], h[15]};
        }
        if (gpre) {
            float ss = 0.f;
#pragma unroll
            for (int e = 0; e < 16; ++e) ss += h[e] * h[e];
            ss = wave_sum(ss); const float r2 = rsqrtf(ss * (1.0f / 1024.0f) + EPS);
            float o[16];
#pragma unroll
            for (int e = 0; e < 8; ++e) { o[e] = h[e] * r2 * gpre[lane * 8 + e]; o[8 + e] = h[8 + e] * r2 * gpre[512 + lane * 8 + e]; }
            *(u32x4*)(XN + (size_t)r * 1024 + lane * 8) = pack8(o); *(u32x4*)(XN + (size_t)r * 1024 + 512 + lane * 8) = pack8(o + 8);
        }
    }
}

template <class F>
__device__ void cvt_tiles(const float* src, int ld_src, int K, bf16_t* dst, int nrows, F srccol, unsigned char* smem) {
    float* lds = (float*)smem; const int tid = ltid();
    const int ntr = nrows / 64, ntk = K / 64, nt_ = ntr * ntk, G_ = lgrid();
    float pv[8];
    { const int t = lbid(); if (t < nt_) { const int tr = t % ntr, tk = t / ntr; const int c0 = srccol(tr * 64);
#pragma unroll
        for (int i = 0; i < 8; ++i) { const int kk = (tid >> 6) + 8 * i, cc = tid & 63; pv[i] = src[(size_t)(tk * 64 + kk) * ld_src + c0 + cc]; } } }
    for (int t = lbid(); t < nt_; t += G_) {
        const int tr = t % ntr, tk = t / ntr;
        __syncthreads();
#pragma unroll
        for (int i = 0; i < 8; ++i) { const int kk = (tid >> 6) + 8 * i, cc = tid & 63; lds[kk * 65 + cc] = pv[i]; }
        __syncthreads();
        { const int t2 = t + G_; if (t2 < nt_) { const int tr2 = t2 % ntr, tk2 = t2 / ntr; const int c2 = srccol(tr2 * 64);
#pragma unroll
            for (int i = 0; i < 8; ++i) { const int kk = (tid >> 6) + 8 * i, cc = tid & 63; pv[i] = src[(size_t)(tk2 * 64 + kk) * ld_src + c2 + cc]; } } }
        const int cc2 = tid >> 3, k8 = (tid & 7) * 8; float v[8];
#pragma unroll
        for (int e = 0; e < 8; ++e) v[e] = lds[(k8 + e) * 65 + cc2];
        *(u32x4*)(dst + (size_t)(tr * 64 + cc2) * K + tk * 64 + k8) = pack8(v);
    }
}
struct ColIdent { int off; __device__ int operator()(int r) const { return r + off; } };
struct ColSwiglu { __device__ int operator()(int r) const { const int pn = r >> 8, rem = r & 255; return (rem >> 7) * DFF + 128 * pn + (rem & 127); } };

__device__ void convert_weights(const Params& P, int l, unsigned char* smem) {
    unsigned char* ws = P.ws; const int tid = ltid();
    cvt_tiles(P.in[3] + (size_t)l * 1024 * 5632, 5632, 1024, (bf16_t*)(ws + W_WI1), 5632, ColSwiglu{}, smem);
    cvt_tiles(P.in[4] + (size_t)l * 2816 * 1024, 1024, 2816, (bf16_t*)(ws + W_WO1), 1024, ColIdent{0}, smem);
    cvt_tiles(P.in[5] + (size_t)l * 1024 * 5632, 5632, 1024, (bf16_t*)(ws + W_WI2), 5632, ColSwiglu{}, smem);
    cvt_tiles(P.in[6] + (size_t)l * 2816 * 1024, 1024, 2816, (bf16_t*)(ws + W_WO2), 1024, ColIdent{0}, smem);
    const float* win = P.in[7] + (size_t)l * 1024 * NIN;
    cvt_tiles(win, NIN, 1024, (bf16_t*)(ws + W_WIN) + (size_t)1024 * 1024, 3584, ColIdent{512}, smem);
    cvt_tiles(win, NIN, 1024, (bf16_t*)(ws + W_WG), 3072, ColIdent{4112}, smem);
    cvt_tiles(P.in[13] + (size_t)l * 512 * 1024, 1024, 512, (bf16_t*)(ws + W_WBR), 1024, ColIdent{0}, smem);
    cvt_tiles(P.in[14] + (size_t)l * 512 * 1024, 1024, 512, (bf16_t*)(ws + W_WBR) + (size_t)1024 * 512, 1024, ColIdent{0}, smem);
    cvt_tiles(P.in[15] + (size_t)l * 512 * 1024, 1024, 512, (bf16_t*)(ws + W_WBR) + (size_t)2048 * 512, 1024, ColIdent{0}, smem);
    cvt_tiles(P.in[16] + (size_t)l * 1024 * 1024, 1024, 1024, (bf16_t*)(ws + W_WOUT), 1024, ColIdent{0}, smem);
    { bf16_t* d = (bf16_t*)(ws + W_WIN) + (size_t)4608 * 1024;
      for (int i = lbid() * 512 + tid; i < 256 * 1024; i += lgrid() * 512) { const int rr = i >> 10, k = i & 1023; d[i] = rr < 16 ? f2bf(win[(size_t)k * NIN + 4096 + rr]) : (bf16_t)0; } }
    { float* Ws = (float*)smem; float* ct = Ws + 64 * 65; float* st = ct + 64;
      __syncthreads();
      if (tid < 64) { float s, c; sincospif((float)tid * (2.0f / 64.0f), &s, &c); ct[tid] = c; st[tid] = s; }
      bf16_t* dp = (bf16_t*)(ws + W_WIN); bf16_t* dq = dp + (size_t)512 * 1024;
      for (int it = lbid(); it < 8 * 16; it += lgrid()) { const int g = it >> 4, kt = it & 15;
          __syncthreads();
#pragma unroll
          for (int i = 0; i < 8; ++i) { const int kk = (tid >> 6) + 8 * i, cc = tid & 63; Ws[kk * 65 + cc] = win[(size_t)(kt * 64 + kk) * NIN + g * 64 + cc]; }
          __syncthreads();
          const int kk = tid & 63;
#pragma unroll 1
          for (int i = 0; i < 8; ++i) { const int cp = (tid >> 6) + 8 * i; float ap = 0.f, aq = 0.f;
#pragma unroll 4
              for (int c = 0; c < 64; ++c) { const float w = Ws[kk * 65 + c]; const int ph = (c * cp) & 63; ap += w * ct[ph]; aq += w * st[ph]; }
              dp[(size_t)(g * 64 + cp) * 1024 + kt * 64 + kk] = f2bf(ap); dq[(size_t)(g * 64 + cp) * 1024 + kt * 64 + kk] = f2bf(aq); }
      }
      __syncthreads(); }
}

__device__ void gen_tables(const Params& P) {
    unsigned char* ws = P.ws; const int gt = lbid() * 512 + ltid(), gs = lgrid() * 512;
    bf16_t* C = (bf16_t*)(ws + S_C257);
    for (int i = gt; i < 512 * KF; i += gs) { const int k2 = i / KF, kk = i - k2 * KF; const int ri = kk >= 320, n2 = kk - ri * 320; float v = 0.f;
        if (k2 < 257 && n2 < 257) { const int m = (k2 * n2) % 257; float s, c; sincospif((float)m * (2.0f / 257.0f), &s, &c); v = ri ? s : c; }
        C[i] = f2bf(v); }
    float* tw = (float*)(ws + S_TWL);
    for (int i = gt; i < LL; i += gs) { float s, c; sincospif((float)i * (2.0f / (float)LL), &s, &c); tw[2 * i] = c; tw[2 * i + 1] = -s; }
}

__device__ void sconv_pass(const Params& P, int l) {
    const int tid_ = ltid(); const int wave = __builtin_amdgcn_readfirstlane(tid_ >> 6), lane = tid_ & 63;
    const bf16_t* SC = (const bf16_t*)(P.ws + O_SC); bf16_t* SCO = (bf16_t*)(P.ws + O_BR) + (size_t)TP * 512;
    const float* w = P.in[8] + (size_t)l * 3 * 512;
    float w0[8], w1[8], w2[8];
#pragma unroll
    for (int e = 0; e < 8; ++e) { w0[e] = w[lane * 8 + e]; w1[e] = w[512 + lane * 8 + e]; w2[e] = w[1024 + lane * 8 + e]; }
    for (int r = lbid() * 8 + wave; r < TT; r += lgrid() * 8) {
        const int b = r / LL, n = r - b * LL; const bf16_t* rp = SC + (size_t)r * 1536 + lane * 8;
        float bb[8], c[8], h[8], acc[8]; unpack8(*(const u32x4*)rp, bb); unpack8(*(const u32x4*)(rp + 512), c); unpack8(*(const u32x4*)(rp + 1024), h);
#pragma unroll
        for (int e = 0; e < 8; ++e) acc[e] = w1[e] * c[e] * h[e];
        if (n > 0) { unpack8(*(const u32x4*)(rp - 1536 + 512), c); unpack8(*(const u32x4*)(rp - 1536 + 1024), h);
#pragma unroll
            for (int e = 0; e < 8; ++e) acc[e] += w0[e] * c[e] * h[e]; }
        if (n < LL - 1) { unpack8(*(const u32x4*)(rp + 1536 + 512), c); unpack8(*(const u32x4*)(rp + 1536 + 1024), h);
#pragma unroll
            for (int e = 0; e < 8; ++e) acc[e] += w2[e] * c[e] * h[e]; }
#pragma unroll
        for (int e = 0; e < 8; ++e) acc[e] *= bb[e];
        *(u32x4*)(SCO + (size_t)r * 512 + lane * 8) = pack8(acc);
    }
}

__device__ void fstep1(const Params& P, unsigned char* smem) {
    const int tid = ltid(), wave = __builtin_amdgcn_readfirstlane(tid >> 6), lane = tid & 63;
    const bf16_t* PQ = (const bf16_t*)(P.ws + O_PQ); bf16_t* AP = (bf16_t*)(P.ws + O_AP); const float* tw = (const float*)(P.ws + S_TWL);
    bf16_t* St = (bf16_t*)smem;
    for (int it = lbid(); it < 8 * 4 * 17; it += lgrid()) {
        const int b = it / 68, rem = it - b * 68, cht = rem / 17, n2t = rem - cht * 17;
        __syncthreads();
#pragma unroll 1
        for (int sub = 0; sub < 2; ++sub) {
            const int n2l = sub * 8 + wave, n2 = n2t * 16 + n2l;
            const int fr = lane & 15, fq = lane >> 4;
            if (n2 < 257) {
                float f0[8], f1[8];
#pragma unroll
                for (int j = 0; j < 8; ++j) { const int n = 257 * (8 * (fq & 1) + j) + n2; const int ph = (fr * n) % LL;
                    const float2 cs_ = *(const float2*)(tw + 2 * ph); const float c_ = cs_.x, ms_ = cs_.y;
                    f0[j] = (fq < 2) ? c_ : ms_; f1[j] = (fq < 2) ? ms_ : -c_; }
                const bf16x8 a0 = __builtin_bit_cast(bf16x8, pack8(f0)), a1 = __builtin_bit_cast(bf16x8, pack8(f1));
                const bf16_t* bp = PQ + (size_t)(b * LL + 257 * 8 * (fq & 1) + n2) * 1024 + (fq >> 1) * 512 + cht * 128 + fr;
#pragma unroll
                for (int ct = 0; ct < 8; ++ct) {
                    bf16x8 bf;
#pragma unroll
                    for (int j = 0; j < 8; ++j) bf[j] = (short)bp[(size_t)j * 257 * 1024 + ct * 16];
                    const f32x4 z = {0.f, 0.f, 0.f, 0.f};
                    const f32x4 c0 = __builtin_amdgcn_mfma_f32_16x16x32_bf16(a0, bf, z, 0, 0, 0), c1 = __builtin_amdgcn_mfma_f32_16x16x32_bf16(a1, bf, z, 0, 0, 0);
                    bf16_t* sp = St + ((4 * fq) * 128 + ct * 16 + fr) * 32 + n2l;
#pragma unroll
                    for (int rg = 0; rg < 4; ++rg) { sp[rg * 4096] = f2bf(c0[rg]); sp[rg * 4096 + 16] = f2bf(c1[rg]); }
                }
            } else {
                for (int q = lane; q < 4096; q += 64) St[q * 16 + n2l] = 0;
            }
        }
        __syncthreads();
#pragma unroll 2
        for (int q = tid; q < 8192; q += 512) { const int half = q & 1, ri = (q >> 1) & 1, chl = (q >> 2) & 127, k1 = q >> 9;
            const int n2c = n2t * 16 + half * 8;
            if (n2c < 320) { const u32x4 v = *(const u32x4*)(St + (size_t)q * 8);
                *(u32x4*)(AP + ((size_t)((b * 16 + k1) * 512 + cht * 128 + chl)) * KF + ri * 320 + n2c) = v; } }
        if (n2t == 16) {
            for (int q = tid; q < 16 * 128 * 2 * 6; q += 512) { const int c6 = q % 6, r2 = q / 6, ri = r2 & 1, chl = (r2 >> 1) & 127, k1 = r2 >> 8;
                *(u32x4*)(AP + ((size_t)((b * 16 + k1) * 512 + cht * 128 + chl)) * KF + ri * 320 + 272 + c6 * 8) = (u32x4){0u, 0u, 0u, 0u}; } }
    }
    __syncthreads();
}

#ifdef DBG_SEC
#define SEC_T(k) do { if (lbid() == 0 && tid == 0) { const unsigned long long _n = __builtin_amdgcn_s_memrealtime(); if (sec_prev_k == DBG_SEC) *(unsigned long long*)(smem + LDS_BYTES - 32) += _n - sec_prev_t; sec_prev_t = _n; sec_prev_k = (k); } } while (0)
#else
#define SEC_T(k) do {} while (0)
#endif
__device__ void dn_prep(const Params& P, int l, unsigned char* smem, int t0, int t1) {
#ifdef DBG_SEC
    unsigned long long sec_prev_t = __builtin_amdgcn_s_memrealtime(); int sec_prev_k = -1;
#endif
    const int tid = ltid(), wave = __builtin_amdgcn_readfirstlane(tid >> 6), lane = tid & 63, fr = lane & 15, fq = lane >> 4;
    unsigned char* ws = P.ws;
    const bf16_t* QKV = (const bf16_t*)(ws + O_QKV); const float* LG = (const float*)(ws + S_LOGIT);
    bf16_t* WP = (bf16_t*)(ws + O_WP); bf16_t* QP = (bf16_t*)(ws + O_QP); bf16_t* KD = (bf16_t*)(ws + O_KD); bf16_t* UF = (bf16_t*)(ws + O_UF); bf16_t* AT = (bf16_t*)(ws + O_AT);
    float* GL = (float*)(ws + S_GL);
    const float* cw = P.in[9] + (size_t)l * 3 * 1536;
    bf16_t* Qs = (bf16_t*)smem;
    bf16_t* Ks = Qs + 64 * 136;
    bf16_t* KT = Ks + 64 * 136;
    bf16_t* VT = KT + 128 * 72;
    bf16_t* T1 = VT + 128 * 72;
    bf16_t* T2 = T1 + 64 * 72;
    bf16_t* Rm = T2 + 64 * 72;
    bf16_t* Rt = Rm + 64 * 72;
    bf16_t* Pm = Rt + 64 * 72;
    float* gcs = (float*)(T2 + 64 * 72 + 2 * 64 * 68 * 2);
    float* bts = gcs + 64;
    float* cwl = bts + 64;
    bf16_t* Xr = T1;
    const int items = (t1 - t0) * 64;
    u32x4 x0[6], xb;
#define PREP_ISSUE(it_) do { const int _tl = (it_) >> 6, _bhd = (it_) & 63, _b = _bhd >> 3, _h = (_bhd >> 1) & 3, _dir = _bhd & 1; const int _nb = (_dir ? 64 - (t0 + _tl) : (t0 + _tl)) * 64 - 48; const u32x4 z4 = {0u, 0u, 0u, 0u}; \
        _Pragma("unroll") for (int rr = 0; rr < 6; ++rr) { const int task = tid + 512 * rr, i = task / 48, cg_ = task - i * 48; const int n = _nb + (_dir ? 63 - i : i); \
            x0[rr] = (n >= 0) ? *(const u32x4*)(QKV + (size_t)(_b * LL + n) * 1536 + (cg_ >> 4) * 512 + _h * 128 + (cg_ & 15) * 8) : z4; } \
        xb = z4; if (tid < 96) { const int which = tid / 48, cg_ = tid - which * 48; const int n = which ? _nb + 64 : _nb - 1; \
            if (n >= 0 && n < LL) xb = *(const u32x4*)(QKV + (size_t)(_b * LL + n) * 1536 + (cg_ >> 4) * 512 + _h * 128 + (cg_ & 15) * 8); } } while (0)
    for (int it = lbid(); it < items; it += lgrid()) {
        const int tl = it >> 6, bhd = it & 63, b = bhd >> 3, h = (bhd >> 1) & 3, dir = bhd & 1;
        const int t = t0 + tl, c = dir ? 64 - t : t; const size_t slot = (size_t)tl * 64 + bhd;
        PREP_ISSUE(it);
        __syncthreads();
        SEC_T(0);
        for (int q = tid; q < 1152; q += 512) { const int tap = q / 384, rem = q - tap * 384; cwl[q] = cw[tap * 1536 + (rem >> 7) * 512 + h * 128 + (rem & 127)]; }
#pragma unroll
        for (int rr = 0; rr < 6; ++rr) { const int task = tid + 512 * rr, i = task / 48, cg_ = task - i * 48; *(u32x4*)(Xr + ((dir ? 63 - i : i) + 1) * 384 + cg_ * 8) = x0[rr]; }
        if (tid < 96) { const int which = tid / 48, cg_ = tid - which * 48; *(u32x4*)(Xr + (which ? 65 : 0) * 384 + cg_ * 8) = xb; }
        __syncthreads();
#pragma unroll 1
        for (int rr = 0; rr < 6; ++rr) {
            const int task = tid + 512 * rr, i = task / 48, cg_ = task - i * 48, kind = cg_ >> 4, cgl = cg_ & 15;
            float v[8], x[8];
            const float* w1 = cwl + 384 + kind * 128 + cgl * 8;
            const bf16_t* xr = Xr + ((dir ? 63 - i : i) + 1) * 384 + cg_ * 8;
            unpack8(*(const u32x4*)xr, x);
#pragma unroll
            for (int e = 0; e < 8; ++e) v[e] = w1[e] * x[e];
            unpack8(*(const u32x4*)(xr - 384), x);
#pragma unroll
            for (int e = 0; e < 8; ++e) v[e] += w1[e - 384] * x[e];
            unpack8(*(const u32x4*)(xr + 384), x);
#pragma unroll
            for (int e = 0; e < 8; ++e) v[e] += w1[e + 384] * x[e];
#pragma unroll
            for (int e = 0; e < 8; ++e) v[e] = siluf_(v[e]);
            float ss = 0.f;
#pragma unroll
            for (int e = 0; e < 8; ++e) ss += v[e] * v[e];
            ss += __shfl_xor(ss, 1); ss += __shfl_xor(ss, 2); ss += __shfl_xor(ss, 4); ss += __shfl_xor(ss, 8);
            if (kind < 2) { const float inv = rsqrtf(ss + EPS) * (kind == 0 ? 0.08838834764831845f : 1.0f);
#pragma unroll
                for (int e = 0; e < 8; ++e) v[e] *= inv; }
            const u32x4 pk = pack8(v);
            const int isw = i ^ ((cgl & 7) << 3);
            if (kind == 0) *(u32x4*)(Qs + i * 136 + cgl * 8) = pk;
            else if (kind == 1) { *(u32x4*)(Ks + i * 136 + cgl * 8) = pk;
#pragma unroll
                for (int e = 0; e < 8; ++e) KT[(cgl * 8 + e) * 72 + isw] = f2bf(v[e]); }
            else {
#pragma unroll
                for (int e = 0; e < 8; ++e) VT[(cgl * 8 + e) * 72 + isw] = f2bf(v[e]); }
        }
        if (wave == 0) {
            const int i = lane, n = c * 64 + (dir ? 63 - i : i) - 48; float beta = 0.f, g = 0.f;
            if (n >= 0) { const float* lg = LG + (size_t)(b * LL + n) * 16; const float bl = lg[dir * 4 + h], al = lg[8 + dir * 4 + h];
                beta = 1.0f / (1.0f + expf(-bl));
                const float xx = al + P.in[11][l * 8 + dir * 4 + h]; const float sp = xx > 20.f ? xx : log1pf(expf(xx));
                g = -expf(P.in[10][l * 8 + dir * 4 + h]) * sp; }
#pragma unroll
            for (int o = 1; o < 64; o <<= 1) { const float tt = __shfl_up(g, o); if (lane >= o) g += tt; }
            gcs[i] = g; bts[i] = beta;
        }
        __syncthreads();
        SEC_T(1);
        if (wave < 4) {
            const int m = wave; f32x4 acc[4];
#pragma unroll
            for (int n = 0; n < 4; ++n) acc[n] = (f32x4){0.f, 0.f, 0.f, 0.f};
#pragma unroll
            for (int s = 0; s < 4; ++s) { const bf16x8 a = *(const bf16x8*)(Ks + (16 * m + fr) * 136 + 32 * s + 8 * fq);
#pragma unroll
                for (int n = 0; n < 4; ++n) { const bf16x8 bb = *(const bf16x8*)(Ks + (16 * n + fr) * 136 + 32 * s + 8 * fq); acc[n] = __builtin_amdgcn_mfma_f32_16x16x32_bf16(a, bb, acc[n], 0, 0, 0); } }
#pragma unroll
            for (int n = 0; n < 4; ++n) { const int i = 16 * n + fr, j0 = 16 * m + 4 * fq;
                float nv[4], pv_[4];
#pragma unroll
                for (int rg = 0; rg < 4; ++rg) { const int j = j0 + rg; const float mv = (i > j) ? bts[i] * acc[n][rg] * __expf(gcs[i] - gcs[j]) : 0.f;
                    nv[rg] = -mv; pv_[rg] = (i == j ? 1.f : 0.f) - mv; Rt[j * 72 + i] = f2bf(-mv); }
                u32x2 w; w.x = cvt_pk_bf16(nv[0], nv[1]); w.y = cvt_pk_bf16(nv[2], nv[3]); *(u32x2*)(Rm + i * 72 + j0) = w;
                w.x = cvt_pk_bf16(pv_[0], pv_[1]); w.y = cvt_pk_bf16(pv_[2], pv_[3]); *(u32x2*)(Pm + i * 72 + j0) = w; }
        } else {
            const int m = wave - 4; f32x4 acc[4];
#pragma unroll
            for (int n = 0; n < 4; ++n) acc[n] = (f32x4){0.f, 0.f, 0.f, 0.f};
#pragma unroll
            for (int s = 0; s < 4; ++s) { const bf16x8 qf = *(const bf16x8*)(Qs + (16 * m + fr) * 136 + 32 * s + 8 * fq);
#pragma unroll
                for (int n = 0; n < 4; ++n) { const bf16x8 kf = *(const bf16x8*)(Ks + (16 * n + fr) * 136 + 32 * s + 8 * fq); acc[n] = __builtin_amdgcn_mfma_f32_16x16x32_bf16(kf, qf, acc[n], 0, 0, 0); } }
            const int i = 16 * m + fr; const float gi = gcs[i];
#pragma unroll
            for (int s2 = 0; s2 < 2; ++s2) { float v[8];
#pragma unroll
                for (int e = 0; e < 8; ++e) { const int j = 32 * s2 + 16 * (e >> 2) + 4 * fq + (e & 3); v[e] = (i >= j) ? acc[2 * s2 + (e >> 2)][e & 3] * __expf(gi - gcs[j]) : 0.f; }
                *(u32x4*)(AT + slot * 4096 + i * 64 + (((4 * s2 + fq) ^ ((i >> 1) & 7)) << 3)) = pack8(v); }
        }
        __syncthreads();
        SEC_T(2);
        {
            const float glast = gcs[63];
            for (int task = tid; task < 2048; task += 512) {
                if (task < 1024) { const int i = task >> 4, s_ = (task >> 2) & 3, f4 = task & 3; const float sc = __expf(gcs[i]);
                    const u32x2 a = *(const u32x2*)(Qs + i * 136 + 32 * s_ + 4 * f4), bq = *(const u32x2*)(Qs + i * 136 + 32 * s_ + 16 + 4 * f4);
                    float v[8]; v[0] = bf2f(a.x & 0xffffu) * sc; v[1] = __uint_as_float(a.x & 0xffff0000u) * sc; v[2] = bf2f(a.y & 0xffffu) * sc; v[3] = __uint_as_float(a.y & 0xffff0000u) * sc;
                    v[4] = bf2f(bq.x & 0xffffu) * sc; v[5] = __uint_as_float(bq.x & 0xffff0000u) * sc; v[6] = bf2f(bq.y & 0xffffu) * sc; v[7] = __uint_as_float(bq.y & 0xffff0000u) * sc;
                    *(u32x4*)(QP + slot * 8192 + i * 128 + (((4 * s_ + f4) ^ (i & 15)) << 3)) = pack8(v);
                } else { const int tt = task - 1024, dk = tt >> 3, s2 = (tt >> 2) & 1, f4 = tt & 3; const int i0 = 32 * s2 + 4 * f4;
                    const int sw = ((dk >> 3) & 7) << 3; const u32x2 a = *(const u32x2*)(KT + dk * 72 + (i0 ^ sw)), bq = *(const u32x2*)(KT + dk * 72 + ((i0 + 16) ^ sw));
                    float v[8]; v[0] = bf2f(a.x & 0xffffu) * __expf(glast - gcs[i0]); v[1] = __uint_as_float(a.x & 0xffff0000u) * __expf(glast - gcs[i0 + 1]);
                    v[2] = bf2f(a.y & 0xffffu) * __expf(glast - gcs[i0 + 2]); v[3] = __uint_as_float(a.y & 0xffff0000u) * __expf(glast - gcs[i0 + 3]);
                    v[4] = bf2f(bq.x & 0xffffu) * __expf(glast - gcs[i0 + 16]); v[5] = __uint_as_float(bq.x & 0xffff0000u) * __expf(glast - gcs[i0 + 17]);
                    v[6] = bf2f(bq.y & 0xffffu) * __expf(glast - gcs[i0 + 18]); v[7] = __uint_as_float(bq.y & 0xffff0000u) * __expf(glast - gcs[i0 + 19]);
                    *(u32x4*)(KD + slot * 8192 + dk * 64 + (((4 * s2 + f4) ^ ((dk >> 1) & 7)) << 3)) = pack8(v); }
            }
            if (tid == 0) GL[slot] = __expf(glast);
            f32x4 accP[2];
#pragma unroll
            for (int e = 0; e < 2; ++e) { const int tt = 2 * wave + e, it_ = tt >> 2, jt = tt & 3;
                const u32x2 pw = *(const u32x2*)(Pm + (16 * it_ + fr) * 72 + 16 * jt + 4 * fq);
                accP[e] = (f32x4){__uint_as_float(pw.x << 16), __uint_as_float(pw.x & 0xffff0000u), __uint_as_float(pw.y << 16), __uint_as_float(pw.y & 0xffff0000u)}; }
#pragma unroll 1
            for (int rd = 0; rd < 6; ++rd) {
                f32x4 accR[2], accT[2];
#pragma unroll
                for (int e = 0; e < 2; ++e) { const int tt = 2 * wave + e, mt = tt >> 2, nt = tt & 3;
                    accR[e] = (f32x4){0.f, 0.f, 0.f, 0.f}; accT[e] = (f32x4){0.f, 0.f, 0.f, 0.f};
#pragma unroll
                    for (int s2 = 0; s2 < 2; ++s2) {
                        const bf16x8 rm = *(const bf16x8*)(Rm + (16 * mt + fr) * 72 + 32 * s2 + 8 * fq), rn = *(const bf16x8*)(Rm + (16 * nt + fr) * 72 + 32 * s2 + 8 * fq);
                        const bf16x8 tm = *(const bf16x8*)(Rt + (16 * mt + fr) * 72 + 32 * s2 + 8 * fq), tn = *(const bf16x8*)(Rt + (16 * nt + fr) * 72 + 32 * s2 + 8 * fq);
                        const bf16x8 pm_ = *(const bf16x8*)(Pm + (16 * mt + fr) * 72 + 32 * s2 + 8 * fq);
                        if (rd < 5) { accR[e] = __builtin_amdgcn_mfma_f32_16x16x32_bf16(rm, tn, accR[e], 0, 0, 0);
                                      accT[e] = __builtin_amdgcn_mfma_f32_16x16x32_bf16(tm, rn, accT[e], 0, 0, 0); }
                        if (rd > 0) accP[e] = __builtin_amdgcn_mfma_f32_16x16x32_bf16(tn, pm_, accP[e], 0, 0, 0);
                    } }
                __syncthreads();
                if (rd < 5) {
#pragma unroll
                    for (int e = 0; e < 2; ++e) { const int tt = 2 * wave + e, mt = tt >> 2, nt = tt & 3; u32x2 w;
                        w.x = cvt_pk_bf16(accR[e][0], accR[e][1]); w.y = cvt_pk_bf16(accR[e][2], accR[e][3]); *(u32x2*)(Rt + (16 * nt + fr) * 72 + 16 * mt + 4 * fq) = w;
                        w.x = cvt_pk_bf16(accT[e][0], accT[e][1]); w.y = cvt_pk_bf16(accT[e][2], accT[e][3]); *(u32x2*)(Rm + (16 * nt + fr) * 72 + 16 * mt + 4 * fq) = w;
                        if (rd > 0) { w.x = cvt_pk_bf16(accP[e][0], accP[e][1]); w.y = cvt_pk_bf16(accP[e][2], accP[e][3]); *(u32x2*)(Pm + (16 * mt + fr) * 72 + 16 * nt + 4 * fq) = w; } }
                    __syncthreads();
                }
            }
#pragma unroll
            for (int e = 0; e < 2; ++e) { const int tt = 2 * wave + e, mt = tt >> 2, nt = tt & 3; const int i = 16 * mt + fr, c0 = 16 * nt + 4 * fq; float v1[4], v2[4];
#pragma unroll
                for (int rg = 0; rg < 4; ++rg) { const float bc = bts[c0 + rg]; v1[rg] = accP[e][rg] * bc; v2[rg] = -accP[e][rg] * bc * __expf(gcs[c0 + rg]); }
                u32x2 w; w.x = cvt_pk_bf16(v1[0], v1[1]); w.y = cvt_pk_bf16(v1[2], v1[3]); *(u32x2*)(T1 + i * 72 + c0) = w;
                w.x = cvt_pk_bf16(v2[0], v2[1]); w.y = cvt_pk_bf16(v2[2], v2[3]); *(u32x2*)(T2 + i * 72 + c0) = w; }
        }
        __syncthreads();
        SEC_T(3);
#pragma unroll 1
        for (int nh = 0; nh < 2; ++nh) {
        if (wave < 4) {
            const int m = wave; f32x4 acc[4];
#pragma unroll
            for (int n = 0; n < 4; ++n) acc[n] = (f32x4){0.f, 0.f, 0.f, 0.f};
#pragma unroll
            for (int s2 = 0; s2 < 2; ++s2) { const bf16x8 a = *(const bf16x8*)(T1 + (16 * m + fr) * 72 + 32 * s2 + 8 * fq);
#pragma unroll
                for (int n = 0; n < 4; ++n) { const int d = 16 * (4 * nh + n) + fr; const bf16x8 bb = *(const bf16x8*)(VT + d * 72 + ((32 * s2 + 8 * fq) ^ (((d >> 3) & 7) << 3))); acc[n] = __builtin_amdgcn_mfma_f32_16x16x32_bf16(a, bb, acc[n], 0, 0, 0); } }
#pragma unroll
            for (int n = 0; n < 4; ++n) { u32x2 w; w.x = cvt_pk_bf16(acc[n][0], acc[n][1]); w.y = cvt_pk_bf16(acc[n][2], acc[n][3]);
                *(u32x2*)(UF + slot * 8192 + (((4 * nh + n) * 4 + m) * 64 + lane) * 4) = w; }
        } else {
            const int m = wave - 4; f32x4 acc[4];
#pragma unroll
            for (int n = 0; n < 4; ++n) acc[n] = (f32x4){0.f, 0.f, 0.f, 0.f};
#pragma unroll
            for (int s2 = 0; s2 < 2; ++s2) { const bf16x8 tf = *(const bf16x8*)(T2 + (16 * m + fr) * 72 + 32 * s2 + 8 * fq);
#pragma unroll
                for (int n = 0; n < 4; ++n) { const int d = 16 * (4 * nh + n) + fr; const bf16x8 kf = *(const bf16x8*)(KT + d * 72 + ((32 * s2 + 8 * fq) ^ (((d >> 3) & 7) << 3))); acc[n] = __builtin_amdgcn_mfma_f32_16x16x32_bf16(kf, tf, acc[n], 0, 0, 0); } }
            const int i = 16 * m + fr;
#pragma unroll
            for (int s = 0; s < 2; ++s) { u32x4 w; w.x = cvt_pk_bf16(acc[2 * s][0], acc[2 * s][1]); w.y = cvt_pk_bf16(acc[2 * s][2], acc[2 * s][3]);
                w.z = cvt_pk_bf16(acc[2 * s + 1][0], acc[2 * s + 1][1]); w.w = cvt_pk_bf16(acc[2 * s + 1][2], acc[2 * s + 1][3]);
                *(u32x4*)(WP + slot * 8192 + i * 128 + (((4 * (2 * nh + s) + fq) ^ (i & 15)) << 3)) = w; }
        }
        }
        SEC_T(4);
    }
    __syncthreads();
}

__device__ void dn_scan(const Params& P, unsigned char* smem, int t0, int t1) {
    if (lbid() >= 128) return;
    const int bhd = lbid() >> 1, half = lbid() & 1;
    const int tid = ltid(), wave = __builtin_amdgcn_readfirstlane(tid >> 6), lane = tid & 63, fr = lane & 15, fq = lane >> 4;
    unsigned char* ws = P.ws;
    const unsigned char* WPb = ws + O_WP; const unsigned char* QPb = ws + O_QP; const unsigned char* KDb = ws + O_KD; const unsigned char* ATb = ws + O_AT;
    const bf16_t* UF = (const bf16_t*)(ws + O_UF); const float* GL = (const float*)(ws + S_GL);
    bf16_t* OO = (bf16_t*)(ws + O_O); f32x4* SS = (f32x4*)(ws + S_SSAVE);
    const int b = bhd >> 3, h = (bhd >> 1) & 3, dir = bhd & 1;
    LAS unsigned char* lds = (LAS unsigned char*)smem;
    constexpr int BUFB = 57344;
#define SCAN_SRC(q_, slot_) ((q_) < 16 ? WPb + (slot_) * 16384 + (q_) * 1024 : (q_) < 32 ? QPb + (slot_) * 16384 + ((q_) - 16) * 1024 : (q_) < 48 ? KDb + (slot_) * 16384 + ((q_) - 32) * 1024 : ATb + (slot_) * 8192 + ((q_) - 48) * 1024)
#define SCAN_LOAD(tl_) do { const size_t _slot = (size_t)(tl_) * 64 + bhd; _Pragma("unroll") for (int _k = 0; _k < 14; ++_k) { const int _q = (wave - 4) * 14 + _k; rg_[_k] = *(const u32x4*)(SCAN_SRC(_q, _slot) + lane * 16); } } while (0)
#define SCAN_WRITE(buf_) do { _Pragma("unroll") for (int _k = 0; _k < 14; ++_k) { const int _q = (wave - 4) * 14 + _k; *(LAS u32x4*)(lds + (buf_) * BUFB + _q * 1024 + lane * 16) = rg_[_k]; } } while (0)
    constexpr int NN = 1; const bool cw_ = wave < 4; const int sl0 = half * 4 + (wave & 3);
    const int nst = t1 - t0;
    if (!cw_) {
        u32x4 rg_[14];
#define SCAN_LOAD(tl_) do { const size_t _slot = (size_t)(tl_) * 64 + bhd; _Pragma("unroll") for (int _k = 0; _k < 14; ++_k) { const int _q = (wave - 4) * 14 + _k; rg_[_k] = *(const u32x4*)(SCAN_SRC(_q, _slot) + lane * 16); } } while (0)
#define SCAN_WRITE(buf_) do { _Pragma("unroll") for (int _k = 0; _k < 14; ++_k) { const int _q = (wave - 4) * 14 + _k; *(LAS u32x4*)(lds + (buf_) * BUFB + _q * 1024 + lane * 16) = rg_[_k]; } } while (0)
        SCAN_LOAD(0); SCAN_WRITE(0); if (nst > 1) SCAN_LOAD(1);
#pragma unroll 1
        for (int tl = 0; tl < nst; ++tl) {
            __syncthreads();
            if (tl + 1 < nst) { SCAN_WRITE((tl + 1) & 1); if (tl + 2 < nst) SCAN_LOAD(tl + 2); }
        }
        asm volatile("s_waitcnt vmcnt(0)" ::: "memory");
        __syncthreads();
        return;
    }
    f32x4 S[8][NN];
#pragma unroll
    for (int t = 0; t < 8; ++t)
#pragma unroll
        for (int nn = 0; nn < NN; ++nn) S[t][nn] = (t0 == 0 || !cw_) ? (f32x4){0.f, 0.f, 0.f, 0.f} : SS[((size_t)(bhd * 8 + sl0 + nn) * 8 + t) * 64 + lane];
    u32x2 un[4][NN];
    if (cw_) {
#pragma unroll
        for (int m = 0; m < 4; ++m)
#pragma unroll
            for (int nn = 0; nn < NN; ++nn) un[m][nn] = *(const u32x2*)(UF + (size_t)bhd * 8192 + (((sl0 + nn) * 4 + m) * 64 + lane) * 4); }
    float gln = __hip_atomic_load(GL + bhd, __ATOMIC_RELAXED, __HIP_MEMORY_SCOPE_AGENT);
#pragma unroll 1
    for (int tl = 0; tl < nst; ++tl) {
        const size_t slot = (size_t)tl * 64 + bhd; const int t = t0 + tl, c = dir ? 64 - t : t;
        const LAS unsigned char* bw = lds + (tl & 1) * BUFB;
        __syncthreads();
        f32x4 av[4][NN], ao[4][NN];
#pragma unroll
        for (int m = 0; m < 4; ++m)
#pragma unroll
            for (int nn = 0; nn < NN; ++nn) { const u32x2 u = un[m][nn];
                av[m][nn] = (f32x4){__uint_as_float(u.x << 16), __uint_as_float(u.x & 0xffff0000u), __uint_as_float(u.y << 16), __uint_as_float(u.y & 0xffff0000u)}; ao[m][nn] = (f32x4){0.f, 0.f, 0.f, 0.f}; }
        const float gl = gln; if (tl + 1 < nst) gln = __hip_atomic_load(GL + slot + 64, __ATOMIC_RELAXED, __HIP_MEMORY_SCOPE_AGENT);
        if (tl + 1 < nst) {
#pragma unroll
            for (int m = 0; m < 4; ++m)
#pragma unroll
                for (int nn = 0; nn < NN; ++nn) un[m][nn] = *(const u32x2*)(UF + (slot + 64) * 8192 + (((sl0 + nn) * 4 + m) * 64 + lane) * 4); }
#pragma unroll
        for (int s = 0; s < 4; ++s) { bf16x8 Sb[NN];
#pragma unroll
            for (int nn = 0; nn < NN; ++nn) { u32x4 w; w.x = cvt_pk_bf16(S[2 * s][nn][0], S[2 * s][nn][1]); w.y = cvt_pk_bf16(S[2 * s][nn][2], S[2 * s][nn][3]); w.z = cvt_pk_bf16(S[2 * s + 1][nn][0], S[2 * s + 1][nn][1]); w.w = cvt_pk_bf16(S[2 * s + 1][nn][2], S[2 * s + 1][nn][3]);
                Sb[nn] = __builtin_bit_cast(bf16x8, w); }
#pragma unroll
            for (int m = 0; m < 4; ++m) { const bf16x8 wf = *(const LAS bf16x8*)(bw + (16 * m + fr) * 256 + (((4 * s + fq) ^ fr) << 4)); const bf16x8 qf = *(const LAS bf16x8*)(bw + 16384 + (16 * m + fr) * 256 + (((4 * s + fq) ^ fr) << 4));
                _Pragma("unroll") for (int nn = 0; nn < NN; ++nn) av[m][nn] = __builtin_amdgcn_mfma_f32_16x16x32_bf16(wf, Sb[nn], av[m][nn], 0, 0, 0);
                _Pragma("unroll") for (int nn = 0; nn < NN; ++nn) ao[m][nn] = __builtin_amdgcn_mfma_f32_16x16x32_bf16(qf, Sb[nn], ao[m][nn], 0, 0, 0); } }
        __builtin_amdgcn_sched_barrier(0);
        bf16x8 Vb[2][NN];
#pragma unroll
        for (int s2 = 0; s2 < 2; ++s2)
#pragma unroll
            for (int nn = 0; nn < NN; ++nn) { u32x4 w; w.x = cvt_pk_bf16(av[2 * s2][nn][0], av[2 * s2][nn][1]); w.y = cvt_pk_bf16(av[2 * s2][nn][2], av[2 * s2][nn][3]); w.z = cvt_pk_bf16(av[2 * s2 + 1][nn][0], av[2 * s2 + 1][nn][1]); w.w = cvt_pk_bf16(av[2 * s2 + 1][nn][2], av[2 * s2 + 1][nn][3]);
                Vb[s2][nn] = __builtin_bit_cast(bf16x8, w); }
#pragma unroll
        for (int m = 0; m < 4; ++m)
#pragma unroll
            for (int s2 = 0; s2 < 2; ++s2) { const int row = 16 * m + fr; const bf16x8 af = *(const LAS bf16x8*)(bw + 49152 + row * 128 + (((4 * s2 + fq) ^ ((row >> 1) & 7)) << 4));
                _Pragma("unroll") for (int nn = 0; nn < NN; ++nn) ao[m][nn] = __builtin_amdgcn_mfma_f32_16x16x32_bf16(af, Vb[s2][nn], ao[m][nn], 0, 0, 0); }
        __builtin_amdgcn_sched_barrier(0);
#pragma unroll
        for (int tt = 0; tt < 8; ++tt) { _Pragma("unroll") for (int nn = 0; nn < NN; ++nn) S[tt][nn] = S[tt][nn] * gl;
#pragma unroll
            for (int s2 = 0; s2 < 2; ++s2) { const int row = 16 * tt + fr; const bf16x8 kf = *(const LAS bf16x8*)(bw + 32768 + row * 128 + (((4 * s2 + fq) ^ ((row >> 1) & 7)) << 4));
                _Pragma("unroll") for (int nn = 0; nn < NN; ++nn) S[tt][nn] = __builtin_amdgcn_mfma_f32_16x16x32_bf16(kf, Vb[s2][nn], S[tt][nn], 0, 0, 0); } }
#pragma unroll
        for (int m = 0; m < 4; ++m)
#pragma unroll
            for (int rg = 0; rg < 4; ++rg) { const int i = 16 * m + 4 * fq + rg, n = c * 64 + (dir ? 63 - i : i) - 48;
                if (n >= 0) { bf16_t* op = OO + ((size_t)dir * TP + (size_t)b * LL + n) * 512 + h * 128 + sl0 * 16 + fr; _Pragma("unroll") for (int nn = 0; nn < NN; ++nn) op[16 * nn] = f2bf(ao[m][nn][rg]); } }
    }
#undef SCAN_SRC
#undef SCAN_LOAD
#undef SCAN_WRITE
    if (t1 < NSTEP && cw_) {
#pragma unroll
        for (int t = 0; t < 8; ++t)
#pragma unroll
            for (int nn = 0; nn < NN; ++nn) SS[((size_t)(bhd * 8 + sl0 + nn) * 8 + t) * 64 + lane] = S[t][nn]; }
    asm volatile("s_waitcnt vmcnt(0)" ::: "memory");
    __syncthreads();
}

__device__ void dn_out(const Params& P, int l) {
    const int tid_ = ltid(); const int wave = __builtin_amdgcn_readfirstlane(tid_ >> 6), lane = tid_ & 63;
    const bf16_t* OO = (const bf16_t*)(P.ws + O_O); const bf16_t* Z = (const bf16_t*)(P.ws + O_Z); bf16_t* DNO = (bf16_t*)(P.ws + O_BR) + (size_t)2 * TP * 512;
    const float* nw = P.in[12] + (size_t)l * 128; float g[8];
#pragma unroll
    for (int e = 0; e < 8; ++e) g[e] = nw[(lane & 15) * 8 + e];
    for (int r = lbid() * 8 + wave; r < TT; r += lgrid() * 8) {
        float a[8], bq[8], z[8]; unpack8(*(const u32x4*)(OO + (size_t)r * 512 + lane * 8), a); unpack8(*(const u32x4*)(OO + ((size_t)TP + r) * 512 + lane * 8), bq); unpack8(*(const u32x4*)(Z + (size_t)r * 512 + lane * 8), z);
        float ss = 0.f;
#pragma unroll
        for (int e = 0; e < 8; ++e) { a[e] += bq[e]; ss += a[e] * a[e]; }
        ss += __shfl_xor(ss, 1); ss += __shfl_xor(ss, 2); ss += __shfl_xor(ss, 4); ss += __shfl_xor(ss, 8);
        const float inv = rsqrtf(ss * (1.0f / 128.0f) + EPS);
#pragma unroll
        for (int e = 0; e < 8; ++e) a[e] = a[e] * inv * g[e] * siluf_(z[e]);
        *(u32x4*)(DNO + (size_t)r * 512 + lane * 8) = pack8(a);
    }
}


#define XB_TMO      128
#define XB_XCNT(j)  (256  + 64 * (j))
#define XB_XSUB(j)  (1280 + 64 * (j))
#define XB_XGEN(j)  (2304 + 64 * (j))
#define XB_TOP      3328
#define XB_TOPGEN   3392
#define XCD_BAR_WORDS 3456
#define XB_SPIN_CAP (1u << 22)
__device__ __forceinline__ unsigned xb_ld(unsigned* p)              { return __hip_atomic_load(p, __ATOMIC_RELAXED, __HIP_MEMORY_SCOPE_AGENT); }
__device__ __forceinline__ unsigned xb_add(unsigned* p, unsigned v) { return __hip_atomic_fetch_add(p, v, __ATOMIC_RELAXED, __HIP_MEMORY_SCOPE_AGENT); }
__device__ __forceinline__ unsigned xb_xcc_id() { return (unsigned)__builtin_amdgcn_s_getreg((3 << 11) | 20) & 0xFu; }
#define XB_SPIN(cond, bar) do { unsigned _sp = 0; while (cond) { __builtin_amdgcn_s_sleep(1); \
    if ((++_sp & 255u) == 0u) { if (xb_ld(&(bar)[XB_TMO])) break; if (_sp > XB_SPIN_CAP) { atomicAdd(&(bar)[XB_TMO], 1u); break; } } } } while (0)
struct XcdBarrier { unsigned* bar; unsigned x; volatile LAS unsigned* st; };
__device__ __forceinline__ XcdBarrier xcd_barrier_post(unsigned* bar, volatile LAS unsigned* st) {
    XcdBarrier b; b.bar = bar; b.x = xb_xcc_id(); b.st = st;
    if (threadIdx.x == 0) (void)xb_add(&bar[XB_XCNT(b.x)], 1u);
    return b;
}
__device__ __forceinline__ void xcd_barrier_complete(unsigned* bar, unsigned x, unsigned& nloc, unsigned& nx) {
    const unsigned G = gridDim.x * gridDim.y * gridDim.z;
    unsigned sum, cnt, mine, sp = 0u;
    for (;;) {
        sum = 0u; cnt = 0u; mine = 0u;
#pragma unroll
        for (unsigned j = 0; j < 16; ++j) { const unsigned c = xb_ld(&bar[XB_XCNT(j)]); sum += c; cnt += (c > 0u) ? 1u : 0u; mine = (j == x) ? c : mine; }
        if (sum == G) break;
        __builtin_amdgcn_s_sleep(1);
        if ((++sp & 255u) == 0u) { if (xb_ld(&bar[XB_TMO])) break; if (sp > XB_SPIN_CAP) { atomicAdd(&bar[XB_TMO], 1u); break; } }
    }
    nloc = mine > 0u ? mine : 1u; nx = cnt > 0u ? cnt : 1u;
}
__device__ __forceinline__ void xcd_barrier(const XcdBarrier& b) {
    asm volatile("s_waitcnt vmcnt(0)" ::: "memory");
    __syncthreads();
    if (threadIdx.x == 0) {
        unsigned* bar = b.bar;
        __builtin_amdgcn_s_waitcnt(0);
        unsigned nloc = b.st[0], nx = b.st[1];
        if (nloc == 0u) { xcd_barrier_complete(bar, b.x, nloc, nx); b.st[0] = nloc; b.st[1] = nx; }
        const unsigned old = xb_add(&bar[XB_XSUB(b.x)], 1u);
        const unsigned gen = old / nloc;
        if (old + 1u == (gen + 1u) * nloc) {
            __builtin_amdgcn_fence(__ATOMIC_RELEASE, "agent");
            asm volatile("s_waitcnt vmcnt(0)" ::: "memory");
            const unsigned og = xb_add(&bar[XB_TOP], 1u);
            const unsigned tg = og / nx;
            if (og + 1u == (tg + 1u) * nx) xb_add(&bar[XB_TOPGEN], 1u);
            else XB_SPIN(xb_ld(&bar[XB_TOPGEN]) == tg, bar);
            __builtin_amdgcn_fence(__ATOMIC_ACQUIRE, "agent");
            xb_add(&bar[XB_XGEN(b.x)], 1u);
            asm volatile("s_waitcnt vmcnt(0)" ::: "memory");
        } else {
            XB_SPIN(xb_ld(&bar[XB_XGEN(b.x)]) == gen, bar);
            __builtin_amdgcn_fence(__ATOMIC_ACQUIRE, "agent");
            asm volatile("s_waitcnt vmcnt(0)" ::: "memory");
        }
    }
    __syncthreads();
}
__device__ __forceinline__ int phase_cat(int ph) { const int p = ph % 22;
    return p == 0 ? 0 : (p == 1 || p == 2 || p == 19 || p == 20) ? 1 : (p == 3 || p == 18 || p == 21) ? 2 : p == 4 ? 3 : p == 5 ? 4 : p == 6 ? 5 : p == 7 ? 6 : (p == 8 || p == 10 || p == 12) ? 7 : (p == 9 || p == 11 || p == 13) ? 8 : p == 14 ? 9 : 10; }
#ifndef SKIP_GEMM
#define GEMM_CALL(a,b,c,d) pg8::gemm_phase(a,b,c,d)
#else
#define GEMM_CALL(a,b,c,d) (void)0
#endif
__global__ void __launch_bounds__(512, 2) fwd_kernel(Params P) {
    extern __shared__ __attribute__((aligned(16))) unsigned char smem[];
    cg::grid_group grid = cg::this_grid();
    unsigned char* ws = P.ws;
    LAS unsigned char* lds = (LAS unsigned char*)smem;
    int ph = 0;
    { volatile LAS unsigned* stw = (volatile LAS unsigned*)(lds + LDS_BYTES - 32); if (threadIdx.x < 8) stw[threadIdx.x] = 0u; }
    __syncthreads();
    XcdBarrier xbar = xcd_barrier_post((unsigned*)(ws + S_BAR), (volatile LAS unsigned*)(lds + LDS_BYTES - 16));
#ifdef DBG_CAT
    unsigned long long t_prev = __builtin_amdgcn_s_memrealtime(), t_acc = 0ull;
#define STAMP() do { const unsigned long long _n = __builtin_amdgcn_s_memrealtime(); if (phase_cat(ph) == DBG_CAT) t_acc += _n - t_prev; t_prev = _n; } while (0)
#else
#define STAMP() do {} while (0)
#endif
#define PHASE_BEGIN if (ph >= P.ph_lo && ph < P.ph_hi) { const int G = lgrid(), bx = lbid(); (void)G; (void)bx;
#define PHASE_END   if (ph + 1 < P.ph_hi) { if (ph == 0) { asm volatile("s_waitcnt vmcnt(0) lgkmcnt(0)" ::: "memory"); grid.sync(); __builtin_amdgcn_fence(__ATOMIC_ACQUIRE, "agent"); asm volatile("s_waitcnt vmcnt(0)" ::: "memory"); __syncthreads(); } else xcd_barrier(xbar); } STAMP(); } ++ph;
    for (ph = P.ph_lo; ph < P.ph_hi; ++ph) {
        const int l = ph / 22, p = ph - l * 22;
        const int G = lgrid(), bx = lbid();
        bf16_t* XN = (bf16_t*)(ws + O_XN); bf16_t* Y = (bf16_t*)(ws + O_Y); bf16_t* ACT = (bf16_t*)(ws + O_ACT);
        const float* ng = P.in[2] + (size_t)l * 6 * 1024;
        switch (p) {
        case 0:
#ifndef SKIP_CVT
            convert_weights(P, l, smem);
#endif
            if (l == 0) { gen_tables(P); rpass(P, nullptr, true, nullptr, 0.f, ng, XN); }
            break;
        case 1: case 19: { pg8::Gemm g{XN, (const bf16_t*)(ws + (p == 1 ? W_WI1 : W_WI2)), TP, 5632, 1024, 128, 1024}; pg8::StaticOrder S; S.init(TP, 5632, G, bx); pg8::EpiSwiglu E{ACT}; GEMM_CALL(lds, g, S, E); } break;
        case 2: case 20: case 17: {
            const bool dn = (p != 17); const int Kx = dn ? 2816 : 1024, nS = dn ? 11 : 4;
            const bf16_t* W = (const bf16_t*)(ws + (p == 2 ? W_WO1 : p == 20 ? W_WO2 : W_WOUT)); const bf16_t* Ax = dn ? ACT : (const bf16_t*)(ws + O_MG);
            { pg8::Gemm g{Ax, W, TP, 1024, Kx, 128, Kx}; pg8::StaticOrder S; S.init(TP, 1024, G, bx, false); pg8::EpiBf16<0> E{Y, 1024}; GEMM_CALL(lds, g, S, E); }
            { pg8::Gemm g{W, Ax + (size_t)32768 * Kx, 1024, 256, Kx, -1, 256}; pg8::TailOrder S{nS, bx}; pg8::EpiSlab E{(float*)(ws + O_SLAB), nS}; GEMM_CALL(lds, g, S, E); } } break;
        case 3: rpass(P, Y, l == 0, ng + 1024, 0.5f, ng + 2048, XN, (const float*)(ws + O_SLAB), 11); break;
        case 4: { pg8::Gemm g{XN, (const bf16_t*)(ws + W_WIN), TP, NPROJ, 1024, 128, 1024}; pg8::StaticOrder S; S.init(TP, NPROJ, G, bx); pg8::EpiInProj E{ws}; GEMM_CALL(lds, g, S, E); } break;
        case 5: sconv_pass(P, l); break;
        case 6:
#ifndef SKIP_F1
            fstep1(P, smem);
#endif
            break;
        case 7: { pg8::Gemm g{(const bf16_t*)(ws + S_C257), (const bf16_t*)(ws + O_AP), 512, 65536, KF, 1, KF}; pg8::StaticOrder S; S.init(512, 65536, G, bx);
                  pg8::EpiFourier E{(bf16_t*)(ws + O_BR), 0.001949317738791423f  }; GEMM_CALL(lds, g, S, E); } break;
        case 8: case 10: case 12: { const int t0 = ((p - 8) >> 1) * SPL, t1 = (t0 + SPL < NSTEP) ? t0 + SPL : NSTEP;
#ifndef SKIP_PREP
            dn_prep(P, l, smem, t0, t1);
#endif
            } break;
        case 9: case 11: case 13: { const int t0 = ((p - 9) >> 1) * SPL, t1 = (t0 + SPL < NSTEP) ? t0 + SPL : NSTEP;
#ifndef SKIP_SCAN
            dn_scan(P, smem, t0, t1);
#endif
            } break;
        case 14: dn_out(P, l); rpass(P, nullptr, false, nullptr, 0.f, ng + 2048, (bf16_t*)(ws + O_XN2)); break;
        case 15: { pg8::Gemm g{(const bf16_t*)(ws + O_XN2), (const bf16_t*)(ws + W_WG), TP, 3072, 1024, 128, 1024}; pg8::StaticOrder S; S.init(TP, 3072, G, bx); pg8::EpiBf16<1> E{(bf16_t*)(ws + O_GATE), 3072}; GEMM_CALL(lds, g, S, E); } break;
        case 16: { pg8::Gemm g{(const bf16_t*)(ws + O_BR), (const bf16_t*)(ws + W_WBR), 3 * TP, 3072, 512, -1, 512}; pg8::MergeOrder S{G, bx}; pg8::EpiMerge E{(const bf16_t*)(ws + O_GATE), (bf16_t*)(ws + O_MG), (bf16_t*)(ws + O_XN2)}; GEMM_CALL(lds, g, S, E); } break;
        case 18: rpass(P, Y, false, ng + 3 * 1024, 1.0f, ng + 4 * 1024, XN, (const float*)(ws + O_SLAB), 4); break;
        default: rpass(P, Y, false, ng + 5 * 1024, 0.5f, l == 0 ? P.in[2] + (size_t)6 * 1024 : nullptr, XN, (const float*)(ws + O_SLAB), 11); break;
        }
        if (ph + 1 < P.ph_hi) {
            if (P.ph_lo < 0) grid.sync();
            xcd_barrier(xbar);
        }
        STAMP();
    }
#ifdef DBG_CAT
    if (lbid() == 0 && threadIdx.x == 0) { const unsigned long long t0 = __builtin_amdgcn_s_memrealtime(); while (__builtin_amdgcn_s_memrealtime() - t0 < t_acc + *(unsigned long long*)(smem + LDS_BYTES - 32)) __builtin_amdgcn_s_sleep(16); }
#endif
#ifdef DBG_FLUSH
    { asm volatile("s_waitcnt vmcnt(0) lgkmcnt(0)" ::: "memory"); grid.sync(); __builtin_amdgcn_fence(__ATOMIC_ACQUIRE, "agent"); asm volatile("s_waitcnt vmcnt(0)" ::: "memory");
      const f32x4* xs = (const f32x4*)P.in[0]; f32x4 a = {0.f, 0.f, 0.f, 0.f};
      for (size_t i = ltid(); i < (size_t)8388608; i += 512) a += xs[i];
      if (a[0] + a[1] + a[2] + a[3] == 1.2345e-30f) ((float*)(ws + S_GL))[4000] = 1.f; }
#endif
#ifdef DBG_OFF
    { asm volatile("s_waitcnt vmcnt(0) lgkmcnt(0)" ::: "memory"); grid.sync(); __builtin_amdgcn_fence(__ATOMIC_ACQUIRE, "agent"); asm volatile("s_waitcnt vmcnt(0)" ::: "memory");
      const bf16_t* src = (const bf16_t*)(ws + DBG_OFF);
      for (size_t i = (size_t)lbid() * 512 + ltid(); i < (size_t)33554432; i += (size_t)lgrid() * 512) P.out[i] = i < (size_t)DBG_CNT ? bf2f(src[i]) : 0.f; }
#endif
}

extern "C" void kernel_launch(void* const* d_in, const int* in_sizes, int n_in, void* d_out, int out_size, void* d_ws, size_t ws_size, hipStream_t stream) {
    static int grid = 0;
    if (grid == 0) {
        int dev = 0, cus = 0, per_cu = 0;
        hipGetDevice(&dev); hipDeviceGetAttribute(&cus, hipDeviceAttributeMultiprocessorCount, dev);
        hipFuncSetAttribute((const void*)fwd_kernel, hipFuncAttributeMaxDynamicSharedMemorySize, LDS_BYTES);
        hipOccupancyMaxActiveBlocksPerMultiprocessor(&per_cu, (const void*)fwd_kernel, 512, LDS_BYTES);
        if (per_cu < 1) { fprintf(stderr, "occupancy query says %d blocks/CU\n", per_cu); per_cu = 1; }
        grid = cus;
        if (ws_size < WS_NEED) fprintf(stderr, "workspace too small: %zu < %zu\n", ws_size, (size_t)WS_NEED);
    }
    Params p{};
    for (int i = 0; i < 17; ++i) p.in[i] = (const float*)d_in[i];
    p.out = (float*)d_out; p.ws = (unsigned char*)d_ws; p.ph_lo = 0; p.ph_hi = 44;
#ifdef DBG_PHI
    p.ph_hi = DBG_PHI;
#endif
    hipMemsetAsync((char*)d_ws + S_BAR, 0, 16384, stream);
    void* args[] = {&p};
    hipError_t e = hipLaunchCooperativeKernel((const void*)fwd_kernel, dim3(grid), dim3(512), args, LDS_BYTES, stream);
    if (e != hipSuccess) fprintf(stderr, "cooperative launch failed: %s (grid %d)\n", hipGetErrorString(e), grid);
}
```

```cpp
#include <hip/hip_runtime.h>
#include <hip/hip_cooperative_groups.h>
#include <cstdio>
namespace cg = cooperative_groups;

#define LAS __attribute__((address_space(3)))
typedef unsigned short bf16_t;
typedef short bf16x8 __attribute__((ext_vector_type(8)));
typedef float f32x4 __attribute__((ext_vector_type(4)));
typedef unsigned u32x4 __attribute__((ext_vector_type(4)));
typedef unsigned u32x2 __attribute__((ext_vector_type(2)));

constexpr int DM = 1024, NB = 8, SEQ = 4096, NMETA = 16, LL = 4112, TT = NB * LL  , TP = 33024  , DFF = 2816;
constexpr int NIN = 7184;
constexpr int NPROJ = 4864;
constexpr float EPS = 1e-6f;
constexpr int NSTEP = 65, SPL = 24, NSPLIT = 3;
constexpr int KF = 640;

constexpr size_t UU = (size_t)TP * 1024;
constexpr size_t W_WI1 = 0, W_WO1 = W_WI1 + (size_t)5632 * 1024 * 2, W_WI2 = W_WO1 + (size_t)1024 * 2816 * 2, W_WO2 = W_WI2 + (size_t)5632 * 1024 * 2,
                 W_WIN = W_WO2 + (size_t)1024 * 2816 * 2, W_WG = W_WIN + (size_t)NPROJ * 1024 * 2, W_WBR = W_WG + (size_t)3072 * 1024 * 2,
                 W_WOUT = W_WBR + (size_t)3072 * 512 * 2, W_END = W_WOUT + (size_t)1024 * 1024 * 2;
constexpr size_t S_C257 = W_END, S_TWL = S_C257 + (size_t)512 * KF * 2, S_HM = S_TWL + 33024, S_LOGIT = S_HM + (size_t)128 * 1024 * 4,
                 S_GL = S_LOGIT + (size_t)TP * 16 * 4, S_SSAVE = S_GL + 16896, S_BAR = S_SSAVE + (size_t)512 * 8 * 64 * 16, S_END = S_BAR + 16384;
constexpr size_t A0 = (S_END + 255) / 256 * 256;
constexpr size_t O_XN = A0, O_Y = A0 + 2 * UU, O_ACT = A0 + 4 * UU;
constexpr size_t O_BR = A0, O_QKV = A0 + 4 * UU, O_Z = A0 + 7 * UU, O_SC = A0 + 8 * UU, O_PQ = A0 + 11 * UU, O_AP = A0 + 8 * UU;
constexpr size_t DNI_SLOTS = (size_t)SPL * 64;
constexpr size_t O_WP = A0 + 8 * UU, O_QP = O_WP + DNI_SLOTS * 16384, O_KD = O_QP + DNI_SLOTS * 16384, O_UF = O_KD + DNI_SLOTS * 16384,
                 O_AT = O_UF + DNI_SLOTS * 16384, O_DNI_END = O_AT + DNI_SLOTS * 8192;
constexpr size_t O_O = (O_DNI_END + 255) / 256 * 256;
constexpr size_t O_XN2 = A0 + 3 * UU, O_GATE = A0 + 5 * UU, O_MG = A0 + 11 * UU;
constexpr size_t O_SLAB = (O_O + 2 * UU + 255) / 256 * 256;
constexpr size_t WS_NEED = O_SLAB + (size_t)44 * 65536 * 4;
static_assert(WS_NEED <= (size_t)536870912, "workspace");
static_assert(O_AP + (size_t)65536 * KF * 2 <= O_PQ, "A' overlaps PQ");
static_assert(O_O >= O_PQ || true, "");
static_assert(O_MG + 2 * UU <= WS_NEED + 2 * UU, "");

constexpr int LDS_BYTES = 132 * 1024;

#define DBG_CNT ((size_t)33554432)


struct Params { const float* in[17]; float* out; unsigned char* ws; int ph_lo, ph_hi; };

__device__ __forceinline__ float bf2f(unsigned v) { return __uint_as_float(v << 16); }
typedef __bf16 bf16x2_t __attribute__((ext_vector_type(2)));
typedef float f32x2_t __attribute__((ext_vector_type(2)));
__device__ __forceinline__ unsigned cvt_pk_bf16(float lo, float hi) { f32x2_t v = {lo, hi}; bf16x2_t b = __builtin_convertvector(v, bf16x2_t); return __builtin_bit_cast(unsigned, b); }
__device__ __forceinline__ bf16_t f2bf(float f) { return (bf16_t)(cvt_pk_bf16(f, 0.f) & 0xffffu); }
__device__ __forceinline__ void unpack8(const u32x4 v, float* f) {
    f[0] = __uint_as_float(v.x << 16); f[1] = __uint_as_float(v.x & 0xffff0000u); f[2] = __uint_as_float(v.y << 16); f[3] = __uint_as_float(v.y & 0xffff0000u);
    f[4] = __uint_as_float(v.z << 16); f[5] = __uint_as_float(v.z & 0xffff0000u); f[6] = __uint_as_float(v.w << 16); f[7] = __uint_as_float(v.w & 0xffff0000u); }
__device__ __forceinline__ u32x4 pack8(const float* f) { u32x4 w; w.x = cvt_pk_bf16(f[0], f[1]); w.y = cvt_pk_bf16(f[2], f[3]); w.z = cvt_pk_bf16(f[4], f[5]); w.w = cvt_pk_bf16(f[6], f[7]); return w; }
__device__ __forceinline__ int ltid() { int t = threadIdx.x; asm volatile("" : "+v"(t)); return t; }
__device__ __forceinline__ int lbid() { int t = blockIdx.x; asm volatile("" : "+s"(t)); return t; }
__device__ __forceinline__ int lgrid() { int t = gridDim.x; asm volatile("" : "+s"(t)); return t; }
__device__ __forceinline__ float wave_sum(float v) { for (int o = 32; o >= 1; o >>= 1) v += __shfl_xor(v, o); return v; }
__device__ __forceinline__ float sigmoidf_(float x) { return __builtin_amdgcn_rcpf(1.0f + __expf(-x)); }
__device__ __forceinline__ float siluf_(float x) { return x * __builtin_amdgcn_rcpf(1.0f + __expf(-x)); }

namespace pg8 {
constexpr int BM = 256, BK = 64, HALF = 128, HTB = HALF * BK * 2, STAGE_BYTES = 8 * HTB, NXCD = 8, WGM = 8;
__device__ __forceinline__ int lds_byte(int r, int c) { const int st = (r >> 4) * 2 + (c >> 5), rr = r & 15, cc = c & 31, ob = rr * 64 + cc * 2; return st * 1024 + (ob ^ (((ob >> 9) & 1) << 5)); }
__device__ __forceinline__ void stage_rc(int b, int& R, int& C) { const int st = b / 1024, sb = b % 1024, swz = sb ^ (((sb >> 9) & 1) << 5); R = (st >> 1) * 16 + swz / 64; C = (st & 1) * 32 + (swz % 64) / 2; }
__device__ __forceinline__ int perm32(int rho) { const int n = rho >> 4, i = rho & 15; return 8 * (i >> 2) + 4 * n + (i & 3); }
struct Unit { int pm, pn, ks; };
struct Gemm { const bf16_t* A; const bf16_t* Bt; int M, N, K; int half_pm; int KL; };
struct StaticOrder {
    int nM, nN, nwg, G, c, ntail;
    __device__ void init(int M, int N, int G_, int c_, bool tail = true) { nM = M / BM - 1; nN = N / BM; nwg = nM * nN; G = G_; c = c_; ntail = tail ? nN : 0; }
    __device__ bool next(int i, Unit& u) const {
        u.ks = 0;
        const long L = (long)i * G + c; if (L >= nwg + ntail) return false;
        if (L >= nwg) { u.pm = nM; u.pn = (int)(L - nwg); return true; }
        int wgid = (int)L; { const int q = nwg / NXCD, r = nwg % NXCD, xcd = wgid % NXCD, off = wgid / NXCD; wgid = (xcd < r ? xcd * (q + 1) : r * (q + 1) + (xcd - r) * q) + off; }
        const int nig = WGM * nN, gid = wgid / nig, fm = gid * WGM, gsz = (nM - fm) < WGM ? (nM - fm) : WGM;
        u.pm = fm + ((wgid % nig) % gsz); u.pn = (wgid % nig) / gsz; return true;
    }
};
struct MergeOrder {
    int G, c;
    __device__ bool next(int i, Unit& u) const { const int L = (i / 3) * G + c; if (L >= 129 * 4) return false; const int j = i % 3; u.pm = j * 129 + (L >> 2); u.pn = j * 4 + (L & 3); u.ks = 0; return true; }
};

struct TailOrder { int nS, c;
    __device__ bool next(int i, Unit& u) const { if (i > 0 || c >= 4 * nS) return false; u.pm = c / nS; u.ks = c - u.pm * nS; u.pn = 0; return true; } };

template <class Epi, class Sched>
__device__ __forceinline__ void gemm_phase(LAS unsigned char* lds, const Gemm g, const Sched& S, const Epi& E) {
    const int tid = ltid(), wid = __builtin_amdgcn_readfirstlane(tid >> 6), lane = tid & 63, wr = wid >> 2, wc = wid & 3, fr = lane & 15, fq = lane >> 4;
    const int K = g.K, nt = g.KL / BK;
    unsigned voffA, voffB;
    { int R, C; stage_rc(tid * 16, R, C); const int Rb = Epi::PERM ? ((R & ~31) + perm32(R & 31)) : R;
        voffA = (unsigned)(R * K + C) * 2u; voffB = (unsigned)(Rb * K + C) * 2u; }
    const size_t r64 = (size_t)64 * K * 2;
    const size_t kstep = (size_t)(BK * 2);
    const size_t hstep = (size_t)HALF * K * 2;
    const size_t tstep = 2 * hstep;
    const unsigned ldsw = (unsigned)wid * 1024u;
    const int aoff = lds_byte(wr * 64 + fr, fq * 8), boff = lds_byte(wc * 32 + fr, fq * 8);
#define PG8_SA(b, h) (((b) * 2 + (h)) * HTB)
#define PG8_SB(b, h) ((4 + (b) * 2 + (h)) * HTB)
#define PG8_STAGE(bufoff, gbase, voff) do { _Pragma("unroll") for (int _i = 0; _i < 2; ++_i) \
        __builtin_amdgcn_global_load_lds((const unsigned*)((const char*)(gbase) + _i * r64 + (voff)), (LAS unsigned*)(lds + (bufoff) + ldsw + _i * 8192), 16, 0, 0); } while (0)
#define PG8_LDA(dst, b, h) do { _Pragma("unroll") for (int m = 0; m < 4; ++m) _Pragma("unroll") for (int k = 0; k < 2; ++k) dst[m][k] = *(const LAS bf16x8*)(lds + PG8_SA(b, h) + aoff + m * 2048 + k * 1024); } while (0)
#define PG8_LDB(dst, b, h) do { _Pragma("unroll") for (int n = 0; n < 2; ++n) _Pragma("unroll") for (int k = 0; k < 2; ++k) dst[n][k] = *(const LAS bf16x8*)(lds + PG8_SB(b, h) + boff + n * 2048 + k * 1024); } while (0)
#define PG8_MMA(ai, bj, At, Bt) do { __builtin_amdgcn_s_setprio(1); _Pragma("unroll") for (int m = 0; m < 4; ++m) _Pragma("unroll") for (int n = 0; n < 2; ++n) _Pragma("unroll") for (int k = 0; k < 2; ++k) \
        acc[ai][bj][m][n] = __builtin_amdgcn_mfma_f32_16x16x32_bf16(Bt[n][k], At[m][k], acc[ai][bj][m][n], 0, 0, 0); __builtin_amdgcn_s_setprio(0); } while (0)
#define PG8_WAIT_V(n) asm volatile("s_waitcnt vmcnt(" #n ")" ::: "memory")
#define PG8_WAIT_L(n) asm volatile("s_waitcnt lgkmcnt(" #n ")" ::: "memory")
#define PG8_BAR __builtin_amdgcn_s_barrier()
#define PG8_SCHED __builtin_amdgcn_sched_barrier(0)
    Unit cur, nxt; int ui = 0;
    if (!S.next(0, cur)) return;
    f32x4 acc[2][2][4][2];
#pragma unroll
    for (int a = 0; a < 2; ++a)
#pragma unroll
        for (int b = 0; b < 2; ++b)
#pragma unroll
            for (int m = 0; m < 4; ++m)
#pragma unroll
                for (int n = 0; n < 2; ++n) acc[a][b][m][n] = (f32x4){0.f, 0.f, 0.f, 0.f};
    bf16x8 At[4][2], B0[2][2], B1[2][2];
    const char* cA = (const char*)g.A + (size_t)cur.pm * tstep + (size_t)cur.ks * g.KL * 2; const char* cB = (const char*)g.Bt + (size_t)cur.pn * tstep + (size_t)cur.ks * g.KL * 2;
    PG8_STAGE(PG8_SB(0, 0), cB, voffB); PG8_STAGE(PG8_SB(0, 1), cB + hstep, voffB); PG8_STAGE(PG8_SA(0, 0), cA, voffA); PG8_STAGE(PG8_SA(0, 1), cA + hstep, voffA);
    if (wr == 1) PG8_BAR;
    PG8_WAIT_V(2); PG8_BAR;
    PG8_STAGE(PG8_SB(1, 0), cB + kstep, voffB); PG8_STAGE(PG8_SA(1, 0), cA + kstep, voffA); PG8_STAGE(PG8_SB(1, 1), cB + hstep + kstep, voffB);
    PG8_WAIT_V(6); PG8_BAR;
    for (;;) {
        const bool has_next = S.next(ui + 1, nxt);
        const char* nA = has_next ? (const char*)g.A + (size_t)nxt.pm * tstep + (size_t)nxt.ks * g.KL * 2 : cA; const char* nB = has_next ? (const char*)g.Bt + (size_t)nxt.pn * tstep + (size_t)nxt.ks * g.KL * 2 : cB;
        for (int t = 0; t < nt; t += 2) {
            const bool last = (t == nt - 2);
            const char* a1 = cA + (size_t)(t + 1) * kstep;
            const char* a2 = last ? nA : cA + (size_t)(t + 2) * kstep; const char* b2 = last ? nB : cB + (size_t)(t + 2) * kstep;
            const char* a3 = a2 + kstep; const char* b3 = b2 + kstep;
            PG8_LDB(B0, 0, 0); PG8_LDB(B1, 0, 1); PG8_SCHED; PG8_LDA(At, 0, 0); PG8_STAGE(PG8_SA(1, 1), a1 + hstep, voffA);
            PG8_WAIT_V(8); PG8_WAIT_L(0); PG8_BAR; PG8_MMA(0, 0, At, B0); PG8_MMA(0, 1, At, B1); PG8_BAR; PG8_SCHED;
            PG8_LDA(At, 0, 1); PG8_STAGE(PG8_SB(0, 0), b2, voffB); PG8_STAGE(PG8_SB(0, 1), b2 + hstep, voffB); PG8_STAGE(PG8_SA(0, 0), a2, voffA);
            PG8_WAIT_V(8); PG8_WAIT_L(0); PG8_BAR; PG8_MMA(1, 0, At, B0); PG8_MMA(1, 1, At, B1); PG8_BAR; PG8_SCHED;
            PG8_LDB(B0, 1, 0); PG8_LDB(B1, 1, 1); PG8_SCHED; PG8_LDA(At, 1, 0); PG8_STAGE(PG8_SA(0, 1), a2 + hstep, voffA);
            PG8_WAIT_V(8); PG8_WAIT_L(0); PG8_BAR; PG8_MMA(0, 0, At, B0); PG8_MMA(0, 1, At, B1); PG8_BAR; PG8_SCHED;
            PG8_LDA(At, 1, 1); PG8_STAGE(PG8_SB(1, 0), b3, voffB); PG8_STAGE(PG8_SB(1, 1), b3 + hstep, voffB); PG8_STAGE(PG8_SA(1, 0), a3, voffA);
            PG8_WAIT_V(8); PG8_WAIT_L(0); PG8_BAR; PG8_MMA(1, 0, At, B0); PG8_MMA(1, 1, At, B1); PG8_BAR; PG8_SCHED;
        }
        if (wr == 0) PG8_BAR;
        E(acc, cur, wr, wc, fr, fq);
        if (!has_next) break;
#pragma unroll
        for (int a = 0; a < 2; ++a)
#pragma unroll
            for (int b = 0; b < 2; ++b)
#pragma unroll
                for (int m = 0; m < 4; ++m)
#pragma unroll
                    for (int n = 0; n < 2; ++n) acc[a][b][m][n] = (f32x4){0.f, 0.f, 0.f, 0.f};
        cur = nxt; cA = nA; cB = nB; ++ui;
        if (wr == 1) PG8_BAR;
    }
    PG8_WAIT_V(0);
    PG8_BAR;
#undef PG8_SA
#undef PG8_SB
#undef PG8_STAGE
#undef PG8_LDA
#undef PG8_LDB
#undef PG8_MMA
#undef PG8_WAIT_V
#undef PG8_WAIT_L
#undef PG8_BAR
#undef PG8_SCHED
}

template <int ACT> struct EpiBf16 {
    static constexpr bool PERM = true;
    bf16_t* O; int ldc;
    __device__ __forceinline__ void operator()(const f32x4 (&acc)[2][2][4][2], const Unit& u, int wr, int wc, int fr, int fq) const {
        const int row0 = u.pm * BM + wr * 64 + fr, col0 = u.pn * BM + wc * 32 + 8 * fq;
#pragma unroll
        for (int ai = 0; ai < 2; ++ai)
#pragma unroll
            for (int m = 0; m < 4; ++m) { bf16_t* rowp = O + (size_t)(row0 + ai * HALF + m * 16) * ldc + col0;
#pragma unroll
                for (int bj = 0; bj < 2; ++bj) { f32x4 v0 = acc[ai][bj][m][0], v1 = acc[ai][bj][m][1];
                    if (ACT == 1) {
#pragma unroll
                        for (int j = 0; j < 4; ++j) { v0[j] = sigmoidf_(v0[j]); v1[j] = sigmoidf_(v1[j]); } }
                    u32x4 w; w.x = cvt_pk_bf16(v0[0], v0[1]); w.y = cvt_pk_bf16(v0[2], v0[3]); w.z = cvt_pk_bf16(v1[0], v1[1]); w.w = cvt_pk_bf16(v1[2], v1[3]);
                    *(u32x4*)(rowp + bj * HALF) = w; } }
    }
};
struct EpiSlab {
    static constexpr bool PERM = true;
    float* slab; int nS;
    __device__ __forceinline__ void operator()(const f32x4 (&acc)[2][2][4][2], const Unit& u, int wr, int wc, int fr, int fq) const {
        float* sp = slab + ((size_t)u.ks * 128 + wc * 32 + 8 * fq) * 1024 + u.pm * 256 + wr * 64 + fr;
#pragma unroll
        for (int ai = 0; ai < 2; ++ai)
#pragma unroll
            for (int m = 0; m < 4; ++m) { float* rp = sp + ai * HALF + m * 16;
#pragma unroll
                for (int n = 0; n < 2; ++n)
#pragma unroll
                    for (int j = 0; j < 4; ++j) rp[(size_t)(4 * n + j) * 1024] = acc[ai][0][m][n][j]; }
    }
};
struct EpiSwiglu {
    static constexpr bool PERM = true;
    bf16_t* O;
    __device__ __forceinline__ void operator()(const f32x4 (&acc)[2][2][4][2], const Unit& u, int wr, int wc, int fr, int fq) const {
        const int row0 = u.pm * BM + wr * 64 + fr, col0 = u.pn * 128 + wc * 32 + 8 * fq;
#pragma unroll
        for (int ai = 0; ai < 2; ++ai)
#pragma unroll
            for (int m = 0; m < 4; ++m) { bf16_t* rowp = O + (size_t)(row0 + ai * HALF + m * 16) * DFF + col0;
                const f32x4 a0 = acc[ai][0][m][0], a1 = acc[ai][0][m][1], b0 = acc[ai][1][m][0], b1 = acc[ai][1][m][1];
                float v[8];
#pragma unroll
                for (int j = 0; j < 4; ++j) { v[j] = siluf_(a0[j]) * b0[j]; v[4 + j] = siluf_(a1[j]) * b1[j]; }
                *(u32x4*)rowp = pack8(v); }
    }
};
struct EpiInProj {
    static constexpr bool PERM = true;
    unsigned char* ws;
    __device__ __forceinline__ void operator()(const f32x4 (&acc)[2][2][4][2], const Unit& u, int wr, int wc, int fr, int fq) const {
        const int row0 = u.pm * BM + wr * 64 + fr, pn = u.pn;
        if (pn == 18) {
            if (wc == 0 && fq < 2) { float* Lg = (float*)(ws + S_LOGIT);
#pragma unroll
                for (int ai = 0; ai < 2; ++ai)
#pragma unroll
                    for (int m = 0; m < 4; ++m) { float* rp = Lg + (size_t)(row0 + ai * HALF + m * 16) * 16 + 8 * fq; *(f32x4*)rp = acc[ai][0][m][0]; *(f32x4*)(rp + 4) = acc[ai][0][m][1]; } }
            return; }
        bf16_t* base; int ld, cb;
        if (pn < 4) { base = (bf16_t*)(ws + O_PQ); ld = 1024; cb = pn * 256; }
        else if (pn < 10) { base = (bf16_t*)(ws + O_SC); ld = 1536; cb = (pn - 4) * 256; }
        else if (pn < 16) { base = (bf16_t*)(ws + O_QKV); ld = 1536; cb = (pn - 10) * 256; }
        else { base = (bf16_t*)(ws + O_Z); ld = 512; cb = (pn - 16) * 256; }
        const int col0 = cb + wc * 32 + 8 * fq;
#pragma unroll
        for (int ai = 0; ai < 2; ++ai)
#pragma unroll
            for (int m = 0; m < 4; ++m) { bf16_t* rowp = base + (size_t)(row0 + ai * HALF + m * 16) * ld + col0;
#pragma unroll
                for (int bj = 0; bj < 2; ++bj) { const f32x4 v0 = acc[ai][bj][m][0], v1 = acc[ai][bj][m][1];
                    u32x4 w; w.x = cvt_pk_bf16(v0[0], v0[1]); w.y = cvt_pk_bf16(v0[2], v0[3]); w.z = cvt_pk_bf16(v1[0], v1[1]); w.w = cvt_pk_bf16(v1[2], v1[3]);
                    *(u32x4*)(rowp + bj * HALF) = w; } }
    }
};
struct EpiFourier {
    static constexpr bool PERM = true;
    bf16_t* FM; float sc;
    __device__ __forceinline__ void operator()(const f32x4 (&acc)[2][2][4][2], const Unit& u, int wr, int wc, int fr, int fq) const {
        const int row0 = u.pm * BM + wr * 64 + fr;
        const int colt = u.pn * BM;
        const int b = colt >> 13, k1 = (colt >> 9) & 15, ch0 = (colt & 511) + wc * 32 + 8 * fq;
#pragma unroll
        for (int ai = 0; ai < 2; ++ai)
#pragma unroll
            for (int m = 0; m < 4; ++m) { const int k2 = row0 + ai * HALF + m * 16;
                if (k2 < 257) { bf16_t* rowp = FM + (size_t)(b * LL + k1 + 16 * k2) * 512 + ch0;
#pragma unroll
                    for (int bj = 0; bj < 2; ++bj) { const f32x4 v0 = acc[ai][bj][m][0] * sc, v1 = acc[ai][bj][m][1] * sc;
                        u32x4 w; w.x = cvt_pk_bf16(v0[0], v0[1]); w.y = cvt_pk_bf16(v0[2], v0[3]); w.z = cvt_pk_bf16(v1[0], v1[1]); w.w = cvt_pk_bf16(v1[2], v1[3]);
                        *(u32x4*)(rowp + bj * HALF) = w; } } }
    }
};
struct EpiMerge {
    static constexpr bool PERM = true;
    const bf16_t* GATE; bf16_t* MG; bf16_t* MGB;
    __device__ __forceinline__ void operator()(const f32x4 (&acc)[2][2][4][2], const Unit& u, int wr, int wc, int fr, int fq) const {
        const int j = u.pm / 129, pm = u.pm - j * 129, pn = u.pn & 3;
        const int row0 = pm * BM + wr * 64 + fr, col0 = pn * BM + wc * 32 + 8 * fq;
        const bf16_t* mold = (j == 1 ? MG : MGB); bf16_t* mnew = (j == 1 ? MGB : MG);
#pragma unroll
        for (int ai = 0; ai < 2; ++ai) {
            u32x4 gv[4][2], ov[4][2];
#pragma unroll
            for (int m = 0; m < 4; ++m)
#pragma unroll
                for (int bj = 0; bj < 2; ++bj) { const size_t r = (size_t)(row0 + ai * HALF + m * 16);
                    gv[m][bj] = *(const u32x4*)(GATE + r * 3072 + j * 1024 + col0 + bj * HALF);
                    if (j > 0) ov[m][bj] = *(const u32x4*)(mold + r * 1024 + col0 + bj * HALF); }
#pragma unroll
            for (int m = 0; m < 4; ++m)
#pragma unroll
                for (int bj = 0; bj < 2; ++bj) { const size_t r = (size_t)(row0 + ai * HALF + m * 16);
                    float g[8], v[8]; unpack8(gv[m][bj], g);
                    const f32x4 v0 = acc[ai][bj][m][0], v1 = acc[ai][bj][m][1];
#pragma unroll
                    for (int e = 0; e < 4; ++e) { v[e] = v0[e] * g[e]; v[4 + e] = v1[e] * g[4 + e]; }
                    if (j > 0) { float o[8]; unpack8(ov[m][bj], o);
#pragma unroll
                        for (int e = 0; e < 8; ++e) v[e] += o[e]; }
                    *(u32x4*)(mnew + r * 1024 + col0 + bj * HALF) = pack8(v); }
            asm volatile("" ::: "memory"); }
    }
};
}

__device__ void rpass(const Params& P, const bf16_t* Y, bool first_h, const float* gpost, float scale, const float* gpre, bf16_t* XN, const float* slab = nullptr, int nS = 0) {
    const int tid_ = ltid(); const int wave = __builtin_amdgcn_readfirstlane(tid_ >> 6), lane = tid_ & 63;
    float* hm = (float*)(P.ws + S_HM);
    for (int r = lbid() * 8 + wave; r < TT; r += lgrid() * 8) {
        const int b = r / LL, n = r - b * LL;
        const float* hin; float* hout;
        if (n < NMETA) { hout = hm + (size_t)(b * 16 + n) * 1024; hin = first_h ? P.in[1] + (size_t)n * 1024 : hout; }
        else { const size_t o = ((size_t)b * SEQ + (n - NMETA)) * 1024; hout = P.out + o; hin = first_h ? P.in[0] + o : hout; }
        float h[16];
        { const f32x4 a = *(const f32x4*)(hin + lane * 8), b4 = *(const f32x4*)(hin + lane * 8 + 4), c = *(const f32x4*)(hin + 512 + lane * 8), d = *(const f32x4*)(hin + 512 + lane * 8 + 4);
#pragma unroll
          for (int e = 0; e < 4; ++e) { h[e] = a[e]; h[4 + e] = b4[e]; h[8 + e] = c[e]; h[12 + e] = d[e]; } }
        if (Y) {
            float y[16];
            if (slab != nullptr && r >= 32768) {
                const float* sp = slab + (size_t)(r - 32768) * 1024 + lane * 8;
                f32x4 s0 = {0.f, 0.f, 0.f, 0.f}, s1 = s0, s2 = s0, s3 = s0;
#pragma unroll 1
                for (int ks = 0; ks < nS; ++ks) { s0 += *(const f32x4*)sp; s1 += *(const f32x4*)(sp + 4); s2 += *(const f32x4*)(sp + 512); s3 += *(const f32x4*)(sp + 516); sp += 131072; }
#pragma unroll
                for (int e = 0; e < 4; ++e) { y[e] = s0[e]; y[4 + e] = s1[e]; y[8 + e] = s2[e]; y[12 + e] = s3[e]; }
            } else { unpack8(*(const u32x4*)(Y + (size_t)r * 1024 + lane * 8), y); unpack8(*(const u32x4*)(Y + (size_t)r * 1024 + 512 + lane * 8), y + 8); }
            float ss = 0.f;
#pragma unroll
            for (int e = 0; e < 16; ++e) ss += y[e] * y[e];
            ss = wave_sum(ss); const float r1 = rsqrtf(ss * (1.0f / 1024.0f) + EPS) * scale;
#pragma unroll
            for (int e = 0; e < 8; ++e) { h[e] += y[e] * r1 * gpost[lane * 8 + e]; h[8 + e] += y[8 + e] * r1 * gpost[512 + lane * 8 + e]; }
            *(f32x4*)(hout + lane * 8) = (f32x4){h[0], h[1], h[2], h[3]}; *(f32x4*)(hout + lane * 8 + 4) = (f32x4){h[4], h[5], h[6], h[7]};
            *(f32x4*)(hout + 512 + lane * 8) = (f32x4){h[8], h[9], h[10], h[11]}; *(f32x4*)(hout + 512 + lane * 8 + 4) = (f32x4){h[12], h[13], h[14], h[15]};
        }
        if (gpre) {
            float ss = 0.f;
#pragma unroll
            for (int e = 0; e < 16; ++e) ss += h[e] * h[e];
            ss = wave_sum(ss); const float r2 = rsqrtf(ss * (1.0f / 1024.0f) + EPS);
            float o[16];
#pragma unroll
            for (int e = 0; e < 8; ++e) { o[e] = h[e] * r2 * gpre[lane * 8 + e]; o[8 + e] = h[8 + e] * r2 * gpre[512 + lane * 8 + e]; }
            *(u32x4*)(XN + (size_t)r * 1024 + lane * 8) = pack8(o); *(u32x4*)(XN + (size_t)r * 1024 + 512 + lane * 8) = pack8(o + 8);
        }
    }
}

template <class F>
__device__ void cvt_tiles(const float* src, int ld_src, int K, bf16_t* dst, int nrows, F srccol, unsigned char* smem) {
    float* lds = (float*)smem; const int tid = ltid();
    const int ntr = nrows / 64, ntk = K / 64, nt_ = ntr * ntk, G_ = lgrid();
    float pv[8];
    { const int t = lbid(); if (t < nt_) { const int tr = t % ntr, tk = t / ntr; const int c0 = srccol(tr * 64);
#pragma unroll
        for (int i = 0; i < 8; ++i) { const int kk = (tid >> 6) + 8 * i, cc = tid & 63; pv[i] = src[(size_t)(tk * 64 + kk) * ld_src + c0 + cc]; } } }
    for (int t = lbid(); t < nt_; t += G_) {
        const int tr = t % ntr, tk = t / ntr;
        __syncthreads();
#pragma unroll
        for (int i = 0; i < 8; ++i) { const int kk = (tid >> 6) + 8 * i, cc = tid & 63; lds[kk * 65 + cc] = pv[i]; }
        __syncthreads();
        { const int t2 = t + G_; if (t2 < nt_) { const int tr2 = t2 % ntr, tk2 = t2 / ntr; const int c2 = srccol(tr2 * 64);
#pragma unroll
            for (int i = 0; i < 8; ++i) { const int kk = (tid >> 6) + 8 * i, cc = tid & 63; pv[i] = src[(size_t)(tk2 * 64 + kk) * ld_src + c2 + cc]; } } }
        const int cc2 = tid >> 3, k8 = (tid & 7) * 8; float v[8];
#pragma unroll
        for (int e = 0; e < 8; ++e) v[e] = lds[(k8 + e) * 65 + cc2];
        *(u32x4*)(dst + (size_t)(tr * 64 + cc2) * K + tk * 64 + k8) = pack8(v);
    }
}
struct ColIdent { int off; __device__ int operator()(int r) const { return r + off; } };
struct ColSwiglu { __device__ int operator()(int r) const { const int pn = r >> 8, rem = r & 255; return (rem >> 7) * DFF + 128 * pn + (rem & 127); } };

__device__ void convert_weights(const Params& P, int l, unsigned char* smem) {
    unsigned char* ws = P.ws; const int tid = ltid();
    cvt_tiles(P.in[3] + (size_t)l * 1024 * 5632, 5632, 1024, (bf16_t*)(ws + W_WI1), 5632, ColSwiglu{}, smem);
    cvt_tiles(P.in[4] + (size_t)l * 2816 * 1024, 1024, 2816, (bf16_t*)(ws + W_WO1), 1024, ColIdent{0}, smem);
    cvt_tiles(P.in[5] + (size_t)l * 1024 * 5632, 5632, 1024, (bf16_t*)(ws + W_WI2), 5632, ColSwiglu{}, smem);
    cvt_tiles(P.in[6] + (size_t)l * 2816 * 1024, 1024, 2816, (bf16_t*)(ws + W_WO2), 1024, ColIdent{0}, smem);
    const float* win = P.in[7] + (size_t)l * 1024 * NIN;
    cvt_tiles(win, NIN, 1024, (bf16_t*)(ws + W_WIN) + (size_t)1024 * 1024, 3584, ColIdent{512}, smem);
    cvt_tiles(win, NIN, 1024, (bf16_t*)(ws + W_WG), 3072, ColIdent{4112}, smem);
    cvt_tiles(P.in[13] + (size_t)l * 512 * 1024, 1024, 512, (bf16_t*)(ws + W_WBR), 1024, ColIdent{0}, smem);
    cvt_tiles(P.in[14] + (size_t)l * 512 * 1024, 1024, 512, (bf16_t*)(ws + W_WBR) + (size_t)1024 * 512, 1024, ColIdent{0}, smem);
    cvt_tiles(P.in[15] + (size_t)l * 512 * 1024, 1024, 512, (bf16_t*)(ws + W_WBR) + (size_t)2048 * 512, 1024, ColIdent{0}, smem);
    cvt_tiles(P.in[16] + (size_t)l * 1024 * 1024, 1024, 1024, (bf16_t*)(ws + W_WOUT), 1024, ColIdent{0}, smem);
    { bf16_t* d = (bf16_t*)(ws + W_WIN) + (size_t)4608 * 1024;
      for (int i = lbid() * 512 + tid; i < 256 * 1024; i += lgrid() * 512) { const int rr = i >> 10, k = i & 1023; d[i] = rr < 16 ? f2bf(win[(size_t)k * NIN + 4096 + rr]) : (bf16_t)0; } }
    { float* Ws = (float*)smem; float* ct = Ws + 64 * 65; float* st = ct + 64;
      __syncthreads();
      if (tid < 64) { float s, c; sincospif((float)tid * (2.0f / 64.0f), &s, &c); ct[tid] = c; st[tid] = s; }
      bf16_t* dp = (bf16_t*)(ws + W_WIN); bf16_t* dq = dp + (size_t)512 * 1024;
      for (int it = lbid(); it < 8 * 16; it += lgrid()) { const int g = it >> 4, kt = it & 15;
          __syncthreads();
#pragma unroll
          for (int i = 0; i < 8; ++i) { const int kk = (tid >> 6) + 8 * i, cc = tid & 63; Ws[kk * 65 + cc] = win[(size_t)(kt * 64 + kk) * NIN + g * 64 + cc]; }
          __syncthreads();
          const int kk = tid & 63;
#pragma unroll 1
          for (int i = 0; i < 8; ++i) { const int cp = (tid >> 6) + 8 * i; float ap = 0.f, aq = 0.f;
#pragma unroll 4
              for (int c = 0; c < 64; ++c) { const float w = Ws[kk * 65 + c]; const int ph = (c * cp) & 63; ap += w * ct[ph]; aq += w * st[ph]; }
              dp[(size_t)(g * 64 + cp) * 1024 + kt * 64 + kk] = f2bf(ap); dq[(size_t)(g * 64 + cp) * 1024 + kt * 64 + kk] = f2bf(aq); }
      }
      __syncthreads(); }
}

__device__ void gen_tables(const Params& P) {
    unsigned char* ws = P.ws; const int gt = lbid() * 512 + ltid(), gs = lgrid() * 512;
    bf16_t* C = (bf16_t*)(ws + S_C257);
    for (int i = gt; i < 512 * KF; i += gs) { const int k2 = i / KF, kk = i - k2 * KF; const int ri = kk >= 320, n2 = kk - ri * 320; float v = 0.f;
        if (k2 < 257 && n2 < 257) { const int m = (k2 * n2) % 257; float s, c; sincospif((float)m * (2.0f / 257.0f), &s, &c); v = ri ? s : c; }
        C[i] = f2bf(v); }
    float* tw = (float*)(ws + S_TWL);
    for (int i = gt; i < LL; i += gs) { float s, c; sincospif((float)i * (2.0f / (float)LL), &s, &c); tw[2 * i] = c; tw[2 * i + 1] = -s; }
}

__device__ void sconv_pass(const Params& P, int l) {
    const int tid_ = ltid(); const int wave = __builtin_amdgcn_readfirstlane(tid_ >> 6), lane = tid_ & 63;
    const bf16_t* SC = (const bf16_t*)(P.ws + O_SC); bf16_t* SCO = (bf16_t*)(P.ws + O_BR) + (size_t)TP * 512;
    const float* w = P.in[8] + (size_t)l * 3 * 512;
    float w0[8], w1[8], w2[8];
#pragma unroll
    for (int e = 0; e < 8; ++e) { w0[e] = w[lane * 8 + e]; w1[e] = w[512 + lane * 8 + e]; w2[e] = w[1024 + lane * 8 + e]; }
    for (int r = lbid() * 8 + wave; r < TT; r += lgrid() * 8) {
        const int b = r / LL, n = r - b * LL; const bf16_t* rp = SC + (size_t)r * 1536 + lane * 8;
        float bb[8], c[8], h[8], acc[8]; unpack8(*(const u32x4*)rp, bb); unpack8(*(const u32x4*)(rp + 512), c); unpack8(*(const u32x4*)(rp + 1024), h);
#pragma unroll
        for (int e = 0; e < 8; ++e) acc[e] = w1[e] * c[e] * h[e];
        if (n > 0) { unpack8(*(const u32x4*)(rp - 1536 + 512), c); unpack8(*(const u32x4*)(rp - 1536 + 1024), h);
#pragma unroll
            for (int e = 0; e < 8; ++e) acc[e] += w0[e] * c[e] * h[e]; }
        if (n < LL - 1) { unpack8(*(const u32x4*)(rp + 1536 + 512), c); unpack8(*(const u32x4*)(rp + 1536 + 1024), h);
#pragma unroll
            for (int e = 0; e < 8; ++e) acc[e] += w2[e] * c[e] * h[e]; }
#pragma unroll
        for (int e = 0; e < 8; ++e) acc[e] *= bb[e];
        *(u32x4*)(SCO + (size_t)r * 512 + lane * 8) = pack8(acc);
    }
}

__device__ void fstep1(const Params& P, unsigned char* smem) {
    const int tid = ltid(), wave = __builtin_amdgcn_readfirstlane(tid >> 6), lane = tid & 63;
    const bf16_t* PQ = (const bf16_t*)(P.ws + O_PQ); bf16_t* AP = (bf16_t*)(P.ws + O_AP); const float* tw = (const float*)(P.ws + S_TWL);
    bf16_t* St = (bf16_t*)smem;
    for (int it = lbid(); it < 8 * 4 * 17; it += lgrid()) {
        const int b = it / 68, rem = it - b * 68, cht = rem / 17, n2t = rem - cht * 17;
        __syncthreads();
#pragma unroll
        for (int sub = 0; sub < 2; ++sub) {
            const int n2l = sub * 8 + wave, n2 = n2t * 16 + n2l;
            const int fr = lane & 15, fq = lane >> 4;
            if (n2 < 257) {
                float f0[8], f1[8];
#pragma unroll
                for (int j = 0; j < 8; ++j) { const int n = 257 * (8 * (fq & 1) + j) + n2; const int ph = (fr * n) % LL;
                    const float2 cs_ = *(const float2*)(tw + 2 * ph); const float c_ = cs_.x, ms_ = cs_.y;
                    f0[j] = (fq < 2) ? c_ : ms_; f1[j] = (fq < 2) ? ms_ : -c_; }
                const bf16x8 a0 = __builtin_bit_cast(bf16x8, pack8(f0)), a1 = __builtin_bit_cast(bf16x8, pack8(f1));
                const bf16_t* bp = PQ + (size_t)(b * LL + 257 * 8 * (fq & 1) + n2) * 1024 + (fq >> 1) * 512 + cht * 128 + fr;
#pragma unroll
                for (int ct = 0; ct < 8; ++ct) {
                    bf16x8 bf;
#pragma unroll
                    for (int j = 0; j < 8; ++j) bf[j] = (short)bp[(size_t)j * 257 * 1024 + ct * 16];
                    const f32x4 z = {0.f, 0.f, 0.f, 0.f};
                    const f32x4 c0 = __builtin_amdgcn_mfma_f32_16x16x32_bf16(a0, bf, z, 0, 0, 0), c1 = __builtin_amdgcn_mfma_f32_16x16x32_bf16(a1, bf, z, 0, 0, 0);
                    bf16_t* sp = St + ((4 * fq) * 128 + ct * 16 + fr) * 32 + n2l;
#pragma unroll
                    for (int rg = 0; rg < 4; ++rg) { sp[rg * 4096] = f2bf(c0[rg]); sp[rg * 4096 + 16] = f2bf(c1[rg]); }
                }
            } else {
                for (int q = lane; q < 4096; q += 64) St[q * 16 + n2l] = 0;
            }
        }
        __syncthreads();
#pragma unroll 2
        for (int q = tid; q < 8192; q += 512) { const int half = q & 1, ri = (q >> 1) & 1, chl = (q >> 2) & 127, k1 = q >> 9;
            const int n2c = n2t * 16 + half * 8;
            if (n2c < 320) { const u32x4 v = *(const u32x4*)(St + (size_t)q * 8);
                *(u32x4*)(AP + ((size_t)((b * 16 + k1) * 512 + cht * 128 + chl)) * KF + ri * 320 + n2c) = v; } }
        if (n2t == 16) {
            for (int q = tid; q < 16 * 128 * 2 * 6; q += 512) { const int c6 = q % 6, r2 = q / 6, ri = r2 & 1, chl = (r2 >> 1) & 127, k1 = r2 >> 8;
                *(u32x4*)(AP + ((size_t)((b * 16 + k1) * 512 + cht * 128 + chl)) * KF + ri * 320 + 272 + c6 * 8) = (u32x4){0u, 0u, 0u, 0u}; } }
    }
    __syncthreads();
}

#ifdef DBG_SEC
#define SEC_T(k) do { if (lbid() == 0 && tid == 0) { const unsigned long long _n = __builtin_amdgcn_s_memrealtime(); if (sec_prev_k == DBG_SEC) *(unsigned long long*)(smem + LDS_BYTES - 32) += _n - sec_prev_t; sec_prev_t = _n; sec_prev_k = (k); } } while (0)
#else
#define SEC_T(k) do {} while (0)
#endif
__device__ void dn_prep(const Params& P, int l, unsigned char* smem, int t0, int t1) {
#ifdef DBG_SEC
    unsigned long long sec_prev_t = __builtin_amdgcn_s_memrealtime(); int sec_prev_k = -1;
#endif
    const int tid = ltid(), wave = __builtin_amdgcn_readfirstlane(tid >> 6), lane = tid & 63, fr = lane & 15, fq = lane >> 4;
    unsigned char* ws = P.ws;
    const bf16_t* QKV = (const bf16_t*)(ws + O_QKV); const float* LG = (const float*)(ws + S_LOGIT);
    bf16_t* WP = (bf16_t*)(ws + O_WP); bf16_t* QP = (bf16_t*)(ws + O_QP); bf16_t* KD = (bf16_t*)(ws + O_KD); bf16_t* UF = (bf16_t*)(ws + O_UF); bf16_t* AT = (bf16_t*)(ws + O_AT);
    float* GL = (float*)(ws + S_GL);
    const float* cw = P.in[9] + (size_t)l * 3 * 1536;
    bf16_t* Qs = (bf16_t*)smem;
    bf16_t* Ks = Qs + 64 * 136;
    bf16_t* KT = Ks + 64 * 136;
    bf16_t* VT = KT + 128 * 72;
    bf16_t* T1 = VT + 128 * 72;
    bf16_t* T2 = T1 + 64 * 72;
    bf16_t* Rm = T2 + 64 * 72;
    bf16_t* Rt = Rm + 64 * 72;
    bf16_t* Pm = Rt + 64 * 72;
    float* gcs = (float*)(T2 + 64 * 72 + 2 * 64 * 68 * 2);
    float* bts = gcs + 64;
    float* cwl = bts + 64;
    bf16_t* Xr = T1;
    const int items = (t1 - t0) * 64;
    u32x4 x0[6], xb;
#define PREP_ISSUE(it_) do { const int _tl = (it_) >> 6, _bhd = (it_) & 63, _b = _bhd >> 3, _h = (_bhd >> 1) & 3, _dir = _bhd & 1; const int _nb = (_dir ? 64 - (t0 + _tl) : (t0 + _tl)) * 64 - 48; const u32x4 z4 = {0u, 0u, 0u, 0u}; \
        _Pragma("unroll") for (int rr = 0; rr < 6; ++rr) { const int task = tid + 512 * rr, i = task / 48, cg_ = task - i * 48; const int n = _nb + (_dir ? 63 - i : i); \
            x0[rr] = (n >= 0) ? *(const u32x4*)(QKV + (size_t)(_b * LL + n) * 1536 + (cg_ >> 4) * 512 + _h * 128 + (cg_ & 15) * 8) : z4; } \
        xb = z4; if (tid < 96) { const int which = tid / 48, cg_ = tid - which * 48; const int n = which ? _nb + 64 : _nb - 1; \
            if (n >= 0 && n < LL) xb = *(const u32x4*)(QKV + (size_t)(_b * LL + n) * 1536 + (cg_ >> 4) * 512 + _h * 128 + (cg_ & 15) * 8); } } while (0)
    for (int it = lbid(); it < items; it += lgrid()) {
        const int tl = it >> 6, bhd = it & 63, b = bhd >> 3, h = (bhd >> 1) & 3, dir = bhd & 1;
        const int t = t0 + tl, c = dir ? 64 - t : t; const size_t slot = (size_t)tl * 64 + bhd;
        PREP_ISSUE(it);
        __syncthreads();
        SEC_T(0);
        for (int q = tid; q < 1152; q += 512) { const int tap = q / 384, rem = q - tap * 384; cwl[q] = cw[tap * 1536 + (rem >> 7) * 512 + h * 128 + (rem & 127)]; }
#pragma unroll
        for (int rr = 0; rr < 6; ++rr) { const int task = tid + 512 * rr, i = task / 48, cg_ = task - i * 48; *(u32x4*)(Xr + ((dir ? 63 - i : i) + 1) * 384 + cg_ * 8) = x0[rr]; }
        if (tid < 96) { const int which = tid / 48, cg_ = tid - which * 48; *(u32x4*)(Xr + (which ? 65 : 0) * 384 + cg_ * 8) = xb; }
        __syncthreads();
#pragma unroll 1
        for (int rr = 0; rr < 6; ++rr) {
            const int task = tid + 512 * rr, i = task / 48, cg_ = task - i * 48, kind = cg_ >> 4, cgl = cg_ & 15;
            float v[8], x[8];
            const float* w1 = cwl + 384 + kind * 128 + cgl * 8;
            const bf16_t* xr = Xr + ((dir ? 63 - i : i) + 1) * 384 + cg_ * 8;
            unpack8(*(const u32x4*)xr, x);
#pragma unroll
            for (int e = 0; e < 8; ++e) v[e] = w1[e] * x[e];
            unpack8(*(const u32x4*)(xr - 384), x);
#pragma unroll
            for (int e = 0; e < 8; ++e) v[e] += w1[e - 384] * x[e];
            unpack8(*(const u32x4*)(xr + 384), x);
#pragma unroll
            for (int e = 0; e < 8; ++e) v[e] += w1[e + 384] * x[e];
#pragma unroll
            for (int e = 0; e < 8; ++e) v[e] = siluf_(v[e]);
            float ss = 0.f;
#pragma unroll
            for (int e = 0; e < 8; ++e) ss += v[e] * v[e];
            ss += __shfl_xor(ss, 1); ss += __shfl_xor(ss, 2); ss += __shfl_xor(ss, 4); ss += __shfl_xor(ss, 8);
            if (kind < 2) { const float inv = rsqrtf(ss + EPS) * (kind == 0 ? 0.08838834764831845f : 1.0f);
#pragma unroll
                for (int e = 0; e < 8; ++e) v[e] *= inv; }
            const u32x4 pk = pack8(v);
            const int isw = i ^ ((cgl & 7) << 3);
            if (kind == 0) *(u32x4*)(Qs + i * 136 + cgl * 8) = pk;
            else if (kind == 1) { *(u32x4*)(Ks + i * 136 + cgl * 8) = pk;
#pragma unroll
                for (int e = 0; e < 8; ++e) KT[(cgl * 8 + e) * 72 + isw] = f2bf(v[e]); }
            else {
#pragma unroll
                for (int e = 0; e < 8; ++e) VT[(cgl * 8 + e) * 72 + isw] = f2bf(v[e]); }
        }
        if (wave == 0) {
            const int i = lane, n = c * 64 + (dir ? 63 - i : i) - 48; float beta = 0.f, g = 0.f;
            if (n >= 0) { const float* lg = LG + (size_t)(b * LL + n) * 16; const float bl = lg[dir * 4 + h], al = lg[8 + dir * 4 + h];
                beta = 1.0f / (1.0f + expf(-bl));
                const float xx = al + P.in[11][l * 8 + dir * 4 + h]; const float sp = xx > 20.f ? xx : log1pf(expf(xx));
                g = -expf(P.in[10][l * 8 + dir * 4 + h]) * sp; }
#pragma unroll
            for (int o = 1; o < 64; o <<= 1) { const float tt = __shfl_up(g, o); if (lane >= o) g += tt; }
            gcs[i] = g; bts[i] = beta;
        }
        __syncthreads();
        SEC_T(1);
        if (wave < 4) {
            const int m = wave; f32x4 acc[4];
#pragma unroll
            for (int n = 0; n < 4; ++n) acc[n] = (f32x4){0.f, 0.f, 0.f, 0.f};
#pragma unroll
            for (int s = 0; s < 4; ++s) { const bf16x8 a = *(const bf16x8*)(Ks + (16 * m + fr) * 136 + 32 * s + 8 * fq);
#pragma unroll
                for (int n = 0; n < 4; ++n) { const bf16x8 bb = *(const bf16x8*)(Ks + (16 * n + fr) * 136 + 32 * s + 8 * fq); acc[n] = __builtin_amdgcn_mfma_f32_16x16x32_bf16(a, bb, acc[n], 0, 0, 0); } }
#pragma unroll
            for (int n = 0; n < 4; ++n) { const int i = 16 * n + fr, j0 = 16 * m + 4 * fq;
                float nv[4], pv_[4];
#pragma unroll
                for (int rg = 0; rg < 4; ++rg) { const int j = j0 + rg; const float mv = (i > j) ? bts[i] * acc[n][rg] * __expf(gcs[i] - gcs[j]) : 0.f;
                    nv[rg] = -mv; pv_[rg] = (i == j ? 1.f : 0.f) - mv; Rt[j * 72 + i] = f2bf(-mv); }
                u32x2 w; w.x = cvt_pk_bf16(nv[0], nv[1]); w.y = cvt_pk_bf16(nv[2], nv[3]); *(u32x2*)(Rm + i * 72 + j0) = w;
                w.x = cvt_pk_bf16(pv_[0], pv_[1]); w.y = cvt_pk_bf16(pv_[2], pv_[3]); *(u32x2*)(Pm + i * 72 + j0) = w; }
        } else {
            const int m = wave - 4; f32x4 acc[4];
#pragma unroll
            for (int n = 0; n < 4; ++n) acc[n] = (f32x4){0.f, 0.f, 0.f, 0.f};
#pragma unroll
            for (int s = 0; s < 4; ++s) { const bf16x8 qf = *(const bf16x8*)(Qs + (16 * m + fr) * 136 + 32 * s + 8 * fq);
#pragma unroll
                for (int n = 0; n < 4; ++n) { const bf16x8 kf = *(const bf16x8*)(Ks + (16 * n + fr) * 136 + 32 * s + 8 * fq); acc[n] = __builtin_amdgcn_mfma_f32_16x16x32_bf16(kf, qf, acc[n], 0, 0, 0); } }
            const int i = 16 * m + fr; const float gi = gcs[i];
#pragma unroll
            for (int s2 = 0; s2 < 2; ++s2) { float v[8];
#pragma unroll
                for (int e = 0; e < 8; ++e) { const int j = 32 * s2 + 16 * (e >> 2) + 4 * fq + (e & 3); v[e] = (i >= j) ? acc[2 * s2 + (e >> 2)][e & 3] * __expf(gi - gcs[j]) : 0.f; }
                *(u32x4*)(AT + slot * 4096 + i * 64 + (((4 * s2 + fq) ^ ((i >> 1) & 7)) << 3)) = pack8(v); }
        }
        __syncthreads();
        SEC_T(2);
        {
            const float glast = gcs[63];
            for (int task = tid; task < 2048; task += 512) {
                if (task < 1024) { const int i = task >> 4, s_ = (task >> 2) & 3, f4 = task & 3; const float sc = __expf(gcs[i]);
                    const u32x2 a = *(const u32x2*)(Qs + i * 136 + 32 * s_ + 4 * f4), bq = *(const u32x2*)(Qs + i * 136 + 32 * s_ + 16 + 4 * f4);
                    float v[8]; v[0] = bf2f(a.x & 0xffffu) * sc; v[1] = __uint_as_float(a.x & 0xffff0000u) * sc; v[2] = bf2f(a.y & 0xffffu) * sc; v[3] = __uint_as_float(a.y & 0xffff0000u) * sc;
                    v[4] = bf2f(bq.x & 0xffffu) * sc; v[5] = __uint_as_float(bq.x & 0xffff0000u) * sc; v[6] = bf2f(bq.y & 0xffffu) * sc; v[7] = __uint_as_float(bq.y & 0xffff0000u) * sc;
                    *(u32x4*)(QP + slot * 8192 + i * 128 + (((4 * s_ + f4) ^ (i & 15)) << 3)) = pack8(v);
                } else { const int tt = task - 1024, dk = tt >> 3, s2 = (tt >> 2) & 1, f4 = tt & 3; const int i0 = 32 * s2 + 4 * f4;
                    const int sw = ((dk >> 3) & 7) << 3; const u32x2 a = *(const u32x2*)(KT + dk * 72 + (i0 ^ sw)), bq = *(const u32x2*)(KT + dk * 72 + ((i0 + 16) ^ sw));
                    float v[8]; v[0] = bf2f(a.x & 0xffffu) * __expf(glast - gcs[i0]); v[1] = __uint_as_float(a.x & 0xffff0000u) * __expf(glast - gcs[i0 + 1]);
                    v[2] = bf2f(a.y & 0xffffu) * __expf(glast - gcs[i0 + 2]); v[3] = __uint_as_float(a.y & 0xffff0000u) * __expf(glast - gcs[i0 + 3]);
                    v[4] = bf2f(bq.x & 0xffffu) * __expf(glast - gcs[i0 + 16]); v[5] = __uint_as_float(bq.x & 0xffff0000u) * __expf(glast - gcs[i0 + 17]);
                    v[6] = bf2f(bq.y & 0xffffu) * __expf(glast - gcs[i0 + 18]); v[7] = __uint_as_float(bq.y & 0xffff0000u) * __expf(glast - gcs[i0 + 19]);
                    *(u32x4*)(KD + slot * 8192 + dk * 64 + (((4 * s2 + f4) ^ ((dk >> 1) & 7)) << 3)) = pack8(v); }
            }
            if (tid == 0) GL[slot] = __expf(glast);
            f32x4 accP[2];
#pragma unroll
            for (int e = 0; e < 2; ++e) { const int tt = 2 * wave + e, it_ = tt >> 2, jt = tt & 3;
                const u32x2 pw = *(const u32x2*)(Pm + (16 * it_ + fr) * 72 + 16 * jt + 4 * fq);
                accP[e] = (f32x4){__uint_as_float(pw.x << 16), __uint_as_float(pw.x & 0xffff0000u), __uint_as_float(pw.y << 16), __uint_as_float(pw.y & 0xffff0000u)}; }
#pragma unroll 1
            for (int rd = 0; rd < 6; ++rd) {
                f32x4 accR[2], accT[2];
#pragma unroll
                for (int e = 0; e < 2; ++e) { const int tt = 2 * wave + e, mt = tt >> 2, nt = tt & 3;
                    accR[e] = (f32x4){0.f, 0.f, 0.f, 0.f}; accT[e] = (f32x4){0.f, 0.f, 0.f, 0.f};
#pragma unroll
                    for (int s2 = 0; s2 < 2; ++s2) {
                        const bf16x8 rm = *(const bf16x8*)(Rm + (16 * mt + fr) * 72 + 32 * s2 + 8 * fq), rn = *(const bf16x8*)(Rm + (16 * nt + fr) * 72 + 32 * s2 + 8 * fq);
                        const bf16x8 tm = *(const bf16x8*)(Rt + (16 * mt + fr) * 72 + 32 * s2 + 8 * fq), tn = *(const bf16x8*)(Rt + (16 * nt + fr) * 72 + 32 * s2 + 8 * fq);
                        const bf16x8 pm_ = *(const bf16x8*)(Pm + (16 * mt + fr) * 72 + 32 * s2 + 8 * fq);
                        if (rd < 5) { accR[e] = __builtin_amdgcn_mfma_f32_16x16x32_bf16(rm, tn, accR[e], 0, 0, 0);
                                      accT[e] = __builtin_amdgcn_mfma_f32_16x16x32_bf16(tm, rn, accT[e], 0, 0, 0); }
                        if (rd > 0) accP[e] = __builtin_amdgcn_mfma_f32_16x16x32_bf16(tn, pm_, accP[e], 0, 0, 0);
                    } }
                __syncthreads();
                if (rd < 5) {
#pragma unroll
                    for (int e = 0; e < 2; ++e) { const int tt = 2 * wave + e, mt = tt >> 2, nt = tt & 3; u32x2 w;
                        w.x = cvt_pk_bf16(accR[e][0], accR[e][1]); w.y = cvt_pk_bf16(accR[e][2], accR[e][3]); *(u32x2*)(Rt + (16 * nt + fr) * 72 + 16 * mt + 4 * fq) = w;
                        w.x = cvt_pk_bf16(accT[e][0], accT[e][1]); w.y = cvt_pk_bf16(accT[e][2], accT[e][3]); *(u32x2*)(Rm + (16 * nt + fr) * 72 + 16 * mt + 4 * fq) = w;
                        if (rd > 0) { w.x = cvt_pk_bf16(accP[e][0], accP[e][1]); w.y = cvt_pk_bf16(accP[e][2], accP[e][3]); *(u32x2*)(Pm + (16 * mt + fr) * 72 + 16 * nt + 4 * fq) = w; } }
                    __syncthreads();
                }
            }
#pragma unroll
            for (int e = 0; e < 2; ++e) { const int tt = 2 * wave + e, mt = tt >> 2, nt = tt & 3; const int i = 16 * mt + fr, c0 = 16 * nt + 4 * fq; float v1[4], v2[4];
#pragma unroll
                for (int rg = 0; rg < 4; ++rg) { const float bc = bts[c0 + rg]; v1[rg] = accP[e][rg] * bc; v2[rg] = -accP[e][rg] * bc * __expf(gcs[c0 + rg]); }
                u32x2 w; w.x = cvt_pk_bf16(v1[0], v1[1]); w.y = cvt_pk_bf16(v1[2], v1[3]); *(u32x2*)(T1 + i * 72 + c0) = w;
                w.x = cvt_pk_bf16(v2[0], v2[1]); w.y = cvt_pk_bf16(v2[2], v2[3]); *(u32x2*)(T2 + i * 72 + c0) = w; }
        }
        __syncthreads();
        SEC_T(3);
#pragma unroll 1
        for (int nh = 0; nh < 2; ++nh) {
        if (wave < 4) {
            const int m = wave; f32x4 acc[4];
#pragma unroll
            for (int n = 0; n < 4; ++n) acc[n] = (f32x4){0.f, 0.f, 0.f, 0.f};
#pragma unroll
            for (int s2 = 0; s2 < 2; ++s2) { const bf16x8 a = *(const bf16x8*)(T1 + (16 * m + fr) * 72 + 32 * s2 + 8 * fq);
#pragma unroll
                for (int n = 0; n < 4; ++n) { const int d = 16 * (4 * nh + n) + fr; const bf16x8 bb = *(const bf16x8*)(VT + d * 72 + ((32 * s2 + 8 * fq) ^ (((d >> 3) & 7) << 3))); acc[n] = __builtin_amdgcn_mfma_f32_16x16x32_bf16(a, bb, acc[n], 0, 0, 0); } }
#pragma unroll
            for (int n = 0; n < 4; ++n) { u32x2 w; w.x = cvt_pk_bf16(acc[n][0], acc[n][1]); w.y = cvt_pk_bf16(acc[n][2], acc[n][3]);
                *(u32x2*)(UF + slot * 8192 + (((4 * nh + n) * 4 + m) * 64 + lane) * 4) = w; }
        } else {
            const int m = wave - 4; f32x4 acc[4];
#pragma unroll
            for (int n = 0; n < 4; ++n) acc[n] = (f32x4){0.f, 0.f, 0.f, 0.f};
#pragma unroll
            for (int s2 = 0; s2 < 2; ++s2) { const bf16x8 tf = *(const bf16x8*)(T2 + (16 * m + fr) * 72 + 32 * s2 + 8 * fq);
#pragma unroll
                for (int n = 0; n < 4; ++n) { const int d = 16 * (4 * nh + n) + fr; const bf16x8 kf = *(const bf16x8*)(KT + d * 72 + ((32 * s2 + 8 * fq) ^ (((d >> 3) & 7) << 3))); acc[n] = __builtin_amdgcn_mfma_f32_16x16x32_bf16(kf, tf, acc[n], 0, 0, 0); } }
            const int i = 16 * m + fr;
#pragma unroll
            for (int s = 0; s < 2; ++s) { u32x4 w; w.x = cvt_pk_bf16(acc[2 * s][0], acc[2 * s][1]); w.y = cvt_pk_bf16(acc[2 * s][2], acc[2 * s][3]);
                w.z = cvt_pk_bf16(acc[2 * s + 1][0], acc[2 * s + 1][1]); w.w = cvt_pk_bf16(acc[2 * s + 1][2], acc[2 * s + 1][3]);
                *(u32x4*)(WP + slot * 8192 + i * 128 + (((4 * (2 * nh + s) + fq) ^ (i & 15)) << 3)) = w; }
        }
        }
        SEC_T(4);
    }
    __syncthreads();
}

__device__ void dn_scan(const Params& P, unsigned char* smem, int t0, int t1) {
    if (lbid() >= 128) return;
    const int bhd = lbid() >> 1, half = lbid() & 1;
    const int tid = ltid(), wave = __builtin_amdgcn_readfirstlane(tid >> 6), lane = tid & 63, fr = lane & 15, fq = lane >> 4;
    unsigned char* ws = P.ws;
    const unsigned char* WPb = ws + O_WP; const unsigned char* QPb = ws + O_QP; const unsigned char* KDb = ws + O_KD; const unsigned char* ATb = ws + O_AT;
    const bf16_t* UF = (const bf16_t*)(ws + O_UF); const float* GL = (const float*)(ws + S_GL);
    bf16_t* OO = (bf16_t*)(ws + O_O); f32x4* SS = (f32x4*)(ws + S_SSAVE);
    const int b = bhd >> 3, h = (bhd >> 1) & 3, dir = bhd & 1;
    LAS unsigned char* lds = (LAS unsigned char*)smem;
    constexpr int BUFB = 57344;
#define SCAN_SRC(q_, slot_) ((q_) < 16 ? WPb + (slot_) * 16384 + (q_) * 1024 : (q_) < 32 ? QPb + (slot_) * 16384 + ((q_) - 16) * 1024 : (q_) < 48 ? KDb + (slot_) * 16384 + ((q_) - 32) * 1024 : ATb + (slot_) * 8192 + ((q_) - 48) * 1024)
#define SCAN_LOAD(tl_) do { const size_t _slot = (size_t)(tl_) * 64 + bhd; _Pragma("unroll") for (int _k = 0; _k < 14; ++_k) { const int _q = (wave - 4) * 14 + _k; rg_[_k] = *(const u32x4*)(SCAN_SRC(_q, _slot) + lane * 16); } } while (0)
#define SCAN_WRITE(buf_) do { _Pragma("unroll") for (int _k = 0; _k < 14; ++_k) { const int _q = (wave - 4) * 14 + _k; *(LAS u32x4*)(lds + (buf_) * BUFB + _q * 1024 + lane * 16) = rg_[_k]; } } while (0)
    constexpr int NN = 1; const bool cw_ = wave < 4; const int sl0 = half * 4 + (wave & 3);
    const int nst = t1 - t0;
    if (!cw_) {
        u32x4 rg_[14];
#define SCAN_LOAD(tl_) do { const size_t _slot = (size_t)(tl_) * 64 + bhd; _Pragma("unroll") for (int _k = 0; _k < 14; ++_k) { const int _q = (wave - 4) * 14 + _k; rg_[_k] = *(const u32x4*)(SCAN_SRC(_q, _slot) + lane * 16); } } while (0)
#define SCAN_WRITE(buf_) do { _Pragma("unroll") for (int _k = 0; _k < 14; ++_k) { const int _q = (wave - 4) * 14 + _k; *(LAS u32x4*)(lds + (buf_) * BUFB + _q * 1024 + lane * 16) = rg_[_k]; } } while (0)
        SCAN_LOAD(0); SCAN_WRITE(0); if (nst > 1) SCAN_LOAD(1);
#pragma unroll 1
        for (int tl = 0; tl < nst; ++tl) {
            __syncthreads();
            if (tl + 1 < nst) { SCAN_WRITE((tl + 1) & 1); if (tl + 2 < nst) SCAN_LOAD(tl + 2); }
        }
        asm volatile("s_waitcnt vmcnt(0)" ::: "memory");
        __syncthreads();
        return;
    }
    f32x4 S[8][NN];
#pragma unroll
    for (int t = 0; t < 8; ++t)
#pragma unroll
        for (int nn = 0; nn < NN; ++nn) S[t][nn] = (t0 == 0 || !cw_) ? (f32x4){0.f, 0.f, 0.f, 0.f} : SS[((size_t)(bhd * 8 + sl0 + nn) * 8 + t) * 64 + lane];
    u32x2 un[4][NN];
    if (cw_) {
#pragma unroll
        for (int m = 0; m < 4; ++m)
#pragma unroll
            for (int nn = 0; nn < NN; ++nn) un[m][nn] = *(const u32x2*)(UF + (size_t)bhd * 8192 + (((sl0 + nn) * 4 + m) * 64 + lane) * 4); }
    float gln = __hip_atomic_load(GL + bhd, __ATOMIC_RELAXED, __HIP_MEMORY_SCOPE_AGENT);
#pragma unroll 1
    for (int tl = 0; tl < nst; ++tl) {
        const size_t slot = (size_t)tl * 64 + bhd; const int t = t0 + tl, c = dir ? 64 - t : t;
        const LAS unsigned char* bw = lds + (tl & 1) * BUFB;
        __syncthreads();
        f32x4 av[4][NN], ao[4][NN];
#pragma unroll
        for (int m = 0; m < 4; ++m)
#pragma unroll
            for (int nn = 0; nn < NN; ++nn) { const u32x2 u = un[m][nn];
                av[m][nn] = (f32x4){__uint_as_float(u.x << 16), __uint_as_float(u.x & 0xffff0000u), __uint_as_float(u.y << 16), __uint_as_float(u.y & 0xffff0000u)}; ao[m][nn] = (f32x4){0.f, 0.f, 0.f, 0.f}; }
        const float gl = gln; if (tl + 1 < nst) gln = __hip_atomic_load(GL + slot + 64, __ATOMIC_RELAXED, __HIP_MEMORY_SCOPE_AGENT);
        if (tl + 1 < nst) {
#pragma unroll
            for (int m = 0; m < 4; ++m)
#pragma unroll
                for (int nn = 0; nn < NN; ++nn) un[m][nn] = *(const u32x2*)(UF + (slot + 64) * 8192 + (((sl0 + nn) * 4 + m) * 64 + lane) * 4); }
#pragma unroll
        for (int s = 0; s < 4; ++s) { bf16x8 Sb[NN];
#pragma unroll
            for (int nn = 0; nn < NN; ++nn) { u32x4 w; w.x = cvt_pk_bf16(S[2 * s][nn][0], S[2 * s][nn][1]); w.y = cvt_pk_bf16(S[2 * s][nn][2], S[2 * s][nn][3]); w.z = cvt_pk_bf16(S[2 * s + 1][nn][0], S[2 * s + 1][nn][1]); w.w = cvt_pk_bf16(S[2 * s + 1][nn][2], S[2 * s + 1][nn][3]);
                Sb[nn] = __builtin_bit_cast(bf16x8, w); }
#pragma unroll
            for (int m = 0; m < 4; ++m) { const bf16x8 wf = *(const LAS bf16x8*)(bw + (16 * m + fr) * 256 + (((4 * s + fq) ^ fr) << 4)); const bf16x8 qf = *(const LAS bf16x8*)(bw + 16384 + (16 * m + fr) * 256 + (((4 * s + fq) ^ fr) << 4));
                _Pragma("unroll") for (int nn = 0; nn < NN; ++nn) av[m][nn] = __builtin_amdgcn_mfma_f32_16x16x32_bf16(wf, Sb[nn], av[m][nn], 0, 0, 0);
                _Pragma("unroll") for (int nn = 0; nn < NN; ++nn) ao[m][nn] = __builtin_amdgcn_mfma_f32_16x16x32_bf16(qf, Sb[nn], ao[m][nn], 0, 0, 0); } }
        __builtin_amdgcn_sched_barrier(0);
        bf16x8 Vb[2][NN];
#pragma unroll
        for (int s2 = 0; s2 < 2; ++s2)
#pragma unroll
            for (int nn = 0; nn < NN; ++nn) { u32x4 w; w.x = cvt_pk_bf16(av[2 * s2][nn][0], av[2 * s2][nn][1]); w.y = cvt_pk_bf16(av[2 * s2][nn][2], av[2 * s2][nn][3]); w.z = cvt_pk_bf16(av[2 * s2 + 1][nn][0], av[2 * s2 + 1][nn][1]); w.w = cvt_pk_bf16(av[2 * s2 + 1][nn][2], av[2 * s2 + 1][nn][3]);
                Vb[s2][nn] = __builtin_bit_cast(bf16x8, w); }
#pragma unroll
        for (int m = 0; m < 4; ++m)
#pragma unroll
            for (int s2 = 0; s2 < 2; ++s2) { const int row = 16 * m + fr; const bf16x8 af = *(const LAS bf16x8*)(bw + 49152 + row * 128 + (((4 * s2 + fq) ^ ((row >> 1) & 7)) << 4));
                _Pragma("unroll") for (int nn = 0; nn < NN; ++nn) ao[m][nn] = __builtin_amdgcn_mfma_f32_16x16x32_bf16(af, Vb[s2][nn], ao[m][nn], 0, 0, 0); }
        __builtin_amdgcn_sched_barrier(0);
#pragma unroll
        for (int tt = 0; tt < 8; ++tt) { _Pragma("unroll") for (int nn = 0; nn < NN; ++nn) S[tt][nn] = S[tt][nn] * gl;
#pragma unroll
            for (int s2 = 0; s2 < 2; ++s2) { const int row = 16 * tt + fr; const bf16x8 kf = *(const LAS bf16x8*)(bw + 32768 + row * 128 + (((4 * s2 + fq) ^ ((row >> 1) & 7)) << 4));
                _Pragma("unroll") for (int nn = 0; nn < NN; ++nn) S[tt][nn] = __builtin_amdgcn_mfma_f32_16x16x32_bf16(kf, Vb[s2][nn], S[tt][nn], 0, 0, 0); } }
#pragma unroll
        for (int m = 0; m < 4; ++m)
#pragma unroll
            for (int rg = 0; rg < 4; ++rg) { const int i = 16 * m + 4 * fq + rg, n = c * 64 + (dir ? 63 - i : i) - 48;
                if (n >= 0) { bf16_t* op = OO + ((size_t)dir * TP + (size_t)b * LL + n) * 512 + h * 128 + sl0 * 16 + fr; _Pragma("unroll") for (int nn = 0; nn < NN; ++nn) op[16 * nn] = f2bf(ao[m][nn][rg]); } }
    }
#undef SCAN_SRC
#undef SCAN_LOAD
#undef SCAN_WRITE
    if (t1 < NSTEP && cw_) {
#pragma unroll
        for (int t = 0; t < 8; ++t)
#pragma unroll
            for (int nn = 0; nn < NN; ++nn) SS[((size_t)(bhd * 8 + sl0 + nn) * 8 + t) * 64 + lane] = S[t][nn]; }
    asm volatile("s_waitcnt vmcnt(0)" ::: "memory");
    __syncthreads();
}

__device__ void dn_out(const Params& P, int l) {
    const int tid_ = ltid(); const int wave = __builtin_amdgcn_readfirstlane(tid_ >> 6), lane = tid_ & 63;
    const bf16_t* OO = (const bf16_t*)(P.ws + O_O); const bf16_t* Z = (const bf16_t*)(P.ws + O_Z); bf16_t* DNO = (bf16_t*)(P.ws + O_BR) + (size_t)2 * TP * 512;
    const float* nw = P.in[12] + (size_t)l * 128; float g[8];
#pragma unroll
    for (int e = 0; e < 8; ++e) g[e] = nw[(lane & 15) * 8 + e];
    for (int r = lbid() * 8 + wave; r < TT; r += lgrid() * 8) {
        float a[8], bq[8], z[8]; unpack8(*(const u32x4*)(OO + (size_t)r * 512 + lane * 8), a); unpack8(*(const u32x4*)(OO + ((size_t)TP + r) * 512 + lane * 8), bq); unpack8(*(const u32x4*)(Z + (size_t)r * 512 + lane * 8), z);
        float ss = 0.f;
#pragma unroll
        for (int e = 0; e < 8; ++e) { a[e] += bq[e]; ss += a[e] * a[e]; }
        ss += __shfl_xor(ss, 1); ss += __shfl_xor(ss, 2); ss += __shfl_xor(ss, 4); ss += __shfl_xor(ss, 8);
        const float inv = rsqrtf(ss * (1.0f / 128.0f) + EPS);
#pragma unroll
        for (int e = 0; e < 8; ++e) a[e] = a[e] * inv * g[e] * siluf_(z[e]);
        *(u32x4*)(DNO + (size_t)r * 512 + lane * 8) = pack8(a);
    }
}


#define XB_TMO      128
#define XB_XCNT(j)  (256  + 64 * (j))
#define XB_XSUB(j)  (1280 + 64 * (j))
#define XB_XGEN(j)  (2304 + 64 * (j))
#define XB_TOP      3328
#define XB_TOPGEN   3392
#define XCD_BAR_WORDS 3456
#define XB_SPIN_CAP (1u << 22)
__device__ __forceinline__ unsigned xb_ld(unsigned* p)              { return __hip_atomic_load(p, __ATOMIC_RELAXED, __HIP_MEMORY_SCOPE_AGENT); }
__device__ __forceinline__ unsigned xb_add(unsigned* p, unsigned v) { return __hip_atomic_fetch_add(p, v, __ATOMIC_RELAXED, __HIP_MEMORY_SCOPE_AGENT); }
__device__ __forceinline__ unsigned xb_xcc_id() { return (unsigned)__builtin_amdgcn_s_getreg((3 << 11) | 20) & 0xFu; }
#define XB_SPIN(cond, bar) do { unsigned _sp = 0; while (cond) { __builtin_amdgcn_s_sleep(1); \
    if ((++_sp & 255u) == 0u) { if (xb_ld(&(bar)[XB_TMO])) break; if (_sp > XB_SPIN_CAP) { atomicAdd(&(bar)[XB_TMO], 1u); break; } } } } while (0)
struct XcdBarrier { unsigned* bar; unsigned x; volatile LAS unsigned* st; };
__device__ __forceinline__ XcdBarrier xcd_barrier_post(unsigned* bar, volatile LAS unsigned* st) {
    XcdBarrier b; b.bar = bar; b.x = xb_xcc_id(); b.st = st;
    if (threadIdx.x == 0) (void)xb_add(&bar[XB_XCNT(b.x)], 1u);
    return b;
}
__device__ __forceinline__ void xcd_barrier_complete(unsigned* bar, unsigned x, unsigned& nloc, unsigned& nx) {
    const unsigned G = gridDim.x * gridDim.y * gridDim.z;
    unsigned sum, cnt, mine, sp = 0u;
    for (;;) {
        sum = 0u; cnt = 0u; mine = 0u;
#pragma unroll
        for (unsigned j = 0; j < 16; ++j) { const unsigned c = xb_ld(&bar[XB_XCNT(j)]); sum += c; cnt += (c > 0u) ? 1u : 0u; mine = (j == x) ? c : mine; }
        if (sum == G) break;
        __builtin_amdgcn_s_sleep(1);
        if ((++sp & 255u) == 0u) { if (xb_ld(&bar[XB_TMO])) break; if (sp > XB_SPIN_CAP) { atomicAdd(&bar[XB_TMO], 1u); break; } }
    }
    nloc = mine > 0u ? mine : 1u; nx = cnt > 0u ? cnt : 1u;
}
__device__ __forceinline__ void xcd_barrier(const XcdBarrier& b) {
    asm volatile("s_waitcnt vmcnt(0)" ::: "memory");
    __syncthreads();
    if (threadIdx.x == 0) {
        unsigned* bar = b.bar;
        __builtin_amdgcn_s_waitcnt(0);
        unsigned nloc = b.st[0], nx = b.st[1];
        if (nloc == 0u) { xcd_barrier_complete(bar, b.x, nloc, nx); b.st[0] = nloc; b.st[1] = nx; }
        const unsigned old = xb_add(&bar[XB_XSUB(b.x)], 1u);
        const unsigned gen = old / nloc;
        if (old + 1u == (gen + 1u) * nloc) {
            __builtin_amdgcn_fence(__ATOMIC_RELEASE, "agent");
            asm volatile("s_waitcnt vmcnt(0)" ::: "memory");
            const unsigned og = xb_add(&bar[XB_TOP], 1u);
            const unsigned tg = og / nx;
            if (og + 1u == (tg + 1u) * nx) xb_add(&bar[XB_TOPGEN], 1u);
            else XB_SPIN(xb_ld(&bar[XB_TOPGEN]) == tg, bar);
            __builtin_amdgcn_fence(__ATOMIC_ACQUIRE, "agent");
            xb_add(&bar[XB_XGEN(b.x)], 1u);
            asm volatile("s_waitcnt vmcnt(0)" ::: "memory");
        } else {
            XB_SPIN(xb_ld(&bar[XB_XGEN(b.x)]) == gen, bar);
            __builtin_amdgcn_fence(__ATOMIC_ACQUIRE, "agent");
            asm volatile("s_waitcnt vmcnt(0)" ::: "memory");
        }
    }
    __syncthreads();
}
__device__ __forceinline__ int phase_cat(int ph) { const int p = ph % 22;
    return p == 0 ? 0 : (p == 1 || p == 2 || p == 19 || p == 20) ? 1 : (p == 3 || p == 18 || p == 21) ? 2 : p == 4 ? 3 : p == 5 ? 4 : p == 6 ? 5 : p == 7 ? 6 : (p == 8 || p == 10 || p == 12) ? 7 : (p == 9 || p == 11 || p == 13) ? 8 : p == 14 ? 9 : 10; }
#ifndef SKIP_GEMM
#define GEMM_CALL(a,b,c,d) pg8::gemm_phase(a,b,c,d)
#else
#define GEMM_CALL(a,b,c,d) (void)0
#endif
__global__ void __launch_bounds__(512, 2) fwd_kernel(Params P) {
    extern __shared__ __attribute__((aligned(16))) unsigned char smem[];
    cg::grid_group grid = cg::this_grid();
    unsigned char* ws = P.ws;
    LAS unsigned char* lds = (LAS unsigned char*)smem;
    int ph = 0;
    { volatile LAS unsigned* stw = (volatile LAS unsigned*)(lds + LDS_BYTES - 32); if (threadIdx.x < 8) stw[threadIdx.x] = 0u; }
    __syncthreads();
    XcdBarrier xbar = xcd_barrier_post((unsigned*)(ws + S_BAR), (volatile LAS unsigned*)(lds + LDS_BYTES - 16));
#ifdef DBG_CAT
    unsigned long long t_prev = __builtin_amdgcn_s_memrealtime(), t_acc = 0ull;
#define STAMP() do { const unsigned long long _n = __builtin_amdgcn_s_memrealtime(); if (phase_cat(ph) == DBG_CAT) t_acc += _n - t_prev; t_prev = _n; } while (0)
#else
#define STAMP() do {} while (0)
#endif
#define PHASE_BEGIN if (ph >= P.ph_lo && ph < P.ph_hi) { const int G = lgrid(), bx = lbid(); (void)G; (void)bx;
#define PHASE_END   if (ph + 1 < P.ph_hi) { if (ph == 0) { asm volatile("s_waitcnt vmcnt(0) lgkmcnt(0)" ::: "memory"); grid.sync(); __builtin_amdgcn_fence(__ATOMIC_ACQUIRE, "agent"); asm volatile("s_waitcnt vmcnt(0)" ::: "memory"); __syncthreads(); } else xcd_barrier(xbar); } STAMP(); } ++ph;
    for (ph = P.ph_lo; ph < P.ph_hi; ++ph) {
        const int l = ph / 22, p = ph - l * 22;
        const int G = lgrid(), bx = lbid();
        bf16_t* XN = (bf16_t*)(ws + O_XN); bf16_t* Y = (bf16_t*)(ws + O_Y); bf16_t* ACT = (bf16_t*)(ws + O_ACT);
        const float* ng = P.in[2] + (size_t)l * 6 * 1024;
        switch (p) {
        case 0:
#ifndef SKIP_CVT
            convert_weights(P, l, smem);
#endif
            if (l == 0) { gen_tables(P); rpass(P, nullptr, true, nullptr, 0.f, ng, XN); }
            break;
        case 1: case 19: { pg8::Gemm g{XN, (const bf16_t*)(ws + (p == 1 ? W_WI1 : W_WI2)), TP, 5632, 1024, 128, 1024}; pg8::StaticOrder S; S.init(TP, 5632, G, bx); pg8::EpiSwiglu E{ACT}; GEMM_CALL(lds, g, S, E); } break;
        case 2: case 20: case 17: {
            const bool dn = (p != 17); const int Kx = dn ? 2816 : 1024, nS = dn ? 11 : 4;
            const bf16_t* W = (const bf16_t*)(ws + (p == 2 ? W_WO1 : p == 20 ? W_WO2 : W_WOUT)); const bf16_t* Ax = dn ? ACT : (const bf16_t*)(ws + O_MG);
            { pg8::Gemm g{Ax, W, TP, 1024, Kx, 128, Kx}; pg8::StaticOrder S; S.init(TP, 1024, G, bx, false); pg8::EpiBf16<0> E{Y, 1024}; GEMM_CALL(lds, g, S, E); }
            { pg8::Gemm g{W, Ax + (size_t)32768 * Kx, 1024, 256, Kx, -1, 256}; pg8::TailOrder S{nS, bx}; pg8::EpiSlab E{(float*)(ws + O_SLAB), nS}; GEMM_CALL(lds, g, S, E); } } break;
        case 3: rpass(P, Y, l == 0, ng + 1024, 0.5f, ng + 2048, XN, (const float*)(ws + O_SLAB), 11); break;
        case 4: { pg8::Gemm g{XN, (const bf16_t*)(ws + W_WIN), TP, NPROJ, 1024, 128, 1024}; pg8::StaticOrder S; S.init(TP, NPROJ, G, bx); pg8::EpiInProj E{ws}; GEMM_CALL(lds, g, S, E); } break;
        case 5: sconv_pass(P, l); break;
        case 6:
#ifndef SKIP_F1
            fstep1(P, smem);
#endif
            break;
        case 7: { pg8::Gemm g{(const bf16_t*)(ws + S_C257), (const bf16_t*)(ws + O_AP), 512, 65536, KF, 1, KF}; pg8::StaticOrder S; S.init(512, 65536, G, bx);
                  pg8::EpiFourier E{(bf16_t*)(ws + O_BR), 0.001949317738791423f  }; GEMM_CALL(lds, g, S, E); } break;
        case 8: case 10: case 12: { const int t0 = ((p - 8) >> 1) * SPL, t1 = (t0 + SPL < NSTEP) ? t0 + SPL : NSTEP;
#ifndef SKIP_PREP
            dn_prep(P, l, smem, t0, t1);
#endif
            } break;
        case 9: case 11: case 13: { const int t0 = ((p - 9) >> 1) * SPL, t1 = (t0 + SPL < NSTEP) ? t0 + SPL : NSTEP;
#ifndef SKIP_SCAN
            dn_scan(P, smem, t0, t1);
#endif
            } break;
        case 14: dn_out(P, l); rpass(P, nullptr, false, nullptr, 0.f, ng + 2048, (bf16_t*)(ws + O_XN2)); break;
        case 15: { pg8::Gemm g{(const bf16_t*)(ws + O_XN2), (const bf16_t*)(ws + W_WG), TP, 3072, 1024, 128, 1024}; pg8::StaticOrder S; S.init(TP, 3072, G, bx); pg8::EpiBf16<1> E{(bf16_t*)(ws + O_GATE), 3072}; GEMM_CALL(lds, g, S, E); } break;
        case 16: { pg8::Gemm g{(const bf16_t*)(ws + O_BR), (const bf16_t*)(ws + W_WBR), 3 * TP, 3072, 512, -1, 512}; pg8::MergeOrder S{G, bx}; pg8::EpiMerge E{(const bf16_t*)(ws + O_GATE), (bf16_t*)(ws + O_MG), (bf16_t*)(ws + O_XN2)}; GEMM_CALL(lds, g, S, E); } break;
        case 18: rpass(P, Y, false, ng + 3 * 1024, 1.0f, ng + 4 * 1024, XN, (const float*)(ws + O_SLAB), 4); break;
        default: rpass(P, Y, false, ng + 5 * 1024, 0.5f, l == 0 ? P.in[2] + (size_t)6 * 1024 : nullptr, XN, (const float*)(ws + O_SLAB), 11); break;
        }
        if (ph + 1 < P.ph_hi) {
            if (P.ph_lo < 0) grid.sync();
            xcd_barrier(xbar);
        }
        STAMP();
    }
#ifdef DBG_CAT
    if (lbid() == 0 && threadIdx.x == 0) { const unsigned long long t0 = __builtin_amdgcn_s_memrealtime(); while (__builtin_amdgcn_s_memrealtime() - t0 < t_acc + *(unsigned long long*)(smem + LDS_BYTES - 32)) __builtin_amdgcn_s_sleep(16); }
#endif
#ifdef DBG_FLUSH
    { asm volatile("s_waitcnt vmcnt(0) lgkmcnt(0)" ::: "memory"); grid.sync(); __builtin_amdgcn_fence(__ATOMIC_ACQUIRE, "agent"); asm volatile("s_waitcnt vmcnt(0)" ::: "memory");
      const f32x4* xs = (const f32x4*)P.in[0]; f32x4 a = {0.f, 0.f, 0.f, 0.f};
      for (size_t i = ltid(); i < (size_t)8388608; i += 512) a += xs[i];
      if (a[0] + a[1] + a[2] + a[3] == 1.2345e-30f) ((float*)(ws + S_GL))[4000] = 1.f; }
#endif
#ifdef DBG_OFF
    { asm volatile("s_waitcnt vmcnt(0) lgkmcnt(0)" ::: "memory"); grid.sync(); __builtin_amdgcn_fence(__ATOMIC_ACQUIRE, "agent"); asm volatile("s_waitcnt vmcnt(0)" ::: "memory");
      const bf16_t* src = (const bf16_t*)(ws + DBG_OFF);
      for (size_t i = (size_t)lbid() * 512 + ltid(); i < (size_t)33554432; i += (size_t)lgrid() * 512) P.out[i] = i < (size_t)DBG_CNT ? bf2f(src[i]) : 0.f; }
#endif
}

extern "C" void kernel_launch(void* const* d_in, const int* in_sizes, int n_in, void* d_out, int out_size, void* d_ws, size_t ws_size, hipStream_t stream) {
    static int grid = 0;
    if (grid == 0) {
        int dev = 0, cus = 0, per_cu = 0;
        hipGetDevice(&dev); hipDeviceGetAttribute(&cus, hipDeviceAttributeMultiprocessorCount, dev);
        hipFuncSetAttribute((const void*)fwd_kernel, hipFuncAttributeMaxDynamicSharedMemorySize, LDS_BYTES);
        hipOccupancyMaxActiveBlocksPerMultiprocessor(&per_cu, (const void*)fwd_kernel, 512, LDS_BYTES);
        if (per_cu < 1) { fprintf(stderr, "occupancy query says %d blocks/CU\n", per_cu); per_cu = 1; }
        grid = cus;
        if (ws_size < WS_NEED) fprintf(stderr, "workspace too small: %zu < %zu\n", ws_size, (size_t)WS_NEED);
    }
    Params p{};
    for (int i = 0; i < 17; ++i) p.in[i] = (const float*)d_in[i];
    p.out = (float*)d_out; p.ws = (unsigned char*)d_ws; p.ph_lo = 0; p.ph_hi = 44;
#ifdef DBG_PHI
    p.ph_hi = DBG_PHI;
#endif
    hipMemsetAsync((char*)d_ws + S_BAR, 0, 16384, stream);
    void* args[] = {&p};
    hipError_t e = hipLaunchCooperativeKernel((const void*)fwd_kernel, dim3(grid), dim3(512), args, LDS_BYTES, stream);
    if (e != hipSuccess) fprintf(stderr, "cooperative launch failed: %s (grid %d)\n", hipGetErrorString(e), grid);
}
```

```cpp
#include <hip/hip_runtime.h>
#include <hip/hip_cooperative_groups.h>
#include <cstdio>
namespace cg = cooperative_groups;

#define LAS __attribute__((address_space(3)))
typedef unsigned short bf16_t;
typedef short bf16x8 __attribute__((ext_vector_type(8)));
typedef float f32x4 __attribute__((ext_vector_type(4)));
typedef unsigned u32x4 __attribute__((ext_vector_type(4)));
typedef unsigned u32x2 __attribute__((ext_vector_type(2)));

constexpr int DM = 1024, NB = 8, SEQ = 4096, NMETA = 16, LL = 4112, TT = NB * LL  , TP = 33024  , DFF = 2816;
constexpr int NIN = 7184;
constexpr int NPROJ = 4864;
constexpr float EPS = 1e-6f;
constexpr int NSTEP = 65, SPL = 24, NSPLIT = 3;
constexpr int KF = 640;

constexpr size_t UU = (size_t)TP * 1024;
constexpr size_t W_WI1 = 0, W_WO1 = W_WI1 + (size_t)5632 * 1024 * 2, W_WI2 = W_WO1 + (size_t)1024 * 2816 * 2, W_WO2 = W_WI2 + (size_t)5632 * 1024 * 2,
                 W_WIN = W_WO2 + (size_t)1024 * 2816 * 2, W_WG = W_WIN + (size_t)NPROJ * 1024 * 2, W_WBR = W_WG + (size_t)3072 * 1024 * 2,
                 W_WOUT = W_WBR + (size_t)3072 * 512 * 2, W_END = W_WOUT + (size_t)1024 * 1024 * 2;
constexpr size_t S_C257 = W_END, S_TWL = S_C257 + (size_t)512 * KF * 2, S_HM = S_TWL + 33024, S_LOGIT = S_HM + (size_t)128 * 1024 * 4,
                 S_GL = S_LOGIT + (size_t)TP * 16 * 4, S_SSAVE = S_GL + 16896, S_BAR = S_SSAVE + (size_t)512 * 8 * 64 * 16, S_END = S_BAR + 16384;
constexpr size_t A0 = (S_END + 255) / 256 * 256;
constexpr size_t O_XN = A0, O_Y = A0 + 2 * UU, O_ACT = A0 + 4 * UU;
constexpr size_t O_BR = A0, O_QKV = A0 + 4 * UU, O_Z = A0 + 7 * UU, O_SC = A0 + 8 * UU, O_PQ = A0 + 11 * UU, O_AP = A0 + 8 * UU;
constexpr size_t DNI_SLOTS = (size_t)SPL * 64;
constexpr size_t O_WP = A0 + 8 * UU, O_QP = O_WP + DNI_SLOTS * 16384, O_KD = O_QP + DNI_SLOTS * 16384, O_UF = O_KD + DNI_SLOTS * 16384,
                 O_AT = O_UF + DNI_SLOTS * 16384, O_DNI_END = O_AT + DNI_SLOTS * 8192;
constexpr size_t O_O = (O_DNI_END + 255) / 256 * 256;
constexpr size_t O_XN2 = A0 + 3 * UU, O_GATE = A0 + 5 * UU, O_MG = A0 + 11 * UU;
constexpr size_t O_SLAB = (O_O + 2 * UU + 255) / 256 * 256;
constexpr size_t WS_NEED = O_SLAB + (size_t)44 * 65536 * 4;
static_assert(WS_NEED <= (size_t)536870912, "workspace");
static_assert(O_AP + (size_t)65536 * KF * 2 <= O_PQ, "A' overlaps PQ");
static_assert(O_O >= O_PQ || true, "");
static_assert(O_MG + 2 * UU <= WS_NEED + 2 * UU, "");

constexpr int LDS_BYTES = 132 * 1024;

#define DBG_CNT ((size_t)33554432)


struct Params { const float* in[17]; float* out; unsigned char* ws; int ph_lo, ph_hi; };

__device__ __forceinline__ float bf2f(unsigned v) { return __uint_as_float(v << 16); }
typedef __bf16 bf16x2_t __attribute__((ext_vector_type(2)));
typedef float f32x2_t __attribute__((ext_vector_type(2)));
__device__ __forceinline__ unsigned cvt_pk_bf16(float lo, float hi) { f32x2_t v = {lo, hi}; bf16x2_t b = __builtin_convertvector(v, bf16x2_t); return __builtin_bit_cast(unsigned, b); }
__device__ __forceinline__ bf16_t f2bf(float f) { return (bf16_t)(cvt_pk_bf16(f, 0.f) & 0xffffu); }
__device__ __forceinline__ void unpack8(const u32x4 v, float* f) {
    f[0] = __uint_as_float(v.x << 16); f[1] = __uint_as_float(v.x & 0xffff0000u); f[2] = __uint_as_float(v.y << 16); f[3] = __uint_as_float(v.y & 0xffff0000u);
    f[4] = __uint_as_float(v.z << 16); f[5] = __uint_as_float(v.z & 0xffff0000u); f[6] = __uint_as_float(v.w << 16); f[7] = __uint_as_float(v.w & 0xffff0000u); }
__device__ __forceinline__ u32x4 pack8(const float* f) { u32x4 w; w.x = cvt_pk_bf16(f[0], f[1]); w.y = cvt_pk_bf16(f[2], f[3]); w.z = cvt_pk_bf16(f[4], f[5]); w.w = cvt_pk_bf16(f[6], f[7]); return w; }
__device__ __forceinline__ int ltid() { int t = threadIdx.x; asm volatile("" : "+v"(t)); return t; }
__device__ __forceinline__ int lbid() { int t = blockIdx.x; asm volatile("" : "+s"(t)); return t; }
__device__ __forceinline__ int lgrid() { int t = gridDim.x; asm volatile("" : "+s"(t)); return t; }
__device__ __forceinline__ float wave_sum(float v) { for (int o = 32; o >= 1; o >>= 1) v += __shfl_xor(v, o); return v; }
__device__ __forceinline__ float sigmoidf_(float x) { return __builtin_amdgcn_rcpf(1.0f + __expf(-x)); }
__device__ __forceinline__ float siluf_(float x) { return x * __builtin_amdgcn_rcpf(1.0f + __expf(-x)); }

namespace pg8 {
constexpr int BM = 256, BK = 64, HALF = 128, HTB = HALF * BK * 2, STAGE_BYTES = 8 * HTB, NXCD = 8, WGM = 8;
__device__ __forceinline__ int lds_byte(int r, int c) { const int st = (r >> 4) * 2 + (c >> 5), rr = r & 15, cc = c & 31, ob = rr * 64 + cc * 2; return st * 1024 + (ob ^ (((ob >> 9) & 1) << 5)); }
__device__ __forceinline__ void stage_rc(int b, int& R, int& C) { const int st = b / 1024, sb = b % 1024, swz = sb ^ (((sb >> 9) & 1) << 5); R = (st >> 1) * 16 + swz / 64; C = (st & 1) * 32 + (swz % 64) / 2; }
__device__ __forceinline__ int perm32(int rho) { const int n = rho >> 4, i = rho & 15; return 8 * (i >> 2) + 4 * n + (i & 3); }
struct Unit { int pm, pn, ks; };
struct Gemm { const bf16_t* A; const bf16_t* Bt; int M, N, K; int half_pm; int KL; };
struct StaticOrder {
    int nM, nN, nwg, G, c, ntail;
    __device__ void init(int M, int N, int G_, int c_, bool tail = true) { nM = M / BM - 1; nN = N / BM; nwg = nM * nN; G = G_; c = c_; ntail = tail ? nN : 0; }
    __device__ bool next(int i, Unit& u) const {
        u.ks = 0;
        const long L = (long)i * G + c; if (L >= nwg + ntail) return false;
        if (L >= nwg) { u.pm = nM; u.pn = (int)(L - nwg); return true; }
        int wgid = (int)L; { const int q = nwg / NXCD, r = nwg % NXCD, xcd = wgid % NXCD, off = wgid / NXCD; wgid = (xcd < r ? xcd * (q + 1) : r * (q + 1) + (xcd - r) * q) + off; }
        const int nig = WGM * nN, gid = wgid / nig, fm = gid * WGM, gsz = (nM - fm) < WGM ? (nM - fm) : WGM;
        u.pm = fm + ((wgid % nig) % gsz); u.pn = (wgid % nig) / gsz; return true;
    }
};
struct MergeOrder {
    int G, c;
    __device__ bool next(int i, Unit& u) const { const int L = (i / 3) * G + c; if (L >= 129 * 4) return false; const int j = i % 3; u.pm = j * 129 + (L >> 2); u.pn = j * 4 + (L & 3); u.ks = 0; return true; }
};

struct TailOrder { int nS, c;
    __device__ bool next(int i, Unit& u) const { if (i > 0 || c >= 4 * nS) return false; u.pm = c / nS; u.ks = c - u.pm * nS; u.pn = 0; return true; } };

template <class Epi, class Sched>
__device__ __forceinline__ void gemm_phase(LAS unsigned char* lds, const Gemm g, const Sched& S, const Epi& E) {
    const int tid = ltid(), wid = __builtin_amdgcn_readfirstlane(tid >> 6), lane = tid & 63, wr = wid >> 2, wc = wid & 3, fr = lane & 15, fq = lane >> 4;
    const int K = g.K, nt = g.KL / BK;
    unsigned voffA, voffB;
    { int R, C; stage_rc(tid * 16, R, C); const int Rb = Epi::PERM ? ((R & ~31) + perm32(R & 31)) : R;
        voffA = (unsigned)(R * K + C) * 2u; voffB = (unsigned)(Rb * K + C) * 2u; }
    const size_t r64 = (size_t)64 * K * 2;
    const size_t kstep = (size_t)(BK * 2);
    const size_t hstep = (size_t)HALF * K * 2;
    const size_t tstep = 2 * hstep;
    const unsigned ldsw = (unsigned)wid * 1024u;
    const int aoff = lds_byte(wr * 64 + fr, fq * 8), boff = lds_byte(wc * 32 + fr, fq * 8);
#define PG8_SA(b, h) (((b) * 2 + (h)) * HTB)
#define PG8_SB(b, h) ((4 + (b) * 2 + (h)) * HTB)
#define PG8_STAGE(bufoff, gbase, voff) do { _Pragma("unroll") for (int _i = 0; _i < 2; ++_i) \
        __builtin_amdgcn_global_load_lds((const unsigned*)((const char*)(gbase) + _i * r64 + (voff)), (LAS unsigned*)(lds + (bufoff) + ldsw + _i * 8192), 16, 0, 0); } while (0)
#define PG8_LDA(dst, b, h) do { _Pragma("unroll") for (int m = 0; m < 4; ++m) _Pragma("unroll") for (int k = 0; k < 2; ++k) dst[m][k] = *(const LAS bf16x8*)(lds + PG8_SA(b, h) + aoff + m * 2048 + k * 1024); } while (0)
#define PG8_LDB(dst, b, h) do { _Pragma("unroll") for (int n = 0; n < 2; ++n) _Pragma("unroll") for (int k = 0; k < 2; ++k) dst[n][k] = *(const LAS bf16x8*)(lds + PG8_SB(b, h) + boff + n * 2048 + k * 1024); } while (0)
#define PG8_MMA(ai, bj, At, Bt) do { __builtin_amdgcn_s_setprio(1); _Pragma("unroll") for (int m = 0; m < 4; ++m) _Pragma("unroll") for (int n = 0; n < 2; ++n) _Pragma("unroll") for (int k = 0; k < 2; ++k) \
        acc[ai][bj][m][n] = __builtin_amdgcn_mfma_f32_16x16x32_bf16(Bt[n][k], At[m][k], acc[ai][bj][m][n], 0, 0, 0); __builtin_amdgcn_s_setprio(0); } while (0)
#define PG8_WAIT_V(n) asm volatile("s_waitcnt vmcnt(" #n ")" ::: "memory")
#define PG8_WAIT_L(n) asm volatile("s_waitcnt lgkmcnt(" #n ")" ::: "memory")
#define PG8_BAR __builtin_amdgcn_s_barrier()
#define PG8_SCHED __builtin_amdgcn_sched_barrier(0)
    Unit cur, nxt; int ui = 0;
    if (!S.next(0, cur)) return;
    f32x4 acc[2][2][4][2];
#pragma unroll
    for (int a = 0; a < 2; ++a)
#pragma unroll
        for (int b = 0; b < 2; ++b)
#pragma unroll
            for (int m = 0; m < 4; ++m)
#pragma unroll
                for (int n = 0; n < 2; ++n) acc[a][b][m][n] = (f32x4){0.f, 0.f, 0.f, 0.f};
    bf16x8 At[4][2], B0[2][2], B1[2][2];
    const char* cA = (const char*)g.A + (size_t)cur.pm * tstep + (size_t)cur.ks * g.KL * 2; const char* cB = (const char*)g.Bt + (size_t)cur.pn * tstep + (size_t)cur.ks * g.KL * 2;
    PG8_STAGE(PG8_SB(0, 0), cB, voffB); PG8_STAGE(PG8_SB(0, 1), cB + hstep, voffB); PG8_STAGE(PG8_SA(0, 0), cA, voffA); PG8_STAGE(PG8_SA(0, 1), cA + hstep, voffA);
    if (wr == 1) PG8_BAR;
    PG8_WAIT_V(2); PG8_BAR;
    PG8_STAGE(PG8_SB(1, 0), cB + kstep, voffB); PG8_STAGE(PG8_SA(1, 0), cA + kstep, voffA); PG8_STAGE(PG8_SB(1, 1), cB + hstep + kstep, voffB);
    PG8_WAIT_V(6); PG8_BAR;
    for (;;) {
        const bool has_next = S.next(ui + 1, nxt);
        const char* nA = has_next ? (const char*)g.A + (size_t)nxt.pm * tstep + (size_t)nxt.ks * g.KL * 2 : cA; const char* nB = has_next ? (const char*)g.Bt + (size_t)nxt.pn * tstep + (size_t)nxt.ks * g.KL * 2 : cB;
        for (int t = 0; t < nt; t += 2) {
            const bool last = (t == nt - 2);
            const char* a1 = cA + (size_t)(t + 1) * kstep;
            const char* a2 = last ? nA : cA + (size_t)(t + 2) * kstep; const char* b2 = last ? nB : cB + (size_t)(t + 2) * kstep;
            const char* a3 = a2 + kstep; const char* b3 = b2 + kstep;
            PG8_LDB(B0, 0, 0); PG8_LDB(B1, 0, 1); PG8_SCHED; PG8_LDA(At, 0, 0); PG8_STAGE(PG8_SA(1, 1), a1 + hstep, voffA);
            PG8_WAIT_V(8); PG8_WAIT_L(0); PG8_BAR; PG8_MMA(0, 0, At, B0); PG8_MMA(0, 1, At, B1); PG8_BAR; PG8_SCHED;
            PG8_LDA(At, 0, 1); PG8_STAGE(PG8_SB(0, 0), b2, voffB); PG8_STAGE(PG8_SB(0, 1), b2 + hstep, voffB); PG8_STAGE(PG8_SA(0, 0), a2, voffA);
            PG8_WAIT_V(8); PG8_WAIT_L(0); PG8_BAR; PG8_MMA(1, 0, At, B0); PG8_MMA(1, 1, At, B1); PG8_BAR; PG8_SCHED;
            PG8_LDB(B0, 1, 0); PG8_LDB(B1, 1, 1); PG8_SCHED; PG8_LDA(At, 1, 0); PG8_STAGE(PG8_SA(0, 1), a2 + hstep, voffA);
            PG8_WAIT_V(8); PG8_WAIT_L(0); PG8_BAR; PG8_MMA(0, 0, At, B0); PG8_MMA(0, 1, At, B1); PG8_BAR; PG8_SCHED;
            PG8_LDA(At, 1, 1); PG8_STAGE(PG8_SB(1, 0), b3, voffB); PG8_STAGE(PG8_SB(1, 1), b3 + hstep, voffB); PG8_STAGE(PG8_SA(1, 0), a3, voffA);
            PG8_WAIT_V(8); PG8_WAIT_L(0); PG8_BAR; PG8_MMA(1, 0, At, B0); PG8_MMA(1, 1, At, B1); PG8_BAR; PG8_SCHED;
        }
        if (wr == 0) PG8_BAR;
        E(acc, cur, wr, wc, fr, fq);
        if (!has_next) break;
#pragma unroll
        for (int a = 0; a < 2; ++a)
#pragma unroll
            for (int b = 0; b < 2; ++b)
#pragma unroll
                for (int m = 0; m < 4; ++m)
#pragma unroll
                    for (int n = 0; n < 2; ++n) acc[a][b][m][n] = (f32x4){0.f, 0.f, 0.f, 0.f};
        cur = nxt; cA = nA; cB = nB; ++ui;
        if (wr == 1) PG8_BAR;
    }
    PG8_WAIT_V(0);
    PG8_BAR;
#undef PG8_SA
#undef PG8_SB
#undef PG8_STAGE
#undef PG8_LDA
#undef PG8_LDB
#undef PG8_MMA
#undef PG8_WAIT_V
#undef PG8_WAIT_L
#undef PG8_BAR
#undef PG8_SCHED
}

template <int ACT> struct EpiBf16 {
    static constexpr bool PERM = true;
    bf16_t* O; int ldc;
    __device__ __forceinline__ void operator()(const f32x4 (&acc)[2][2][4][2], const Unit& u, int wr, int wc, int fr, int fq) const {
        const int row0 = u.pm * BM + wr * 64 + fr, col0 = u.pn * BM + wc * 32 + 8 * fq;
#pragma unroll
        for (int ai = 0; ai < 2; ++ai)
#pragma unroll
            for (int m = 0; m < 4; ++m) { bf16_t* rowp = O + (size_t)(row0 + ai * HALF + m * 16) * ldc + col0;
#pragma unroll
                for (int bj = 0; bj < 2; ++bj) { f32x4 v0 = acc[ai][bj][m][0], v1 = acc[ai][bj][m][1];
                    if (ACT == 1) {
#pragma unroll
                        for (int j = 0; j < 4; ++j) { v0[j] = sigmoidf_(v0[j]); v1[j] = sigmoidf_(v1[j]); } }
                    u32x4 w; w.x = cvt_pk_bf16(v0[0], v0[1]); w.y = cvt_pk_bf16(v0[2], v0[3]); w.z = cvt_pk_bf16(v1[0], v1[1]); w.w = cvt_pk_bf16(v1[2], v1[3]);
                    *(u32x4*)(rowp + bj * HALF) = w; } }
    }
};
struct EpiSlab {
    static constexpr bool PERM = true;
    float* slab; int nS;
    __device__ __forceinline__ void operator()(const f32x4 (&acc)[2][2][4][2], const Unit& u, int wr, int wc, int fr, int fq) const {
        float* sp = slab + ((size_t)u.ks * 128 + wc * 32 + 8 * fq) * 1024 + u.pm * 256 + wr * 64 + fr;
#pragma unroll
        for (int ai = 0; ai < 2; ++ai)
#pragma unroll
            for (int m = 0; m < 4; ++m) { float* rp = sp + ai * HALF + m * 16;
#pragma unroll
                for (int n = 0; n < 2; ++n)
#pragma unroll
                    for (int j = 0; j < 4; ++j) rp[(size_t)(4 * n + j) * 1024] = acc[ai][0][m][n][j]; }
    }
};
struct EpiSwiglu {
    static constexpr bool PERM = true;
    bf16_t* O;
    __device__ __forceinline__ void operator()(const f32x4 (&acc)[2][2][4][2], const Unit& u, int wr, int wc, int fr, int fq) const {
        const int row0 = u.pm * BM + wr * 64 + fr, col0 = u.pn * 128 + wc * 32 + 8 * fq;
#pragma unroll
        for (int ai = 0; ai < 2; ++ai)
#pragma unroll
            for (int m = 0; m < 4; ++m) { bf16_t* rowp = O + (size_t)(row0 + ai * HALF + m * 16) * DFF + col0;
                const f32x4 a0 = acc[ai][0][m][0], a1 = acc[ai][0][m][1], b0 = acc[ai][1][m][0], b1 = acc[ai][1][m][1];
                float v[8];
#pragma unroll
                for (int j = 0; j < 4; ++j) { v[j] = siluf_(a0[j]) * b0[j]; v[4 + j] = siluf_(a1[j]) * b1[j]; }
                *(u32x4*)rowp = pack8(v); }
    }
};
struct EpiInProj {
    static constexpr bool PERM = true;
    unsigned char* ws;
    __device__ __forceinline__ void operator()(const f32x4 (&acc)[2][2][4][2], const Unit& u, int wr, int wc, int fr, int fq) const {
        const int row0 = u.pm * BM + wr * 64 + fr, pn = u.pn;
        if (pn == 18) {
            if (wc == 0 && fq < 2) { float* Lg = (float*)(ws + S_LOGIT);
#pragma unroll
                for (int ai = 0; ai < 2; ++ai)
#pragma unroll
                    for (int m = 0; m < 4; ++m) { float* rp = Lg + (size_t)(row0 + ai * HALF + m * 16) * 16 + 8 * fq; *(f32x4*)rp = acc[ai][0][m][0]; *(f32x4*)(rp + 4) = acc[ai][0][m][1]; } }
            return; }
        bf16_t* base; int ld, cb;
        if (pn < 4) { base = (bf16_t*)(ws + O_PQ); ld = 1024; cb = pn * 256; }
        else if (pn < 10) { base = (bf16_t*)(ws + O_SC); ld = 1536; cb = (pn - 4) * 256; }
        else if (pn < 16) { base = (bf16_t*)(ws + O_QKV); ld = 1536; cb = (pn - 10) * 256; }
        else { base = (bf16_t*)(ws + O_Z); ld = 512; cb = (pn - 16) * 256; }
        const int col0 = cb + wc * 32 + 8 * fq;
#pragma unroll
        for (int ai = 0; ai < 2; ++ai)
#pragma unroll
            for (int m = 0; m < 4; ++m) { bf16_t* rowp = base + (size_t)(row0 + ai * HALF + m * 16) * ld + col0;
#pragma unroll
                for (int bj = 0; bj < 2; ++bj) { const f32x4 v0 = acc[ai][bj][m][0], v1 = acc[ai][bj][m][1];
                    u32x4 w; w.x = cvt_pk_bf16(v0[0], v0[1]); w.y = cvt_pk_bf16(v0[2], v0[3]); w.z = cvt_pk_bf16(v1[0], v1[1]); w.w = cvt_pk_bf16(v1[2], v1[3]);
                    *(u32x4*)(rowp + bj * HALF) = w; } }
    }
};
struct EpiFourier {
    static constexpr bool PERM = true;
    bf16_t* FM; float sc;
    __device__ __forceinline__ void operator()(const f32x4 (&acc)[2][2][4][2], const Unit& u, int wr, int wc, int fr, int fq) const {
        const int row0 = u.pm * BM + wr * 64 + fr;
        const int colt = u.pn * BM;
        const int b = colt >> 13, k1 = (colt >> 9) & 15, ch0 = (colt & 511) + wc * 32 + 8 * fq;
#pragma unroll
        for (int ai = 0; ai < 2; ++ai)
#pragma unroll
            for (int m = 0; m < 4; ++m) { const int k2 = row0 + ai * HALF + m * 16;
                if (k2 < 257) { bf16_t* rowp = FM + (size_t)(b * LL + k1 + 16 * k2) * 512 + ch0;
#pragma unroll
                    for (int bj = 0; bj < 2; ++bj) { const f32x4 v0 = acc[ai][bj][m][0] * sc, v1 = acc[ai][bj][m][1] * sc;
                        u32x4 w; w.x = cvt_pk_bf16(v0[0], v0[1]); w.y = cvt_pk_bf16(v0[2], v0[3]); w.z = cvt_pk_bf16(v1[0], v1[1]); w.w = cvt_pk_bf16(v1[2], v1[3]);
                        *(u32x4*)(rowp + bj * HALF) = w; } } }
    }
};
struct EpiMerge {
    static constexpr bool PERM = true;
    const bf16_t* GATE; bf16_t* MG; bf16_t* MGB;
    __device__ __forceinline__ void operator()(const f32x4 (&acc)[2][2][4][2], const Unit& u, int wr, int wc, int fr, int fq) const {
        const int j = u.pm / 129, pm = u.pm - j * 129, pn = u.pn & 3;
        const int row0 = pm * BM + wr * 64 + fr, col0 = pn * BM + wc * 32 + 8 * fq;
        const bf16_t* mold = (j == 1 ? MG : MGB); bf16_t* mnew = (j == 1 ? MGB : MG);
#pragma unroll
        for (int ai = 0; ai < 2; ++ai) {
            u32x4 gv[4][2], ov[4][2];
#pragma unroll
            for (int m = 0; m < 4; ++m)
#pragma unroll
                for (int bj = 0; bj < 2; ++bj) { const size_t r = (size_t)(row0 + ai * HALF + m * 16);
                    gv[m][bj] = *(const u32x4*)(GATE + r * 3072 + j * 1024 + col0 + bj * HALF);
                    if (j > 0) ov[m][bj] = *(const u32x4*)(mold + r * 1024 + col0 + bj * HALF); }
#pragma unroll
            for (int m = 0; m < 4; ++m)
#pragma unroll
                for (int bj = 0; bj < 2; ++bj) { const size_t r = (size_t)(row0 + ai * HALF + m * 16);
                    float g[8], v[8]; unpack8(gv[m][bj], g);
                    const f32x4 v0 = acc[ai][bj][m][0], v1 = acc[ai][bj][m][1];
#pragma unroll
                    for (int e = 0; e < 4; ++e) { v[e] = v0[e] * g[e]; v[4 + e] = v1[e] * g[4 + e]; }
                    if (j > 0) { float o[8]; unpack8(ov[m][bj], o);
#pragma unroll
                        for (int e = 0; e < 8; ++e) v[e] += o[e]; }
                    *(u32x4*)(mnew + r * 1024 + col0 + bj * HALF) = pack8(v); }
            asm volatile("" ::: "memory"); }
    }
};
}

__device__ void rpass(const Params& P, const bf16_t* Y, bool first_h, const float* gpost, float scale, const float* gpre, bf16_t* XN, const float* slab = nullptr, int nS = 0) {
    const int tid_ = ltid(); const int wave = __builtin_amdgcn_readfirstlane(tid_ >> 6), lane = tid_ & 63;
    float* hm = (float*)(P.ws + S_HM);
    for (int r = lbid() * 8 + wave; r < TT; r += lgrid() * 8) {
        const int b = r / LL, n = r - b * LL;
        const float* hin; float* hout;
        if (n < NMETA) { hout = hm + (size_t)(b * 16 + n) * 1024; hin = first_h ? P.in[1] + (size_t)n * 1024 : hout; }
        else { const size_t o = ((size_t)b * SEQ + (n - NMETA)) * 1024; hout = P.out + o; hin = first_h ? P.in[0] + o : hout; }
        float h[16];
        { const f32x4 a = *(const f32x4*)(hin + lane * 8), b4 = *(const f32x4*)(hin + lane * 8 + 4), c = *(const f32x4*)(hin + 512 + lane * 8), d = *(const f32x4*)(hin + 512 + lane * 8 + 4);
#pragma unroll
          for (int e = 0; e < 4; ++e) { h[e] = a[e]; h[4 + e] = b4[e]; h[8 + e] = c[e]; h[12 + e] = d[e]; } }
        if (Y) {
            float y[16];
            if (slab != nullptr && r >= 32768) {
                const float* sp = slab + (size_t)(r - 32768) * 1024 + lane * 8;
                f32x4 s0 = {0.f, 0.f, 0.f, 0.f}, s1 = s0, s2 = s0, s3 = s0;
#pragma unroll 1
                for (int ks = 0; ks < nS; ++ks) { s0 += *(const f32x4*)sp; s1 += *(const f32x4*)(sp + 4); s2 += *(const f32x4*)(sp + 512); s3 += *(const f32x4*)(sp + 516); sp += 131072; }
#pragma unroll
                for (int e = 0; e < 4; ++e) { y[e] = s0[e]; y[4 + e] = s1[e]; y[8 + e] = s2[e]; y[12 + e] = s3[e]; }
            } else { unpack8(*(const u32x4*)(Y + (size_t)r * 1024 + lane * 8), y); unpack8(*(const u32x4*)(Y + (size_t)r * 1024 + 512 + lane * 8), y + 8); }
            float ss = 0.f;
#pragma unroll
            for (int e = 0; e < 16; ++e) ss += y[e] * y[e];
            ss = wave_sum(ss); const float r1 = rsqrtf(ss * (1.0f / 1024.0f) + EPS) * scale;
#pragma unroll
            for (int e = 0; e < 8; ++e) { h[e] += y[e] * r1 * gpost[lane * 8 + e]; h[8 + e] += y[8 + e] * r1 * gpost[512 + lane * 8 + e]; }
            *(f32x4*)(hout + lane * 8) = (f32x4){h[0], h[1], h[2], h[3]}; *(f32x4*)(hout + lane * 8 + 4) = (f32x4){h[4], h[5], h[6], h[7]};
            *(f32x4*)(hout + 512 + lane * 8) = (f32x4){h[8], h[9], h[10], h[11]}; *(f32x4*)(hout + 512 + lane * 8 + 4) = (f32x4){h[12], h[13], h[14], h[15]};
        }
        if (gpre) {
            float ss = 0.f;
#pragma unroll
            for (int e = 0; e < 16; ++e) ss += h[e] * h[e];
            ss = wave_sum(ss); const float r2 = rsqrtf(ss * (1.0f / 1024.0f) + EPS);
            float o[16];
#pragma unroll
            for (int e = 0; e < 8; ++e) { o[e] = h[e] * r2 * gpre[lane * 8 + e]; o[8 + e] = h[8 + e] * r2 * gpre[512 + lane * 8 + e]; }
            *(u32x4*)(XN + (size_t)r * 1024 + lane * 8) = pack8(o); *(u32x4*)(XN + (size_t)r * 1024 + 512 + lane * 8) = pack8(o + 8);
        }
    }
}

template <class F>
__device__ void cvt_tiles(const float* src, int ld_src, int K, bf16_t* dst, int nrows, F srccol, unsigned char* smem) {
    float* lds = (float*)smem; const int tid = ltid();
    const int ntr = nrows / 64, ntk = K / 64, nt_ = ntr * ntk, G_ = lgrid();
    float pv[8];
    { const int t = lbid(); if (t < nt_) { const int tr = t % ntr, tk = t / ntr; const int c0 = srccol(tr * 64);
#pragma unroll
        for (int i = 0; i < 8; ++i) { const int kk = (tid >> 6) + 8 * i, cc = tid & 63; pv[i] = src[(size_t)(tk * 64 + kk) * ld_src + c0 + cc]; } } }
    for (int t = lbid(); t < nt_; t += G_) {
        const int tr = t % ntr, tk = t / ntr;
        __syncthreads();
#pragma unroll
        for (int i = 0; i < 8; ++i) { const int kk = (tid >> 6) + 8 * i, cc = tid & 63; lds[kk * 65 + cc] = pv[i]; }
        __syncthreads();
        { const int t2 = t + G_; if (t2 < nt_) { const int tr2 = t2 % ntr, tk2 = t2 / ntr; const int c2 = srccol(tr2 * 64);
#pragma unroll
            for (int i = 0; i < 8; ++i) { const int kk = (tid >> 6) + 8 * i, cc = tid & 63; pv[i] = src[(size_t)(tk2 * 64 + kk) * ld_src + c2 + cc]; } } }
        const int cc2 = tid >> 3, k8 = (tid & 7) * 8; float v[8];
#pragma unroll
        for (int e = 0; e < 8; ++e) v[e] = lds[(k8 + e) * 65 + cc2];
        *(u32x4*)(dst + (size_t)(tr * 64 + cc2) * K + tk * 64 + k8) = pack8(v);
    }
}
struct ColIdent { int off; __device__ int operator()(int r) const { return r + off; } };
struct ColSwiglu { __device__ int operator()(int r) const { const int pn = r >> 8, rem = r & 255; return (rem >> 7) * DFF + 128 * pn + (rem & 127); } };

__device__ void convert_weights(const Params& P, int l, unsigned char* smem) {
    unsigned char* ws = P.ws; const int tid = ltid();
    cvt_tiles(P.in[3] + (size_t)l * 1024 * 5632, 5632, 1024, (bf16_t*)(ws + W_WI1), 5632, ColSwiglu{}, smem);
    cvt_tiles(P.in[4] + (size_t)l * 2816 * 1024, 1024, 2816, (bf16_t*)(ws + W_WO1), 1024, ColIdent{0}, smem);
    cvt_tiles(P.in[5] + (size_t)l * 1024 * 5632, 5632, 1024, (bf16_t*)(ws + W_WI2), 5632, ColSwiglu{}, smem);
    cvt_tiles(P.in[6] + (size_t)l * 2816 * 1024, 1024, 2816, (bf16_t*)(ws + W_WO2), 1024, ColIdent{0}, smem);
    const float* win = P.in[7] + (size_t)l * 1024 * NIN;
    cvt_tiles(win, NIN, 1024, (bf16_t*)(ws + W_WIN) + (size_t)1024 * 1024, 3584, ColIdent{512}, smem);
    cvt_tiles(win, NIN, 1024, (bf16_t*)(ws + W_WG), 3072, ColIdent{4112}, smem);
    cvt_tiles(P.in[13] + (size_t)l * 512 * 1024, 1024, 512, (bf16_t*)(ws + W_WBR), 1024, ColIdent{0}, smem);
    cvt_tiles(P.in[14] + (size_t)l * 512 * 1024, 1024, 512, (bf16_t*)(ws + W_WBR) + (size_t)1024 * 512, 1024, ColIdent{0}, smem);
    cvt_tiles(P.in[15] + (size_t)l * 512 * 1024, 1024, 512, (bf16_t*)(ws + W_WBR) + (size_t)2048 * 512, 1024, ColIdent{0}, smem);
    cvt_tiles(P.in[16] + (size_t)l * 1024 * 1024, 1024, 1024, (bf16_t*)(ws + W_WOUT), 1024, ColIdent{0}, smem);
    { bf16_t* d = (bf16_t*)(ws + W_WIN) + (size_t)4608 * 1024;
      for (int i = lbid() * 512 + tid; i < 256 * 1024; i += lgrid() * 512) { const int rr = i >> 10, k = i & 1023; d[i] = rr < 16 ? f2bf(win[(size_t)k * NIN + 4096 + rr]) : (bf16_t)0; } }
    { float* Ws = (float*)smem; float* ct = Ws + 64 * 65; float* st = ct + 64;
      __syncthreads();
      if (tid < 64) { float s, c; sincospif((float)tid * (2.0f / 64.0f), &s, &c); ct[tid] = c; st[tid] = s; }
      bf16_t* dp = (bf16_t*)(ws + W_WIN); bf16_t* dq = dp + (size_t)512 * 1024;
      for (int it = lbid(); it < 8 * 16; it += lgrid()) { const int g = it >> 4, kt = it & 15;
          __syncthreads();
#pragma unroll
          for (int i = 0; i < 8; ++i) { const int kk = (tid >> 6) + 8 * i, cc = tid & 63; Ws[kk * 65 + cc] = win[(size_t)(kt * 64 + kk) * NIN + g * 64 + cc]; }
          __syncthreads();
          const int kk = tid & 63;
#pragma unroll 1
          for (int i = 0; i < 8; ++i) { const int cp = (tid >> 6) + 8 * i; float ap = 0.f, aq = 0.f;
#pragma unroll 4
              for (int c = 0; c < 64; ++c) { const float w = Ws[kk * 65 + c]; const int ph = (c * cp) & 63; ap += w * ct[ph]; aq += w * st[ph]; }
              dp[(size_t)(g * 64 + cp) * 1024 + kt * 64 + kk] = f2bf(ap); dq[(size_t)(g * 64 + cp) * 1024 + kt * 64 + kk] = f2bf(aq); }
      }
      __syncthreads(); }
}

__device__ void gen_tables(const Params& P) {
    unsigned char* ws = P.ws; const int gt = lbid() * 512 + ltid(), gs = lgrid() * 512;
    bf16_t* C = (bf16_t*)(ws + S_C257);
    for (int i = gt; i < 512 * KF; i += gs) { const int k2 = i / KF, kk = i - k2 * KF; const int ri = kk >= 320, n2 = kk - ri * 320; float v = 0.f;
        if (k2 < 257 && n2 < 257) { const int m = (k2 * n2) % 257; float s, c; sincospif((float)m * (2.0f / 257.0f), &s, &c); v = ri ? s : c; }
        C[i] = f2bf(v); }
    float* tw = (float*)(ws + S_TWL);
    for (int i = gt; i < LL; i += gs) { float s, c; sincospif((float)i * (2.0f / (float)LL), &s, &c); tw[2 * i] = c; tw[2 * i + 1] = -s; }
}

__device__ void sconv_pass(const Params& P, int l) {
    const int tid_ = ltid(); const int wave = __builtin_amdgcn_readfirstlane(tid_ >> 6), lane = tid_ & 63;
    const bf16_t* SC = (const bf16_t*)(P.ws + O_SC); bf16_t* SCO = (bf16_t*)(P.ws + O_BR) + (size_t)TP * 512;
    const float* w = P.in[8] + (size_t)l * 3 * 512;
    float w0[8], w1[8], w2[8];
#pragma unroll
    for (int e = 0; e < 8; ++e) { w0[e] = w[lane * 8 + e]; w1[e] = w[512 + lane * 8 + e]; w2[e] = w[1024 + lane * 8 + e]; }
    for (int r = lbid() * 8 + wave; r < TT; r += lgrid() * 8) {
        const int b = r / LL, n = r - b * LL; const bf16_t* rp = SC + (size_t)r * 1536 + lane * 8;
        float bb[8], c[8], h[8], acc[8]; unpack8(*(const u32x4*)rp, bb); unpack8(*(const u32x4*)(rp + 512), c); unpack8(*(const u32x4*)(rp + 1024), h);
#pragma unroll
        for (int e = 0; e < 8; ++e) acc[e] = w1[e] * c[e] * h[e];
        if (n > 0) { unpack8(*(const u32x4*)(rp - 1536 + 512), c); unpack8(*(const u32x4*)(rp - 1536 + 1024), h);
#pragma unroll
            for (int e = 0; e < 8; ++e) acc[e] += w0[e] * c[e] * h[e]; }
        if (n < LL - 1) { unpack8(*(const u32x4*)(rp + 1536 + 512), c); unpack8(*(const u32x4*)(rp + 1536 + 1024), h);
#pragma unroll
            for (int e = 0; e < 8; ++e) acc[e] += w2[e] * c[e] * h[e]; }
#pragma unroll
        for (int e = 0; e < 8; ++e) acc[e] *= bb[e];
        *(u32x4*)(SCO + (size_t)r * 512 + lane * 8) = pack8(acc);
    }
}

__device__ void fstep1(const Params& P, unsigned char* smem) {
    const int tid = ltid(), wave = __builtin_amdgcn_readfirstlane(tid >> 6), lane = tid & 63;
    const bf16_t* PQ = (const bf16_t*)(P.ws + O_PQ); bf16_t* AP = (bf16_t*)(P.ws + O_AP); const float* tw = (const float*)(P.ws + S_TWL);
    bf16_t* St = (bf16_t*)smem;
    for (int it = lbid(); it < 8 * 4 * 17; it += lgrid()) {
        const int b = it / 68, rem = it - b * 68, cht = rem / 17, n2t = rem - cht * 17;
        __syncthreads();
#pragma unroll
        for (int sub = 0; sub < 2; ++sub) {
            const int n2l = sub * 8 + wave, n2 = n2t * 16 + n2l;
            const int fr = lane & 15, fq = lane >> 4;
            if (n2 < 257) {
                float f0[8], f1[8];
#pragma unroll
                for (int j = 0; j < 8; ++j) { const int n = 257 * (8 * (fq & 1) + j) + n2; const int ph = (fr * n) % LL;
                    const float2 cs_ = *(const float2*)(tw + 2 * ph); const float c_ = cs_.x, ms_ = cs_.y;
                    f0[j] = (fq < 2) ? c_ : ms_; f1[j] = (fq < 2) ? ms_ : -c_; }
                const bf16x8 a0 = __builtin_bit_cast(bf16x8, pack8(f0)), a1 = __builtin_bit_cast(bf16x8, pack8(f1));
                const bf16_t* bp = PQ + (size_t)(b * LL + 257 * 8 * (fq & 1) + n2) * 1024 + (fq >> 1) * 512 + cht * 128 + fr;
#pragma unroll
                for (int ct = 0; ct < 8; ++ct) {
                    bf16x8 bf;
#pragma unroll
                    for (int j = 0; j < 8; ++j) bf[j] = (short)bp[(size_t)j * 257 * 1024 + ct * 16];
                    const f32x4 z = {0.f, 0.f, 0.f, 0.f};
                    const f32x4 c0 = __builtin_amdgcn_mfma_f32_16x16x32_bf16(a0, bf, z, 0, 0, 0), c1 = __builtin_amdgcn_mfma_f32_16x16x32_bf16(a1, bf, z, 0, 0, 0);
                    bf16_t* sp = St + ((4 * fq) * 128 + ct * 16 + fr) * 32 + n2l;
#pragma unroll
                    for (int rg = 0; rg < 4; ++rg) { sp[rg * 4096] = f2bf(c0[rg]); sp[rg * 4096 + 16] = f2bf(c1[rg]); }
                }
            } else {
                for (int q = lane; q < 4096; q += 64) St[q * 16 + n2l] = 0;
            }
        }
        __syncthreads();
#pragma unroll 2
        for (int q = tid; q < 8192; q += 512) { const int half = q & 1, ri = (q >> 1) & 1, chl = (q >> 2) & 127, k1 = q >> 9;
            const int n2c = n2t * 16 + half * 8;
            if (n2c < 320) { const u32x4 v = *(const u32x4*)(St + (size_t)q * 8);
                *(u32x4*)(AP + ((size_t)((b * 16 + k1) * 512 + cht * 128 + chl)) * KF + ri * 320 + n2c) = v; } }
        if (n2t == 16) {
            for (int q = tid; q < 16 * 128 * 2 * 6; q += 512) { const int c6 = q % 6, r2 = q / 6, ri = r2 & 1, chl = (r2 >> 1) & 127, k1 = r2 >> 8;
                *(u32x4*)(AP + ((size_t)((b * 16 + k1) * 512 + cht * 128 + chl)) * KF + ri * 320 + 272 + c6 * 8) = (u32x4){0u, 0u, 0u, 0u}; } }
    }
    __syncthreads();
}

#ifdef DBG_SEC
#define SEC_T(k) do { if (lbid() == 0 && tid == 0) { const unsigned long long _n = __builtin_amdgcn_s_memrealtime(); if (sec_prev_k == DBG_SEC) *(unsigned long long*)(smem + LDS_BYTES - 32) += _n - sec_prev_t; sec_prev_t = _n; sec_prev_k = (k); } } while (0)
#else
#define SEC_T(k) do {} while (0)
#endif
__device__ void dn_prep(const Params& P, int l, unsigned char* smem, int t0, int t1) {
#ifdef DBG_SEC
    unsigned long long sec_prev_t = __builtin_amdgcn_s_memrealtime(); int sec_prev_k = -1;
#endif
    const int tid = ltid(), wave = __builtin_amdgcn_readfirstlane(tid >> 6), lane = tid & 63, fr = lane & 15, fq = lane >> 4;
    unsigned char* ws = P.ws;
    const bf16_t* QKV = (const bf16_t*)(ws + O_QKV); const float* LG = (const float*)(ws + S_LOGIT);
    bf16_t* WP = (bf16_t*)(ws + O_WP); bf16_t* QP = (bf16_t*)(ws + O_QP); bf16_t* KD = (bf16_t*)(ws + O_KD); bf16_t* UF = (bf16_t*)(ws + O_UF); bf16_t* AT = (bf16_t*)(ws + O_AT);
    float* GL = (float*)(ws + S_GL);
    const float* cw = P.in[9] + (size_t)l * 3 * 1536;
    bf16_t* Qs = (bf16_t*)smem;
    bf16_t* Ks = Qs + 64 * 136;
    bf16_t* KT = Ks + 64 * 136;
    bf16_t* VT = KT + 128 * 72;
    bf16_t* T1 = VT + 128 * 72;
    bf16_t* T2 = T1 + 64 * 72;
    bf16_t* Rm = T2 + 64 * 72;
    bf16_t* Rt = Rm + 64 * 72;
    bf16_t* Pm = Rt + 64 * 72;
    float* gcs = (float*)(T2 + 64 * 72 + 2 * 64 * 68 * 2);
    float* bts = gcs + 64;
    float* cwl = bts + 64;
    bf16_t* Xr = T1;
    const int items = (t1 - t0) * 64;
    u32x4 x0[6], xb;
#define PREP_ISSUE(it_) do { const int _tl = (it_) >> 6, _bhd = (it_) & 63, _b = _bhd >> 3, _h = (_bhd >> 1) & 3, _dir = _bhd & 1; const int _nb = (_dir ? 64 - (t0 + _tl) : (t0 + _tl)) * 64 - 48; const u32x4 z4 = {0u, 0u, 0u, 0u}; \
        _Pragma("unroll") for (int rr = 0; rr < 6; ++rr) { const int task = tid + 512 * rr, i = task / 48, cg_ = task - i * 48; const int n = _nb + (_dir ? 63 - i : i); \
            x0[rr] = (n >= 0) ? *(const u32x4*)(QKV + (size_t)(_b * LL + n) * 1536 + (cg_ >> 4) * 512 + _h * 128 + (cg_ & 15) * 8) : z4; } \
        xb = z4; if (tid < 96) { const int which = tid / 48, cg_ = tid - which * 48; const int n = which ? _nb + 64 : _nb - 1; \
            if (n >= 0 && n < LL) xb = *(const u32x4*)(QKV + (size_t)(_b * LL + n) * 1536 + (cg_ >> 4) * 512 + _h * 128 + (cg_ & 15) * 8); } } while (0)
    for (int it = lbid(); it < items; it += lgrid()) {
        const int tl = it >> 6, bhd = it & 63, b = bhd >> 3, h = (bhd >> 1) & 3, dir = bhd & 1;
        const int t = t0 + tl, c = dir ? 64 - t : t; const size_t slot = (size_t)tl * 64 + bhd;
        PREP_ISSUE(it);
        float bl_ = 0.f, al_ = 0.f;
        { const int n_ = c * 64 + (dir ? 63 - lane : lane) - 48; if (wave == 0 && n_ >= 0) { const float* lg = LG + (size_t)(b * LL + n_) * 16; bl_ = lg[dir * 4 + h]; al_ = lg[8 + dir * 4 + h]; } }
        __syncthreads();
        SEC_T(0);
        for (int q = tid; q < 1152; q += 512) { const int tap = q / 384, rem = q - tap * 384; cwl[q] = cw[tap * 1536 + (rem >> 7) * 512 + h * 128 + (rem & 127)]; }
#pragma unroll
        for (int rr = 0; rr < 6; ++rr) { const int task = tid + 512 * rr, i = task / 48, cg_ = task - i * 48; *(u32x4*)(Xr + ((dir ? 63 - i : i) + 1) * 384 + cg_ * 8) = x0[rr]; }
        if (tid < 96) { const int which = tid / 48, cg_ = tid - which * 48; *(u32x4*)(Xr + (which ? 65 : 0) * 384 + cg_ * 8) = xb; }
        __syncthreads();
#pragma unroll 1
        for (int rr = 0; rr < 6; ++rr) {
            const int task = tid + 512 * rr, i = task / 48, cg_ = task - i * 48, kind = cg_ >> 4, cgl = cg_ & 15;
            float v[8], x[8];
            const float* w1 = cwl + 384 + kind * 128 + cgl * 8;
            const bf16_t* xr = Xr + ((dir ? 63 - i : i) + 1) * 384 + cg_ * 8;
            unpack8(*(const u32x4*)xr, x);
#pragma unroll
            for (int e = 0; e < 8; ++e) v[e] = w1[e] * x[e];
            unpack8(*(const u32x4*)(xr - 384), x);
#pragma unroll
            for (int e = 0; e < 8; ++e) v[e] += w1[e - 384] * x[e];
            unpack8(*(const u32x4*)(xr + 384), x);
#pragma unroll
            for (int e = 0; e < 8; ++e) v[e] += w1[e + 384] * x[e];
#pragma unroll
            for (int e = 0; e < 8; ++e) v[e] = siluf_(v[e]);
            float ss = 0.f;
#pragma unroll
            for (int e = 0; e < 8; ++e) ss += v[e] * v[e];
            ss += __shfl_xor(ss, 1); ss += __shfl_xor(ss, 2); ss += __shfl_xor(ss, 4); ss += __shfl_xor(ss, 8);
            if (kind < 2) { const float inv = rsqrtf(ss + EPS) * (kind == 0 ? 0.08838834764831845f : 1.0f);
#pragma unroll
                for (int e = 0; e < 8; ++e) v[e] *= inv; }
            const u32x4 pk = pack8(v);
            const int isw = i ^ ((cgl & 7) << 3);
            if (kind == 0) *(u32x4*)(Qs + i * 136 + cgl * 8) = pk;
            else if (kind == 1) { *(u32x4*)(Ks + i * 136 + cgl * 8) = pk;
#pragma unroll
                for (int e = 0; e < 8; ++e) KT[(cgl * 8 + e) * 72 + isw] = f2bf(v[e]); }
            else {
#pragma unroll
                for (int e = 0; e < 8; ++e) VT[(cgl * 8 + e) * 72 + isw] = f2bf(v[e]); }
        }
        if (wave == 0) {
            const int i = lane, n = c * 64 + (dir ? 63 - i : i) - 48; float beta = 0.f, g = 0.f;
            if (n >= 0) { const float bl = bl_, al = al_;
                beta = 1.0f / (1.0f + expf(-bl));
                const float xx = al + P.in[11][l * 8 + dir * 4 + h]; const float sp = xx > 20.f ? xx : log1pf(expf(xx));
                g = -expf(P.in[10][l * 8 + dir * 4 + h]) * sp; }
#pragma unroll
            for (int o = 1; o < 64; o <<= 1) { const float tt = __shfl_up(g, o); if (lane >= o) g += tt; }
            gcs[i] = g; bts[i] = beta;
        }
        __syncthreads();
        SEC_T(1);
        if (wave < 4) {
            const int m = wave; f32x4 acc[4];
#pragma unroll
            for (int n = 0; n < 4; ++n) acc[n] = (f32x4){0.f, 0.f, 0.f, 0.f};
#pragma unroll
            for (int s = 0; s < 4; ++s) { const bf16x8 a = *(const bf16x8*)(Ks + (16 * m + fr) * 136 + 32 * s + 8 * fq);
#pragma unroll
                for (int n = 0; n < 4; ++n) { const bf16x8 bb = *(const bf16x8*)(Ks + (16 * n + fr) * 136 + 32 * s + 8 * fq); acc[n] = __builtin_amdgcn_mfma_f32_16x16x32_bf16(a, bb, acc[n], 0, 0, 0); } }
#pragma unroll
            for (int n = 0; n < 4; ++n) { const int i = 16 * n + fr, j0 = 16 * m + 4 * fq;
                float nv[4], pv_[4];
#pragma unroll
                for (int rg = 0; rg < 4; ++rg) { const int j = j0 + rg; const float mv = (i > j) ? bts[i] * acc[n][rg] * __expf(gcs[i] - gcs[j]) : 0.f;
                    nv[rg] = -mv; pv_[rg] = (i == j ? 1.f : 0.f) - mv; Rt[j * 72 + i] = f2bf(-mv); }
                u32x2 w; w.x = cvt_pk_bf16(nv[0], nv[1]); w.y = cvt_pk_bf16(nv[2], nv[3]); *(u32x2*)(Rm + i * 72 + j0) = w;
                w.x = cvt_pk_bf16(pv_[0], pv_[1]); w.y = cvt_pk_bf16(pv_[2], pv_[3]); *(u32x2*)(Pm + i * 72 + j0) = w; }
        } else {
            const int m = wave - 4; f32x4 acc[4];
#pragma unroll
            for (int n = 0; n < 4; ++n) acc[n] = (f32x4){0.f, 0.f, 0.f, 0.f};
#pragma unroll
            for (int s = 0; s < 4; ++s) { const bf16x8 qf = *(const bf16x8*)(Qs + (16 * m + fr) * 136 + 32 * s + 8 * fq);
#pragma unroll
                for (int n = 0; n < 4; ++n) { const bf16x8 kf = *(const bf16x8*)(Ks + (16 * n + fr) * 136 + 32 * s + 8 * fq); acc[n] = __builtin_amdgcn_mfma_f32_16x16x32_bf16(kf, qf, acc[n], 0, 0, 0); } }
            const int i = 16 * m + fr; const float gi = gcs[i];
#pragma unroll
            for (int s2 = 0; s2 < 2; ++s2) { float v[8];
#pragma unroll
                for (int e = 0; e < 8; ++e) { const int j = 32 * s2 + 16 * (e >> 2) + 4 * fq + (e & 3); v[e] = (i >= j) ? acc[2 * s2 + (e >> 2)][e & 3] * __expf(gi - gcs[j]) : 0.f; }
                *(u32x4*)(AT + slot * 4096 + i * 64 + (((4 * s2 + fq) ^ ((i >> 1) & 7)) << 3)) = pack8(v); }
        }
        __syncthreads();
        SEC_T(2);
        {
            const float glast = gcs[63];
            for (int task = tid; task < 2048; task += 512) {
                if (task < 1024) { const int i = task >> 4, s_ = (task >> 2) & 3, f4 = task & 3; const float sc = __expf(gcs[i]);
                    const u32x2 a = *(const u32x2*)(Qs + i * 136 + 32 * s_ + 4 * f4), bq = *(const u32x2*)(Qs + i * 136 + 32 * s_ + 16 + 4 * f4);
                    float v[8]; v[0] = bf2f(a.x & 0xffffu) * sc; v[1] = __uint_as_float(a.x & 0xffff0000u) * sc; v[2] = bf2f(a.y & 0xffffu) * sc; v[3] = __uint_as_float(a.y & 0xffff0000u) * sc;
                    v[4] = bf2f(bq.x & 0xffffu) * sc; v[5] = __uint_as_float(bq.x & 0xffff0000u) * sc; v[6] = bf2f(bq.y & 0xffffu) * sc; v[7] = __uint_as_float(bq.y & 0xffff0000u) * sc;
                    *(u32x4*)(QP + slot * 8192 + i * 128 + (((4 * s_ + f4) ^ (i & 15)) << 3)) = pack8(v);
                } else { const int tt = task - 1024, dk = tt >> 3, s2 = (tt >> 2) & 1, f4 = tt & 3; const int i0 = 32 * s2 + 4 * f4;
                    const int sw = ((dk >> 3) & 7) << 3; const u32x2 a = *(const u32x2*)(KT + dk * 72 + (i0 ^ sw)), bq = *(const u32x2*)(KT + dk * 72 + ((i0 + 16) ^ sw));
                    float v[8]; v[0] = bf2f(a.x & 0xffffu) * __expf(glast - gcs[i0]); v[1] = __uint_as_float(a.x & 0xffff0000u) * __expf(glast - gcs[i0 + 1]);
                    v[2] = bf2f(a.y & 0xffffu) * __expf(glast - gcs[i0 + 2]); v[3] = __uint_as_float(a.y & 0xffff0000u) * __expf(glast - gcs[i0 + 3]);
                    v[4] = bf2f(bq.x & 0xffffu) * __expf(glast - gcs[i0 + 16]); v[5] = __uint_as_float(bq.x & 0xffff0000u) * __expf(glast - gcs[i0 + 17]);
                    v[6] = bf2f(bq.y & 0xffffu) * __expf(glast - gcs[i0 + 18]); v[7] = __uint_as_float(bq.y & 0xffff0000u) * __expf(glast - gcs[i0 + 19]);
                    *(u32x4*)(KD + slot * 8192 + dk * 64 + (((4 * s2 + f4) ^ ((dk >> 1) & 7)) << 3)) = pack8(v); }
            }
            if (tid == 0) GL[slot] = __expf(glast);
            f32x4 accP[2];
#pragma unroll
            for (int e = 0; e < 2; ++e) { const int tt = 2 * wave + e, it_ = tt >> 2, jt = tt & 3;
                const u32x2 pw = *(const u32x2*)(Pm + (16 * it_ + fr) * 72 + 16 * jt + 4 * fq);
                accP[e] = (f32x4){__uint_as_float(pw.x << 16), __uint_as_float(pw.x & 0xffff0000u), __uint_as_float(pw.y << 16), __uint_as_float(pw.y & 0xffff0000u)}; }
#pragma unroll 1
            for (int rd = 0; rd < 6; ++rd) {
                f32x4 accR[2], accT[2];
#pragma unroll
                for (int e = 0; e < 2; ++e) { const int tt = 2 * wave + e, mt = tt >> 2, nt = tt & 3;
                    accR[e] = (f32x4){0.f, 0.f, 0.f, 0.f}; accT[e] = (f32x4){0.f, 0.f, 0.f, 0.f};
#pragma unroll
                    for (int s2 = 0; s2 < 2; ++s2) {
                        const bf16x8 rm = *(const bf16x8*)(Rm + (16 * mt + fr) * 72 + 32 * s2 + 8 * fq), rn = *(const bf16x8*)(Rm + (16 * nt + fr) * 72 + 32 * s2 + 8 * fq);
                        const bf16x8 tm = *(const bf16x8*)(Rt + (16 * mt + fr) * 72 + 32 * s2 + 8 * fq), tn = *(const bf16x8*)(Rt + (16 * nt + fr) * 72 + 32 * s2 + 8 * fq);
                        const bf16x8 pm_ = *(const bf16x8*)(Pm + (16 * mt + fr) * 72 + 32 * s2 + 8 * fq);
                        if (rd < 5) { accR[e] = __builtin_amdgcn_mfma_f32_16x16x32_bf16(rm, tn, accR[e], 0, 0, 0);
                                      accT[e] = __builtin_amdgcn_mfma_f32_16x16x32_bf16(tm, rn, accT[e], 0, 0, 0); }
                        if (rd > 0) accP[e] = __builtin_amdgcn_mfma_f32_16x16x32_bf16(tn, pm_, accP[e], 0, 0, 0);
                    } }
                __syncthreads();
                if (rd < 5) {
#pragma unroll
                    for (int e = 0; e < 2; ++e) { const int tt = 2 * wave + e, mt = tt >> 2, nt = tt & 3; u32x2 w;
                        w.x = cvt_pk_bf16(accR[e][0], accR[e][1]); w.y = cvt_pk_bf16(accR[e][2], accR[e][3]); *(u32x2*)(Rt + (16 * nt + fr) * 72 + 16 * mt + 4 * fq) = w;
                        w.x = cvt_pk_bf16(accT[e][0], accT[e][1]); w.y = cvt_pk_bf16(accT[e][2], accT[e][3]); *(u32x2*)(Rm + (16 * nt + fr) * 72 + 16 * mt + 4 * fq) = w;
                        if (rd > 0) { w.x = cvt_pk_bf16(accP[e][0], accP[e][1]); w.y = cvt_pk_bf16(accP[e][2], accP[e][3]); *(u32x2*)(Pm + (16 * mt + fr) * 72 + 16 * nt + 4 * fq) = w; } }
                    __syncthreads();
                }
            }
#pragma unroll
            for (int e = 0; e < 2; ++e) { const int tt = 2 * wave + e, mt = tt >> 2, nt = tt & 3; const int i = 16 * mt + fr, c0 = 16 * nt + 4 * fq; float v1[4], v2[4];
#pragma unroll
                for (int rg = 0; rg < 4; ++rg) { const float bc = bts[c0 + rg]; v1[rg] = accP[e][rg] * bc; v2[rg] = -accP[e][rg] * bc * __expf(gcs[c0 + rg]); }
                u32x2 w; w.x = cvt_pk_bf16(v1[0], v1[1]); w.y = cvt_pk_bf16(v1[2], v1[3]); *(u32x2*)(T1 + i * 72 + c0) = w;
                w.x = cvt_pk_bf16(v2[0], v2[1]); w.y = cvt_pk_bf16(v2[2], v2[3]); *(u32x2*)(T2 + i * 72 + c0) = w; }
        }
        __syncthreads();
        SEC_T(3);
#pragma unroll 1
        for (int nh = 0; nh < 2; ++nh) {
        if (wave < 4) {
            const int m = wave; f32x4 acc[4];
#pragma unroll
            for (int n = 0; n < 4; ++n) acc[n] = (f32x4){0.f, 0.f, 0.f, 0.f};
#pragma unroll
            for (int s2 = 0; s2 < 2; ++s2) { const bf16x8 a = *(const bf16x8*)(T1 + (16 * m + fr) * 72 + 32 * s2 + 8 * fq);
#pragma unroll
                for (int n = 0; n < 4; ++n) { const int d = 16 * (4 * nh + n) + fr; const bf16x8 bb = *(const bf16x8*)(VT + d * 72 + ((32 * s2 + 8 * fq) ^ (((d >> 3) & 7) << 3))); acc[n] = __builtin_amdgcn_mfma_f32_16x16x32_bf16(a, bb, acc[n], 0, 0, 0); } }
#pragma unroll
            for (int n = 0; n < 4; ++n) { u32x2 w; w.x = cvt_pk_bf16(acc[n][0], acc[n][1]); w.y = cvt_pk_bf16(acc[n][2], acc[n][3]);
                *(u32x2*)(UF + slot * 8192 + (((4 * nh + n) * 4 + m) * 64 + lane) * 4) = w; }
        } else {
            const int m = wave - 4; f32x4 acc[4];
#pragma unroll
            for (int n = 0; n < 4; ++n) acc[n] = (f32x4){0.f, 0.f, 0.f, 0.f};
#pragma unroll
            for (int s2 = 0; s2 < 2; ++s2) { const bf16x8 tf = *(const bf16x8*)(T2 + (16 * m + fr) * 72 + 32 * s2 + 8 * fq);
#pragma unroll
                for (int n = 0; n < 4; ++n) { const int d = 16 * (4 * nh + n) + fr; const bf16x8 kf = *(const bf16x8*)(KT + d * 72 + ((32 * s2 + 8 * fq) ^ (((d >> 3) & 7) << 3))); acc[n] = __builtin_amdgcn_mfma_f32_16x16x32_bf16(kf, tf, acc[n], 0, 0, 0); } }
            const int i = 16 * m + fr;
#pragma unroll
            for (int s = 0; s < 2; ++s) { u32x4 w; w.x = cvt_pk_bf16(acc[2 * s][0], acc[2 * s][1]); w.y = cvt_pk_bf16(acc[2 * s][2], acc[2 * s][3]);
                w.z = cvt_pk_bf16(acc[2 * s + 1][0], acc[2 * s + 1][1]); w.w = cvt_pk_bf16(acc[2 * s + 1][2], acc[2 * s + 1][3]);
                *(u32x4*)(WP + slot * 8192 + i * 128 + (((4 * (2 * nh + s) + fq) ^ (i & 15)) << 3)) = w; }
        }
        }
        SEC_T(4);
    }
    __syncthreads();
}

__device__ void dn_scan(const Params& P, unsigned char* smem, int t0, int t1) {
    if (lbid() >= 128) return;
    const int bhd = lbid() >> 1, half = lbid() & 1;
    const int tid = ltid(), wave = __builtin_amdgcn_readfirstlane(tid >> 6), lane = tid & 63, fr = lane & 15, fq = lane >> 4;
    unsigned char* ws = P.ws;
    const unsigned char* WPb = ws + O_WP; const unsigned char* QPb = ws + O_QP; const unsigned char* KDb = ws + O_KD; const unsigned char* ATb = ws + O_AT;
    const bf16_t* UF = (const bf16_t*)(ws + O_UF); const float* GL = (const float*)(ws + S_GL);
    bf16_t* OO = (bf16_t*)(ws + O_O); f32x4* SS = (f32x4*)(ws + S_SSAVE);
    const int b = bhd >> 3, h = (bhd >> 1) & 3, dir = bhd & 1;
    LAS unsigned char* lds = (LAS unsigned char*)smem;
    constexpr int BUFB = 57344;
#define SCAN_SRC(q_, slot_) ((q_) < 16 ? WPb + (slot_) * 16384 + (q_) * 1024 : (q_) < 32 ? QPb + (slot_) * 16384 + ((q_) - 16) * 1024 : (q_) < 48 ? KDb + (slot_) * 16384 + ((q_) - 32) * 1024 : ATb + (slot_) * 8192 + ((q_) - 48) * 1024)
#define SCAN_LOAD(tl_) do { const size_t _slot = (size_t)(tl_) * 64 + bhd; _Pragma("unroll") for (int _k = 0; _k < 14; ++_k) { const int _q = (wave - 4) * 14 + _k; rg_[_k] = *(const u32x4*)(SCAN_SRC(_q, _slot) + lane * 16); } } while (0)
#define SCAN_WRITE(buf_) do { _Pragma("unroll") for (int _k = 0; _k < 14; ++_k) { const int _q = (wave - 4) * 14 + _k; *(LAS u32x4*)(lds + (buf_) * BUFB + _q * 1024 + lane * 16) = rg_[_k]; } } while (0)
    constexpr int NN = 1; const bool cw_ = wave < 4; const int sl0 = half * 4 + (wave & 3);
    const int nst = t1 - t0;
    if (!cw_) {
        u32x4 rg_[14];
#define SCAN_LOAD(tl_) do { const size_t _slot = (size_t)(tl_) * 64 + bhd; _Pragma("unroll") for (int _k = 0; _k < 14; ++_k) { const int _q = (wave - 4) * 14 + _k; rg_[_k] = *(const u32x4*)(SCAN_SRC(_q, _slot) + lane * 16); } } while (0)
#define SCAN_WRITE(buf_) do { _Pragma("unroll") for (int _k = 0; _k < 14; ++_k) { const int _q = (wave - 4) * 14 + _k; *(LAS u32x4*)(lds + (buf_) * BUFB + _q * 1024 + lane * 16) = rg_[_k]; } } while (0)
        SCAN_LOAD(0); SCAN_WRITE(0); if (nst > 1) SCAN_LOAD(1);
#pragma unroll 1
        for (int tl = 0; tl < nst; ++tl) {
            __syncthreads();
            if (tl + 1 < nst) { SCAN_WRITE((tl + 1) & 1); if (tl + 2 < nst) SCAN_LOAD(tl + 2); }
        }
        asm volatile("s_waitcnt vmcnt(0)" ::: "memory");
        __syncthreads();
        return;
    }
    f32x4 S[8][NN];
#pragma unroll
    for (int t = 0; t < 8; ++t)
#pragma unroll
        for (int nn = 0; nn < NN; ++nn) S[t][nn] = (t0 == 0 || !cw_) ? (f32x4){0.f, 0.f, 0.f, 0.f} : SS[((size_t)(bhd * 8 + sl0 + nn) * 8 + t) * 64 + lane];
    u32x2 un[4][NN];
    if (cw_) {
#pragma unroll
        for (int m = 0; m < 4; ++m)
#pragma unroll
            for (int nn = 0; nn < NN; ++nn) un[m][nn] = *(const u32x2*)(UF + (size_t)bhd * 8192 + (((sl0 + nn) * 4 + m) * 64 + lane) * 4); }
    float gln = __hip_atomic_load(GL + bhd, __ATOMIC_RELAXED, __HIP_MEMORY_SCOPE_AGENT);
#pragma unroll 1
    for (int tl = 0; tl < nst; ++tl) {
        const size_t slot = (size_t)tl * 64 + bhd; const int t = t0 + tl, c = dir ? 64 - t : t;
        const LAS unsigned char* bw = lds + (tl & 1) * BUFB;
        __syncthreads();
        f32x4 av[4][NN], ao[4][NN];
#pragma unroll
        for (int m = 0; m < 4; ++m)
#pragma unroll
            for (int nn = 0; nn < NN; ++nn) { const u32x2 u = un[m][nn];
                av[m][nn] = (f32x4){__uint_as_float(u.x << 16), __uint_as_float(u.x & 0xffff0000u), __uint_as_float(u.y << 16), __uint_as_float(u.y & 0xffff0000u)}; ao[m][nn] = (f32x4){0.f, 0.f, 0.f, 0.f}; }
        const float gl = gln; if (tl + 1 < nst) gln = __hip_atomic_load(GL + slot + 64, __ATOMIC_RELAXED, __HIP_MEMORY_SCOPE_AGENT);
        if (tl + 1 < nst) {
#pragma unroll
            for (int m = 0; m < 4; ++m)
#pragma unroll
                for (int nn = 0; nn < NN; ++nn) un[m][nn] = *(const u32x2*)(UF + (slot + 64) * 8192 + (((sl0 + nn) * 4 + m) * 64 + lane) * 4); }
#pragma unroll
        for (int s = 0; s < 4; ++s) { bf16x8 Sb[NN];
#pragma unroll
            for (int nn = 0; nn < NN; ++nn) { u32x4 w; w.x = cvt_pk_bf16(S[2 * s][nn][0], S[2 * s][nn][1]); w.y = cvt_pk_bf16(S[2 * s][nn][2], S[2 * s][nn][3]); w.z = cvt_pk_bf16(S[2 * s + 1][nn][0], S[2 * s + 1][nn][1]); w.w = cvt_pk_bf16(S[2 * s + 1][nn][2], S[2 * s + 1][nn][3]);
                Sb[nn] = __builtin_bit_cast(bf16x8, w); }
#pragma unroll
            for (int m = 0; m < 4; ++m) { const bf16x8 wf = *(const LAS bf16x8*)(bw + (16 * m + fr) * 256 + (((4 * s + fq) ^ fr) << 4)); const bf16x8 qf = *(const LAS bf16x8*)(bw + 16384 + (16 * m + fr) * 256 + (((4 * s + fq) ^ fr) << 4));
                _Pragma("unroll") for (int nn = 0; nn < NN; ++nn) av[m][nn] = __builtin_amdgcn_mfma_f32_16x16x32_bf16(wf, Sb[nn], av[m][nn], 0, 0, 0);
                _Pragma("unroll") for (int nn = 0; nn < NN; ++nn) ao[m][nn] = __builtin_amdgcn_mfma_f32_16x16x32_bf16(qf, Sb[nn], ao[m][nn], 0, 0, 0); } }
        __builtin_amdgcn_sched_barrier(0);
        bf16x8 Vb[2][NN];
#pragma unroll
        for (int s2 = 0; s2 < 2; ++s2)
#pragma unroll
            for (int nn = 0; nn < NN; ++nn) { u32x4 w; w.x = cvt_pk_bf16(av[2 * s2][nn][0], av[2 * s2][nn][1]); w.y = cvt_pk_bf16(av[2 * s2][nn][2], av[2 * s2][nn][3]); w.z = cvt_pk_bf16(av[2 * s2 + 1][nn][0], av[2 * s2 + 1][nn][1]); w.w = cvt_pk_bf16(av[2 * s2 + 1][nn][2], av[2 * s2 + 1][nn][3]);
                Vb[s2][nn] = __builtin_bit_cast(bf16x8, w); }
#pragma unroll
        for (int m = 0; m < 4; ++m)
#pragma unroll
            for (int s2 = 0; s2 < 2; ++s2) { const int row = 16 * m + fr; const bf16x8 af = *(const LAS bf16x8*)(bw + 49152 + row * 128 + (((4 * s2 + fq) ^ ((row >> 1) & 7)) << 4));
                _Pragma("unroll") for (int nn = 0; nn < NN; ++nn) ao[m][nn] = __builtin_amdgcn_mfma_f32_16x16x32_bf16(af, Vb[s2][nn], ao[m][nn], 0, 0, 0); }
        __builtin_amdgcn_sched_barrier(0);
#pragma unroll
        for (int tt = 0; tt < 8; ++tt) { _Pragma("unroll") for (int nn = 0; nn < NN; ++nn) S[tt][nn] = S[tt][nn] * gl;
#pragma unroll
            for (int s2 = 0; s2 < 2; ++s2) { const int row = 16 * tt + fr; const bf16x8 kf = *(const LAS bf16x8*)(bw + 32768 + row * 128 + (((4 * s2 + fq) ^ ((row >> 1) & 7)) << 4));
                _Pragma("unroll") for (int nn = 0; nn < NN; ++nn) S[tt][nn] = __builtin_amdgcn_mfma_f32_16x16x32_bf16(kf, Vb[s2][nn], S[tt][nn], 0, 0, 0); } }
#pragma unroll
        for (int m = 0; m < 4; ++m)
#pragma unroll
            for (int rg = 0; rg < 4; ++rg) { const int i = 16 * m + 4 * fq + rg, n = c * 64 + (dir ? 63 - i : i) - 48;
                if (n >= 0) { bf16_t* op = OO + ((size_t)dir * TP + (size_t)b * LL + n) * 512 + h * 128 + sl0 * 16 + fr; _Pragma("unroll") for (int nn = 0; nn < NN; ++nn) op[16 * nn] = f2bf(ao[m][nn][rg]); } }
    }
#undef SCAN_SRC
#undef SCAN_LOAD
#undef SCAN_WRITE
    if (t1 < NSTEP && cw_) {
#pragma unroll
        for (int t = 0; t < 8; ++t)
#pragma unroll
            for (int nn = 0; nn < NN; ++nn) SS[((size_t)(bhd * 8 + sl0 + nn) * 8 + t) * 64 + lane] = S[t][nn]; }
    asm volatile("s_waitcnt vmcnt(0)" ::: "memory");
    __syncthreads();
}

__device__ void dn_out(const Params& P, int l) {
    const int tid_ = ltid(); const int wave = __builtin_amdgcn_readfirstlane(tid_ >> 6), lane = tid_ & 63;
    const bf16_t* OO = (const bf16_t*)(P.ws + O_O); const bf16_t* Z = (const bf16_t*)(P.ws + O_Z); bf16_t* DNO = (bf16_t*)(P.ws + O_BR) + (size_t)2 * TP * 512;
    const float* nw = P.in[12] + (size_t)l * 128; float g[8];
#pragma unroll
    for (int e = 0; e < 8; ++e) g[e] = nw[(lane & 15) * 8 + e];
    for (int r = lbid() * 8 + wave; r < TT; r += lgrid() * 8) {
        float a[8], bq[8], z[8]; unpack8(*(const u32x4*)(OO + (size_t)r * 512 + lane * 8), a); unpack8(*(const u32x4*)(OO + ((size_t)TP + r) * 512 + lane * 8), bq); unpack8(*(const u32x4*)(Z + (size_t)r * 512 + lane * 8), z);
        float ss = 0.f;
#pragma unroll
        for (int e = 0; e < 8; ++e) { a[e] += bq[e]; ss += a[e] * a[e]; }
        ss += __shfl_xor(ss, 1); ss += __shfl_xor(ss, 2); ss += __shfl_xor(ss, 4); ss += __shfl_xor(ss, 8);
        const float inv = rsqrtf(ss * (1.0f / 128.0f) + EPS);
#pragma unroll
        for (int e = 0; e < 8; ++e) a[e] = a[e] * inv * g[e] * siluf_(z[e]);
        *(u32x4*)(DNO + (size_t)r * 512 + lane * 8) = pack8(a);
    }
}


#define XB_TMO      128
#define XB_XCNT(j)  (256  + 64 * (j))
#define XB_XSUB(j)  (1280 + 64 * (j))
#define XB_XGEN(j)  (2304 + 64 * (j))
#define XB_TOP      3328
#define XB_TOPGEN   3392
#define XCD_BAR_WORDS 3456
#define XB_SPIN_CAP (1u << 22)
__device__ __forceinline__ unsigned xb_ld(unsigned* p)              { return __hip_atomic_load(p, __ATOMIC_RELAXED, __HIP_MEMORY_SCOPE_AGENT); }
__device__ __forceinline__ unsigned xb_add(unsigned* p, unsigned v) { return __hip_atomic_fetch_add(p, v, __ATOMIC_RELAXED, __HIP_MEMORY_SCOPE_AGENT); }
__device__ __forceinline__ unsigned xb_xcc_id() { return (unsigned)__builtin_amdgcn_s_getreg((3 << 11) | 20) & 0xFu; }
#define XB_SPIN(cond, bar) do { unsigned _sp = 0; while (cond) { __builtin_amdgcn_s_sleep(1); \
    if ((++_sp & 255u) == 0u) { if (xb_ld(&(bar)[XB_TMO])) break; if (_sp > XB_SPIN_CAP) { atomicAdd(&(bar)[XB_TMO], 1u); break; } } } } while (0)
struct XcdBarrier { unsigned* bar; unsigned x; volatile LAS unsigned* st; };
__device__ __forceinline__ XcdBarrier xcd_barrier_post(unsigned* bar, volatile LAS unsigned* st) {
    XcdBarrier b; b.bar = bar; b.x = xb_xcc_id(); b.st = st;
    if (threadIdx.x == 0) (void)xb_add(&bar[XB_XCNT(b.x)], 1u);
    return b;
}
__device__ __forceinline__ void xcd_barrier_complete(unsigned* bar, unsigned x, unsigned& nloc, unsigned& nx) {
    const unsigned G = gridDim.x * gridDim.y * gridDim.z;
    unsigned sum, cnt, mine, sp = 0u;
    for (;;) {
        sum = 0u; cnt = 0u; mine = 0u;
#pragma unroll
        for (unsigned j = 0; j < 16; ++j) { const unsigned c = xb_ld(&bar[XB_XCNT(j)]); sum += c; cnt += (c > 0u) ? 1u : 0u; mine = (j == x) ? c : mine; }
        if (sum == G) break;
        __builtin_amdgcn_s_sleep(1);
        if ((++sp & 255u) == 0u) { if (xb_ld(&bar[XB_TMO])) break; if (sp > XB_SPIN_CAP) { atomicAdd(&bar[XB_TMO], 1u); break; } }
    }
    nloc = mine > 0u ? mine : 1u; nx = cnt > 0u ? cnt : 1u;
}
__device__ __forceinline__ void xcd_barrier(const XcdBarrier& b) {
    asm volatile("s_waitcnt vmcnt(0)" ::: "memory");
    __syncthreads();
    if (threadIdx.x == 0) {
        unsigned* bar = b.bar;
        __builtin_amdgcn_s_waitcnt(0);
        unsigned nloc = b.st[0], nx = b.st[1];
        if (nloc == 0u) { xcd_barrier_complete(bar, b.x, nloc, nx); b.st[0] = nloc; b.st[1] = nx; }
        const unsigned old = xb_add(&bar[XB_XSUB(b.x)], 1u);
        const unsigned gen = old / nloc;
        if (old + 1u == (gen + 1u) * nloc) {
            __builtin_amdgcn_fence(__ATOMIC_RELEASE, "agent");
            asm volatile("s_waitcnt vmcnt(0)" ::: "memory");
            const unsigned og = xb_add(&bar[XB_TOP], 1u);
            const unsigned tg = og / nx;
            if (og + 1u == (tg + 1u) * nx) xb_add(&bar[XB_TOPGEN], 1u);
            else XB_SPIN(xb_ld(&bar[XB_TOPGEN]) == tg, bar);
            __builtin_amdgcn_fence(__ATOMIC_ACQUIRE, "agent");
            xb_add(&bar[XB_XGEN(b.x)], 1u);
            asm volatile("s_waitcnt vmcnt(0)" ::: "memory");
        } else {
            XB_SPIN(xb_ld(&bar[XB_XGEN(b.x)]) == gen, bar);
            __builtin_amdgcn_fence(__ATOMIC_ACQUIRE, "agent");
            asm volatile("s_waitcnt vmcnt(0)" ::: "memory");
        }
    }
    __syncthreads();
}
__device__ __forceinline__ int phase_cat(int ph) { const int p = ph % 22;
    return p == 0 ? 0 : (p == 1 || p == 2 || p == 19 || p == 20) ? 1 : (p == 3 || p == 18 || p == 21) ? 2 : p == 4 ? 3 : p == 5 ? 4 : p == 6 ? 5 : p == 7 ? 6 : (p == 8 || p == 10 || p == 12) ? 7 : (p == 9 || p == 11 || p == 13) ? 8 : p == 14 ? 9 : 10; }
#ifndef SKIP_GEMM
#define GEMM_CALL(a,b,c,d) pg8::gemm_phase(a,b,c,d)
#else
#define GEMM_CALL(a,b,c,d) (void)0
#endif
__global__ void __launch_bounds__(512, 2) fwd_kernel(Params P) {
    extern __shared__ __attribute__((aligned(16))) unsigned char smem[];
    cg::grid_group grid = cg::this_grid();
    unsigned char* ws = P.ws;
    LAS unsigned char* lds = (LAS unsigned char*)smem;
    int ph = 0;
    { volatile LAS unsigned* stw = (volatile LAS unsigned*)(lds + LDS_BYTES - 32); if (threadIdx.x < 8) stw[threadIdx.x] = 0u; }
    __syncthreads();
    XcdBarrier xbar = xcd_barrier_post((unsigned*)(ws + S_BAR), (volatile LAS unsigned*)(lds + LDS_BYTES - 16));
#ifdef DBG_CAT
    unsigned long long t_prev = __builtin_amdgcn_s_memrealtime(), t_acc = 0ull;
#define STAMP() do { const unsigned long long _n = __builtin_amdgcn_s_memrealtime(); if (phase_cat(ph) == DBG_CAT) t_acc += _n - t_prev; t_prev = _n; } while (0)
#else
#define STAMP() do {} while (0)
#endif
#define PHASE_BEGIN if (ph >= P.ph_lo && ph < P.ph_hi) { const int G = lgrid(), bx = lbid(); (void)G; (void)bx;
#define PHASE_END   if (ph + 1 < P.ph_hi) { if (ph == 0) { asm volatile("s_waitcnt vmcnt(0) lgkmcnt(0)" ::: "memory"); grid.sync(); __builtin_amdgcn_fence(__ATOMIC_ACQUIRE, "agent"); asm volatile("s_waitcnt vmcnt(0)" ::: "memory"); __syncthreads(); } else xcd_barrier(xbar); } STAMP(); } ++ph;
    for (ph = P.ph_lo; ph < P.ph_hi; ++ph) {
        const int l = ph / 22, p = ph - l * 22;
        const int G = lgrid(), bx = lbid();
        bf16_t* XN = (bf16_t*)(ws + O_XN); bf16_t* Y = (bf16_t*)(ws + O_Y); bf16_t* ACT = (bf16_t*)(ws + O_ACT);
        const float* ng = P.in[2] + (size_t)l * 6 * 1024;
        switch (p) {
        case 0:
#ifndef SKIP_CVT
            convert_weights(P, l, smem);
#endif
            if (l == 0) { gen_tables(P); rpass(P, nullptr, true, nullptr, 0.f, ng, XN); }
            break;
        case 1: case 19: { pg8::Gemm g{XN, (const bf16_t*)(ws + (p == 1 ? W_WI1 : W_WI2)), TP, 5632, 1024, 128, 1024}; pg8::StaticOrder S; S.init(TP, 5632, G, bx); pg8::EpiSwiglu E{ACT}; GEMM_CALL(lds, g, S, E); } break;
        case 2: case 20: case 17: {
            const bool dn = (p != 17); const int Kx = dn ? 2816 : 1024, nS = dn ? 11 : 4;
            const bf16_t* W = (const bf16_t*)(ws + (p == 2 ? W_WO1 : p == 20 ? W_WO2 : W_WOUT)); const bf16_t* Ax = dn ? ACT : (const bf16_t*)(ws + O_MG);
            { pg8::Gemm g{Ax, W, TP, 1024, Kx, 128, Kx}; pg8::StaticOrder S; S.init(TP, 1024, G, bx, false); pg8::EpiBf16<0> E{Y, 1024}; GEMM_CALL(lds, g, S, E); }
            { pg8::Gemm g{W, Ax + (size_t)32768 * Kx, 1024, 256, Kx, -1, 256}; pg8::TailOrder S{nS, bx}; pg8::EpiSlab E{(float*)(ws + O_SLAB), nS}; GEMM_CALL(lds, g, S, E); } } break;
        case 3: rpass(P, Y, l == 0, ng + 1024, 0.5f, ng + 2048, XN, (const float*)(ws + O_SLAB), 11); break;
        case 4: { pg8::Gemm g{XN, (const bf16_t*)(ws + W_WIN), TP, NPROJ, 1024, 128, 1024}; pg8::StaticOrder S; S.init(TP, NPROJ, G, bx); pg8::EpiInProj E{ws}; GEMM_CALL(lds, g, S, E); } break;
        case 5: sconv_pass(P, l); break;
        case 6:
#ifndef SKIP_F1
            fstep1(P, smem);
#endif
            break;
        case 7: { pg8::Gemm g{(const bf16_t*)(ws + S_C257), (const bf16_t*)(ws + O_AP), 512, 65536, KF, 1, KF}; pg8::StaticOrder S; S.init(512, 65536, G, bx);
                  pg8::EpiFourier E{(bf16_t*)(ws + O_BR), 0.001949317738791423f  }; GEMM_CALL(lds, g, S, E); } break;
        case 8: case 10: case 12: { const int t0 = ((p - 8) >> 1) * SPL, t1 = (t0 + SPL < NSTEP) ? t0 + SPL : NSTEP;
#ifndef SKIP_PREP
            dn_prep(P, l, smem, t0, t1);
#endif
            } break;
        case 9: case 11: case 13: { const int t0 = ((p - 9) >> 1) * SPL, t1 = (t0 + SPL < NSTEP) ? t0 + SPL : NSTEP;
#ifndef SKIP_SCAN
            dn_scan(P, smem, t0, t1);
#endif
            } break;
        case 14: dn_out(P, l); rpass(P, nullptr, false, nullptr, 0.f, ng + 2048, (bf16_t*)(ws + O_XN2)); break;
        case 15: { pg8::Gemm g{(const bf16_t*)(ws + O_XN2), (const bf16_t*)(ws + W_WG), TP, 3072, 1024, 128, 1024}; pg8::StaticOrder S; S.init(TP, 3072, G, bx); pg8::EpiBf16<1> E{(bf16_t*)(ws + O_GATE), 3072}; GEMM_CALL(lds, g, S, E); } break;
        case 16: { pg8::Gemm g{(const bf16_t*)(ws + O_BR), (const bf16_t*)(ws + W_WBR), 3 * TP, 3072, 512, -1, 512}; pg8::MergeOrder S{G, bx}; pg8::EpiMerge E{(const bf16_t*)(ws + O_GATE), (bf16_t*)(ws + O_MG), (bf16_t*)(ws + O_XN2)}; GEMM_CALL(lds, g, S, E); } break;
        case 18: rpass(P, Y, false, ng + 3 * 1024, 1.0f, ng + 4 * 1024, XN, (const float*)(ws + O_SLAB), 4); break;
        default: rpass(P, Y, false, ng + 5 * 1024, 0.5f, l == 0 ? P.in[2] + (size_t)6 * 1024 : nullptr, XN, (const float*)(ws + O_SLAB), 11); break;
        }
        if (ph + 1 < P.ph_hi) {
            if (P.ph_lo < 0) grid.sync();
            xcd_barrier(xbar);
        }
        STAMP();
    }
#ifdef DBG_CAT
    if (lbid() == 0 && threadIdx.x == 0) { const unsigned long long t0 = __builtin_amdgcn_s_memrealtime(); while (__builtin_amdgcn_s_memrealtime() - t0 < t_acc + *(unsigned long long*)(smem + LDS_BYTES - 32)) __builtin_amdgcn_s_sleep(16); }
#endif
#ifdef DBG_FLUSH
    { asm volatile("s_waitcnt vmcnt(0) lgkmcnt(0)" ::: "memory"); grid.sync(); __builtin_amdgcn_fence(__ATOMIC_ACQUIRE, "agent"); asm volatile("s_waitcnt vmcnt(0)" ::: "memory");
      const f32x4* xs = (const f32x4*)P.in[0]; f32x4 a = {0.f, 0.f, 0.f, 0.f};
      for (size_t i = ltid(); i < (size_t)8388608; i += 512) a += xs[i];
      if (a[0] + a[1] + a[2] + a[3] == 1.2345e-30f) ((float*)(ws + S_GL))[4000] = 1.f; }
#endif
#ifdef DBG_OFF
    { asm volatile("s_waitcnt vmcnt(0) lgkmcnt(0)" ::: "memory"); grid.sync(); __builtin_amdgcn_fence(__ATOMIC_ACQUIRE, "agent"); asm volatile("s_waitcnt vmcnt(0)" ::: "memory");
      const bf16_t* src = (const bf16_t*)(ws + DBG_OFF);
      for (size_t i = (size_t)lbid() * 512 + ltid(); i < (size_t)33554432; i += (size_t)lgrid() * 512) P.out[i] = i < (size_t)DBG_CNT ? bf2f(src[i]) : 0.f; }
#endif
}

extern "C" void kernel_launch(void* const* d_in, const int* in_sizes, int n_in, void* d_out, int out_size, void* d_ws, size_t ws_size, hipStream_t stream) {
    static int grid = 0;
    if (grid == 0) {
        int dev = 0, cus = 0, per_cu = 0;
        hipGetDevice(&dev); hipDeviceGetAttribute(&cus, hipDeviceAttributeMultiprocessorCount, dev);
        hipFuncSetAttribute((const void*)fwd_kernel, hipFuncAttributeMaxDynamicSharedMemorySize, LDS_BYTES);
        hipOccupancyMaxActiveBlocksPerMultiprocessor(&per_cu, (const void*)fwd_kernel, 512, LDS_BYTES);
        if (per_cu < 1) { fprintf(stderr, "occupancy query says %d blocks/CU\n", per_cu); per_cu = 1; }
        grid = cus;
        if (ws_size < WS_NEED) fprintf(stderr, "workspace too small: %zu < %zu\n", ws_size, (size_t)WS_NEED);
    }
    Params p{};
    for (int i = 0; i < 17; ++i) p.in[i] = (const float*)d_in[i];
    p.out = (float*)d_out; p.ws = (unsigned char*)d_ws; p.ph_lo = 0; p.ph_hi = 44;
#ifdef DBG_PHI
    p.ph_hi = DBG_PHI;
#endif
    hipMemsetAsync((char*)d_ws + S_BAR, 0, 16384, stream);
    void* args[] = {&p};
    hipError_t e = hipLaunchCooperativeKernel((const void*)fwd_kernel, dim3(grid), dim3(512), args, LDS_BYTES, stream);
    if (e != hipSuccess) fprintf(stderr, "cooperative launch failed: %s (grid %d)\n", hipGetErrorString(e), grid);
}
```

```cpp
#include <hip/hip_runtime.h>
#include <hip/hip_cooperative_groups.h>
#include <cstdio>
namespace cg = cooperative_groups;

#define LAS __attribute__((address_space(3)))
typedef unsigned short bf16_t;
typedef short bf16x8 __attribute__((ext_vector_type(8)));
typedef float f32x4 __attribute__((ext_vector_type(4)));
typedef unsigned u32x4 __attribute__((ext_vector_type(4)));
typedef unsigned u32x2 __attribute__((ext_vector_type(2)));

constexpr int DM = 1024, NB = 8, SEQ = 4096, NMETA = 16, LL = 4112, TT = NB * LL  , TP = 33024  , DFF = 2816;
constexpr int NIN = 7184;
constexpr int NPROJ = 4864;
constexpr float EPS = 1e-6f;
constexpr int NSTEP = 65, SPL = 24, NSPLIT = 3;
constexpr int KF = 640;

constexpr size_t UU = (size_t)TP * 1024;
constexpr size_t W_WI1 = 0, W_WO1 = W_WI1 + (size_t)5632 * 1024 * 2, W_WI2 = W_WO1 + (size_t)1024 * 2816 * 2, W_WO2 = W_WI2 + (size_t)5632 * 1024 * 2,
                 W_WIN = W_WO2 + (size_t)1024 * 2816 * 2, W_WG = W_WIN + (size_t)NPROJ * 1024 * 2, W_WBR = W_WG + (size_t)3072 * 1024 * 2,
                 W_WOUT = W_WBR + (size_t)3072 * 512 * 2, W_END = W_WOUT + (size_t)1024 * 1024 * 2;
constexpr size_t S_C257 = W_END, S_TWL = S_C257 + (size_t)512 * KF * 2, S_HM = S_TWL + 33024, S_LOGIT = S_HM + (size_t)128 * 1024 * 4,
                 S_GL = S_LOGIT + (size_t)TP * 16 * 4, S_SSAVE = S_GL + 16896, S_BAR = S_SSAVE + (size_t)512 * 8 * 64 * 16, S_END = S_BAR + 16384;
constexpr size_t A0 = (S_END + 255) / 256 * 256;
constexpr size_t O_XN = A0, O_Y = A0 + 2 * UU, O_ACT = A0 + 4 * UU;
constexpr size_t O_BR = A0, O_QKV = A0 + 4 * UU, O_Z = A0 + 7 * UU, O_SC = A0 + 8 * UU, O_PQ = A0 + 11 * UU, O_AP = A0 + 8 * UU;
constexpr size_t DNI_SLOTS = (size_t)SPL * 64;
constexpr size_t O_WP = A0 + 8 * UU, O_QP = O_WP + DNI_SLOTS * 16384, O_KD = O_QP + DNI_SLOTS * 16384, O_UF = O_KD + DNI_SLOTS * 16384,
                 O_AT = O_UF + DNI_SLOTS * 16384, O_DNI_END = O_AT + DNI_SLOTS * 8192;
constexpr size_t O_O = (O_DNI_END + 255) / 256 * 256;
constexpr size_t O_XN2 = A0 + 3 * UU, O_GATE = A0 + 5 * UU, O_MG = A0 + 11 * UU;
constexpr size_t O_SLAB = (O_O + 2 * UU + 255) / 256 * 256;
constexpr size_t WS_NEED = O_SLAB + (size_t)44 * 65536 * 4;
static_assert(WS_NEED <= (size_t)536870912, "workspace");
static_assert(O_AP + (size_t)65536 * KF * 2 <= O_PQ, "A' overlaps PQ");
static_assert(O_O >= O_PQ || true, "");
static_assert(O_MG + 2 * UU <= WS_NEED + 2 * UU, "");

constexpr int LDS_BYTES = 132 * 1024;

#define DBG_CNT ((size_t)33554432)


struct Params { const float* in[17]; float* out; unsigned char* ws; int ph_lo, ph_hi; };

__device__ __forceinline__ float bf2f(unsigned v) { return __uint_as_float(v << 16); }
typedef __bf16 bf16x2_t __attribute__((ext_vector_type(2)));
typedef float f32x2_t __attribute__((ext_vector_type(2)));
__device__ __forceinline__ unsigned cvt_pk_bf16(float lo, float hi) { f32x2_t v = {lo, hi}; bf16x2_t b = __builtin_convertvector(v, bf16x2_t); return __builtin_bit_cast(unsigned, b); }
__device__ __forceinline__ bf16_t f2bf(float f) { return (bf16_t)(cvt_pk_bf16(f, 0.f) & 0xffffu); }
__device__ __forceinline__ void unpack8(const u32x4 v, float* f) {
    f[0] = __uint_as_float(v.x << 16); f[1] = __uint_as_float(v.x & 0xffff0000u); f[2] = __uint_as_float(v.y << 16); f[3] = __uint_as_float(v.y & 0xffff0000u);
    f[4] = __uint_as_float(v.z << 16); f[5] = __uint_as_float(v.z & 0xffff0000u); f[6] = __uint_as_float(v.w << 16); f[7] = __uint_as_float(v.w & 0xffff0000u); }
__device__ __forceinline__ u32x4 pack8(const float* f) { u32x4 w; w.x = cvt_pk_bf16(f[0], f[1]); w.y = cvt_pk_bf16(f[2], f[3]); w.z = cvt_pk_bf16(f[4], f[5]); w.w = cvt_pk_bf16(f[6], f[7]); return w; }
__device__ __forceinline__ int ltid() { int t = threadIdx.x; asm volatile("" : "+v"(t)); return t; }
__device__ __forceinline__ int lbid() { int t = blockIdx.x; asm volatile("" : "+s"(t)); return t; }
__device__ __forceinline__ int lgrid() { int t = gridDim.x; asm volatile("" : "+s"(t)); return t; }
__device__ __forceinline__ float wave_sum(float v) { for (int o = 32; o >= 1; o >>= 1) v += __shfl_xor(v, o); return v; }
__device__ __forceinline__ float sigmoidf_(float x) { return __builtin_amdgcn_rcpf(1.0f + __expf(-x)); }
__device__ __forceinline__ float siluf_(float x) { return x * __builtin_amdgcn_rcpf(1.0f + __expf(-x)); }

namespace pg8 {
constexpr int BM = 256, BK = 64, HALF = 128, HTB = HALF * BK * 2, STAGE_BYTES = 8 * HTB, NXCD = 8, WGM = 8;
__device__ __forceinline__ int lds_byte(int r, int c) { const int st = (r >> 4) * 2 + (c >> 5), rr = r & 15, cc = c & 31, ob = rr * 64 + cc * 2; return st * 1024 + (ob ^ (((ob >> 9) & 1) << 5)); }
__device__ __forceinline__ void stage_rc(int b, int& R, int& C) { const int st = b / 1024, sb = b % 1024, swz = sb ^ (((sb >> 9) & 1) << 5); R = (st >> 1) * 16 + swz / 64; C = (st & 1) * 32 + (swz % 64) / 2; }
__device__ __forceinline__ int perm32(int rho) { const int n = rho >> 4, i = rho & 15; return 8 * (i >> 2) + 4 * n + (i & 3); }
struct Unit { int pm, pn, ks; };
struct Gemm { const bf16_t* A; const bf16_t* Bt; int M, N, K; int half_pm; int KL; };
struct StaticOrder {
    int nM, nN, nwg, G, c, ntail;
    __device__ void init(int M, int N, int G_, int c_, bool tail = true) { nM = M / BM - 1; nN = N / BM; nwg = nM * nN; G = G_; c = c_; ntail = tail ? nN : 0; }
    __device__ bool next(int i, Unit& u) const {
        u.ks = 0;
        const long L = (long)i * G + c; if (L >= nwg + ntail) return false;
        if (L >= nwg) { u.pm = nM; u.pn = (int)(L - nwg); return true; }
        int wgid = (int)L; { const int q = nwg / NXCD, r = nwg % NXCD, xcd = wgid % NXCD, off = wgid / NXCD; wgid = (xcd < r ? xcd * (q + 1) : r * (q + 1) + (xcd - r) * q) + off; }
        const int nig = WGM * nN, gid = wgid / nig, fm = gid * WGM, gsz = (nM - fm) < WGM ? (nM - fm) : WGM;
        u.pm = fm + ((wgid % nig) % gsz); u.pn = (wgid % nig) / gsz; return true;
    }
};
struct MergeOrder {
    int G, c;
    __device__ bool next(int i, Unit& u) const { const int L = (i / 3) * G + c; if (L >= 129 * 4) return false; const int j = i % 3; u.pm = j * 129 + (L >> 2); u.pn = j * 4 + (L & 3); u.ks = 0; return true; }
};

struct TailOrder { int nS, c;
    __device__ bool next(int i, Unit& u) const { if (i > 0 || c >= 4 * nS) return false; u.pm = c / nS; u.ks = c - u.pm * nS; u.pn = 0; return true; } };

template <class Epi, class Sched>
__device__ __forceinline__ void gemm_phase(LAS unsigned char* lds, const Gemm g, const Sched& S, const Epi& E) {
    const int tid = ltid(), wid = __builtin_amdgcn_readfirstlane(tid >> 6), lane = tid & 63, wr = wid >> 2, wc = wid & 3, fr = lane & 15, fq = lane >> 4;
    const int K = g.K, nt = g.KL / BK;
    unsigned voffA, voffB;
    { int R, C; stage_rc(tid * 16, R, C); const int Rb = Epi::PERM ? ((R & ~31) + perm32(R & 31)) : R;
        voffA = (unsigned)(R * K + C) * 2u; voffB = (unsigned)(Rb * K + C) * 2u; }
    const size_t r64 = (size_t)64 * K * 2;
    const size_t kstep = (size_t)(BK * 2);
    const size_t hstep = (size_t)HALF * K * 2;
    const size_t tstep = 2 * hstep;
    const unsigned ldsw = (unsigned)wid * 1024u;
    const int aoff = lds_byte(wr * 64 + fr, fq * 8), boff = lds_byte(wc * 32 + fr, fq * 8);
#define PG8_SA(b, h) (((b) * 2 + (h)) * HTB)
#define PG8_SB(b, h) ((4 + (b) * 2 + (h)) * HTB)
#define PG8_STAGE(bufoff, gbase, voff) do { _Pragma("unroll") for (int _i = 0; _i < 2; ++_i) \
        __builtin_amdgcn_global_load_lds((const unsigned*)((const char*)(gbase) + _i * r64 + (voff)), (LAS unsigned*)(lds + (bufoff) + ldsw + _i * 8192), 16, 0, 0); } while (0)
#define PG8_LDA(dst, b, h) do { _Pragma("unroll") for (int m = 0; m < 4; ++m) _Pragma("unroll") for (int k = 0; k < 2; ++k) dst[m][k] = *(const LAS bf16x8*)(lds + PG8_SA(b, h) + aoff + m * 2048 + k * 1024); } while (0)
#define PG8_LDB(dst, b, h) do { _Pragma("unroll") for (int n = 0; n < 2; ++n) _Pragma("unroll") for (int k = 0; k < 2; ++k) dst[n][k] = *(const LAS bf16x8*)(lds + PG8_SB(b, h) + boff + n * 2048 + k * 1024); } while (0)
#define PG8_MMA(ai, bj, At, Bt) do { __builtin_amdgcn_s_setprio(1); _Pragma("unroll") for (int m = 0; m < 4; ++m) _Pragma("unroll") for (int n = 0; n < 2; ++n) _Pragma("unroll") for (int k = 0; k < 2; ++k) \
        acc[ai][bj][m][n] = __builtin_amdgcn_mfma_f32_16x16x32_bf16(Bt[n][k], At[m][k], acc[ai][bj][m][n], 0, 0, 0); __builtin_amdgcn_s_setprio(0); } while (0)
#define PG8_WAIT_V(n) asm volatile("s_waitcnt vmcnt(" #n ")" ::: "memory")
#define PG8_WAIT_L(n) asm volatile("s_waitcnt lgkmcnt(" #n ")" ::: "memory")
#define PG8_BAR __builtin_amdgcn_s_barrier()
#define PG8_SCHED __builtin_amdgcn_sched_barrier(0)
    Unit cur, nxt; int ui = 0;
    if (!S.next(0, cur)) return;
    f32x4 acc[2][2][4][2];
#pragma unroll
    for (int a = 0; a < 2; ++a)
#pragma unroll
        for (int b = 0; b < 2; ++b)
#pragma unroll
            for (int m = 0; m < 4; ++m)
#pragma unroll
                for (int n = 0; n < 2; ++n) acc[a][b][m][n] = (f32x4){0.f, 0.f, 0.f, 0.f};
    bf16x8 At[4][2], B0[2][2], B1[2][2];
    const char* cA = (const char*)g.A + (size_t)cur.pm * tstep + (size_t)cur.ks * g.KL * 2; const char* cB = (const char*)g.Bt + (size_t)cur.pn * tstep + (size_t)cur.ks * g.KL * 2;
    PG8_STAGE(PG8_SB(0, 0), cB, voffB); PG8_STAGE(PG8_SB(0, 1), cB + hstep, voffB); PG8_STAGE(PG8_SA(0, 0), cA, voffA); PG8_STAGE(PG8_SA(0, 1), cA + hstep, voffA);
    if (wr == 1) PG8_BAR;
    PG8_WAIT_V(2); PG8_BAR;
    PG8_STAGE(PG8_SB(1, 0), cB + kstep, voffB); PG8_STAGE(PG8_SA(1, 0), cA + kstep, voffA); PG8_STAGE(PG8_SB(1, 1), cB + hstep + kstep, voffB);
    PG8_WAIT_V(6); PG8_BAR;
    for (;;) {
        const bool has_next = S.next(ui + 1, nxt);
        const char* nA = has_next ? (const char*)g.A + (size_t)nxt.pm * tstep + (size_t)nxt.ks * g.KL * 2 : cA; const char* nB = has_next ? (const char*)g.Bt + (size_t)nxt.pn * tstep + (size_t)nxt.ks * g.KL * 2 : cB;
        for (int t = 0; t < nt; t += 2) {
            const bool last = (t == nt - 2);
            const char* a1 = cA + (size_t)(t + 1) * kstep;
            const char* a2 = last ? nA : cA + (size_t)(t + 2) * kstep; const char* b2 = last ? nB : cB + (size_t)(t + 2) * kstep;
            const char* a3 = a2 + kstep; const char* b3 = b2 + kstep;
            PG8_LDB(B0, 0, 0); PG8_LDB(B1, 0, 1); PG8_SCHED; PG8_LDA(At, 0, 0); PG8_STAGE(PG8_SA(1, 1), a1 + hstep, voffA);
            PG8_WAIT_V(8); PG8_WAIT_L(0); PG8_BAR; PG8_MMA(0, 0, At, B0); PG8_MMA(0, 1, At, B1); PG8_BAR; PG8_SCHED;
            PG8_LDA(At, 0, 1); PG8_STAGE(PG8_SB(0, 0), b2, voffB); PG8_STAGE(PG8_SB(0, 1), b2 + hstep, voffB); PG8_STAGE(PG8_SA(0, 0), a2, voffA);
            PG8_WAIT_V(8); PG8_WAIT_L(0); PG8_BAR; PG8_MMA(1, 0, At, B0); PG8_MMA(1, 1, At, B1); PG8_BAR; PG8_SCHED;
            PG8_LDB(B0, 1, 0); PG8_LDB(B1, 1, 1); PG8_SCHED; PG8_LDA(At, 1, 0); PG8_STAGE(PG8_SA(0, 1), a2 + hstep, voffA);
            PG8_WAIT_V(8); PG8_WAIT_L(0); PG8_BAR; PG8_MMA(0, 0, At, B0); PG8_MMA(0, 1, At, B1); PG8_BAR; PG8_SCHED;
            PG8_LDA(At, 1, 1); PG8_STAGE(PG8_SB(1, 0), b3, voffB); PG8_STAGE(PG8_SB(1, 1), b3 + hstep, voffB); PG8_STAGE(PG8_SA(1, 0), a3, voffA);
            PG8_WAIT_V(8); PG8_WAIT_L(0); PG8_BAR; PG8_MMA(1, 0, At, B0); PG8_MMA(1, 1, At, B1); PG8_BAR; PG8_SCHED;
        }
        if (wr == 0) PG8_BAR;
        E(acc, cur, wr, wc, fr, fq);
        if (!has_next) break;
#pragma unroll
        for (int a = 0; a < 2; ++a)
#pragma unroll
            for (int b = 0; b < 2; ++b)
#pragma unroll
                for (int m = 0; m < 4; ++m)
#pragma unroll
                    for (int n = 0; n < 2; ++n) acc[a][b][m][n] = (f32x4){0.f, 0.f, 0.f, 0.f};
        cur = nxt; cA = nA; cB = nB; ++ui;
        if (wr == 1) PG8_BAR;
    }
    PG8_WAIT_V(0);
    PG8_BAR;
#undef PG8_SA
#undef PG8_SB
#undef PG8_STAGE
#undef PG8_LDA
#undef PG8_LDB
#undef PG8_MMA
#undef PG8_WAIT_V
#undef PG8_WAIT_L
#undef PG8_BAR
#undef PG8_SCHED
}

template <int ACT> struct EpiBf16 {
    static constexpr bool PERM = true;
    bf16_t* O; int ldc;
    __device__ __forceinline__ void operator()(const f32x4 (&acc)[2][2][4][2], const Unit& u, int wr, int wc, int fr, int fq) const {
        const int row0 = u.pm * BM + wr * 64 + fr, col0 = u.pn * BM + wc * 32 + 8 * fq;
#pragma unroll
        for (int ai = 0; ai < 2; ++ai)
#pragma unroll
            for (int m = 0; m < 4; ++m) { bf16_t* rowp = O + (size_t)(row0 + ai * HALF + m * 16) * ldc + col0;
#pragma unroll
                for (int bj = 0; bj < 2; ++bj) { f32x4 v0 = acc[ai][bj][m][0], v1 = acc[ai][bj][m][1];
                    if (ACT == 1) {
#pragma unroll
                        for (int j = 0; j < 4; ++j) { v0[j] = sigmoidf_(v0[j]); v1[j] = sigmoidf_(v1[j]); } }
                    u32x4 w; w.x = cvt_pk_bf16(v0[0], v0[1]); w.y = cvt_pk_bf16(v0[2], v0[3]); w.z = cvt_pk_bf16(v1[0], v1[1]); w.w = cvt_pk_bf16(v1[2], v1[3]);
                    *(u32x4*)(rowp + bj * HALF) = w; } }
    }
};
struct EpiSlab {
    static constexpr bool PERM = true;
    float* slab; int nS;
    __device__ __forceinline__ void operator()(const f32x4 (&acc)[2][2][4][2], const Unit& u, int wr, int wc, int fr, int fq) const {
        float* sp = slab + ((size_t)u.ks * 128 + wc * 32 + 8 * fq) * 1024 + u.pm * 256 + wr * 64 + fr;
#pragma unroll
        for (int ai = 0; ai < 2; ++ai)
#pragma unroll
            for (int m = 0; m < 4; ++m) { float* rp = sp + ai * HALF + m * 16;
#pragma unroll
                for (int n = 0; n < 2; ++n)
#pragma unroll
                    for (int j = 0; j < 4; ++j) rp[(size_t)(4 * n + j) * 1024] = acc[ai][0][m][n][j]; }
    }
};
struct EpiSwiglu {
    static constexpr bool PERM = true;
    bf16_t* O;
    __device__ __forceinline__ void operator()(const f32x4 (&acc)[2][2][4][2], const Unit& u, int wr, int wc, int fr, int fq) const {
        const int row0 = u.pm * BM + wr * 64 + fr, col0 = u.pn * 128 + wc * 32 + 8 * fq;
#pragma unroll
        for (int ai = 0; ai < 2; ++ai)
#pragma unroll
            for (int m = 0; m < 4; ++m) { bf16_t* rowp = O + (size_t)(row0 + ai * HALF + m * 16) * DFF + col0;
                const f32x4 a0 = acc[ai][0][m][0], a1 = acc[ai][0][m][1], b0 = acc[ai][1][m][0], b1 = acc[ai][1][m][1];
                float v[8];
#pragma unroll
                for (int j = 0; j < 4; ++j) { v[j] = siluf_(a0[j]) * b0[j]; v[4 + j] = siluf_(a1[j]) * b1[j]; }
                *(u32x4*)rowp = pack8(v); }
    }
};
struct EpiInProj {
    static constexpr bool PERM = true;
    unsigned char* ws;
    __device__ __forceinline__ void operator()(const f32x4 (&acc)[2][2][4][2], const Unit& u, int wr, int wc, int fr, int fq) const {
        const int row0 = u.pm * BM + wr * 64 + fr, pn = u.pn;
        if (pn == 18) {
            if (wc == 0 && fq < 2) { float* Lg = (float*)(ws + S_LOGIT);
#pragma unroll
                for (int ai = 0; ai < 2; ++ai)
#pragma unroll
                    for (int m = 0; m < 4; ++m) { float* rp = Lg + (size_t)(row0 + ai * HALF + m * 16) * 16 + 8 * fq; *(f32x4*)rp = acc[ai][0][m][0]; *(f32x4*)(rp + 4) = acc[ai][0][m][1]; } }
            return; }
        bf16_t* base; int ld, cb;
        if (pn < 4) { base = (bf16_t*)(ws + O_PQ); ld = 1024; cb = pn * 256; }
        else if (pn < 10) { base = (bf16_t*)(ws + O_SC); ld = 1536; cb = (pn - 4) * 256; }
        else if (pn < 16) { base = (bf16_t*)(ws + O_QKV); ld = 1536; cb = (pn - 10) * 256; }
        else { base = (bf16_t*)(ws + O_Z); ld = 512; cb = (pn - 16) * 256; }
        const int col0 = cb + wc * 32 + 8 * fq;
#pragma unroll
        for (int ai = 0; ai < 2; ++ai)
#pragma unroll
            for (int m = 0; m < 4; ++m) { bf16_t* rowp = base + (size_t)(row0 + ai * HALF + m * 16) * ld + col0;
#pragma unroll
                for (int bj = 0; bj < 2; ++bj) { const f32x4 v0 = acc[ai][bj][m][0], v1 = acc[ai][bj][m][1];
                    u32x4 w; w.x = cvt_pk_bf16(v0[0], v0[1]); w.y = cvt_pk_bf16(v0[2], v0[3]); w.z = cvt_pk_bf16(v1[0], v1[1]); w.w = cvt_pk_bf16(v1[2], v1[3]);
                    *(u32x4*)(rowp + bj * HALF) = w; } }
    }
};
struct EpiFourier {
    static constexpr bool PERM = true;
    bf16_t* FM; float sc;
    __device__ __forceinline__ void operator()(const f32x4 (&acc)[2][2][4][2], const Unit& u, int wr, int wc, int fr, int fq) const {
        const int row0 = u.pm * BM + wr * 64 + fr;
        const int colt = u.pn * BM;
        const int b = colt >> 13, k1 = (colt >> 9) & 15, ch0 = (colt & 511) + wc * 32 + 8 * fq;
#pragma unroll
        for (int ai = 0; ai < 2; ++ai)
#pragma unroll
            for (int m = 0; m < 4; ++m) { const int k2 = row0 + ai * HALF + m * 16;
                if (k2 < 257) { bf16_t* rowp = FM + (size_t)(b * LL + k1 + 16 * k2) * 512 + ch0;
#pragma unroll
                    for (int bj = 0; bj < 2; ++bj) { const f32x4 v0 = acc[ai][bj][m][0] * sc, v1 = acc[ai][bj][m][1] * sc;
                        u32x4 w; w.x = cvt_pk_bf16(v0[0], v0[1]); w.y = cvt_pk_bf16(v0[2], v0[3]); w.z = cvt_pk_bf16(v1[0], v1[1]); w.w = cvt_pk_bf16(v1[2], v1[3]);
                        *(u32x4*)(rowp + bj * HALF) = w; } } }
    }
};
struct EpiMerge {
    static constexpr bool PERM = true;
    const bf16_t* GATE; bf16_t* MG; bf16_t* MGB;
    __device__ __forceinline__ void operator()(const f32x4 (&acc)[2][2][4][2], const Unit& u, int wr, int wc, int fr, int fq) const {
        const int j = u.pm / 129, pm = u.pm - j * 129, pn = u.pn & 3;
        const int row0 = pm * BM + wr * 64 + fr, col0 = pn * BM + wc * 32 + 8 * fq;
        const bf16_t* mold = (j == 1 ? MG : MGB); bf16_t* mnew = (j == 1 ? MGB : MG);
#pragma unroll
        for (int ai = 0; ai < 2; ++ai) {
            u32x4 gv[4][2], ov[4][2];
#pragma unroll
            for (int m = 0; m < 4; ++m)
#pragma unroll
                for (int bj = 0; bj < 2; ++bj) { const size_t r = (size_t)(row0 + ai * HALF + m * 16);
                    gv[m][bj] = *(const u32x4*)(GATE + r * 3072 + j * 1024 + col0 + bj * HALF);
                    if (j > 0) ov[m][bj] = *(const u32x4*)(mold + r * 1024 + col0 + bj * HALF); }
#pragma unroll
            for (int m = 0; m < 4; ++m)
#pragma unroll
                for (int bj = 0; bj < 2; ++bj) { const size_t r = (size_t)(row0 + ai * HALF + m * 16);
                    float g[8], v[8]; unpack8(gv[m][bj], g);
                    const f32x4 v0 = acc[ai][bj][m][0], v1 = acc[ai][bj][m][1];
#pragma unroll
                    for (int e = 0; e < 4; ++e) { v[e] = v0[e] * g[e]; v[4 + e] = v1[e] * g[4 + e]; }
                    if (j > 0) { float o[8]; unpack8(ov[m][bj], o);
#pragma unroll
                        for (int e = 0; e < 8; ++e) v[e] += o[e]; }
                    *(u32x4*)(mnew + r * 1024 + col0 + bj * HALF) = pack8(v); }
            asm volatile("" ::: "memory"); }
    }
};
}

__device__ void rpass(const Params& P, const bf16_t* Y, bool first_h, const float* gpost, float scale, const float* gpre, bf16_t* XN, const float* slab = nullptr, int nS = 0) {
    const int tid_ = ltid(); const int wave = __builtin_amdgcn_readfirstlane(tid_ >> 6), lane = tid_ & 63;
    float* hm = (float*)(P.ws + S_HM);
    for (int r = lbid() * 8 + wave; r < TT; r += lgrid() * 8) {
        const int b = r / LL, n = r - b * LL;
        const float* hin; float* hout;
        if (n < NMETA) { hout = hm + (size_t)(b * 16 + n) * 1024; hin = first_h ? P.in[1] + (size_t)n * 1024 : hout; }
        else { const size_t o = ((size_t)b * SEQ + (n - NMETA)) * 1024; hout = P.out + o; hin = first_h ? P.in[0] + o : hout; }
        float h[16];
        { const f32x4 a = *(const f32x4*)(hin + lane * 8), b4 = *(const f32x4*)(hin + lane * 8 + 4), c = *(const f32x4*)(hin + 512 + lane * 8), d = *(const f32x4*)(hin + 512 + lane * 8 + 4);
#pragma unroll
          for (int e = 0; e < 4; ++e) { h[e] = a[e]; h[4 + e] = b4[e]; h[8 + e] = c[e]; h[12 + e] = d[e]; } }
        if (Y) {
            float y[16];
            if (slab != nullptr && r >= 32768) {
                const float* sp = slab + (size_t)(r - 32768) * 1024 + lane * 8;
                f32x4 s0 = {0.f, 0.f, 0.f, 0.f}, s1 = s0, s2 = s0, s3 = s0;
#pragma unroll 1
                for (int ks = 0; ks < nS; ++ks) { s0 += *(const f32x4*)sp; s1 += *(const f32x4*)(sp + 4); s2 += *(const f32x4*)(sp + 512); s3 += *(const f32x4*)(sp + 516); sp += 131072; }
#pragma unroll
                for (int e = 0; e < 4; ++e) { y[e] = s0[e]; y[4 + e] = s1[e]; y[8 + e] = s2[e]; y[12 + e] = s3[e]; }
            } else { unpack8(*(const u32x4*)(Y + (size_t)r * 1024 + lane * 8), y); unpack8(*(const u32x4*)(Y + (size_t)r * 1024 + 512 + lane * 8), y + 8); }
            float ss = 0.f;
#pragma unroll
            for (int e = 0; e < 16; ++e) ss += y[e] * y[e];
            ss = wave_sum(ss); const float r1 = rsqrtf(ss * (1.0f / 1024.0f) + EPS) * scale;
#pragma unroll
            for (int e = 0; e < 8; ++e) { h[e] += y[e] * r1 * gpost[lane * 8 + e]; h[8 + e] += y[8 + e] * r1 * gpost[512 + lane * 8 + e]; }
            *(f32x4*)(hout + lane * 8) = (f32x4){h[0], h[1], h[2], h[3]}; *(f32x4*)(hout + lane * 8 + 4) = (f32x4){h[4], h[5], h[6], h[7]};
            *(f32x4*)(hout + 512 + lane * 8) = (f32x4){h[8], h[9], h[10], h[11]}; *(f32x4*)(hout + 512 + lane * 8 + 4) = (f32x4){h[12], h[13], h[14], h[15]};
        }
        if (gpre) {
            float ss = 0.f;
#pragma unroll
            for (int e = 0; e < 16; ++e) ss += h[e] * h[e];
            ss = wave_sum(ss); const float r2 = rsqrtf(ss * (1.0f / 1024.0f) + EPS);
            float o[16];
#pragma unroll
            for (int e = 0; e < 8; ++e) { o[e] = h[e] * r2 * gpre[lane * 8 + e]; o[8 + e] = h[8 + e] * r2 * gpre[512 + lane * 8 + e]; }
            *(u32x4*)(XN + (size_t)r * 1024 + lane * 8) = pack8(o); *(u32x4*)(XN + (size_t)r * 1024 + 512 + lane * 8) = pack8(o + 8);
        }
    }
}

template <class F>
__device__ void cvt_tiles(const float* src, int ld_src, int K, bf16_t* dst, int nrows, F srccol, unsigned char* smem) {
    float* lds = (float*)smem; const int tid = ltid();
    const int ntr = nrows / 64, ntk = K / 64, nt_ = ntr * ntk, G_ = lgrid();
    float pv[8];
    { const int t = lbid(); if (t < nt_) { const int tr = t % ntr, tk = t / ntr; const int c0 = srccol(tr * 64);
#pragma unroll
        for (int i = 0; i < 8; ++i) { const int kk = (tid >> 6) + 8 * i, cc = tid & 63; pv[i] = src[(size_t)(tk * 64 + kk) * ld_src + c0 + cc]; } } }
    for (int t = lbid(); t < nt_; t += G_) {
        const int tr = t % ntr, tk = t / ntr;
        __syncthreads();
#pragma unroll
        for (int i = 0; i < 8; ++i) { const int kk = (tid >> 6) + 8 * i, cc = tid & 63; lds[kk * 65 + cc] = pv[i]; }
        __syncthreads();
        { const int t2 = t + G_; if (t2 < nt_) { const int tr2 = t2 % ntr, tk2 = t2 / ntr; const int c2 = srccol(tr2 * 64);
#pragma unroll
            for (int i = 0; i < 8; ++i) { const int kk = (tid >> 6) + 8 * i, cc = tid & 63; pv[i] = src[(size_t)(tk2 * 64 + kk) * ld_src + c2 + cc]; } } }
        const int cc2 = tid >> 3, k8 = (tid & 7) * 8; float v[8];
#pragma unroll
        for (int e = 0; e < 8; ++e) v[e] = lds[(k8 + e) * 65 + cc2];
        *(u32x4*)(dst + (size_t)(tr * 64 + cc2) * K + tk * 64 + k8) = pack8(v);
    }
}
struct ColIdent { int off; __device__ int operator()(int r) const { return r + off; } };
struct ColSwiglu { __device__ int operator()(int r) const { const int pn = r >> 8, rem = r & 255; return (rem >> 7) * DFF + 128 * pn + (rem & 127); } };

__device__ void convert_weights(const Params& P, int l, unsigned char* smem) {
    unsigned char* ws = P.ws; const int tid = ltid();
    cvt_tiles(P.in[3] + (size_t)l * 1024 * 5632, 5632, 1024, (bf16_t*)(ws + W_WI1), 5632, ColSwiglu{}, smem);
    cvt_tiles(P.in[4] + (size_t)l * 2816 * 1024, 1024, 2816, (bf16_t*)(ws + W_WO1), 1024, ColIdent{0}, smem);
    cvt_tiles(P.in[5] + (size_t)l * 1024 * 5632, 5632, 1024, (bf16_t*)(ws + W_WI2), 5632, ColSwiglu{}, smem);
    cvt_tiles(P.in[6] + (size_t)l * 2816 * 1024, 1024, 2816, (bf16_t*)(ws + W_WO2), 1024, ColIdent{0}, smem);
    const float* win = P.in[7] + (size_t)l * 1024 * NIN;
    cvt_tiles(win, NIN, 1024, (bf16_t*)(ws + W_WIN) + (size_t)1024 * 1024, 3584, ColIdent{512}, smem);
    cvt_tiles(win, NIN, 1024, (bf16_t*)(ws + W_WG), 3072, ColIdent{4112}, smem);
    cvt_tiles(P.in[13] + (size_t)l * 512 * 1024, 1024, 512, (bf16_t*)(ws + W_WBR), 1024, ColIdent{0}, smem);
    cvt_tiles(P.in[14] + (size_t)l * 512 * 1024, 1024, 512, (bf16_t*)(ws + W_WBR) + (size_t)1024 * 512, 1024, ColIdent{0}, smem);
    cvt_tiles(P.in[15] + (size_t)l * 512 * 1024, 1024, 512, (bf16_t*)(ws + W_WBR) + (size_t)2048 * 512, 1024, ColIdent{0}, smem);
    cvt_tiles(P.in[16] + (size_t)l * 1024 * 1024, 1024, 1024, (bf16_t*)(ws + W_WOUT), 1024, ColIdent{0}, smem);
    { bf16_t* d = (bf16_t*)(ws + W_WIN) + (size_t)4608 * 1024;
      for (int i = lbid() * 512 + tid; i < 256 * 1024; i += lgrid() * 512) { const int rr = i >> 10, k = i & 1023; d[i] = rr < 16 ? f2bf(win[(size_t)k * NIN + 4096 + rr]) : (bf16_t)0; } }
    { float* Ws = (float*)smem; float* ct = Ws + 64 * 65; float* st = ct + 64;
      __syncthreads();
      if (tid < 64) { float s, c; sincospif((float)tid * (2.0f / 64.0f), &s, &c); ct[tid] = c; st[tid] = s; }
      bf16_t* dp = (bf16_t*)(ws + W_WIN); bf16_t* dq = dp + (size_t)512 * 1024;
      for (int it = lbid(); it < 8 * 16; it += lgrid()) { const int g = it >> 4, kt = it & 15;
          __syncthreads();
#pragma unroll
          for (int i = 0; i < 8; ++i) { const int kk = (tid >> 6) + 8 * i, cc = tid & 63; Ws[kk * 65 + cc] = win[(size_t)(kt * 64 + kk) * NIN + g * 64 + cc]; }
          __syncthreads();
          const int kk = tid & 63;
#pragma unroll 1
          for (int i = 0; i < 8; ++i) { const int cp = (tid >> 6) + 8 * i; float ap = 0.f, aq = 0.f;
#pragma unroll 4
              for (int c = 0; c < 64; ++c) { const float w = Ws[kk * 65 + c]; const int ph = (c * cp) & 63; ap += w * ct[ph]; aq += w * st[ph]; }
              dp[(size_t)(g * 64 + cp) * 1024 + kt * 64 + kk] = f2bf(ap); dq[(size_t)(g * 64 + cp) * 1024 + kt * 64 + kk] = f2bf(aq); }
      }
      __syncthreads(); }
}

__device__ void gen_tables(const Params& P) {
    unsigned char* ws = P.ws; const int gt = lbid() * 512 + ltid(), gs = lgrid() * 512;
    bf16_t* C = (bf16_t*)(ws + S_C257);
    for (int i = gt; i < 512 * KF; i += gs) { const int k2 = i / KF, kk = i - k2 * KF; const int ri = kk >= 320, n2 = kk - ri * 320; float v = 0.f;
        if (k2 < 257 && n2 < 257) { const int m = (k2 * n2) % 257; float s, c; sincospif((float)m * (2.0f / 257.0f), &s, &c); v = ri ? s : c; }
        C[i] = f2bf(v); }
    float* tw = (float*)(ws + S_TWL);
    for (int i = gt; i < LL; i += gs) { float s, c; sincospif((float)i * (2.0f / (float)LL), &s, &c); tw[2 * i] = c; tw[2 * i + 1] = -s; }
}

__device__ void sconv_pass(const Params& P, int l) {
    const int tid_ = ltid(); const int wave = __builtin_amdgcn_readfirstlane(tid_ >> 6), lane = tid_ & 63;
    const bf16_t* SC = (const bf16_t*)(P.ws + O_SC); bf16_t* SCO = (bf16_t*)(P.ws + O_BR) + (size_t)TP * 512;
    const float* w = P.in[8] + (size_t)l * 3 * 512;
    float w0[8], w1[8], w2[8];
#pragma unroll
    for (int e = 0; e < 8; ++e) { w0[e] = w[lane * 8 + e]; w1[e] = w[512 + lane * 8 + e]; w2[e] = w[1024 + lane * 8 + e]; }
    for (int r = lbid() * 8 + wave; r < TT; r += lgrid() * 8) {
        const int b = r / LL, n = r - b * LL; const bf16_t* rp = SC + (size_t)r * 1536 + lane * 8;
        float bb[8], c[8], h[8], acc[8]; unpack8(*(const u32x4*)rp, bb); unpack8(*(const u32x4*)(rp + 512), c); unpack8(*(const u32x4*)(rp + 1024), h);
#pragma unroll
        for (int e = 0; e < 8; ++e) acc[e] = w1[e] * c[e] * h[e];
        if (n > 0) { unpack8(*(const u32x4*)(rp - 1536 + 512), c); unpack8(*(const u32x4*)(rp - 1536 + 1024), h);
#pragma unroll
            for (int e = 0; e < 8; ++e) acc[e] += w0[e] * c[e] * h[e]; }
        if (n < LL - 1) { unpack8(*(const u32x4*)(rp + 1536 + 512), c); unpack8(*(const u32x4*)(rp + 1536 + 1024), h);
#pragma unroll
            for (int e = 0; e < 8; ++e) acc[e] += w2[e] * c[e] * h[e]; }
#pragma unroll
        for (int e = 0; e < 8; ++e) acc[e] *= bb[e];
        *(u32x4*)(SCO + (size_t)r * 512 + lane * 8) = pack8(acc);
    }
}

__device__ void fstep1(const Params& P, unsigned char* smem) {
    const int tid = ltid(), wave = __builtin_amdgcn_readfirstlane(tid >> 6), lane = tid & 63;
    const bf16_t* PQ = (const bf16_t*)(P.ws + O_PQ); bf16_t* AP = (bf16_t*)(P.ws + O_AP); const float* tw = (const float*)(P.ws + S_TWL);
    bf16_t* St = (bf16_t*)smem;
    for (int it = lbid(); it < 8 * 4 * 17; it += lgrid()) {
        const int b = it / 68, rem = it - b * 68, cht = rem / 17, n2t = rem - cht * 17;
        __syncthreads();
#pragma unroll
        for (int sub = 0; sub < 2; ++sub) {
            const int n2l = sub * 8 + wave, n2 = n2t * 16 + n2l;
            const int fr = lane & 15, fq = lane >> 4;
            if (n2 < 257) {
                float f0[8], f1[8];
#pragma unroll
                for (int j = 0; j < 8; ++j) { const int n = 257 * (8 * (fq & 1) + j) + n2; const int ph = (fr * n) % LL;
                    const float2 cs_ = *(const float2*)(tw + 2 * ph); const float c_ = cs_.x, ms_ = cs_.y;
                    f0[j] = (fq < 2) ? c_ : ms_; f1[j] = (fq < 2) ? ms_ : -c_; }
                const bf16x8 a0 = __builtin_bit_cast(bf16x8, pack8(f0)), a1 = __builtin_bit_cast(bf16x8, pack8(f1));
                const bf16_t* bp = PQ + (size_t)(b * LL + 257 * 8 * (fq & 1) + n2) * 1024 + (fq >> 1) * 512 + cht * 128 + fr;
#pragma unroll
                for (int ct = 0; ct < 8; ++ct) {
                    bf16x8 bf;
#pragma unroll
                    for (int j = 0; j < 8; ++j) bf[j] = (short)bp[(size_t)j * 257 * 1024 + ct * 16];
                    const f32x4 z = {0.f, 0.f, 0.f, 0.f};
                    const f32x4 c0 = __builtin_amdgcn_mfma_f32_16x16x32_bf16(a0, bf, z, 0, 0, 0), c1 = __builtin_amdgcn_mfma_f32_16x16x32_bf16(a1, bf, z, 0, 0, 0);
                    bf16_t* sp = St + ((4 * fq) * 128 + ct * 16 + fr) * 32 + n2l;
#pragma unroll
                    for (int rg = 0; rg < 4; ++rg) { sp[rg * 4096] = f2bf(c0[rg]); sp[rg * 4096 + 16] = f2bf(c1[rg]); }
                }
            } else {
                for (int q = lane; q < 4096; q += 64) St[q * 16 + n2l] = 0;
            }
        }
        __syncthreads();
#pragma unroll 2
        for (int q = tid; q < 8192; q += 512) { const int half = q & 1, ri = (q >> 1) & 1, chl = (q >> 2) & 127, k1 = q >> 9;
            const int n2c = n2t * 16 + half * 8;
            if (n2c < 320) { const u32x4 v = *(const u32x4*)(St + (size_t)q * 8);
                *(u32x4*)(AP + ((size_t)((b * 16 + k1) * 512 + cht * 128 + chl)) * KF + ri * 320 + n2c) = v; } }
        if (n2t == 16) {
            for (int q = tid; q < 16 * 128 * 2 * 6; q += 512) { const int c6 = q % 6, r2 = q / 6, ri = r2 & 1, chl = (r2 >> 1) & 127, k1 = r2 >> 8;
                *(u32x4*)(AP + ((size_t)((b * 16 + k1) * 512 + cht * 128 + chl)) * KF + ri * 320 + 272 + c6 * 8) = (u32x4){0u, 0u, 0u, 0u}; } }
    }
    __syncthreads();
}

#ifdef DBG_SEC
#define SEC_T(k) do { if (lbid() == 0 && tid == 0) { const unsigned long long _n = __builtin_amdgcn_s_memrealtime(); if (sec_prev_k == DBG_SEC) *(unsigned long long*)(smem + LDS_BYTES - 32) += _n - sec_prev_t; sec_prev_t = _n; sec_prev_k = (k); } } while (0)
#else
#define SEC_T(k) do {} while (0)
#endif
__device__ void dn_prep(const Params& P, int l, unsigned char* smem, int t0, int t1) {
#ifdef DBG_SEC
    unsigned long long sec_prev_t = __builtin_amdgcn_s_memrealtime(); int sec_prev_k = -1;
#endif
    const int tid = ltid(), wave = __builtin_amdgcn_readfirstlane(tid >> 6), lane = tid & 63, fr = lane & 15, fq = lane >> 4;
    unsigned char* ws = P.ws;
    const bf16_t* QKV = (const bf16_t*)(ws + O_QKV); const float* LG = (const float*)(ws + S_LOGIT);
    bf16_t* WP = (bf16_t*)(ws + O_WP); bf16_t* QP = (bf16_t*)(ws + O_QP); bf16_t* KD = (bf16_t*)(ws + O_KD); bf16_t* UF = (bf16_t*)(ws + O_UF); bf16_t* AT = (bf16_t*)(ws + O_AT);
    float* GL = (float*)(ws + S_GL);
    const float* cw = P.in[9] + (size_t)l * 3 * 1536;
    bf16_t* Qs = (bf16_t*)smem;
    bf16_t* Ks = Qs + 64 * 136;
    bf16_t* KT = Ks + 64 * 136;
    bf16_t* VT = KT + 128 * 72;
    bf16_t* T1 = VT + 128 * 72;
    bf16_t* T2 = T1 + 64 * 72;
    bf16_t* Rm = T2 + 64 * 72;
    bf16_t* Rt = Rm + 64 * 72;
    bf16_t* Pm = Rt + 64 * 72;
    float* gcs = (float*)(T2 + 64 * 72 + 2 * 64 * 68 * 2);
    float* bts = gcs + 64;
    float* cwl = bts + 64;
    bf16_t* Xr = T1;
    const int items = (t1 - t0) * 64;
    u32x4 x0[6], xb;
#define PREP_ISSUE(it_) do { const int _tl = (it_) >> 6, _bhd = (it_) & 63, _b = _bhd >> 3, _h = (_bhd >> 1) & 3, _dir = _bhd & 1; const int _nb = (_dir ? 64 - (t0 + _tl) : (t0 + _tl)) * 64 - 48; const u32x4 z4 = {0u, 0u, 0u, 0u}; \
        _Pragma("unroll") for (int rr = 0; rr < 6; ++rr) { const int task = tid + 512 * rr, i = task / 48, cg_ = task - i * 48; const int n = _nb + (_dir ? 63 - i : i); \
            x0[rr] = (n >= 0) ? *(const u32x4*)(QKV + (size_t)(_b * LL + n) * 1536 + (cg_ >> 4) * 512 + _h * 128 + (cg_ & 15) * 8) : z4; } \
        xb = z4; if (tid < 96) { const int which = tid / 48, cg_ = tid - which * 48; const int n = which ? _nb + 64 : _nb - 1; \
            if (n >= 0 && n < LL) xb = *(const u32x4*)(QKV + (size_t)(_b * LL + n) * 1536 + (cg_ >> 4) * 512 + _h * 128 + (cg_ & 15) * 8); } } while (0)
    for (int it = lbid(); it < items; it += lgrid()) {
        const int tl = it >> 6, bhd = it & 63, b = bhd >> 3, h = (bhd >> 1) & 3, dir = bhd & 1;
        const int t = t0 + tl, c = dir ? 64 - t : t; const size_t slot = (size_t)tl * 64 + bhd;
        PREP_ISSUE(it);
        float bl_ = 0.f, al_ = 0.f;
        { const int n_ = c * 64 + (dir ? 63 - lane : lane) - 48; if (wave == 0 && n_ >= 0) { const float* lg = LG + (size_t)(b * LL + n_) * 16; bl_ = lg[dir * 4 + h]; al_ = lg[8 + dir * 4 + h]; } }
        __syncthreads();
        SEC_T(0);
        for (int q = tid; q < 1152; q += 512) { const int tap = q / 384, rem = q - tap * 384; cwl[q] = cw[tap * 1536 + (rem >> 7) * 512 + h * 128 + (rem & 127)]; }
#pragma unroll
        for (int rr = 0; rr < 6; ++rr) { const int task = tid + 512 * rr, i = task / 48, cg_ = task - i * 48; *(u32x4*)(Xr + ((dir ? 63 - i : i) + 1) * 384 + cg_ * 8) = x0[rr]; }
        if (tid < 96) { const int which = tid / 48, cg_ = tid - which * 48; *(u32x4*)(Xr + (which ? 65 : 0) * 384 + cg_ * 8) = xb; }
        __syncthreads();
#pragma unroll 1
        for (int rr = 0; rr < 6; ++rr) {
            const int task = tid + 512 * rr, i = task / 48, cg_ = task - i * 48, kind = cg_ >> 4, cgl = cg_ & 15;
            float v[8], x[8];
            const float* w1 = cwl + 384 + kind * 128 + cgl * 8;
            const bf16_t* xr = Xr + ((dir ? 63 - i : i) + 1) * 384 + cg_ * 8;
            unpack8(*(const u32x4*)xr, x);
#pragma unroll
            for (int e = 0; e < 8; ++e) v[e] = w1[e] * x[e];
            unpack8(*(const u32x4*)(xr - 384), x);
#pragma unroll
            for (int e = 0; e < 8; ++e) v[e] += w1[e - 384] * x[e];
            unpack8(*(const u32x4*)(xr + 384), x);
#pragma unroll
            for (int e = 0; e < 8; ++e) v[e] += w1[e + 384] * x[e];
#pragma unroll
            for (int e = 0; e < 8; ++e) v[e] = siluf_(v[e]);
            float ss = 0.f;
#pragma unroll
            for (int e = 0; e < 8; ++e) ss += v[e] * v[e];
            ss += __shfl_xor(ss, 1); ss += __shfl_xor(ss, 2); ss += __shfl_xor(ss, 4); ss += __shfl_xor(ss, 8);
            if (kind < 2) { const float inv = rsqrtf(ss + EPS) * (kind == 0 ? 0.08838834764831845f : 1.0f);
#pragma unroll
                for (int e = 0; e < 8; ++e) v[e] *= inv; }
            const u32x4 pk = pack8(v);
            const int isw = i ^ ((cgl & 7) << 3);
            if (kind == 0) *(u32x4*)(Qs + i * 136 + cgl * 8) = pk;
            else if (kind == 1) { *(u32x4*)(Ks + i * 136 + cgl * 8) = pk;
#pragma unroll
                for (int e = 0; e < 8; ++e) KT[(cgl * 8 + e) * 72 + isw] = f2bf(v[e]); }
            else {
#pragma unroll
                for (int e = 0; e < 8; ++e) VT[(cgl * 8 + e) * 72 + isw] = f2bf(v[e]); }
        }
        if (wave == 0) {
            const int i = lane, n = c * 64 + (dir ? 63 - i : i) - 48; float beta = 0.f, g = 0.f;
            if (n >= 0) { const float bl = bl_, al = al_;
                beta = 1.0f / (1.0f + expf(-bl));
                const float xx = al + P.in[11][l * 8 + dir * 4 + h]; const float sp = xx > 20.f ? xx : log1pf(expf(xx));
                g = -expf(P.in[10][l * 8 + dir * 4 + h]) * sp; }
#pragma unroll
            for (int o = 1; o < 64; o <<= 1) { const float tt = __shfl_up(g, o); if (lane >= o) g += tt; }
            gcs[i] = g; bts[i] = beta;
        }
        __syncthreads();
        SEC_T(1);
        if (wave < 4) {
            const int m = wave; f32x4 acc[4];
#pragma unroll
            for (int n = 0; n < 4; ++n) acc[n] = (f32x4){0.f, 0.f, 0.f, 0.f};
#pragma unroll
            for (int s = 0; s < 4; ++s) { const bf16x8 a = *(const bf16x8*)(Ks + (16 * m + fr) * 136 + 32 * s + 8 * fq);
#pragma unroll
                for (int n = 0; n < 4; ++n) { const bf16x8 bb = *(const bf16x8*)(Ks + (16 * n + fr) * 136 + 32 * s + 8 * fq); acc[n] = __builtin_amdgcn_mfma_f32_16x16x32_bf16(a, bb, acc[n], 0, 0, 0); } }
#pragma unroll
            for (int n = 0; n < 4; ++n) { const int i = 16 * n + fr, j0 = 16 * m + 4 * fq;
                float nv[4], pv_[4];
#pragma unroll
                for (int rg = 0; rg < 4; ++rg) { const int j = j0 + rg; const float mv = (i > j) ? bts[i] * acc[n][rg] * __expf(gcs[i] - gcs[j]) : 0.f;
                    nv[rg] = -mv; pv_[rg] = (i == j ? 1.f : 0.f) - mv; Rt[j * 72 + i] = f2bf(-mv); }
                u32x2 w; w.x = cvt_pk_bf16(nv[0], nv[1]); w.y = cvt_pk_bf16(nv[2], nv[3]); *(u32x2*)(Rm + i * 72 + j0) = w;
                w.x = cvt_pk_bf16(pv_[0], pv_[1]); w.y = cvt_pk_bf16(pv_[2], pv_[3]); *(u32x2*)(Pm + i * 72 + j0) = w; }
        } else {
            const int m = wave - 4; f32x4 acc[4];
#pragma unroll
            for (int n = 0; n < 4; ++n) acc[n] = (f32x4){0.f, 0.f, 0.f, 0.f};
#pragma unroll
            for (int s = 0; s < 4; ++s) { const bf16x8 qf = *(const bf16x8*)(Qs + (16 * m + fr) * 136 + 32 * s + 8 * fq);
#pragma unroll
                for (int n = 0; n < 4; ++n) { const bf16x8 kf = *(const bf16x8*)(Ks + (16 * n + fr) * 136 + 32 * s + 8 * fq); acc[n] = __builtin_amdgcn_mfma_f32_16x16x32_bf16(kf, qf, acc[n], 0, 0, 0); } }
            const int i = 16 * m + fr; const float gi = gcs[i];
#pragma unroll
            for (int s2 = 0; s2 < 2; ++s2) { float v[8];
#pragma unroll
                for (int e = 0; e < 8; ++e) { const int j = 32 * s2 + 16 * (e >> 2) + 4 * fq + (e & 3); v[e] = (i >= j) ? acc[2 * s2 + (e >> 2)][e & 3] * __expf(gi - gcs[j]) : 0.f; }
                *(u32x4*)(AT + slot * 4096 + i * 64 + (((4 * s2 + fq) ^ ((i >> 1) & 7)) << 3)) = pack8(v); }
        }
        __syncthreads();
        SEC_T(2);
        {
            const float glast = gcs[63];
            for (int task = tid; task < 2048; task += 512) {
                if (task < 1024) { const int i = task >> 4, s_ = (task >> 2) & 3, f4 = task & 3; const float sc = __expf(gcs[i]);
                    const u32x2 a = *(const u32x2*)(Qs + i * 136 + 32 * s_ + 4 * f4), bq = *(const u32x2*)(Qs + i * 136 + 32 * s_ + 16 + 4 * f4);
                    float v[8]; v[0] = bf2f(a.x & 0xffffu) * sc; v[1] = __uint_as_float(a.x & 0xffff0000u) * sc; v[2] = bf2f(a.y & 0xffffu) * sc; v[3] = __uint_as_float(a.y & 0xffff0000u) * sc;
                    v[4] = bf2f(bq.x & 0xffffu) * sc; v[5] = __uint_as_float(bq.x & 0xffff0000u) * sc; v[6] = bf2f(bq.y & 0xffffu) * sc; v[7] = __uint_as_float(bq.y & 0xffff0000u) * sc;
                    *(u32x4*)(QP + slot * 8192 + i * 128 + (((4 * s_ + f4) ^ (i & 15)) << 3)) = pack8(v);
                } else { const int tt = task - 1024, dk = tt >> 3, s2 = (tt >> 2) & 1, f4 = tt & 3; const int i0 = 32 * s2 + 4 * f4;
                    const int sw = ((dk >> 3) & 7) << 3; const u32x2 a = *(const u32x2*)(KT + dk * 72 + (i0 ^ sw)), bq = *(const u32x2*)(KT + dk * 72 + ((i0 + 16) ^ sw));
                    float v[8]; v[0] = bf2f(a.x & 0xffffu) * __expf(glast - gcs[i0]); v[1] = __uint_as_float(a.x & 0xffff0000u) * __expf(glast - gcs[i0 + 1]);
                    v[2] = bf2f(a.y & 0xffffu) * __expf(glast - gcs[i0 + 2]); v[3] = __uint_as_float(a.y & 0xffff0000u) * __expf(glast - gcs[i0 + 3]);
                    v[4] = bf2f(bq.x & 0xffffu) * __expf(glast - gcs[i0 + 16]); v[5] = __uint_as_float(bq.x & 0xffff0000u) * __expf(glast - gcs[i0 + 17]);
                    v[6] = bf2f(bq.y & 0xffffu) * __expf(glast - gcs[i0 + 18]); v[7] = __uint_as_float(bq.y & 0xffff0000u) * __expf(glast - gcs[i0 + 19]);
                    *(u32x4*)(KD + slot * 8192 + dk * 64 + (((4 * s2 + f4) ^ ((dk >> 1) & 7)) << 3)) = pack8(v); }
            }
            if (tid == 0) GL[slot] = __expf(glast);
            f32x4 accP[2];
#pragma unroll
            for (int e = 0; e < 2; ++e) { const int tt = 2 * wave + e, it_ = tt >> 2, jt = tt & 3;
                const u32x2 pw = *(const u32x2*)(Pm + (16 * it_ + fr) * 72 + 16 * jt + 4 * fq);
                accP[e] = (f32x4){__uint_as_float(pw.x << 16), __uint_as_float(pw.x & 0xffff0000u), __uint_as_float(pw.y << 16), __uint_as_float(pw.y & 0xffff0000u)}; }
#pragma unroll 1
            for (int rd = 0; rd < 6; ++rd) {
                f32x4 accR[2], accT[2];
#pragma unroll
                for (int e = 0; e < 2; ++e) { const int tt = 2 * wave + e, mt = tt >> 2, nt = tt & 3;
                    accR[e] = (f32x4){0.f, 0.f, 0.f, 0.f}; accT[e] = (f32x4){0.f, 0.f, 0.f, 0.f};
#pragma unroll
                    for (int s2 = 0; s2 < 2; ++s2) {
                        const bf16x8 rm = *(const bf16x8*)(Rm + (16 * mt + fr) * 72 + 32 * s2 + 8 * fq), rn = *(const bf16x8*)(Rm + (16 * nt + fr) * 72 + 32 * s2 + 8 * fq);
                        const bf16x8 tm = *(const bf16x8*)(Rt + (16 * mt + fr) * 72 + 32 * s2 + 8 * fq), tn = *(const bf16x8*)(Rt + (16 * nt + fr) * 72 + 32 * s2 + 8 * fq);
                        const bf16x8 pm_ = *(const bf16x8*)(Pm + (16 * mt + fr) * 72 + 32 * s2 + 8 * fq);
                        if (rd < 5) { accR[e] = __builtin_amdgcn_mfma_f32_16x16x32_bf16(rm, tn, accR[e], 0, 0, 0);
                                      accT[e] = __builtin_amdgcn_mfma_f32_16x16x32_bf16(tm, rn, accT[e], 0, 0, 0); }
                        if (rd > 0) accP[e] = __builtin_amdgcn_mfma_f32_16x16x32_bf16(tn, pm_, accP[e], 0, 0, 0);
                    } }
                __syncthreads();
                if (rd < 5) {
#pragma unroll
                    for (int e = 0; e < 2; ++e) { const int tt = 2 * wave + e, mt = tt >> 2, nt = tt & 3; u32x2 w;
                        w.x = cvt_pk_bf16(accR[e][0], accR[e][1]); w.y = cvt_pk_bf16(accR[e][2], accR[e][3]); *(u32x2*)(Rt + (16 * nt + fr) * 72 + 16 * mt + 4 * fq) = w;
                        w.x = cvt_pk_bf16(accT[e][0], accT[e][1]); w.y = cvt_pk_bf16(accT[e][2], accT[e][3]); *(u32x2*)(Rm + (16 * nt + fr) * 72 + 16 * mt + 4 * fq) = w;
                        if (rd > 0) { w.x = cvt_pk_bf16(accP[e][0], accP[e][1]); w.y = cvt_pk_bf16(accP[e][2], accP[e][3]); *(u32x2*)(Pm + (16 * mt + fr) * 72 + 16 * nt + 4 * fq) = w; } }
                    __syncthreads();
                }
            }
#pragma unroll
            for (int e = 0; e < 2; ++e) { const int tt = 2 * wave + e, mt = tt >> 2, nt = tt & 3; const int i = 16 * mt + fr, c0 = 16 * nt + 4 * fq; float v1[4], v2[4];
#pragma unroll
                for (int rg = 0; rg < 4; ++rg) { const float bc = bts[c0 + rg]; v1[rg] = accP[e][rg] * bc; v2[rg] = -accP[e][rg] * bc * __expf(gcs[c0 + rg]); }
                u32x2 w; w.x = cvt_pk_bf16(v1[0], v1[1]); w.y = cvt_pk_bf16(v1[2], v1[3]); *(u32x2*)(T1 + i * 72 + c0) = w;
                w.x = cvt_pk_bf16(v2[0], v2[1]); w.y = cvt_pk_bf16(v2[2], v2[3]); *(u32x2*)(T2 + i * 72 + c0) = w; }
        }
        __syncthreads();
        SEC_T(3);
#pragma unroll 1
        for (int nh = 0; nh < 2; ++nh) {
        if (wave < 4) {
            const int m = wave; f32x4 acc[4];
#pragma unroll
            for (int n = 0; n < 4; ++n) acc[n] = (f32x4){0.f, 0.f, 0.f, 0.f};
#pragma unroll
            for (int s2 = 0; s2 < 2; ++s2) { const bf16x8 a = *(const bf16x8*)(T1 + (16 * m + fr) * 72 + 32 * s2 + 8 * fq);
#pragma unroll
                for (int n = 0; n < 4; ++n) { const int d = 16 * (4 * nh + n) + fr; const bf16x8 bb = *(const bf16x8*)(VT + d * 72 + ((32 * s2 + 8 * fq) ^ (((d >> 3) & 7) << 3))); acc[n] = __builtin_amdgcn_mfma_f32_16x16x32_bf16(a, bb, acc[n], 0, 0, 0); } }
#pragma unroll
            for (int n = 0; n < 4; ++n) { u32x2 w; w.x = cvt_pk_bf16(acc[n][0], acc[n][1]); w.y = cvt_pk_bf16(acc[n][2], acc[n][3]);
                *(u32x2*)(UF + slot * 8192 + (((4 * nh + n) * 4 + m) * 64 + lane) * 4) = w; }
        } else {
            const int m = wave - 4; f32x4 acc[4];
#pragma unroll
            for (int n = 0; n < 4; ++n) acc[n] = (f32x4){0.f, 0.f, 0.f, 0.f};
#pragma unroll
            for (int s2 = 0; s2 < 2; ++s2) { const bf16x8 tf = *(const bf16x8*)(T2 + (16 * m + fr) * 72 + 32 * s2 + 8 * fq);
#pragma unroll
                for (int n = 0; n < 4; ++n) { const int d = 16 * (4 * nh + n) + fr; const bf16x8 kf = *(const bf16x8*)(KT + d * 72 + ((32 * s2 + 8 * fq) ^ (((d >> 3) & 7) << 3))); acc[n] = __builtin_amdgcn_mfma_f32_16x16x32_bf16(kf, tf, acc[n], 0, 0, 0); } }
            const int i = 16 * m + fr;
#pragma unroll
            for (int s = 0; s < 2; ++s) { u32x4 w; w.x = cvt_pk_bf16(acc[2 * s][0], acc[2 * s][1]); w.y = cvt_pk_bf16(acc[2 * s][2], acc[2 * s][3]);
                w.z = cvt_pk_bf16(acc[2 * s + 1][0], acc[2 * s + 1][1]); w.w = cvt_pk_bf16(acc[2 * s + 1][2], acc[2 * s + 1][3]);
                *(u32x4*)(WP + slot * 8192 + i * 128 + (((4 * (2 * nh + s) + fq) ^ (i & 15)) << 3)) = w; }
        }
        }
        SEC_T(4);
    }
    __syncthreads();
}

__device__ void dn_scan(const Params& P, unsigned char* smem, int t0, int t1) {
    if (lbid() >= 128) return;
    const int bhd = (lbid() >> 4) * 8 + (lbid() & 7), half = (lbid() >> 3) & 1;
    const int tid = ltid(), wave = __builtin_amdgcn_readfirstlane(tid >> 6), lane = tid & 63, fr = lane & 15, fq = lane >> 4;
    unsigned char* ws = P.ws;
    const unsigned char* WPb = ws + O_WP; const unsigned char* QPb = ws + O_QP; const unsigned char* KDb = ws + O_KD; const unsigned char* ATb = ws + O_AT;
    const bf16_t* UF = (const bf16_t*)(ws + O_UF); const float* GL = (const float*)(ws + S_GL);
    bf16_t* OO = (bf16_t*)(ws + O_O); f32x4* SS = (f32x4*)(ws + S_SSAVE);
    const int b = bhd >> 3, h = (bhd >> 1) & 3, dir = bhd & 1;
    LAS unsigned char* lds = (LAS unsigned char*)smem;
    constexpr int BUFB = 57344;
#define SCAN_SRC(q_, slot_) ((q_) < 16 ? WPb + (slot_) * 16384 + (q_) * 1024 : (q_) < 32 ? QPb + (slot_) * 16384 + ((q_) - 16) * 1024 : (q_) < 48 ? KDb + (slot_) * 16384 + ((q_) - 32) * 1024 : ATb + (slot_) * 8192 + ((q_) - 48) * 1024)
#define SCAN_LOAD(tl_) do { const size_t _slot = (size_t)(tl_) * 64 + bhd; _Pragma("unroll") for (int _k = 0; _k < 14; ++_k) { const int _q = (wave - 4) * 14 + _k; rg_[_k] = *(const u32x4*)(SCAN_SRC(_q, _slot) + lane * 16); } } while (0)
#define SCAN_WRITE(buf_) do { _Pragma("unroll") for (int _k = 0; _k < 14; ++_k) { const int _q = (wave - 4) * 14 + _k; *(LAS u32x4*)(lds + (buf_) * BUFB + _q * 1024 + lane * 16) = rg_[_k]; } } while (0)
    constexpr int NN = 1; const bool cw_ = wave < 4; const int sl0 = half * 4 + (wave & 3);
    const int nst = t1 - t0;
    if (!cw_) {
        u32x4 rg_[14];
#define SCAN_LOAD(tl_) do { const size_t _slot = (size_t)(tl_) * 64 + bhd; _Pragma("unroll") for (int _k = 0; _k < 14; ++_k) { const int _q = (wave - 4) * 14 + _k; rg_[_k] = *(const u32x4*)(SCAN_SRC(_q, _slot) + lane * 16); } } while (0)
#define SCAN_WRITE(buf_) do { _Pragma("unroll") for (int _k = 0; _k < 14; ++_k) { const int _q = (wave - 4) * 14 + _k; *(LAS u32x4*)(lds + (buf_) * BUFB + _q * 1024 + lane * 16) = rg_[_k]; } } while (0)
        SCAN_LOAD(0); SCAN_WRITE(0); if (nst > 1) SCAN_LOAD(1);
#pragma unroll 1
        for (int tl = 0; tl < nst; ++tl) {
            __syncthreads();
            if (tl + 1 < nst) { SCAN_WRITE((tl + 1) & 1); if (tl + 2 < nst) SCAN_LOAD(tl + 2); }
        }
        asm volatile("s_waitcnt vmcnt(0)" ::: "memory");
        __syncthreads();
        return;
    }
    f32x4 S[8][NN];
#pragma unroll
    for (int t = 0; t < 8; ++t)
#pragma unroll
        for (int nn = 0; nn < NN; ++nn) S[t][nn] = (t0 == 0 || !cw_) ? (f32x4){0.f, 0.f, 0.f, 0.f} : SS[((size_t)(bhd * 8 + sl0 + nn) * 8 + t) * 64 + lane];
    u32x2 un[4][NN];
    if (cw_) {
#pragma unroll
        for (int m = 0; m < 4; ++m)
#pragma unroll
            for (int nn = 0; nn < NN; ++nn) un[m][nn] = *(const u32x2*)(UF + (size_t)bhd * 8192 + (((sl0 + nn) * 4 + m) * 64 + lane) * 4); }
    float gln = __hip_atomic_load(GL + bhd, __ATOMIC_RELAXED, __HIP_MEMORY_SCOPE_AGENT);
#pragma unroll 1
    for (int tl = 0; tl < nst; ++tl) {
        const size_t slot = (size_t)tl * 64 + bhd; const int t = t0 + tl, c = dir ? 64 - t : t;
        const LAS unsigned char* bw = lds + (tl & 1) * BUFB;
        __syncthreads();
        f32x4 av[4][NN], ao[4][NN];
#pragma unroll
        for (int m = 0; m < 4; ++m)
#pragma unroll
            for (int nn = 0; nn < NN; ++nn) { const u32x2 u = un[m][nn];
                av[m][nn] = (f32x4){__uint_as_float(u.x << 16), __uint_as_float(u.x & 0xffff0000u), __uint_as_float(u.y << 16), __uint_as_float(u.y & 0xffff0000u)}; ao[m][nn] = (f32x4){0.f, 0.f, 0.f, 0.f}; }
        const float gl = gln; if (tl + 1 < nst) gln = __hip_atomic_load(GL + slot + 64, __ATOMIC_RELAXED, __HIP_MEMORY_SCOPE_AGENT);
        if (tl + 1 < nst) {
#pragma unroll
            for (int m = 0; m < 4; ++m)
#pragma unroll
                for (int nn = 0; nn < NN; ++nn) un[m][nn] = *(const u32x2*)(UF + (slot + 64) * 8192 + (((sl0 + nn) * 4 + m) * 64 + lane) * 4); }
#pragma unroll
        for (int s = 0; s < 4; ++s) { bf16x8 Sb[NN];
#pragma unroll
            for (int nn = 0; nn < NN; ++nn) { u32x4 w; w.x = cvt_pk_bf16(S[2 * s][nn][0], S[2 * s][nn][1]); w.y = cvt_pk_bf16(S[2 * s][nn][2], S[2 * s][nn][3]); w.z = cvt_pk_bf16(S[2 * s + 1][nn][0], S[2 * s + 1][nn][1]); w.w = cvt_pk_bf16(S[2 * s + 1][nn][2], S[2 * s + 1][nn][3]);
                Sb[nn] = __builtin_bit_cast(bf16x8, w); }
#pragma unroll
            for (int m = 0; m < 4; ++m) { const bf16x8 wf = *(const LAS bf16x8*)(bw + (16 * m + fr) * 256 + (((4 * s + fq) ^ fr) << 4)); const bf16x8 qf = *(const LAS bf16x8*)(bw + 16384 + (16 * m + fr) * 256 + (((4 * s + fq) ^ fr) << 4));
                _Pragma("unroll") for (int nn = 0; nn < NN; ++nn) av[m][nn] = __builtin_amdgcn_mfma_f32_16x16x32_bf16(wf, Sb[nn], av[m][nn], 0, 0, 0);
                _Pragma("unroll") for (int nn = 0; nn < NN; ++nn) ao[m][nn] = __builtin_amdgcn_mfma_f32_16x16x32_bf16(qf, Sb[nn], ao[m][nn], 0, 0, 0); } }
        __builtin_amdgcn_sched_barrier(0);
        bf16x8 Vb[2][NN];
#pragma unroll
        for (int s2 = 0; s2 < 2; ++s2)
#pragma unroll
            for (int nn = 0; nn < NN; ++nn) { u32x4 w; w.x = cvt_pk_bf16(av[2 * s2][nn][0], av[2 * s2][nn][1]); w.y = cvt_pk_bf16(av[2 * s2][nn][2], av[2 * s2][nn][3]); w.z = cvt_pk_bf16(av[2 * s2 + 1][nn][0], av[2 * s2 + 1][nn][1]); w.w = cvt_pk_bf16(av[2 * s2 + 1][nn][2], av[2 * s2 + 1][nn][3]);
                Vb[s2][nn] = __builtin_bit_cast(bf16x8, w); }
#pragma unroll
        for (int m = 0; m < 4; ++m)
#pragma unroll
            for (int s2 = 0; s2 < 2; ++s2) { const int row = 16 * m + fr; const bf16x8 af = *(const LAS bf16x8*)(bw + 49152 + row * 128 + (((4 * s2 + fq) ^ ((row >> 1) & 7)) << 4));
                _Pragma("unroll") for (int nn = 0; nn < NN; ++nn) ao[m][nn] = __builtin_amdgcn_mfma_f32_16x16x32_bf16(af, Vb[s2][nn], ao[m][nn], 0, 0, 0); }
        __builtin_amdgcn_sched_barrier(0);
#pragma unroll
        for (int tt = 0; tt < 8; ++tt) { _Pragma("unroll") for (int nn = 0; nn < NN; ++nn) S[tt][nn] = S[tt][nn] * gl;
#pragma unroll
            for (int s2 = 0; s2 < 2; ++s2) { const int row = 16 * tt + fr; const bf16x8 kf = *(const LAS bf16x8*)(bw + 32768 + row * 128 + (((4 * s2 + fq) ^ ((row >> 1) & 7)) << 4));
                _Pragma("unroll") for (int nn = 0; nn < NN; ++nn) S[tt][nn] = __builtin_amdgcn_mfma_f32_16x16x32_bf16(kf, Vb[s2][nn], S[tt][nn], 0, 0, 0); } }
#pragma unroll
        for (int m = 0; m < 4; ++m)
#pragma unroll
            for (int rg = 0; rg < 4; ++rg) { const int i = 16 * m + 4 * fq + rg, n = c * 64 + (dir ? 63 - i : i) - 48;
                if (n >= 0) { bf16_t* op = OO + ((size_t)dir * TP + (size_t)b * LL + n) * 512 + h * 128 + sl0 * 16 + fr; _Pragma("unroll") for (int nn = 0; nn < NN; ++nn) op[16 * nn] = f2bf(ao[m][nn][rg]); } }
    }
#undef SCAN_SRC
#undef SCAN_LOAD
#undef SCAN_WRITE
    if (t1 < NSTEP && cw_) {
#pragma unroll
        for (int t = 0; t < 8; ++t)
#pragma unroll
            for (int nn = 0; nn < NN; ++nn) SS[((size_t)(bhd * 8 + sl0 + nn) * 8 + t) * 64 + lane] = S[t][nn]; }
    asm volatile("s_waitcnt vmcnt(0)" ::: "memory");
    __syncthreads();
}

__device__ void dn_out(const Params& P, int l) {
    const int tid_ = ltid(); const int wave = __builtin_amdgcn_readfirstlane(tid_ >> 6), lane = tid_ & 63;
    const bf16_t* OO = (const bf16_t*)(P.ws + O_O); const bf16_t* Z = (const bf16_t*)(P.ws + O_Z); bf16_t* DNO = (bf16_t*)(P.ws + O_BR) + (size_t)2 * TP * 512;
    const float* nw = P.in[12] + (size_t)l * 128; float g[8];
#pragma unroll
    for (int e = 0; e < 8; ++e) g[e] = nw[(lane & 15) * 8 + e];
    for (int r = lbid() * 8 + wave; r < TT; r += lgrid() * 8) {
        float a[8], bq[8], z[8]; unpack8(*(const u32x4*)(OO + (size_t)r * 512 + lane * 8), a); unpack8(*(const u32x4*)(OO + ((size_t)TP + r) * 512 + lane * 8), bq); unpack8(*(const u32x4*)(Z + (size_t)r * 512 + lane * 8), z);
        float ss = 0.f;
#pragma unroll
        for (int e = 0; e < 8; ++e) { a[e] += bq[e]; ss += a[e] * a[e]; }
        ss += __shfl_xor(ss, 1); ss += __shfl_xor(ss, 2); ss += __shfl_xor(ss, 4); ss += __shfl_xor(ss, 8);
        const float inv = rsqrtf(ss * (1.0f / 128.0f) + EPS);
#pragma unroll
        for (int e = 0; e < 8; ++e) a[e] = a[e] * inv * g[e] * siluf_(z[e]);
        *(u32x4*)(DNO + (size_t)r * 512 + lane * 8) = pack8(a);
    }
}


#define XB_TMO      128
#define XB_XCNT(j)  (256  + 64 * (j))
#define XB_XSUB(j)  (1280 + 64 * (j))
#define XB_XGEN(j)  (2304 + 64 * (j))
#define XB_TOP      3328
#define XB_TOPGEN   3392
#define XCD_BAR_WORDS 3456
#define XB_SPIN_CAP (1u << 22)
__device__ __forceinline__ unsigned xb_ld(unsigned* p)              { return __hip_atomic_load(p, __ATOMIC_RELAXED, __HIP_MEMORY_SCOPE_AGENT); }
__device__ __forceinline__ unsigned xb_add(unsigned* p, unsigned v) { return __hip_atomic_fetch_add(p, v, __ATOMIC_RELAXED, __HIP_MEMORY_SCOPE_AGENT); }
__device__ __forceinline__ unsigned xb_xcc_id() { return (unsigned)__builtin_amdgcn_s_getreg((3 << 11) | 20) & 0xFu; }
#define XB_SPIN(cond, bar) do { unsigned _sp = 0; while (cond) { __builtin_amdgcn_s_sleep(1); \
    if ((++_sp & 255u) == 0u) { if (xb_ld(&(bar)[XB_TMO])) break; if (_sp > XB_SPIN_CAP) { atomicAdd(&(bar)[XB_TMO], 1u); break; } } } } while (0)
struct XcdBarrier { unsigned* bar; unsigned x; volatile LAS unsigned* st; };
__device__ __forceinline__ XcdBarrier xcd_barrier_post(unsigned* bar, volatile LAS unsigned* st) {
    XcdBarrier b; b.bar = bar; b.x = xb_xcc_id(); b.st = st;
    if (threadIdx.x == 0) (void)xb_add(&bar[XB_XCNT(b.x)], 1u);
    return b;
}
__device__ __forceinline__ void xcd_barrier_complete(unsigned* bar, unsigned x, unsigned& nloc, unsigned& nx) {
    const unsigned G = gridDim.x * gridDim.y * gridDim.z;
    unsigned sum, cnt, mine, sp = 0u;
    for (;;) {
        sum = 0u; cnt = 0u; mine = 0u;
#pragma unroll
        for (unsigned j = 0; j < 16; ++j) { const unsigned c = xb_ld(&bar[XB_XCNT(j)]); sum += c; cnt += (c > 0u) ? 1u : 0u; mine = (j == x) ? c : mine; }
        if (sum == G) break;
        __builtin_amdgcn_s_sleep(1);
        if ((++sp & 255u) == 0u) { if (xb_ld(&bar[XB_TMO])) break; if (sp > XB_SPIN_CAP) { atomicAdd(&bar[XB_TMO], 1u); break; } }
    }
    nloc = mine > 0u ? mine : 1u; nx = cnt > 0u ? cnt : 1u;
}
__device__ __forceinline__ void xcd_barrier(const XcdBarrier& b) {
    asm volatile("s_waitcnt vmcnt(0)" ::: "memory");
    __syncthreads();
    if (threadIdx.x == 0) {
        unsigned* bar = b.bar;
        __builtin_amdgcn_s_waitcnt(0);
        unsigned nloc = b.st[0], nx = b.st[1];
        if (nloc == 0u) { xcd_barrier_complete(bar, b.x, nloc, nx); b.st[0] = nloc; b.st[1] = nx; }
        const unsigned old = xb_add(&bar[XB_XSUB(b.x)], 1u);
        const unsigned gen = old / nloc;
        if (old + 1u == (gen + 1u) * nloc) {
            __builtin_amdgcn_fence(__ATOMIC_RELEASE, "agent");
            asm volatile("s_waitcnt vmcnt(0)" ::: "memory");
            const unsigned og = xb_add(&bar[XB_TOP], 1u);
            const unsigned tg = og / nx;
            if (og + 1u == (tg + 1u) * nx) xb_add(&bar[XB_TOPGEN], 1u);
            else XB_SPIN(xb_ld(&bar[XB_TOPGEN]) == tg, bar);
            __builtin_amdgcn_fence(__ATOMIC_ACQUIRE, "agent");
            xb_add(&bar[XB_XGEN(b.x)], 1u);
            asm volatile("s_waitcnt vmcnt(0)" ::: "memory");
        } else {
            XB_SPIN(xb_ld(&bar[XB_XGEN(b.x)]) == gen, bar);
            __builtin_amdgcn_fence(__ATOMIC_ACQUIRE, "agent");
            asm volatile("s_waitcnt vmcnt(0)" ::: "memory");
        }
    }
    __syncthreads();
}
__device__ __forceinline__ int phase_cat(int ph) { const int p = ph % 22;
    return p == 0 ? 0 : (p == 1 || p == 2 || p == 19 || p == 20) ? 1 : (p == 3 || p == 18 || p == 21) ? 2 : p == 4 ? 3 : p == 5 ? 4 : p == 6 ? 5 : p == 7 ? 6 : (p == 8 || p == 10 || p == 12) ? 7 : (p == 9 || p == 11 || p == 13) ? 8 : p == 14 ? 9 : 10; }
#ifndef SKIP_GEMM
#define GEMM_CALL(a,b,c,d) pg8::gemm_phase(a,b,c,d)
#else
#define GEMM_CALL(a,b,c,d) (void)0
#endif
__global__ void __launch_bounds__(512, 2) fwd_kernel(Params P) {
    extern __shared__ __attribute__((aligned(16))) unsigned char smem[];
    cg::grid_group grid = cg::this_grid();
    unsigned char* ws = P.ws;
    LAS unsigned char* lds = (LAS unsigned char*)smem;
    int ph = 0;
    { volatile LAS unsigned* stw = (volatile LAS unsigned*)(lds + LDS_BYTES - 32); if (threadIdx.x < 8) stw[threadIdx.x] = 0u; }
    __syncthreads();
    XcdBarrier xbar = xcd_barrier_post((unsigned*)(ws + S_BAR), (volatile LAS unsigned*)(lds + LDS_BYTES - 16));
#ifdef DBG_CAT
    unsigned long long t_prev = __builtin_amdgcn_s_memrealtime(), t_acc = 0ull;
#define STAMP() do { const unsigned long long _n = __builtin_amdgcn_s_memrealtime(); if (phase_cat(ph) == DBG_CAT) t_acc += _n - t_prev; t_prev = _n; } while (0)
#else
#define STAMP() do {} while (0)
#endif
#define PHASE_BEGIN if (ph >= P.ph_lo && ph < P.ph_hi) { const int G = lgrid(), bx = lbid(); (void)G; (void)bx;
#define PHASE_END   if (ph + 1 < P.ph_hi) { if (ph == 0) { asm volatile("s_waitcnt vmcnt(0) lgkmcnt(0)" ::: "memory"); grid.sync(); __builtin_amdgcn_fence(__ATOMIC_ACQUIRE, "agent"); asm volatile("s_waitcnt vmcnt(0)" ::: "memory"); __syncthreads(); } else xcd_barrier(xbar); } STAMP(); } ++ph;
    for (ph = P.ph_lo; ph < P.ph_hi; ++ph) {
        const int l = ph / 22, p = ph - l * 22;
        const int G = lgrid(), bx = lbid();
        bf16_t* XN = (bf16_t*)(ws + O_XN); bf16_t* Y = (bf16_t*)(ws + O_Y); bf16_t* ACT = (bf16_t*)(ws + O_ACT);
        const float* ng = P.in[2] + (size_t)l * 6 * 1024;
        switch (p) {
        case 0:
#ifndef SKIP_CVT
            convert_weights(P, l, smem);
#endif
            if (l == 0) { gen_tables(P); rpass(P, nullptr, true, nullptr, 0.f, ng, XN); }
            break;
        case 1: case 19: { pg8::Gemm g{XN, (const bf16_t*)(ws + (p == 1 ? W_WI1 : W_WI2)), TP, 5632, 1024, 128, 1024}; pg8::StaticOrder S; S.init(TP, 5632, G, bx); pg8::EpiSwiglu E{ACT}; GEMM_CALL(lds, g, S, E); } break;
        case 2: case 20: case 17: {
            const bool dn = (p != 17); const int Kx = dn ? 2816 : 1024, nS = dn ? 11 : 4;
            const bf16_t* W = (const bf16_t*)(ws + (p == 2 ? W_WO1 : p == 20 ? W_WO2 : W_WOUT)); const bf16_t* Ax = dn ? ACT : (const bf16_t*)(ws + O_MG);
            { pg8::Gemm g{Ax, W, TP, 1024, Kx, 128, Kx}; pg8::StaticOrder S; S.init(TP, 1024, G, bx, false); pg8::EpiBf16<0> E{Y, 1024}; GEMM_CALL(lds, g, S, E); }
            { pg8::Gemm g{W, Ax + (size_t)32768 * Kx, 1024, 256, Kx, -1, 256}; pg8::TailOrder S{nS, bx}; pg8::EpiSlab E{(float*)(ws + O_SLAB), nS}; GEMM_CALL(lds, g, S, E); } } break;
        case 3: rpass(P, Y, l == 0, ng + 1024, 0.5f, ng + 2048, XN, (const float*)(ws + O_SLAB), 11); break;
        case 4: { pg8::Gemm g{XN, (const bf16_t*)(ws + W_WIN), TP, NPROJ, 1024, 128, 1024}; pg8::StaticOrder S; S.init(TP, NPROJ, G, bx); pg8::EpiInProj E{ws}; GEMM_CALL(lds, g, S, E); } break;
        case 5: sconv_pass(P, l); break;
        case 6:
#ifndef SKIP_F1
            fstep1(P, smem);
#endif
            break;
        case 7: { pg8::Gemm g{(const bf16_t*)(ws + S_C257), (const bf16_t*)(ws + O_AP), 512, 65536, KF, 1, KF}; pg8::StaticOrder S; S.init(512, 65536, G, bx);
                  pg8::EpiFourier E{(bf16_t*)(ws + O_BR), 0.001949317738791423f  }; GEMM_CALL(lds, g, S, E); } break;
        case 8: case 10: case 12: { const int t0 = ((p - 8) >> 1) * SPL, t1 = (t0 + SPL < NSTEP) ? t0 + SPL : NSTEP;
#ifndef SKIP_PREP
            dn_prep(P, l, smem, t0, t1);
#endif
            } break;
        case 9: case 11: case 13: { const int t0 = ((p - 9) >> 1) * SPL, t1 = (t0 + SPL < NSTEP) ? t0 + SPL : NSTEP;
#ifndef SKIP_SCAN
            dn_scan(P, smem, t0, t1);
#endif
            } break;
        case 14: dn_out(P, l); rpass(P, nullptr, false, nullptr, 0.f, ng + 2048, (bf16_t*)(ws + O_XN2)); break;
        case 15: { pg8::Gemm g{(const bf16_t*)(ws + O_XN2), (const bf16_t*)(ws + W_WG), TP, 3072, 1024, 128, 1024}; pg8::StaticOrder S; S.init(TP, 3072, G, bx); pg8::EpiBf16<1> E{(bf16_t*)(ws + O_GATE), 3072}; GEMM_CALL(lds, g, S, E); } break;
        case 16: { pg8::Gemm g{(const bf16_t*)(ws + O_BR), (const bf16_t*)(ws + W_WBR), 3 * TP, 3072, 512, -1, 512}; pg8::MergeOrder S{G, bx}; pg8::EpiMerge E{(const bf16_t*)(ws + O_GATE), (bf16_t*)(ws + O_MG), (bf16_t*)(ws + O_XN2)}; GEMM_CALL(lds, g, S, E); } break;
        case 18: rpass(P, Y, false, ng + 3 * 1024, 1.0f, ng + 4 * 1024, XN, (const float*)(ws + O_SLAB), 4); break;
        default: rpass(P, Y, false, ng + 5 * 1024, 0.5f, l == 0 ? P.in[2] + (size_t)6 * 1024 : nullptr, XN, (const float*)(ws + O_SLAB), 11); break;
        }
        if (ph + 1 < P.ph_hi) {
            if (P.ph_lo < 0) grid.sync();
            xcd_barrier(xbar);
        }
        STAMP();
    }
#ifdef DBG_CAT
    if (lbid() == 0 && threadIdx.x == 0) { const unsigned long long t0 = __builtin_amdgcn_s_memrealtime(); while (__builtin_amdgcn_s_memrealtime() - t0 < t_acc + *(unsigned long long*)(smem + LDS_BYTES - 32)) __builtin_amdgcn_s_sleep(16); }
#endif
#ifdef DBG_FLUSH
    { asm volatile("s_waitcnt vmcnt(0) lgkmcnt(0)" ::: "memory"); grid.sync(); __builtin_amdgcn_fence(__ATOMIC_ACQUIRE, "agent"); asm volatile("s_waitcnt vmcnt(0)" ::: "memory");
      const f32x4* xs = (const f32x4*)P.in[0]; f32x4 a = {0.f, 0.f, 0.f, 0.f};
      for (size_t i = ltid(); i < (size_t)8388608; i += 512) a += xs[i];
      if (a[0] + a[1] + a[2] + a[3] == 1.2345e-30f) ((float*)(ws + S_GL))[4000] = 1.f; }
#endif
#ifdef DBG_OFF
    { asm volatile("s_waitcnt vmcnt(0) lgkmcnt(0)" ::: "memory"); grid.sync(); __builtin_amdgcn_fence(__ATOMIC_ACQUIRE, "agent"); asm volatile("s_waitcnt vmcnt(0)" ::: "memory");
      const bf16_t* src = (const bf16_t*)(ws + DBG_OFF);
      for (size_t i = (size_t)lbid() * 512 + ltid(); i < (size_t)33554432; i += (size_t)lgrid() * 512) P.out[i] = i < (size_t)DBG_CNT ? bf2f(src[i]) : 0.f; }
#endif
}

extern "C" void kernel_launch(void* const* d_in, const int* in_sizes, int n_in, void* d_out, int out_size, void* d_ws, size_t ws_size, hipStream_t stream) {
    static int grid = 0;
    if (grid == 0) {
        int dev = 0, cus = 0, per_cu = 0;
        hipGetDevice(&dev); hipDeviceGetAttribute(&cus, hipDeviceAttributeMultiprocessorCount, dev);
        hipFuncSetAttribute((const void*)fwd_kernel, hipFuncAttributeMaxDynamicSharedMemorySize, LDS_BYTES);
        hipOccupancyMaxActiveBlocksPerMultiprocessor(&per_cu, (const void*)fwd_kernel, 512, LDS_BYTES);
        if (per_cu < 1) { fprintf(stderr, "occupancy query says %d blocks/CU\n", per_cu); per_cu = 1; }
        grid = cus;
        if (ws_size < WS_NEED) fprintf(stderr, "workspace too small: %zu < %zu\n", ws_size, (size_t)WS_NEED);
    }
    Params p{};
    for (int i = 0; i < 17; ++i) p.in[i] = (const float*)d_in[i];
    p.out = (float*)d_out; p.ws = (unsigned char*)d_ws; p.ph_lo = 0; p.ph_hi = 44;
#ifdef DBG_PHI
    p.ph_hi = DBG_PHI;
#endif
    hipMemsetAsync((char*)d_ws + S_BAR, 0, 16384, stream);
    void* args[] = {&p};
    hipError_t e = hipLaunchCooperativeKernel((const void*)fwd_kernel, dim3(grid), dim3(512), args, LDS_BYTES, stream);
    if (e != hipSuccess) fprintf(stderr, "cooperative launch failed: %s (grid %d)\n", hipGetErrorString(e), grid);
}
```
